# Optimizing an MI355X kernel written in HIP

```python
import math
import jax, jax.numpy as jnp
from jax import lax
import numpy as np

D_MODEL = 1024
BATCH = 16
SEQ = 4096
DEPTH = 1

N_MEM = 256
D_MIX = D_MODEL
D_MLSTM = D_MIX // 2
N_MLSTM_HEADS = 4
MLSTM_HEAD_DIM = D_MLSTM // N_MLSTM_HEADS
MLSTM_CHUNK = 128
CONV_WIDTH = 5
D_GMLP = D_MIX - D_MLSTM
N_GMLP_GROUPS = 4
GMLP_GROUP_DIM = D_GMLP // N_GMLP_GROUPS
GMLP_CHUNK = 128
N_GATES = 4 * N_MLSTM_HEADS
PROJ_COLS = 4 * D_MLSTM + N_GATES + 2 * D_GMLP
N_XATTN_HEADS = 4
XATTN_HEAD_DIM = D_MODEL // N_XATTN_HEADS
N_EXPERT_GROUPS = 4
EXPERTS_PER_GROUP = 8
N_EXPERTS = N_EXPERT_GROUPS * EXPERTS_PER_GROUP
TOP_K_IN_GROUP = 2
D_EXPERT = D_MODEL // 2
MOE_BLOCK = 128
RMS_EPS = 1e-6
LN_EPS = 1e-5
NEG_INIT = -1e30

kernel_name = 'hybrid_mlstm_gmlp_xattn_hmoe_encoder'


def rms_norm(x, g):
    xf = x.astype(jnp.float32)
    y = xf * lax.rsqrt(jnp.mean(xf * xf, axis=-1, keepdims=True) + RMS_EPS)
    return (y * g.astype(jnp.float32)).astype(x.dtype)


def layer_norm(x, g, b):
    xf = x.astype(jnp.float32)
    mu = jnp.mean(xf, axis=-1, keepdims=True)
    xc = xf - mu
    y = xc * lax.rsqrt(jnp.mean(xc * xc, axis=-1, keepdims=True) + LN_EPS)
    return (y * g.astype(jnp.float32) + b.astype(jnp.float32)).astype(x.dtype)


def mlstm_chunkwise(q, k, v, i_pre, f_pre):
    Bq, H, S, dh = q.shape
    L = MLSTM_CHUNK
    NC = S // L
    q = q.reshape(Bq, H, NC, L, dh)
    k = k.reshape(Bq, H, NC, L, dh) * (dh ** -0.5)
    v = v.reshape(Bq, H, NC, L, dh)
    ig = i_pre.reshape(Bq, H, NC, L)
    b = jnp.cumsum(jax.nn.log_sigmoid(f_pre.reshape(Bq, H, NC, L)), axis=-1)
    F = b[..., -1]
    a = F[..., None] - b + ig
    m_loc = jnp.max(a, axis=-1)
    kw = k * jnp.exp(a - m_loc[..., None])[..., None]
    C_loc = jnp.einsum('bhcsd,bhcse->bhcde', kw, v)
    n_loc = jnp.sum(kw, axis=-2)

    def step(carry, inp):
        C, n, m = carry
        F_c, m_c, C_c, n_c = inp
        m_new = jnp.maximum(F_c + m, m_c)
        s_old = jnp.exp(F_c + m - m_new)
        s_new = jnp.exp(m_c - m_new)
        C_new = s_old[..., None, None] * C + s_new[..., None, None] * C_c
        n_new = s_old[..., None] * n + s_new[..., None] * n_c
        return (C_new, n_new, m_new), (C, n, m)

    init = (jnp.zeros((Bq, H, dh, dh), jnp.float32),
            jnp.zeros((Bq, H, dh), jnp.float32),
            jnp.full((Bq, H), NEG_INIT, jnp.float32))
    xs = (jnp.moveaxis(F, 2, 0), jnp.moveaxis(m_loc, 2, 0),
          jnp.moveaxis(C_loc, 2, 0), jnp.moveaxis(n_loc, 2, 0))
    _, (C_prev, n_prev, m_prev) = lax.scan(step, init, xs)
    C_prev = jnp.moveaxis(C_prev, 0, 2)
    n_prev = jnp.moveaxis(n_prev, 0, 2)
    m_prev = jnp.moveaxis(m_prev, 0, 2)

    mask = jnp.tril(jnp.ones((L, L), dtype=bool))
    Dm = jnp.where(mask, b[..., :, None] - b[..., None, :] + ig[..., None, :], -jnp.inf)
    inter = b + m_prev[..., None]
    m_t = jnp.maximum(inter, jnp.max(Dm, axis=-1))
    Wqk = jnp.exp(Dm - m_t[..., None]) * jnp.einsum('bhctd,bhcsd->bhcts', q, k)
    s_inter = jnp.exp(inter - m_t)
    num = (jnp.einsum('bhcts,bhcse->bhcte', Wqk, v)
           + s_inter[..., None] * jnp.einsum('bhctd,bhcde->bhcte', q, C_prev))
    den = jnp.sum(Wqk, axis=-1) + s_inter * jnp.einsum('bhctd,bhcd->bhct', q, n_prev)
    h = num / jnp.maximum(jnp.abs(den), jnp.exp(-m_t))[..., None]
    return h.reshape(Bq, H, S, dh)


def parallel_mixer(h, w_in, conv_w, conv_b, gate_b, g_head, ln_v_g, ln_v_b, w_s, b_s, w_out):
    Bq, S, _ = h.shape
    z = h @ w_in
    cuts = [D_MLSTM, 2 * D_MLSTM, 3 * D_MLSTM, 4 * D_MLSTM,
            4 * D_MLSTM + N_GATES, 4 * D_MLSTM + N_GATES + D_GMLP]
    q, k, v, o, gates, gu, gv = jnp.split(z, cuts, axis=-1)

    qk = lax.conv_general_dilated(jnp.concatenate([q, k], axis=-1), conv_w, (1,), 'SAME',
                                  dimension_numbers=('NWC', 'WIO', 'NWC'),
                                  feature_group_count=2 * D_MLSTM)
    qk = jax.nn.silu(qk + conv_b)
    q, k = qk[..., :D_MLSTM], qk[..., D_MLSTM:]

    def heads(t):
        return t.reshape(Bq, S, N_MLSTM_HEADS, MLSTM_HEAD_DIM).transpose(0, 2, 1, 3).astype(jnp.float32)

    qh, kh, vh = heads(q), heads(k), heads(v)
    g = (gates.astype(jnp.float32) + gate_b.astype(jnp.float32)).reshape(Bq, S, 4, N_MLSTM_HEADS)
    g = g.transpose(2, 0, 3, 1)
    i_f, f_f, i_b, f_b = g[0], g[1], g[2], g[3]

    def flip(t):
        return jnp.flip(t, axis=2)

    h_fwd = mlstm_chunkwise(qh, kh, vh, i_f, f_f)
    h_bwd = flip(mlstm_chunkwise(flip(qh), flip(kh), flip(vh), flip(i_b), flip(f_b)))
    hs = h_fwd + h_bwd
    gh = g_head.astype(jnp.float32).reshape(N_MLSTM_HEADS, 1, MLSTM_HEAD_DIM)
    hs = hs * lax.rsqrt(jnp.mean(hs * hs, axis=-1, keepdims=True) + RMS_EPS) * gh
    hs = hs.transpose(0, 2, 1, 3).reshape(Bq, S, D_MLSTM)
    y_mlstm = (jax.nn.sigmoid(o.astype(jnp.float32)) * hs).astype(h.dtype)

    gu = jax.nn.gelu(gu)
    gv = layer_norm(jax.nn.gelu(gv), ln_v_g, ln_v_b)
    NC = S // GMLP_CHUNK
    gv = gv.reshape(Bq, NC, GMLP_CHUNK, N_GMLP_GROUPS, GMLP_GROUP_DIM)
    sp = jnp.einsum('gts,bcsgd->bctgd', w_s, gv) + b_s.T[:, :, None]
    y_gmlp = gu * sp.reshape(Bq, S, D_GMLP)

    return jnp.concatenate([y_mlstm, y_gmlp], axis=-1) @ w_out


def memory_cross_attention(h, hm, w_q, w_kv, w_o):
    Bq, S, _ = h.shape
    M = hm.shape[1]
    q = (h @ w_q).reshape(Bq, S, N_XATTN_HEADS, XATTN_HEAD_DIM)
    kv = (hm @ w_kv).reshape(Bq, M, 2, N_XATTN_HEADS, XATTN_HEAD_DIM)
    k, v = kv[:, :, 0], kv[:, :, 1]
    s = jnp.einsum('bshd,bmhd->bhsm', q, k).astype(jnp.float32) * (XATTN_HEAD_DIM ** -0.5)
    p = jax.nn.softmax(s, axis=-1).astype(h.dtype)
    o = jnp.einsum('bhsm,bmhd->bshd', p, v).reshape(Bq, S, N_XATTN_HEADS * XATTN_HEAD_DIM)
    return o @ w_o


def hier_moe(h, w_rg, b_rg, w_re, b_re, w_gate, w_up, w_down):
    T, D = h.shape
    g_logits = (h @ w_rg).astype(jnp.float32) + b_rg.astype(jnp.float32)
    p_group = jax.nn.softmax(g_logits, axis=-1)
    p_top, g_idx = lax.top_k(p_group, 1)
    e_logits = ((h @ w_re).astype(jnp.float32) + b_re.astype(jnp.float32)).reshape(
        T, N_EXPERT_GROUPS, EXPERTS_PER_GROUP)
    e_logits = jnp.take_along_axis(e_logits, g_idx[:, :, None], axis=1)[:, 0]
    e_top, e_local = lax.top_k(e_logits, TOP_K_IN_GROUP)
    weights = p_top * jax.nn.softmax(e_top, axis=-1)
    expert_id = g_idx * EXPERTS_PER_GROUP + e_local

    A = T * TOP_K_IN_GROUP
    e_flat = expert_id.reshape(A)
    t_flat = jnp.repeat(jnp.arange(T), TOP_K_IN_GROUP)
    w_flat = weights.reshape(A)
    order = jnp.argsort(e_flat)
    e_sorted, t_sorted, w_sorted = e_flat[order], t_flat[order], w_flat[order]
    counts = jnp.bincount(e_flat, length=N_EXPERTS)
    padded = ((counts + MOE_BLOCK - 1) // MOE_BLOCK) * MOE_BLOCK
    start = jnp.cumsum(counts) - counts
    pend = jnp.cumsum(padded)
    pstart = pend - padded
    dest = pstart[e_sorted] + (jnp.arange(A) - start[e_sorted])
    NB = A // MOE_BLOCK + N_EXPERTS
    P = NB * MOE_BLOCK
    x_disp = jnp.zeros((P, D), h.dtype).at[dest].set(h[t_sorted])
    blk_e = jnp.clip(jnp.searchsorted(pend, jnp.arange(NB) * MOE_BLOCK, side='right'), 0, N_EXPERTS - 1)

    def expert_block(args):
        xb, e = args
        return (jax.nn.silu(xb @ w_gate[e]) * (xb @ w_up[e])) @ w_down[e]

    y_disp = lax.map(expert_block, (x_disp.reshape(NB, MOE_BLOCK, D), blk_e)).reshape(P, D)
    contrib = (w_sorted[:, None] * y_disp[dest].astype(jnp.float32))
    out = jnp.zeros((T, D), jnp.float32).at[t_sorted].add(contrib)
    return out.astype(h.dtype)


def setup_inputs(seed: int = 0) -> dict:
    key = jax.random.key(seed)
    ks = jax.random.split(key, 32)

    def nrm(k, shape, scale):
        return jax.random.normal(k, shape, jnp.float32) * scale

    def gain(k, shape):
        return 1.0 + 0.1 * jax.random.normal(k, shape, jnp.float32)

    H = N_MLSTM_HEADS
    f_bias = jnp.linspace(3.0, 6.0, H, dtype=jnp.float32)
    gk = jax.random.split(ks[6], 4)
    gate_b = jnp.concatenate([
        nrm(gk[0], (DEPTH, H), 0.1),
        f_bias + nrm(gk[1], (DEPTH, H), 0.1),
        nrm(gk[2], (DEPTH, H), 0.1),
        f_bias + nrm(gk[3], (DEPTH, H), 0.1)], axis=-1)
    return {
        'x': nrm(ks[0], (BATCH, SEQ, D_MODEL), 1.0),
        'mem': nrm(ks[1], (BATCH, N_MEM, D_MODEL), 1.0),
        'g_mix': gain(ks[2], (DEPTH, D_MODEL)),
        'w_in': nrm(ks[3], (DEPTH, D_MODEL, PROJ_COLS), D_MODEL ** -0.5),
        'conv_w': nrm(ks[4], (DEPTH, CONV_WIDTH, 1, 2 * D_MLSTM), CONV_WIDTH ** -0.5),
        'conv_b': nrm(ks[5], (DEPTH, 2 * D_MLSTM), 0.01),
        'gate_b': gate_b,
        'g_head': gain(ks[7], (DEPTH, D_MLSTM)),
        'ln_v_g': gain(ks[8], (DEPTH, D_GMLP)),
        'ln_v_b': nrm(ks[9], (DEPTH, D_GMLP), 0.01),
        'w_s': nrm(ks[10], (DEPTH, N_GMLP_GROUPS, GMLP_CHUNK, GMLP_CHUNK), GMLP_CHUNK ** -0.5),
        'b_s': gain(ks[11], (DEPTH, N_GMLP_GROUPS, GMLP_CHUNK)),
        'w_out': nrm(ks[12], (DEPTH, D_MIX, D_MODEL), D_MIX ** -0.5),
        'g_xattn': gain(ks[13], (DEPTH, D_MODEL)),
        'g_mem': gain(ks[14], (DEPTH, D_MODEL)),
        'w_q_x': nrm(ks[15], (DEPTH, D_MODEL, N_XATTN_HEADS * XATTN_HEAD_DIM), D_MODEL ** -0.5),
        'w_kv_x': nrm(ks[16], (DEPTH, D_MODEL, 2 * N_XATTN_HEADS * XATTN_HEAD_DIM), D_MODEL ** -0.5),
        'w_o_x': nrm(ks[17], (DEPTH, N_XATTN_HEADS * XATTN_HEAD_DIM, D_MODEL), D_MODEL ** -0.5),
        'g_moe': gain(ks[18], (DEPTH, D_MODEL)),
        'w_rg': nrm(ks[19], (DEPTH, D_MODEL, N_EXPERT_GROUPS), D_MODEL ** -0.5),
        'b_rg': nrm(ks[20], (DEPTH, N_EXPERT_GROUPS), 0.01),
        'w_re': nrm(ks[21], (DEPTH, D_MODEL, N_EXPERTS), D_MODEL ** -0.5),
        'b_re': nrm(ks[22], (DEPTH, N_EXPERTS), 0.01),
        'w_gate': nrm(ks[23], (DEPTH, N_EXPERTS, D_MODEL, D_EXPERT), D_MODEL ** -0.5),
        'w_up': nrm(ks[24], (DEPTH, N_EXPERTS, D_MODEL, D_EXPERT), D_MODEL ** -0.5),
        'w_down': nrm(ks[25], (DEPTH, N_EXPERTS, D_EXPERT, D_MODEL), D_EXPERT ** -0.5),
        'g_final': gain(ks[26], (D_MODEL,)),
    }


def reference(x, mem, g_mix, w_in, conv_w, conv_b, gate_b, g_head, ln_v_g, ln_v_b, w_s, b_s, w_out,
              g_xattn, g_mem, w_q_x, w_kv_x, w_o_x, g_moe, w_rg, b_rg, w_re, b_re,
              w_gate, w_up, w_down, g_final):
    Bq, S, D = x.shape
    for l in range(DEPTH):
        x = x + parallel_mixer(rms_norm(x, g_mix[l]), w_in[l], conv_w[l], conv_b[l], gate_b[l],
                               g_head[l], ln_v_g[l], ln_v_b[l], w_s[l], b_s[l], w_out[l])
        x = x + memory_cross_attention(rms_norm(x, g_xattn[l]), rms_norm(mem, g_mem[l]),
                                       w_q_x[l], w_kv_x[l], w_o_x[l])
        x = x + hier_moe(rms_norm(x, g_moe[l]).reshape(Bq * S, D), w_rg[l], b_rg[l], w_re[l], b_re[l],
                         w_gate[l], w_up[l], w_down[l]).reshape(Bq, S, D)
    return rms_norm(x, g_final)
```

```cpp
#include <hip/hip_runtime.h>
#include <cstdio>
#include <cstdint>
#define MK_N_LAUNCHES 12
namespace pg8 {
#define PG8_LAS __attribute__((address_space(3)))
typedef unsigned short bf16_t;
typedef short bf16x8 __attribute__((ext_vector_type(8)));
typedef float f32x4 __attribute__((ext_vector_type(4)));
typedef unsigned u32x4 __attribute__((ext_vector_type(4)));
typedef unsigned u32x2 __attribute__((ext_vector_type(2)));
constexpr int BM = 256, BK = 64, HALF = 128, HTB = HALF * BK * 2  , STAGE_BYTES = 8 * HTB, NXCD = 8, WGM = 8;

__host__ __device__ __forceinline__ int lds_byte(int r, int c) { const int st = (r >> 4) * 2 + (c >> 5), rr = r & 15, cc = c & 31, ob = rr * 64 + cc * 2; return st * 1024 + (ob ^ (((ob >> 9) & 1) << 5)); }
__host__ __device__ __forceinline__ void stage_rc(int b, int& R, int& C) { const int st = b / 1024, sb = b % 1024, swz = sb ^ (((sb >> 9) & 1) << 5); R = (st >> 1) * 16 + swz / 64; C = (st & 1) * 32 + (swz % 64) / 2; }
__host__ __device__ __forceinline__ int perm32(int rho) { const int n = rho >> 4, i = rho & 15; return 8 * (i >> 2) + 4 * n + (i & 3); }

struct Unit { int pm, pn; const int* ridx; int nvalid; int orow, ocol, ex; };
struct Gemm { const bf16_t* A; const bf16_t* Bt; int M, N, K; };

struct StaticOrder {
    int nM, nN, nwg, G, c;
    __host__ __device__ void init(int M, int N, int G_, int c_) { nM = M / BM; nN = N / BM; nwg = nM * nN; G = G_; c = c_; }
    __host__ __device__ bool next(int i, Unit& u) const {
        const long L = (long)i * G + c; if (L >= nwg) return false;
        int wgid = (int)L; { const int q = nwg / NXCD, r = nwg % NXCD, xcd = wgid % NXCD, off = wgid / NXCD; wgid = (xcd < r ? xcd * (q + 1) : r * (q + 1) + (xcd - r) * q) + off; }
        const int nig = WGM * nN, gid = wgid / nig, fm = gid * WGM, gsz = (nM - fm) < WGM ? (nM - fm) : WGM;
        u.pm = fm + ((wgid % nig) % gsz); u.pn = (wgid % nig) / gsz; u.ridx = nullptr; u.nvalid = 256; u.orow = u.pm; u.ocol = u.pn * BM; u.ex = 0; return true;
    }
};

__device__ __forceinline__ unsigned cvt_pk_bf16(float lo, float hi) { unsigned r; asm volatile("v_cvt_pk_bf16_f32 %0, %1, %2" : "=v"(r) : "v"(lo), "v"(hi)); return r; }

template <class Epi, class Sched, bool ALIGN_EPI, bool SP2, bool GATHER>
__device__ __forceinline__ void gemm_phase(PG8_LAS unsigned char* lds, const Gemm g, const Sched& S, const Epi& E) {
    const int tid = threadIdx.x, wid = __builtin_amdgcn_readfirstlane(tid >> 6), lane = tid & 63, wr = wid >> 2, wc = wid & 3, fr = lane & 15, fq = lane >> 4;
    const int K = g.K, nt = K / BK;
    unsigned voffA[2], voffB[2];
#pragma unroll
    for (int i = 0; i < 2; ++i) { int R, C; stage_rc(tid * 16 + i * 8192, R, C); const int Rb = Epi::PERM ? ((R & ~31) + perm32(R & 31)) : R;
        voffA[i] = (unsigned)(R * K + C) * 2u; voffB[i] = (unsigned)(Rb * K + C) * 2u; }
    const size_t kstep = (size_t)(BK * 2);
    const size_t hstepB = (size_t)HALF * K * 2;
    const size_t hstepA = GATHER ? (size_t)0 : hstepB;
    const size_t tstep = 2 * hstepB;
    const unsigned ldsw = (unsigned)wid * 1024u;
    const int aoff = lds_byte(wr * 64 + fr, fq * 8), boff = lds_byte(wc * 32 + fr, fq * 8);
    unsigned vgC[2][2], vgN[2][2];
#define PG8_SA(b, h) (((b) * 2 + (h)) * HTB)
#define PG8_SB(b, h) ((4 + (b) * 2 + (h)) * HTB)
#define PG8_STAGE(bufoff, gbase, voff) do { _Pragma("unroll") for (int _i = 0; _i < 2; ++_i) \
        __builtin_amdgcn_global_load_lds((const unsigned*)((const char*)(gbase) + (voff)[_i]), (PG8_LAS unsigned*)(lds + (bufoff) + ldsw + _i * 8192), 16, 0, 0); } while (0)
#define PG8_STAGE_A(bufoff, gbase, h, nx) do { if constexpr (GATHER) { unsigned _v[2]; _v[0] = (nx) ? vgN[h][0] : vgC[h][0]; _v[1] = (nx) ? vgN[h][1] : vgC[h][1]; PG8_STAGE(bufoff, gbase, _v); } \
        else { PG8_STAGE(bufoff, (gbase) + (h) * hstepA, voffA); } } while (0)
#define PG8_GOFF(dst, u) do { _Pragma("unroll") for (int _h = 0; _h < 2; ++_h) _Pragma("unroll") for (int _i = 0; _i < 2; ++_i) { int _R, _C; stage_rc(tid * 16 + _i * 8192, _R, _C); int _r = _h * HALF + _R; _r = _r < (u).nvalid ? _r : (u).nvalid - 1; \
        dst[_h][_i] = (unsigned)(u).ridx[_r] * (unsigned)(K * 2) + (unsigned)(_C * 2); } } while (0)
#define PG8_LDA(dst, b, h) do { _Pragma("unroll") for (int m = 0; m < 4; ++m) _Pragma("unroll") for (int k = 0; k < 2; ++k) dst[m][k] = *(const PG8_LAS bf16x8*)(lds + PG8_SA(b, h) + aoff + m * 2048 + k * 1024); } while (0)
#define PG8_LDB(dst, b, h) do { _Pragma("unroll") for (int n = 0; n < 2; ++n) _Pragma("unroll") for (int k = 0; k < 2; ++k) dst[n][k] = *(const PG8_LAS bf16x8*)(lds + PG8_SB(b, h) + boff + n * 2048 + k * 1024); } while (0)
#define PG8_MMA(ai, bj, At, Bt) do { __builtin_amdgcn_s_setprio(1); _Pragma("unroll") for (int m = 0; m < 4; ++m) _Pragma("unroll") for (int n = 0; n < 2; ++n) _Pragma("unroll") for (int k = 0; k < 2; ++k) \
        acc[ai][bj][m][n] = __builtin_amdgcn_mfma_f32_16x16x32_bf16(Bt[n][k], At[m][k], acc[ai][bj][m][n], 0, 0, 0); __builtin_amdgcn_s_setprio(0); } while (0)
#define PG8_WAIT_V(n) asm volatile("s_waitcnt vmcnt(" #n ")" ::: "memory")
#define PG8_WAIT_L(n) asm volatile("s_waitcnt lgkmcnt(" #n ")" ::: "memory")
#define PG8_BAR __builtin_amdgcn_s_barrier()
#define PG8_SCHED __builtin_amdgcn_sched_barrier(0)
    Unit cur, nxt; int ui = 0;
    if (!S.next(0, cur)) return;
    f32x4 acc[2][2][4][2];
#pragma unroll
    for (int a = 0; a < 2; ++a)
#pragma unroll
        for (int b = 0; b < 2; ++b)
#pragma unroll
            for (int m = 0; m < 4; ++m)
#pragma unroll
                for (int n = 0; n < 2; ++n) acc[a][b][m][n] = (f32x4){0.f, 0.f, 0.f, 0.f};
    bf16x8 At[4][2], B0[2][2], B1[2][2];
    const char* cA = GATHER ? (const char*)g.A : (const char*)g.A + (size_t)cur.pm * tstep; const char* cB = (const char*)g.Bt + (size_t)cur.pn * tstep;
    if constexpr (GATHER) { PG8_GOFF(vgC, cur); }
    if constexpr (SP2) {
        PG8_STAGE(PG8_SB(0, 0), cB, voffB); PG8_STAGE(PG8_SB(0, 1), cB + hstepB, voffB); PG8_STAGE_A(PG8_SA(0, 0), cA, 0, false); PG8_STAGE_A(PG8_SA(0, 1), cA, 1, false);
        if (wr == 1) PG8_BAR;
        PG8_WAIT_V(2); PG8_BAR;
        PG8_STAGE(PG8_SB(1, 0), cB + kstep, voffB); PG8_STAGE_A(PG8_SA(1, 0), cA + kstep, 0, false); PG8_STAGE(PG8_SB(1, 1), cB + hstepB + kstep, voffB);
        PG8_WAIT_V(6); PG8_BAR;
    } else {
        PG8_STAGE(PG8_SB(0, 0), cB, voffB); PG8_STAGE_A(PG8_SA(0, 0), cA, 0, false); PG8_STAGE(PG8_SB(0, 1), cB + hstepB, voffB); PG8_STAGE_A(PG8_SA(0, 1), cA, 1, false);
        if (wr == 1) PG8_BAR;
        PG8_WAIT_V(4); PG8_BAR;
        PG8_STAGE(PG8_SB(1, 0), cB + kstep, voffB); PG8_STAGE_A(PG8_SA(1, 0), cA + kstep, 0, false); PG8_STAGE(PG8_SB(1, 1), cB + hstepB + kstep, voffB);
        PG8_WAIT_V(6); PG8_BAR;
    }
    for (;;) {
        const bool has_next = S.next(ui + 1, nxt);
        const char* nA = GATHER ? (const char*)g.A : (has_next ? (const char*)g.A + (size_t)nxt.pm * tstep : cA); const char* nB = has_next ? (const char*)g.Bt + (size_t)nxt.pn * tstep : cB;
        if constexpr (GATHER) { if (has_next) { PG8_GOFF(vgN, nxt); } else {
#pragma unroll
            for (int _h = 0; _h < 2; ++_h) { vgN[_h][0] = vgC[_h][0]; vgN[_h][1] = vgC[_h][1]; } } }
        for (int t = 0; t < nt; t += 2) {
            const bool last = (t == nt - 2);
            const char* a1 = cA + (size_t)(t + 1) * kstep;
            const char* a2 = last ? nA : cA + (size_t)(t + 2) * kstep; const char* b2 = last ? nB : cB + (size_t)(t + 2) * kstep;
            const char* a3 = a2 + kstep; const char* b3 = b2 + kstep;
            if constexpr (SP2) {
            PG8_LDB(B0, 0, 0); PG8_LDB(B1, 0, 1); PG8_SCHED; PG8_LDA(At, 0, 0); PG8_STAGE_A(PG8_SA(1, 1), a1, 1, false);
            PG8_WAIT_V(8); PG8_WAIT_L(0); PG8_BAR; PG8_MMA(0, 0, At, B0); PG8_MMA(0, 1, At, B1); PG8_BAR; PG8_SCHED;
            PG8_LDA(At, 0, 1); PG8_STAGE(PG8_SB(0, 0), b2, voffB); PG8_STAGE(PG8_SB(0, 1), b2 + hstepB, voffB); PG8_STAGE_A(PG8_SA(0, 0), a2, 0, last);
            PG8_WAIT_V(8); PG8_WAIT_L(0); PG8_BAR; PG8_MMA(1, 0, At, B0); PG8_MMA(1, 1, At, B1); PG8_BAR; PG8_SCHED;
            PG8_LDB(B0, 1, 0); PG8_LDB(B1, 1, 1); PG8_SCHED; PG8_LDA(At, 1, 0); PG8_STAGE_A(PG8_SA(0, 1), a2, 1, last);
            PG8_WAIT_V(8); PG8_WAIT_L(0); PG8_BAR; PG8_MMA(0, 0, At, B0); PG8_MMA(0, 1, At, B1); PG8_BAR; PG8_SCHED;
            PG8_LDA(At, 1, 1); PG8_STAGE(PG8_SB(1, 0), b3, voffB); PG8_STAGE(PG8_SB(1, 1), b3 + hstepB, voffB); PG8_STAGE_A(PG8_SA(1, 0), a3, 0, last);
            PG8_WAIT_V(8); PG8_WAIT_L(0); PG8_BAR; PG8_MMA(1, 0, At, B0); PG8_MMA(1, 1, At, B1); PG8_BAR; PG8_SCHED;
            } else {
            PG8_LDB(B0, 0, 0); PG8_SCHED; PG8_LDA(At, 0, 0); PG8_STAGE_A(PG8_SA(1, 1), a1, 1, false);
            PG8_WAIT_L(8); PG8_BAR; PG8_WAIT_L(0); PG8_MMA(0, 0, At, B0); PG8_BAR; PG8_SCHED;
            PG8_LDB(B1, 0, 1); PG8_STAGE(PG8_SB(0, 0), b2, voffB);
            PG8_BAR; PG8_WAIT_L(0); PG8_MMA(0, 1, At, B1); PG8_BAR;
            PG8_LDA(At, 0, 1); PG8_STAGE_A(PG8_SA(0, 0), a2, 0, last);
            PG8_BAR; PG8_WAIT_L(0); PG8_MMA(1, 0, At, B0); PG8_BAR; PG8_SCHED;
            PG8_STAGE(PG8_SB(0, 1), b2 + hstepB, voffB);
            PG8_WAIT_V(6); PG8_BAR; PG8_MMA(1, 1, At, B1); PG8_BAR;
            PG8_LDB(B0, 1, 0); PG8_SCHED; PG8_LDA(At, 1, 0); PG8_STAGE_A(PG8_SA(0, 1), a2, 1, last);
            PG8_WAIT_L(8); PG8_BAR; PG8_WAIT_L(0); PG8_MMA(0, 0, At, B0); PG8_BAR; PG8_SCHED;
            PG8_LDB(B1, 1, 1); PG8_STAGE(PG8_SB(1, 0), b3, voffB);
            PG8_BAR; PG8_WAIT_L(0); PG8_MMA(0, 1, At, B1); PG8_BAR;
            PG8_LDA(At, 1, 1); PG8_STAGE_A(PG8_SA(1, 0), a3, 0, last);
            PG8_BAR; PG8_WAIT_L(0); PG8_MMA(1, 0, At, B0); PG8_BAR; PG8_SCHED;
            PG8_STAGE(PG8_SB(1, 1), b3 + hstepB, voffB);
            PG8_WAIT_V(6); PG8_BAR; PG8_MMA(1, 1, At, B1); PG8_BAR;
            }
        }
        if constexpr (ALIGN_EPI) { if (wr == 0) PG8_BAR; }
        E(acc, cur, wr, wc, fr, fq);
        if (!has_next) break;
#pragma unroll
        for (int a = 0; a < 2; ++a)
#pragma unroll
            for (int b = 0; b < 2; ++b)
#pragma unroll
                for (int m = 0; m < 4; ++m)
#pragma unroll
                    for (int n = 0; n < 2; ++n) acc[a][b][m][n] = (f32x4){0.f, 0.f, 0.f, 0.f};
        cur = nxt; cA = nA; cB = nB; ++ui;
        if constexpr (GATHER) {
#pragma unroll
            for (int _h = 0; _h < 2; ++_h) { vgC[_h][0] = vgN[_h][0]; vgC[_h][1] = vgN[_h][1]; } }
        if constexpr (ALIGN_EPI) { if (wr == 1) PG8_BAR; }
    }
    PG8_WAIT_V(0);
    if constexpr (!ALIGN_EPI) { if (wr == 0) PG8_BAR; }
    PG8_BAR;
#undef PG8_SA
#undef PG8_SB
#undef PG8_STAGE
#undef PG8_STAGE_A
#undef PG8_GOFF
#undef PG8_LDA
#undef PG8_LDB
#undef PG8_MMA
#undef PG8_WAIT_V
#undef PG8_WAIT_L
#undef PG8_BAR
#undef PG8_SCHED
}
}
#define DI __device__ __forceinline__
#define LAS __attribute__((address_space(3)))
typedef unsigned short bf16;
typedef short bf16x8 __attribute__((ext_vector_type(8)));
typedef short s16x4 __attribute__((ext_vector_type(4)));
typedef float f32x4 __attribute__((ext_vector_type(4)));
typedef float f32x2 __attribute__((ext_vector_type(2)));
typedef unsigned u32x4 __attribute__((ext_vector_type(4)));
typedef unsigned u32x2 __attribute__((ext_vector_type(2)));
typedef unsigned char uchar;

constexpr int NB = 16, SEQ = 4096, DM = 1024, NTOK = NB * SEQ;
constexpr int NMEM = 256, NMROWS = NB * NMEM;
constexpr int ZC = 3072;
constexpr int NEXP = 32, DEXP = 512;
constexpr int MAXTILES = 544, MAXSLOTS = MAXTILES * 256;
constexpr float RMS_EPS = 1e-6f, LN_EPS = 1e-5f;
constexpr int NWAVES = 8, NTHR = 512;
constexpr int LDS_BYTES = 163840;

constexpr size_t MiB = 1u << 20;
constexpr size_t O_CTL = 0, CTL_BYTES = 1 * MiB;
constexpr size_t O_RS0 = 1 * MiB, O_RSM = O_RS0 + 256 * 1024, O_RS3 = O_RS0 + 512 * 1024;
constexpr size_t O_GATES = 2 * MiB;
constexpr size_t O_SS1 = 6 * MiB;
constexpr size_t O_TOK = 10 * MiB;
constexpr size_t O_RIDX = 12 * MiB;
constexpr size_t O_NST = 20 * MiB, O_MST = 22 * MiB;
constexpr size_t O_WSB = 23 * MiB;
constexpr size_t O_WIN = 32 * MiB, O_WOUT = 38 * MiB, O_WQ = 40 * MiB, O_WKV = 42 * MiB, O_WO = 46 * MiB, O_WGU = 48 * MiB, O_WD = 112 * MiB;
constexpr size_t O_XB = 160 * MiB;
constexpr size_t O_MEMB = 288 * MiB, O_KV = 296 * MiB;
constexpr size_t O_Z = 320 * MiB;
constexpr size_t O_CST = 704 * MiB;
constexpr size_t O_Y = 840 * MiB;
constexpr size_t O_Q = O_Z, O_O = O_Z + 128 * MiB;
constexpr size_t O_H = O_Z, O_YD = O_Z + 144 * MiB;
constexpr size_t WS_NEED = 968 * MiB;
constexpr int CW_CNT = 0, CW_BAR = 4096;
constexpr int CW_CNT_UNUSED = 0;

#define LDS_WAIT() asm volatile("s_waitcnt lgkmcnt(0)" ::: "memory")
DI unsigned f2bf(float f) { unsigned u = __builtin_bit_cast(unsigned, f); return (u + 0x7fffu + ((u >> 16) & 1u)) >> 16; }
DI unsigned pk2(float lo, float hi) { return pg8::cvt_pk_bf16(lo, hi); }
DI float bf2f(unsigned short h) { return __builtin_bit_cast(float, (unsigned)h << 16); }
DI float bflo(unsigned w) { return __builtin_bit_cast(float, w << 16); }
DI float bfhi(unsigned w) { return __builtin_bit_cast(float, w & 0xffff0000u); }
DI float wave_sum(float v) {
#pragma unroll
    for (int o = 1; o < 64; o <<= 1) v += __shfl_xor(v, o);
    return v;
}
DI float wave_max(float v) {
#pragma unroll
    for (int o = 1; o < 64; o <<= 1) v = fmaxf(v, __shfl_xor(v, o));
    return v;
}
DI float wscan_add(float v, int lane) {
#pragma unroll
    for (int o = 1; o < 64; o <<= 1) { const float u = __shfl_up(v, o); v = (lane >= o) ? v + u : v; }
    return v;
}
DI float wscan_max(float v, int lane) {
#pragma unroll
    for (int o = 1; o < 64; o <<= 1) { const float u = __shfl_up(v, o); v = (lane >= o) ? fmaxf(v, u) : v; }
    return v;
}
DI float wscan_max_rev(float v, int lane) {
#pragma unroll
    for (int o = 1; o < 64; o <<= 1) { const float u = __shfl_down(v, o); v = (lane + o < 64) ? fmaxf(v, u) : v; }
    return v;
}
DI float fast_exp(float x) { return __expf(x); }
DI float sigmoidf_(float x) { return 1.0f / (1.0f + __expf(-x)); }
DI float siluf_(float x) { return x / (1.0f + __expf(-x)); }
DI float gelu_tanh(float x) { const float u = 0.7978845608028654f * (x + 0.044715f * x * x * x); return x / (1.0f + __expf(-2.0f * u)); }
DI float log_sigmoid(float x) { return fminf(x, 0.f) - log1pf(__expf(-fabsf(x))); }

DI unsigned offb(unsigned row, unsigned ch) { return 256u * row + 16u * (ch ^ (((row & 3u) << 2) | ((row >> 2) & 3u))); }
DI bf16x8 frag_row(const LAS uchar* tile, int r0, int kk, int lane) { return *(const LAS bf16x8*)(tile + offb(r0 + (lane & 15), 4 * kk + (lane >> 4))); }
DI bf16x8 frag_tr(const LAS uchar* tile, int k0, int c0, int lane) {
    const unsigned g = lane >> 4, q = (lane & 15) >> 2, p = lane & 3;
    const unsigned ch = (c0 >> 3) + (p >> 1), bo = 8u * (p & 1);
    const s16x4 lo = __builtin_amdgcn_ds_read_tr16_b64_v4i16((LAS s16x4*)(tile + offb(k0 + 8 * g + q, ch) + bo));
    const s16x4 hi = __builtin_amdgcn_ds_read_tr16_b64_v4i16((LAS s16x4*)(tile + offb(k0 + 8 * g + 4 + q, ch) + bo));
    return (bf16x8){lo[0], lo[1], lo[2], lo[3], hi[0], hi[1], hi[2], hi[3]};
}
DI f32x4 mfma16(bf16x8 x, bf16x8 y, f32x4 acc) { return __builtin_amdgcn_mfma_f32_16x16x32_bf16(x, y, acc, 0, 0, 0); }

struct Args { const float* in[27]; float* out; uchar* ws; int ph_lo, ph_hi; };
struct Frame {
    LAS uchar* lds;
    int tid, lane, wave, G, bid;
    const float* const* in;
    float* out; uchar* ws;
};
enum { I_X = 0, I_MEM, I_GMIX, I_WIN, I_CONVW, I_CONVB, I_GATEB, I_GHEAD, I_LNVG, I_LNVB, I_WS, I_BS, I_WOUT, I_GXATTN, I_GMEM, I_WQ, I_WKV, I_WO, I_GMOE, I_WRG, I_BRG, I_WRE, I_BRE, I_WGATE, I_WUP, I_WDOWN, I_GFINAL };
DI void p0_transpose_item(const float* W, int K, int ldw, int scol0, bf16* WT, size_t drow0, const float* gain, LAS float* scr, int k0, int lane) {
#pragma unroll 8
    for (int i = 0; i < 32; ++i) { const int kk = 2 * i + (lane >> 5); float v = W[(size_t)(k0 + kk) * ldw + scol0 + (lane & 31)]; if (gain) v *= gain[k0 + kk]; scr[kk * 33 + (lane & 31)] = v; }
    LDS_WAIT(); asm volatile("" ::: "memory");
    const int c = lane & 7;
#pragma unroll
    for (int j = 0; j < 4; ++j) { const int n = (lane >> 3) + 8 * j; const LAS float* s = scr + (8 * c) * 33 + n;
        u32x4 o; o.x = pk2(s[0 * 33], s[1 * 33]); o.y = pk2(s[2 * 33], s[3 * 33]); o.z = pk2(s[4 * 33], s[5 * 33]); o.w = pk2(s[6 * 33], s[7 * 33]);
        *(u32x4*)(WT + (drow0 + n) * (size_t)K + k0 + 8 * c) = o; }
    LDS_WAIT(); asm volatile("" ::: "memory");
}

DI void phase0(Frame& F) {
    const int gw = F.bid * NWAVES + F.wave, NGW = F.G * NWAVES, lane = F.lane;
    uchar* ws = F.ws;
    {
        LAS float* scr = (LAS float*)(F.lds + F.wave * 16384);
        constexpr int I_IN = 16 * 96, I_SQ = 16 * 32, I_KV = 16 * 64, I_GU = 32 * 16 * 16, I_DN = 32 * 8 * 32;
        constexpr int NITEMS = I_IN + 3 * I_SQ + I_KV + 2 * I_GU + I_DN;
        for (int it = gw; it < NITEMS; it += NGW) {
            int r = it;
            if (r < I_IN) { const int kb = r / 96, nb = r % 96; const int sc = nb * 32 < 2048 ? nb * 32 : nb * 32 + 16;
                p0_transpose_item(F.in[I_WIN], 1024, 3088, sc, (bf16*)(ws + O_WIN), (size_t)nb * 32, F.in[I_GMIX], scr, kb * 64, lane); continue; } r -= I_IN;
            if (r < I_SQ) { const int kb = r / 32, nb = r % 32; p0_transpose_item(F.in[I_WOUT], 1024, 1024, nb * 32, (bf16*)(ws + O_WOUT), (size_t)nb * 32, nullptr, scr, kb * 64, lane); continue; } r -= I_SQ;
            if (r < I_SQ) { const int kb = r / 32, nb = r % 32; p0_transpose_item(F.in[I_WQ], 1024, 1024, nb * 32, (bf16*)(ws + O_WQ), (size_t)nb * 32, F.in[I_GXATTN], scr, kb * 64, lane); continue; } r -= I_SQ;
            if (r < I_KV) { const int kb = r / 64, nb = r % 64; p0_transpose_item(F.in[I_WKV], 1024, 2048, nb * 32, (bf16*)(ws + O_WKV), (size_t)nb * 32, F.in[I_GMEM], scr, kb * 64, lane); continue; } r -= I_KV;
            if (r < I_SQ) { const int kb = r / 32, nb = r % 32; p0_transpose_item(F.in[I_WO], 1024, 1024, nb * 32, (bf16*)(ws + O_WO), (size_t)nb * 32, nullptr, scr, kb * 64, lane); continue; } r -= I_SQ;
            if (r < 2 * I_GU) { const int up = r >= I_GU; if (up) r -= I_GU; const int e = r / 256, q = r % 256, kb = q / 16, nb = q % 16;
                const float* W = F.in[up ? I_WUP : I_WGATE] + (size_t)e * 1024 * 512;
                const size_t drow = (size_t)e * 1024 + 256 * (nb / 4) + (up ? 128 : 0) + (nb % 4) * 32;
                p0_transpose_item(W, 1024, 512, nb * 32, (bf16*)(ws + O_WGU), drow, F.in[I_GMOE], scr, kb * 64, lane); continue; } r -= 2 * I_GU;
            { const int e = r / 256, q = r % 256, kb = q / 32, nb = q % 32;
                p0_transpose_item(F.in[I_WDOWN] + (size_t)e * 512 * 1024, 512, 1024, nb * 32, (bf16*)(ws + O_WD), (size_t)e * 1024 + nb * 32, nullptr, scr, kb * 64, lane); }
        }
        for (int i = F.bid * NTHR + F.tid; i < 4 * 128 * 128 / 2; i += F.G * NTHR) { const f32x2 v = *(const f32x2*)(F.in[I_WS] + 2 * i); ((unsigned*)(ws + O_WSB))[i] = pk2(v.x, v.y); }
    }
    __syncthreads();
    LAS float* wg = (LAS float*)F.lds;
    for (int idx = F.tid; idx < 1024 * 16; idx += NTHR) { const int i = idx >> 4, j = idx & 15; const float v = F.in[I_WIN][(size_t)i * 3088 + 2048 + j] * F.in[I_GMIX][i];
        const int jj = i >> 8, l = (i & 255) >> 2, ii = i & 3, j4 = j >> 2, jr = j & 3; wg[((((jj * 4 + ii) * 4 + j4) * 64 + l) << 2) + jr] = v; }
    __syncthreads();
    {
        bf16* XB = (bf16*)(ws + O_XB); float* rs0 = (float*)(ws + O_RS0); float* gates = (float*)(ws + O_GATES);
        const float gb = F.in[I_GATEB][lane >> 2];
        for (int m = gw; m < NTOK; m += NGW) {
            const f32x4* xr = (const f32x4*)(F.in[I_X] + (size_t)m * DM) + lane;
            f32x4 v[4]; float s = 0.f;
#pragma unroll
            for (int j = 0; j < 4; ++j) { v[j] = xr[64 * j]; s += (v[j].x * v[j].x + v[j].y * v[j].y) + (v[j].z * v[j].z + v[j].w * v[j].w); }
            const float rs = 1.0f / sqrtf(wave_sum(s) * (1.f / DM) + RMS_EPS);
            unsigned long long* o8 = (unsigned long long*)(XB + (size_t)m * DM) + lane;
#pragma unroll
            for (int j = 0; j < 4; ++j) o8[64 * j] = (unsigned long long)pk2(v[j].x, v[j].y) | ((unsigned long long)pk2(v[j].z, v[j].w) << 32);
            float p[16];
#pragma unroll
            for (int j = 0; j < 16; ++j) p[j] = 0.f;
#pragma unroll
            for (int jj = 0; jj < 4; ++jj)
#pragma unroll
                for (int ii = 0; ii < 4; ++ii) { const float xv = v[jj][ii];
#pragma unroll
                    for (int j4 = 0; j4 < 4; ++j4) { const f32x4 w = *(const LAS f32x4*)(wg + ((((jj * 4 + ii) * 4 + j4) * 64 + lane) << 2));
                        p[4 * j4 + 0] += xv * w.x; p[4 * j4 + 1] += xv * w.y; p[4 * j4 + 2] += xv * w.z; p[4 * j4 + 3] += xv * w.w; } }
            float q8[8], q4[4], q2[2], q1;
            { const bool hi = (lane & 32) != 0;
#pragma unroll
              for (int k = 0; k < 8; ++k) { const float send = hi ? p[k] : p[k + 8], keep = hi ? p[k + 8] : p[k]; q8[k] = keep + __shfl_xor(send, 32); } }
            { const bool hi = (lane & 16) != 0;
#pragma unroll
              for (int k = 0; k < 4; ++k) { const float send = hi ? q8[k] : q8[k + 4], keep = hi ? q8[k + 4] : q8[k]; q4[k] = keep + __shfl_xor(send, 16); } }
            { const bool hi = (lane & 8) != 0;
#pragma unroll
              for (int k = 0; k < 2; ++k) { const float send = hi ? q4[k] : q4[k + 2], keep = hi ? q4[k + 2] : q4[k]; q2[k] = keep + __shfl_xor(send, 8); } }
            { const bool hi = (lane & 4) != 0; const float send = hi ? q2[0] : q2[1], keep = hi ? q2[1] : q2[0]; q1 = keep + __shfl_xor(send, 4); }
            q1 += __shfl_xor(q1, 2); q1 += __shfl_xor(q1, 1);
            if ((lane & 3) == 0) gates[(size_t)m * 16 + (lane >> 2)] = q1 * rs + gb;
            if (lane == 0) rs0[m] = rs;
        }
    }
    {
        bf16* MB = (bf16*)(ws + O_MEMB); float* rsm = (float*)(ws + O_RSM);
        for (int m = gw; m < NMROWS; m += NGW) {
            const f32x4* xr = (const f32x4*)(F.in[I_MEM] + (size_t)m * DM) + lane;
            f32x4 v[4]; float s = 0.f;
#pragma unroll
            for (int j = 0; j < 4; ++j) { v[j] = xr[64 * j]; s += (v[j].x * v[j].x + v[j].y * v[j].y) + (v[j].z * v[j].z + v[j].w * v[j].w); }
            const float rs = 1.0f / sqrtf(wave_sum(s) * (1.f / DM) + RMS_EPS);
            unsigned long long* o8 = (unsigned long long*)(MB + (size_t)m * DM) + lane;
#pragma unroll
            for (int j = 0; j < 4; ++j) o8[64 * j] = (unsigned long long)pk2(v[j].x, v[j].y) | ((unsigned long long)pk2(v[j].z, v[j].w) << 32);
            if (lane == 0) rsm[m] = rs;
        }
    }
}
using pg8::Unit;
typedef const f32x4 (&AccRef)[2][2][4][2];

template <int MODE> struct EpiRowScale {
    static constexpr bool PERM = true;
    bf16* O; int ldc; const float* rs; float extra;
    DI void operator()(AccRef acc, const Unit& u, int wr, int wc, int fr, int fq) const {
        const int row0 = u.orow * 256 + wr * 64 + fr, col0 = u.ocol + wc * 32 + 8 * fq;
        const int act = (MODE == 0) ? (u.pn >= 8 ? 2 : (u.pn >= 6 ? 1 : 0)) : 0;
#pragma unroll
        for (int ai = 0; ai < 2; ++ai)
#pragma unroll
            for (int m = 0; m < 4; ++m) { const int row = row0 + ai * 128 + m * 16; const float s = rs[row] * extra; bf16* rowp = O + (size_t)row * ldc + col0;
#pragma unroll
                for (int bj = 0; bj < 2; ++bj) { f32x4 v0 = acc[ai][bj][m][0] * s, v1 = acc[ai][bj][m][1] * s;
                    if (act == 1) {
#pragma unroll
                        for (int j = 0; j < 4; ++j) { v0[j] = sigmoidf_(v0[j]); v1[j] = sigmoidf_(v1[j]); } }
                    else if (act == 2) {
#pragma unroll
                        for (int j = 0; j < 4; ++j) { v0[j] = gelu_tanh(v0[j]); v1[j] = gelu_tanh(v1[j]); } }
                    u32x4 w; w.x = pk2(v0[0], v0[1]); w.y = pk2(v0[2], v0[3]); w.z = pk2(v1[0], v1[1]); w.w = pk2(v1[2], v1[3]);
                    *(u32x4*)(rowp + bj * 128) = w; } }
    }
};
struct EpiQ {
    static constexpr bool PERM = true;
    bf16* O; const float* ssp; float extra;
    DI void operator()(AccRef acc, const Unit& u, int wr, int wc, int fr, int fq) const {
        const int row0 = u.orow * 256 + wr * 64 + fr, col0 = u.ocol + wc * 32 + 8 * fq;
#pragma unroll
        for (int ai = 0; ai < 2; ++ai)
#pragma unroll
            for (int m = 0; m < 4; ++m) { const int row = row0 + ai * 128 + m * 16; const f32x4* sp = (const f32x4*)(ssp + (size_t)row * 16);
                const f32x4 a = sp[0], b = sp[1], c = sp[2], d = sp[3];
                const float ss = (((a.x + a.y) + (a.z + a.w)) + ((b.x + b.y) + (b.z + b.w))) + (((c.x + c.y) + (c.z + c.w)) + ((d.x + d.y) + (d.z + d.w)));
                const float s = extra / sqrtf(ss * (1.f / DM) + RMS_EPS); bf16* rowp = O + (size_t)row * DM + col0;
#pragma unroll
                for (int bj = 0; bj < 2; ++bj) { const f32x4 v0 = acc[ai][bj][m][0] * s, v1 = acc[ai][bj][m][1] * s;
                    u32x4 w; w.x = pk2(v0[0], v0[1]); w.y = pk2(v0[2], v0[3]); w.z = pk2(v1[0], v1[1]); w.w = pk2(v1[2], v1[3]);
                    *(u32x4*)(rowp + bj * 128) = w; } }
    }
};
template <bool SS> struct EpiRes {
    static constexpr bool PERM = false;
    const float* base; float* out; bf16* xb; float* ssp;
    DI void operator()(AccRef acc, const Unit& u, int wr, int wc, int fr, int fq) const {
        const int row0 = u.orow * 256 + wr * 64 + fr, col0 = u.ocol + wc * 32 + 4 * fq;
#pragma unroll
        for (int ai = 0; ai < 2; ++ai)
#pragma unroll
            for (int m = 0; m < 4; ++m) { const int row = row0 + ai * 128 + m * 16; const size_t off = (size_t)row * DM + col0; float q = 0.f;
#pragma unroll
                for (int bj = 0; bj < 2; ++bj)
#pragma unroll
                    for (int n = 0; n < 2; ++n) { const size_t o2 = off + bj * 128 + n * 16; const f32x4 v = *(const f32x4*)(base + o2) + acc[ai][bj][m][n];
                        *(f32x4*)(out + o2) = v; u32x2 w; w.x = pk2(v[0], v[1]); w.y = pk2(v[2], v[3]); *(u32x2*)(xb + o2) = w;
                        if (SS) q += (v[0] * v[0] + v[1] * v[1]) + (v[2] * v[2] + v[3] * v[3]); }
                if (SS) { q += __shfl_xor(q, 16); q += __shfl_xor(q, 32); if (fq == 0) ssp[(size_t)row * 16 + u.pn * 4 + wc] = q; } }
    }
};
struct EpiGU {
    static constexpr bool PERM = true;
    bf16* H; const float* rs3;
    DI void operator()(AccRef acc, const Unit& u, int wr, int wc, int fr, int fq) const {
        const int rl0 = wr * 64 + fr, col0 = u.ocol + wc * 32 + 8 * fq;
#pragma unroll
        for (int ai = 0; ai < 2; ++ai)
#pragma unroll
            for (int m = 0; m < 4; ++m) { const int rl = rl0 + ai * 128 + m * 16; const int rc = rl < u.nvalid ? rl : u.nvalid - 1; const float s = rs3[u.ridx[rc]];
                bf16* rowp = H + (size_t)(u.orow * 256 + rl) * DEXP + col0;
                f32x4 h0, h1;
#pragma unroll
                for (int j = 0; j < 4; ++j) { h0[j] = siluf_(acc[ai][0][m][0][j] * s) * (acc[ai][1][m][0][j] * s); h1[j] = siluf_(acc[ai][0][m][1][j] * s) * (acc[ai][1][m][1][j] * s); }
                u32x4 w; w.x = pk2(h0[0], h0[1]); w.y = pk2(h0[2], h0[3]); w.z = pk2(h1[0], h1[1]); w.w = pk2(h1[2], h1[3]);
                *(u32x4*)rowp = w; }
    }
};
struct EpiPlain {
    static constexpr bool PERM = true;
    bf16* O; int ldc;
    DI void operator()(AccRef acc, const Unit& u, int wr, int wc, int fr, int fq) const {
        const int row0 = u.orow * 256 + wr * 64 + fr, col0 = u.ocol + wc * 32 + 8 * fq;
#pragma unroll
        for (int ai = 0; ai < 2; ++ai)
#pragma unroll
            for (int m = 0; m < 4; ++m) { bf16* rowp = O + (size_t)(row0 + ai * 128 + m * 16) * ldc + col0;
#pragma unroll
                for (int bj = 0; bj < 2; ++bj) { const f32x4 v0 = acc[ai][bj][m][0], v1 = acc[ai][bj][m][1];
                    u32x4 w; w.x = pk2(v0[0], v0[1]); w.y = pk2(v0[2], v0[3]); w.z = pk2(v1[0], v1[1]); w.w = pk2(v1[2], v1[3]);
                    *(u32x4*)(rowp + bj * 128) = w; } }
    }
};
struct MoeOrder {
    const LAS int* cum; const LAS int* cnt; const int* ridx; int G, c; bool down;
    DI bool next(int i, Unit& u) const {
        const int L = i * G + c, T = L >> 2, j = L & 3; if (T >= cum[32]) return false;
        int e = 0;
        for (int k = 1; k < 32; ++k) e += (cum[k] <= T) ? 1 : 0;
        const int mt = T - cum[e];
        u.ex = e; u.orow = T; u.nvalid = min(256, cnt[e] - mt * 256); u.ridx = ridx + (size_t)e * NTOK + mt * 256;
        if (down) { u.pm = T; u.pn = e * 4 + j; u.ocol = 256 * j; } else { u.pm = 0; u.pn = e * 4 + j; u.ocol = 128 * j; }
        return true;
    }
};
#define SFENCE() do { asm volatile("" ::: "memory"); __builtin_amdgcn_sched_barrier(0); } while (0)
DI void build_conv_tile(LAS uchar* tile, const bf16* z, int b, int c, int zcol0, const float* convw, const float* convb, float scale, const LAS float* wrow, int tid) {
    const int dg = tid & 15, sg = tid >> 4;
    float in[8][8];
#pragma unroll
    for (int r = 0; r < 8; ++r) { const int pos = c * 128 + 4 * sg - 2 + r; u32x4 raw = (u32x4){0u, 0u, 0u, 0u};
        if (pos >= 0 && pos < SEQ) raw = *(const u32x4*)(z + (size_t)(b * SEQ + pos) * ZC + zcol0 + 8 * dg);
        in[r][0] = bflo(raw.x); in[r][1] = bfhi(raw.x); in[r][2] = bflo(raw.y); in[r][3] = bfhi(raw.y); in[r][4] = bflo(raw.z); in[r][5] = bfhi(raw.z); in[r][6] = bflo(raw.w); in[r][7] = bfhi(raw.w); }
    float cw[5][8], cb[8];
#pragma unroll
    for (int j = 0; j < 5; ++j) { const f32x4 a = *(const f32x4*)(convw + j * 1024 + zcol0 + 8 * dg), bq = *(const f32x4*)(convw + j * 1024 + zcol0 + 8 * dg + 4);
        cw[j][0] = a.x; cw[j][1] = a.y; cw[j][2] = a.z; cw[j][3] = a.w; cw[j][4] = bq.x; cw[j][5] = bq.y; cw[j][6] = bq.z; cw[j][7] = bq.w; }
    { const f32x4 a = *(const f32x4*)(convb + zcol0 + 8 * dg), bq = *(const f32x4*)(convb + zcol0 + 8 * dg + 4);
        cb[0] = a.x; cb[1] = a.y; cb[2] = a.z; cb[3] = a.w; cb[4] = bq.x; cb[5] = bq.y; cb[6] = bq.z; cb[7] = bq.w; }
#pragma unroll
    for (int rr = 0; rr < 4; ++rr) { const float sc = wrow ? scale * wrow[4 * sg + rr] : scale; float o[8];
#pragma unroll
        for (int i = 0; i < 8; ++i) { float a = cb[i];
#pragma unroll
            for (int j = 0; j < 5; ++j) a += in[rr + j][i] * cw[j][i];
            o[i] = siluf_(a) * sc; }
        u32x4 w; w.x = pk2(o[0], o[1]); w.y = pk2(o[2], o[3]); w.z = pk2(o[4], o[5]); w.w = pk2(o[6], o[7]);
        *(LAS u32x4*)(tile + offb(4 * sg + rr, dg)) = w; }
}
DI void build_copy_tile(LAS uchar* tile, const bf16* src, size_t row0, int ld, int col0, int tid) {
    const int dg = tid & 15, sg = tid >> 4;
#pragma unroll
    for (int rr = 0; rr < 4; ++rr) { const int r = 4 * sg + rr; *(LAS u32x4*)(tile + offb(r, dg)) = *(const u32x4*)(src + (row0 + r) * (size_t)ld + col0 + 8 * dg); }
}

DI void mlstm_scan(Frame& F, int seq) {
    int tid = F.tid, lane = F.lane; const int w = F.wave;
    const int dir = seq & 1, h = (seq >> 1) & 3, b = seq >> 3;
    LAS uchar* T_KW = F.lds; LAS uchar* T_V = F.lds + 32768;
    LAS float* wrow = (LAS float*)(F.lds + 65536);
    LAS float* misc = (LAS float*)(F.lds + 65536 + 1024);
    const bf16* z = (const bf16*)(F.ws + O_Z); const float* gates = (const float*)(F.ws + O_GATES);
    bf16* cst = (bf16*)(F.ws + O_CST); float* nst = (float*)(F.ws + O_NST); float* mst = (float*)(F.ws + O_MST);
    const int d0 = 64 * (w & 1), e0 = 32 * (w >> 1);
    f32x4 acc[4][2], accn[4];
#pragma unroll
    for (int mt = 0; mt < 4; ++mt) { acc[mt][0] = (f32x4){0.f, 0.f, 0.f, 0.f}; acc[mt][1] = (f32x4){0.f, 0.f, 0.f, 0.f}; accn[mt] = (f32x4){0.f, 0.f, 0.f, 0.f}; }
    float mstate = -1e30f;
    const bf16x8 ones = (bf16x8){0x3F80, 0x3F80, 0x3F80, 0x3F80, 0x3F80, 0x3F80, 0x3F80, 0x3F80};
    for (int ci = 0; ci < 32; ++ci) {
        const int c = dir ? 31 - ci : ci, par = ci & 1;
        asm volatile("" : "+v"(tid), "+v"(lane));
        const size_t row0 = (size_t)b * SEQ + c * 128;
        if (w == 0) {
            const int gi = dir * 8 + h, gf = dir * 8 + 4 + h;
            const float ig0 = gates[(row0 + 2 * lane) * 16 + gi], ig1 = gates[(row0 + 2 * lane + 1) * 16 + gi];
            const float lf0 = log_sigmoid(gates[(row0 + 2 * lane) * 16 + gf]), lf1 = log_sigmoid(gates[(row0 + 2 * lane + 1) * 16 + gf]);
            const float incl = wscan_add(lf0 + lf1, lane);
            const float bf0 = incl - lf1, bf1 = incl, Ftot = __shfl(incl, 63);
            const float a0 = dir ? (bf0 - lf0 + ig0) : (Ftot - bf0 + ig0), a1 = dir ? (bf1 - lf1 + ig1) : (Ftot - bf1 + ig1);
            const float mloc = wave_max(fmaxf(a0, a1));
            const float mnew = fmaxf(Ftot + mstate, mloc);
            const float sc_old = __expf(Ftot + mstate - mnew);
            wrow[par * 128 + 2 * lane] = __expf(a0 - mnew); wrow[par * 128 + 2 * lane + 1] = __expf(a1 - mnew);
            if (lane == 0) { misc[par * 8 + 0] = sc_old; mst[seq * 32 + c] = mstate; }
            mstate = mnew;
        }
        __syncthreads();
        {
            bf16* cp = cst + ((size_t)seq * 32 + c) * 16384;
#pragma unroll
            for (int mt = 0; mt < 4; ++mt)
#pragma unroll
                for (int nt = 0; nt < 2; ++nt) { const int d = d0 + 16 * mt + 4 * (lane >> 4), e = e0 + 16 * nt + (lane & 15);
                    u32x2 v; v.x = pk2(acc[mt][nt][0], acc[mt][nt][1]); v.y = pk2(acc[mt][nt][2], acc[mt][nt][3]); *(u32x2*)(cp + e * 128 + d) = v; }
            if (w < 2 && (lane & 15) == 0) {
#pragma unroll
                for (int mt = 0; mt < 4; ++mt) *(f32x4*)(nst + ((size_t)seq * 32 + c) * 128 + d0 + 16 * mt + 4 * (lane >> 4)) = accn[mt]; }
        }
        build_conv_tile(T_KW, z, b, c, 512 + h * 128, F.in[I_CONVW], F.in[I_CONVB], 0.08838834764831845f, wrow + par * 128, tid);
        build_copy_tile(T_V, z, row0, ZC, 1024 + h * 128, tid);
        __syncthreads();
        const float sc_old = misc[par * 8 + 0];
#pragma unroll
        for (int mt = 0; mt < 4; ++mt) { acc[mt][0] *= sc_old; acc[mt][1] *= sc_old; accn[mt] *= sc_old; }
#pragma unroll
        for (int kk = 0; kk < 4; ++kk) {
            bf16x8 X[4], Y[2];
#pragma unroll
            for (int mt = 0; mt < 4; ++mt) X[mt] = frag_tr(T_KW, 32 * kk, d0 + 16 * mt, lane);
#pragma unroll
            for (int nt = 0; nt < 2; ++nt) Y[nt] = frag_tr(T_V, 32 * kk, e0 + 16 * nt, lane);
#pragma unroll
            for (int mt = 0; mt < 4; ++mt) { acc[mt][0] = mfma16(X[mt], Y[0], acc[mt][0]); acc[mt][1] = mfma16(X[mt], Y[1], acc[mt][1]); }
            if (w < 2) {
#pragma unroll
                for (int mt = 0; mt < 4; ++mt) accn[mt] = mfma16(X[mt], ones, accn[mt]); }
            __builtin_amdgcn_sched_barrier(0);
        }
    }
    __syncthreads();
}

DI void gmlp_unit(Frame& F, int unit) {
    int tid = F.tid, lane = F.lane; const int w = F.wave; asm volatile("" : "+v"(tid), "+v"(lane));
    const size_t row0 = (size_t)unit * 128;
    LAS uchar* T_G = F.lds; LAS float* mean = (LAS float*)(F.lds + 131072); LAS float* rstd = mean + 128;
    const bf16* z = (const bf16*)(F.ws + O_Z); bf16* Y = (bf16*)(F.ws + O_Y); const bf16* wsb = (const bf16*)(F.ws + O_WSB);
    for (int r = 16 * w; r < 16 * w + 16; ++r) {
        const u32x4 raw = *(const u32x4*)(z + (row0 + r) * ZC + 2560 + 8 * lane);
        float v[8] = {bflo(raw.x), bfhi(raw.x), bflo(raw.y), bfhi(raw.y), bflo(raw.z), bfhi(raw.z), bflo(raw.w), bfhi(raw.w)};
        float s = 0.f;
#pragma unroll
        for (int i = 0; i < 8; ++i) s += v[i];
        const float mu = wave_sum(s) * (1.f / 512.f); float q = 0.f;
#pragma unroll
        for (int i = 0; i < 8; ++i) { const float dlt = v[i] - mu; q += dlt * dlt; }
        const float var = wave_sum(q) * (1.f / 512.f);
        if (lane == 0) { mean[r] = mu; rstd[r] = 1.0f / sqrtf(var + LN_EPS); }
    }
    __syncthreads();
    for (int g = 0; g < 4; ++g) {
        {
            const int dg = tid & 15, sg = tid >> 4;
            const f32x4 ga = *(const f32x4*)(F.in[I_LNVG] + g * 128 + 8 * dg), gb2 = *(const f32x4*)(F.in[I_LNVG] + g * 128 + 8 * dg + 4);
            const f32x4 ba = *(const f32x4*)(F.in[I_LNVB] + g * 128 + 8 * dg), bb2 = *(const f32x4*)(F.in[I_LNVB] + g * 128 + 8 * dg + 4);
#pragma unroll
            for (int rr = 0; rr < 4; ++rr) { const int r = 4 * sg + rr; const u32x4 raw = *(const u32x4*)(z + (row0 + r) * ZC + 2560 + g * 128 + 8 * dg);
                const float mu = mean[r], rs = rstd[r];
                float o[8] = {bflo(raw.x), bfhi(raw.x), bflo(raw.y), bfhi(raw.y), bflo(raw.z), bfhi(raw.z), bflo(raw.w), bfhi(raw.w)};
                o[0] = (o[0] - mu) * rs * ga.x + ba.x; o[1] = (o[1] - mu) * rs * ga.y + ba.y; o[2] = (o[2] - mu) * rs * ga.z + ba.z; o[3] = (o[3] - mu) * rs * ga.w + ba.w;
                o[4] = (o[4] - mu) * rs * gb2.x + bb2.x; o[5] = (o[5] - mu) * rs * gb2.y + bb2.y; o[6] = (o[6] - mu) * rs * gb2.z + bb2.z; o[7] = (o[7] - mu) * rs * gb2.w + bb2.w;
                u32x4 wv; wv.x = pk2(o[0], o[1]); wv.y = pk2(o[2], o[3]); wv.z = pk2(o[4], o[5]); wv.w = pk2(o[6], o[7]);
                *(LAS u32x4*)(T_G + offb(r, dg)) = wv; }
        }
        __syncthreads();
        f32x4 acc[8];
#pragma unroll
        for (int mt = 0; mt < 8; ++mt) acc[mt] = (f32x4){0.f, 0.f, 0.f, 0.f};
#pragma unroll
        for (int kk = 0; kk < 4; ++kk) {
            const bf16x8 Yw = *(const bf16x8*)(wsb + ((size_t)g * 128 + 16 * w + (lane & 15)) * 128 + 32 * kk + 8 * (lane >> 4));
#pragma unroll
            for (int mt = 0; mt < 8; ++mt) acc[mt] = mfma16(frag_tr(T_G, 32 * kk, 16 * mt, lane), Yw, acc[mt]);
            __builtin_amdgcn_sched_barrier(0);
        }
        const int tl = 16 * w + (lane & 15); const size_t row = row0 + tl; const float bs = F.in[I_BS][g * 128 + tl];
#pragma unroll
        for (int mt = 0; mt < 8; ++mt) { const int d = 16 * mt + 4 * (lane >> 4);
            const u32x2 gu = *(const u32x2*)(z + row * ZC + 2048 + g * 128 + d);
            u32x2 o; o.x = pk2(bflo(gu.x) * (acc[mt][0] + bs), bfhi(gu.x) * (acc[mt][1] + bs)); o.y = pk2(bflo(gu.y) * (acc[mt][2] + bs), bfhi(gu.y) * (acc[mt][3] + bs));
            *(u32x2*)(Y + row * DM + 512 + g * 128 + d) = o; }
        __syncthreads();
    }
}

DI void phase2(Frame& F) {
    if (F.G >= 256) {
        if (F.bid < 128) mlstm_scan(F, F.bid);
        else for (int u = F.bid - 128; u < 512; u += F.G - 128) gmlp_unit(F, u);
    } else {
        for (int s = F.bid; s < 128; s += F.G) mlstm_scan(F, s);
        for (int u = F.bid; u < 512; u += F.G) gmlp_unit(F, u);
    }
}

DI void mlstm_out_unit(Frame& F, int unit) {
    int tid = F.tid, lane = F.lane; const int w = F.wave; asm volatile("" : "+v"(tid), "+v"(lane));
    const int c = unit & 31, h = (unit >> 5) & 3, b = unit >> 7;
    const size_t row0 = (size_t)b * SEQ + c * 128;
    LAS uchar* T_Q = F.lds; LAS uchar* T_K = F.lds + 32768; LAS uchar* T_V = F.lds + 65536; LAS uchar* T_C = F.lds + 98304;
    LAS float* sm = (LAS float*)(F.lds + 131072);
    LAS float* gfa = sm, *gba = sm + 128, *Mfa = sm + 256, *Mba = sm + 384, *sIf = sm + 512, *sIb = sm + 640, *enf = sm + 768, *enb = sm + 896, *nfa = sm + 1024, *nba = sm + 1152, *qnf = sm + 1280, *qnb = sm + 1408;
    const bf16* z = (const bf16*)(F.ws + O_Z); const float* gates = (const float*)(F.ws + O_GATES);
    const bf16* cst = (const bf16*)(F.ws + O_CST); const float* nst = (const float*)(F.ws + O_NST); const float* mst = (const float*)(F.ws + O_MST);
    bf16* Y = (bf16*)(F.ws + O_Y);
    const int sqf = ((b * 4 + h) * 2 + 0) * 32 + c, sqb = ((b * 4 + h) * 2 + 1) * 32 + c;
    if (w == 0) {
        const float mpf = mst[sqf], mpb = mst[sqb];
        const size_t r0 = (row0 + 2 * lane) * 16, r1 = (row0 + 2 * lane + 1) * 16;
        {
            const float ig0 = gates[r0 + h], ig1 = gates[r1 + h], lf0 = log_sigmoid(gates[r0 + 4 + h]), lf1 = log_sigmoid(gates[r1 + 4 + h]);
            const float incl = wscan_add(lf0 + lf1, lane), bf0 = incl - lf1, bf1 = incl;
            const float g0 = ig0 - bf0, g1 = ig1 - bf1;
            const float pin = wscan_max(fmaxf(g0, g1), lane); float pex = __shfl_up(pin, 1); if (lane == 0) pex = -3.0e38f;
            const float M0 = fmaxf(mpf, fmaxf(pex, g0)), M1 = fmaxf(mpf, pin);
            gfa[2 * lane] = g0; gfa[2 * lane + 1] = g1; Mfa[2 * lane] = M0; Mfa[2 * lane + 1] = M1;
            sIf[2 * lane] = __expf(mpf - M0); sIf[2 * lane + 1] = __expf(mpf - M1);
            enf[2 * lane] = __expf(-bf0 - M0); enf[2 * lane + 1] = __expf(-bf1 - M1);
        }
        {
            const float ig0 = gates[r0 + 8 + h], ig1 = gates[r1 + 8 + h], lf0 = log_sigmoid(gates[r0 + 12 + h]), lf1 = log_sigmoid(gates[r1 + 12 + h]);
            const float incl = wscan_add(lf0 + lf1, lane), Ftot = __shfl(incl, 63);
            const float bb0 = Ftot - incl + lf0 + lf1, bb1 = Ftot - incl + lf1;
            const float g0 = ig0 - bb0, g1 = ig1 - bb1;
            const float sin_ = wscan_max_rev(fmaxf(g0, g1), lane); float sex = __shfl_down(sin_, 1); if (lane == 63) sex = -3.0e38f;
            const float M0 = fmaxf(mpb, sin_), M1 = fmaxf(mpb, fmaxf(sex, g1));
            gba[2 * lane] = g0; gba[2 * lane + 1] = g1; Mba[2 * lane] = M0; Mba[2 * lane + 1] = M1;
            sIb[2 * lane] = __expf(mpb - M0); sIb[2 * lane + 1] = __expf(mpb - M1);
            enb[2 * lane] = __expf(-bb0 - M0); enb[2 * lane + 1] = __expf(-bb1 - M1);
        }
    }
    if (tid < 128) { nfa[tid] = nst[(size_t)sqf * 128 + tid]; nba[tid] = nst[(size_t)sqb * 128 + tid]; }
    SFENCE();
    build_conv_tile(T_Q, z, b, c, h * 128, F.in[I_CONVW], F.in[I_CONVB], 1.0f, nullptr, tid);
    SFENCE();
    build_conv_tile(T_K, z, b, c, 512 + h * 128, F.in[I_CONVW], F.in[I_CONVB], 0.08838834764831845f, nullptr, tid);
    SFENCE();
    build_copy_tile(T_V, z, row0, ZC, 1024 + h * 128, tid);
    build_copy_tile(T_C, cst + (size_t)sqf * 16384, 0, 128, 0, tid);
    __syncthreads();
    {
        const int t = tid >> 2, part = tid & 3; float af = 0.f, ab = 0.f;
#pragma unroll
        for (int cc = 0; cc < 4; ++cc) { const u32x4 raw = *(const LAS u32x4*)(T_Q + offb(t, 4 * part + cc)); const int dd = 32 * part + 8 * cc;
            const float qv[8] = {bflo(raw.x), bfhi(raw.x), bflo(raw.y), bfhi(raw.y), bflo(raw.z), bfhi(raw.z), bflo(raw.w), bfhi(raw.w)};
#pragma unroll
            for (int i = 0; i < 8; ++i) { af += qv[i] * nfa[dd + i]; ab += qv[i] * nba[dd + i]; } }
        af += __shfl_xor(af, 1); af += __shfl_xor(af, 2); ab += __shfl_xor(ab, 1); ab += __shfl_xor(ab, 2);
        if (part == 0) { qnf[t] = af; qnb[t] = ab; }
    }
    u32x4 cbreg[4];
    { const int dg = tid & 15, sg = tid >> 4; const bf16* src = cst + (size_t)sqb * 16384;
#pragma unroll
      for (int rr = 0; rr < 4; ++rr) cbreg[rr] = *(const u32x4*)(src + (size_t)(4 * sg + rr) * 128 + 8 * dg); }
    bf16x8 Qf[4];
#pragma unroll
    for (int kk = 0; kk < 4; ++kk) Qf[kk] = frag_row(T_Q, 16 * w, kk, lane);
    f32x4 aS[8];
#pragma unroll
    for (int mt = 0; mt < 8; ++mt) aS[mt] = (f32x4){0.f, 0.f, 0.f, 0.f};
#pragma unroll
    for (int kk = 0; kk < 4; ++kk) {
#pragma unroll
        for (int mt = 0; mt < 8; ++mt) aS[mt] = mfma16(frag_row(T_K, 16 * mt, kk, lane), Qf[kk], aS[mt]);
        __builtin_amdgcn_sched_barrier(0); }
    __syncthreads();
    const int tl = 16 * w + (lane & 15);
    float cf, cb_;
    {
        const float Mf = Mfa[tl], Mb = Mba[tl];
        f32x4 wf[8], wb[8]; float sumf = 0.f, sumb = 0.f;
#pragma unroll
        for (int mt = 0; mt < 8; ++mt) { const int s0 = 16 * mt + 4 * (lane >> 4); const f32x4 gf4 = *(const LAS f32x4*)(gfa + s0), gb4 = *(const LAS f32x4*)(gba + s0);
#pragma unroll
            for (int j = 0; j < 4; ++j) { const int s = s0 + j; const float sv = aS[mt][j];
                const float a = (s <= tl) ? __expf(gf4[j] - Mf) * sv : 0.f, bq = (s >= tl) ? __expf(gb4[j] - Mb) * sv : 0.f;
                wf[mt][j] = a; wb[mt][j] = bq; sumf += a; sumb += bq; } }
        sumf += __shfl_xor(sumf, 16); sumf += __shfl_xor(sumf, 32); sumb += __shfl_xor(sumb, 16); sumb += __shfl_xor(sumb, 32);
        const float sif = sIf[tl], sib = sIb[tl];
        const float denf = sumf + sif * qnf[tl], denb = sumb + sib * qnb[tl];
        const float rf = 1.0f / fmaxf(fabsf(denf), enf[tl]), rb = 1.0f / fmaxf(fabsf(denb), enb[tl]);
        cf = sif * rf; cb_ = sib * rb;
#pragma unroll
        for (int mt = 0; mt < 8; ++mt) { const int s0 = 16 * mt + 4 * (lane >> 4);
            u32x2 v; v.x = pk2(wf[mt][0] * rf + wb[mt][0] * rb, wf[mt][1] * rf + wb[mt][1] * rb); v.y = pk2(wf[mt][2] * rf + wb[mt][2] * rb, wf[mt][3] * rf + wb[mt][3] * rb);
            *(LAS u32x2*)(T_K + offb(tl, s0 >> 3) + (s0 & 7) * 2) = v; }
    }
    f32x4 aO[8], aZ[8];
#pragma unroll
    for (int mt = 0; mt < 8; ++mt) { aO[mt] = (f32x4){0.f, 0.f, 0.f, 0.f}; aZ[mt] = (f32x4){0.f, 0.f, 0.f, 0.f}; }
#pragma unroll
    for (int kk = 0; kk < 4; ++kk) { const bf16x8 Yw = frag_row(T_K, 16 * w, kk, lane);
#pragma unroll
        for (int mt = 0; mt < 8; ++mt) aO[mt] = mfma16(frag_tr(T_V, 32 * kk, 16 * mt, lane), Yw, aO[mt]);
        __builtin_amdgcn_sched_barrier(0); }
#pragma unroll
    for (int kk = 0; kk < 4; ++kk) {
#pragma unroll
        for (int mt = 0; mt < 8; ++mt) aZ[mt] = mfma16(frag_row(T_C, 16 * mt, kk, lane), Qf[kk], aZ[mt]);
        __builtin_amdgcn_sched_barrier(0); }
#pragma unroll
    for (int mt = 0; mt < 8; ++mt) { aO[mt] += aZ[mt] * cf; aZ[mt] = (f32x4){0.f, 0.f, 0.f, 0.f}; }
    __syncthreads();
    { const int dg = tid & 15, sg = tid >> 4;
#pragma unroll
      for (int rr = 0; rr < 4; ++rr) *(LAS u32x4*)(T_C + offb(4 * sg + rr, dg)) = cbreg[rr]; }
    __syncthreads();
#pragma unroll
    for (int kk = 0; kk < 4; ++kk) {
#pragma unroll
        for (int mt = 0; mt < 8; ++mt) aZ[mt] = mfma16(frag_row(T_C, 16 * mt, kk, lane), Qf[kk], aZ[mt]);
        __builtin_amdgcn_sched_barrier(0); }
    float ssq = 0.f;
#pragma unroll
    for (int mt = 0; mt < 8; ++mt) { aO[mt] += aZ[mt] * cb_; ssq += (aO[mt][0] * aO[mt][0] + aO[mt][1] * aO[mt][1]) + (aO[mt][2] * aO[mt][2] + aO[mt][3] * aO[mt][3]); }
    ssq += __shfl_xor(ssq, 16); ssq += __shfl_xor(ssq, 32);
    const float rinv = 1.0f / sqrtf(ssq * (1.f / 128.f) + RMS_EPS);
    const size_t row = row0 + tl;
#pragma unroll
    for (int mt = 0; mt < 8; ++mt) { const int e = 16 * mt + 4 * (lane >> 4);
        const u32x2 og = *(const u32x2*)(z + row * ZC + 1536 + h * 128 + e); const f32x4 gh = *(const f32x4*)(F.in[I_GHEAD] + h * 128 + e);
        u32x2 o; o.x = pk2(bflo(og.x) * aO[mt][0] * rinv * gh.x, bfhi(og.x) * aO[mt][1] * rinv * gh.y); o.y = pk2(bflo(og.y) * aO[mt][2] * rinv * gh.z, bfhi(og.y) * aO[mt][3] * rinv * gh.w);
        *(u32x2*)(Y + row * DM + h * 128 + e) = o; }
    __syncthreads();
}
DI void load_kv_half(LAS uchar* buf, const bf16* kv, int b, int col0, int tid) {
    const int ch = tid & 15, r = tid >> 4;
#pragma unroll
    for (int i = 0; i < 8; ++i) { const int m = r + 32 * i; *(LAS u32x4*)(buf + offb(m, ch)) = *(const u32x4*)(kv + (size_t)(b * NMEM + m) * 2048 + col0 + 8 * ch); }
}
DI void attn_unit(Frame& F, int unit) {
    int tid = F.tid, lane = F.lane; const int w = F.wave; asm volatile("" : "+v"(tid), "+v"(lane));
    const int qb = unit & 31, hd = (unit >> 5) & 3, b = unit >> 7;
    LAS uchar* KV = F.lds; LAS uchar* P0 = F.lds + 65536;
    const bf16* Q = (const bf16*)(F.ws + O_Q); const bf16* kv = (const bf16*)(F.ws + O_KV); bf16* O = (bf16*)(F.ws + O_O);
    const int ql = 16 * w + (lane & 15); const size_t qrow = (size_t)b * SEQ + qb * 128 + ql;
    f32x4 aS[16];
#pragma unroll
    for (int mt = 0; mt < 16; ++mt) aS[mt] = (f32x4){0.f, 0.f, 0.f, 0.f};
    for (int dh = 0; dh < 2; ++dh) {
        __syncthreads();
        load_kv_half(KV, kv, b, hd * 256 + dh * 128, tid);
        bf16x8 Qf[4];
#pragma unroll
        for (int kk = 0; kk < 4; ++kk) Qf[kk] = *(const bf16x8*)(Q + qrow * DM + hd * 256 + dh * 128 + 32 * kk + 8 * (lane >> 4));
        __syncthreads();
#pragma unroll
        for (int kk = 0; kk < 4; ++kk)
#pragma unroll
            for (int mt = 0; mt < 16; ++mt) aS[mt] = mfma16(frag_row(KV, 16 * mt, kk, lane), Qf[kk], aS[mt]);
    }
    float mx = -3.0e38f;
#pragma unroll
    for (int mt = 0; mt < 16; ++mt) mx = fmaxf(mx, fmaxf(fmaxf(aS[mt][0], aS[mt][1]), fmaxf(aS[mt][2], aS[mt][3])));
    mx = fmaxf(mx, __shfl_xor(mx, 16)); mx = fmaxf(mx, __shfl_xor(mx, 32));
    float sum = 0.f;
#pragma unroll
    for (int mt = 0; mt < 16; ++mt) {
        f32x4 p;
#pragma unroll
        for (int j = 0; j < 4; ++j) { p[j] = __expf(aS[mt][j] - mx); sum += p[j]; }
        const int m0 = 16 * mt + 4 * (lane >> 4);
        u32x2 v; v.x = pk2(p[0], p[1]); v.y = pk2(p[2], p[3]);
        *(LAS u32x2*)(P0 + (m0 >> 7) * 32768 + offb(ql, (m0 & 127) >> 3) + (m0 & 7) * 2) = v;
    }
    sum += __shfl_xor(sum, 16); sum += __shfl_xor(sum, 32);
    const float rinv = 1.0f / sum;
    for (int eh = 0; eh < 2; ++eh) {
        __syncthreads();
        load_kv_half(KV, kv, b, 1024 + hd * 256 + eh * 128, tid);
        __syncthreads();
        f32x4 aO[8];
#pragma unroll
        for (int mt = 0; mt < 8; ++mt) aO[mt] = (f32x4){0.f, 0.f, 0.f, 0.f};
#pragma unroll
        for (int kk = 0; kk < 8; ++kk) { const bf16x8 Yp = frag_row(P0 + (kk >> 2) * 32768, 16 * w, kk & 3, lane);
#pragma unroll
            for (int mt = 0; mt < 8; ++mt) aO[mt] = mfma16(frag_tr(KV, 32 * kk, 16 * mt, lane), Yp, aO[mt]); }
#pragma unroll
        for (int mt = 0; mt < 8; ++mt) { const int e = 16 * mt + 4 * (lane >> 4);
            u32x2 o; o.x = pk2(aO[mt][0] * rinv, aO[mt][1] * rinv); o.y = pk2(aO[mt][2] * rinv, aO[mt][3] * rinv);
            *(u32x2*)(O + qrow * DM + hd * 256 + eh * 128 + e) = o; }
    }
    __syncthreads();
}

DI void route_block(Frame& F, int blk) {
    const int tid = F.tid, lane = F.lane, w = F.wave;
    LAS float* wrg = (LAS float*)F.lds;
    LAS float* wre = (LAS float*)(F.lds + 16384);
    LAS int* tokE = (LAS int*)(F.lds + 147456);
    LAS int* tokR = tokE + 512;
    LAS int* wcnt = tokR + 512;
    LAS int* base = wcnt + 256;
    const float* x2 = F.out; float* rs3 = (float*)(F.ws + O_RS3); unsigned* tok = (unsigned*)(F.ws + O_TOK); int* ridx = (int*)(F.ws + O_RIDX);
    unsigned* cnt = (unsigned*)(F.ws + O_CTL) + CW_CNT;
    const float brg0 = F.in[I_BRG][0], brg1 = F.in[I_BRG][1], brg2 = F.in[I_BRG][2], brg3 = F.in[I_BRG][3];
    for (int rl = 32 * w; rl < 32 * w + 32; ++rl) {
        const int m = blk * 256 + rl;
        const f32x4* xr = (const f32x4*)(x2 + (size_t)m * DM) + lane;
        f32x4 v[4]; float s = 0.f;
#pragma unroll
        for (int j = 0; j < 4; ++j) { v[j] = xr[64 * j]; s += (v[j].x * v[j].x + v[j].y * v[j].y) + (v[j].z * v[j].z + v[j].w * v[j].w); }
        const float rs = 1.0f / sqrtf(wave_sum(s) * (1.f / DM) + RMS_EPS);
        f32x4 pg = (f32x4){0.f, 0.f, 0.f, 0.f};
#pragma unroll
        for (int jj = 0; jj < 4; ++jj)
#pragma unroll
            for (int ii = 0; ii < 4; ++ii) pg += *(const LAS f32x4*)(wrg + (((jj * 4 + ii) * 64 + lane) << 2)) * v[jj][ii];
        const float l0 = wave_sum(pg.x) * rs + brg0, l1 = wave_sum(pg.y) * rs + brg1, l2 = wave_sum(pg.z) * rs + brg2, l3 = wave_sum(pg.w) * rs + brg3;
        int gi = 0; float lm = l0;
        if (l1 > lm) { lm = l1; gi = 1; } if (l2 > lm) { lm = l2; gi = 2; } if (l3 > lm) { lm = l3; gi = 3; }
        const float ptop = 1.0f / (__expf(l0 - lm) + __expf(l1 - lm) + __expf(l2 - lm) + __expf(l3 - lm));
        gi = __builtin_amdgcn_readfirstlane(gi);
        f32x4 pa = (f32x4){0.f, 0.f, 0.f, 0.f}, pb = (f32x4){0.f, 0.f, 0.f, 0.f};
        const LAS float* wg = wre + (size_t)gi * (16 * 2 * 64 * 4);
#pragma unroll
        for (int jj = 0; jj < 4; ++jj)
#pragma unroll
            for (int ii = 0; ii < 4; ++ii) { const float xv = v[jj][ii]; pa += *(const LAS f32x4*)(wg + ((((jj * 4 + ii) * 2 + 0) * 64 + lane) << 2)) * xv; pb += *(const LAS f32x4*)(wg + ((((jj * 4 + ii) * 2 + 1) * 64 + lane) << 2)) * xv; }
        float le[8];
        le[0] = wave_sum(pa.x); le[1] = wave_sum(pa.y); le[2] = wave_sum(pa.z); le[3] = wave_sum(pa.w); le[4] = wave_sum(pb.x); le[5] = wave_sum(pb.y); le[6] = wave_sum(pb.z); le[7] = wave_sum(pb.w);
#pragma unroll
        for (int j = 0; j < 8; ++j) le[j] = le[j] * rs + F.in[I_BRE][gi * 8 + j];
        int e0 = 0; float m0 = le[0];
#pragma unroll
        for (int j = 1; j < 8; ++j) if (le[j] > m0) { m0 = le[j]; e0 = j; }
        int e1 = -1; float m1 = -3.0e38f;
#pragma unroll
        for (int j = 0; j < 8; ++j) if (j != e0 && le[j] > m1) { m1 = le[j]; e1 = j; }
        const float t = __expf(m1 - m0), w0 = ptop / (1.0f + t), w1 = ptop * t / (1.0f + t);
        if (lane == 0) { tokE[2 * rl] = gi * 8 + e0; tokE[2 * rl + 1] = gi * 8 + e1; rs3[m] = rs;
            tok[(size_t)m * 8 + 4] = __builtin_bit_cast(unsigned, w0); tok[(size_t)m * 8 + 5] = __builtin_bit_cast(unsigned, w1); }
    }
    __syncthreads();
    {
        const int myE = tokE[tid]; int myR = 0;
        for (int e = 0; e < 32; ++e) { const unsigned long long mk = __ballot(myE == e); if (myE == e) myR = __popcll(mk & ((1ull << lane) - 1ull)); if (lane == 0) wcnt[w * 32 + e] = __popcll(mk); }
        __syncthreads();
        int add = 0;
        for (int ww = 0; ww < w; ++ww) add += wcnt[ww * 32 + myE];
        tokR[tid] = myR + add;
        if (tid < 32) { int tot = 0; for (int ww = 0; ww < 8; ++ww) tot += wcnt[ww * 32 + tid]; base[tid] = (int)__hip_atomic_fetch_add(cnt + tid, (unsigned)tot, __ATOMIC_RELAXED, __HIP_MEMORY_SCOPE_AGENT); }
        __syncthreads();
        const int pos = base[myE] + tokR[tid], m = blk * 256 + (tid >> 1);
        ridx[(size_t)myE * NTOK + pos] = m;
        tok[(size_t)m * 8 + (tid & 1) * 2 + 0] = (unsigned)myE; tok[(size_t)m * 8 + (tid & 1) * 2 + 1] = (unsigned)pos;
    }
    __syncthreads();
}
DI void phase8(Frame& F) {
    LAS float* wrg = (LAS float*)F.lds; LAS float* wre = (LAS float*)(F.lds + 16384);
    const float* gm = F.in[I_GMOE];
    for (int idx = F.tid; idx < 1024 * 4; idx += NTHR) { const int i = idx >> 2, j = idx & 3; const int jj = i >> 8, l = (i & 255) >> 2, ii = i & 3;
        wrg[(((jj * 4 + ii) * 64 + l) << 2) + j] = F.in[I_WRG][idx] * gm[i]; }
    for (int idx = F.tid; idx < 1024 * 32; idx += NTHR) { const int i = idx >> 5, j = idx & 31; const int jj = i >> 8, l = (i & 255) >> 2, ii = i & 3, g = j >> 3, hh = (j & 7) >> 2, jr = j & 3;
        wre[((((g * 16 + (jj * 4 + ii)) * 2 + hh) * 64 + l) << 2) + jr] = F.in[I_WRE][idx] * gm[i]; }
    __syncthreads();
    for (int blk = F.bid; blk < NTOK / 256; blk += F.G) route_block(F, blk);
}

DI void moe_tables(Frame& F, LAS int*& cum, LAS int*& cntl) {
    cum = (LAS int*)(F.lds + 131072); cntl = cum + 64;
    const unsigned* cnt = (const unsigned*)(F.ws + O_CTL) + CW_CNT;
    if (F.tid < 32) cntl[F.tid] = (int)__hip_atomic_load(cnt + F.tid, __ATOMIC_RELAXED, __HIP_MEMORY_SCOPE_AGENT);
    __syncthreads();
    if (F.tid == 0) { int a = 0; for (int e = 0; e < 32; ++e) { cum[e] = a; a += (cntl[e] + 255) >> 8; } cum[32] = a; }
    __syncthreads();
}

DI void phase11(Frame& F) {
    LAS int* cum; LAS int* cntl; moe_tables(F, cum, cntl);
    const int gw = F.bid * NWAVES + F.wave, NGW = F.G * NWAVES, lane = F.lane;
    const unsigned* tok = (const unsigned*)(F.ws + O_TOK); const bf16* YD = (const bf16*)(F.ws + O_YD);
    f32x4 gfin[4];
#pragma unroll
    for (int j = 0; j < 4; ++j) gfin[j] = ((const f32x4*)F.in[I_GFINAL])[lane + 64 * j];
    for (int m = gw; m < NTOK; m += NGW) {
        const u32x4 ti = *(const u32x4*)(tok + (size_t)m * 8); const unsigned tw0 = tok[(size_t)m * 8 + 4], tw1 = tok[(size_t)m * 8 + 5];
        const size_t s0 = (size_t)cum[ti.x] * 256 + ti.y, s1 = (size_t)cum[ti.z] * 256 + ti.w;
        const float w0 = __uint_as_float(tw0), w1 = __uint_as_float(tw1);
        f32x4* xr = (f32x4*)(F.out + (size_t)m * DM) + lane;
        const u32x2* y0 = (const u32x2*)(YD + s0 * DM) + lane; const u32x2* y1 = (const u32x2*)(YD + s1 * DM) + lane;
        f32x4 v[4]; float s = 0.f;
#pragma unroll
        for (int j = 0; j < 4; ++j) { const u32x2 a = y0[64 * j], bq = y1[64 * j];
            f32x4 mo; mo.x = w0 * bflo(a.x) + w1 * bflo(bq.x); mo.y = w0 * bfhi(a.x) + w1 * bfhi(bq.x); mo.z = w0 * bflo(a.y) + w1 * bflo(bq.y); mo.w = w0 * bfhi(a.y) + w1 * bfhi(bq.y);
            v[j] = xr[64 * j] + mo; s += (v[j].x * v[j].x + v[j].y * v[j].y) + (v[j].z * v[j].z + v[j].w * v[j].w); }
        const float rs = 1.0f / sqrtf(wave_sum(s) * (1.f / DM) + RMS_EPS);
#pragma unroll
        for (int j = 0; j < 4; ++j) xr[64 * j] = v[j] * rs * gfin[j];
    }
}
#define GAS __attribute__((address_space(1)))
typedef GAS unsigned gu32;
#define RLX_AGENT __ATOMIC_RELAXED, __HIP_MEMORY_SCOPE_AGENT
#define XB_TMO      128
#define XB_XCNT(j)  (256  + 64 * (j))
#define XB_XSUB(j)  (1280 + 64 * (j))
#define XB_XGEN(j)  (2304 + 64 * (j))
#define XB_TOP      3328
#define XB_TOPGEN   3392
#define XCD_BAR_WORDS 3456
#define XB_SPIN_CAP (1u << 18)

__device__ __forceinline__ unsigned xb_ld(unsigned* p)              { return __hip_atomic_load(p, __ATOMIC_RELAXED, __HIP_MEMORY_SCOPE_AGENT); }
__device__ __forceinline__ unsigned xb_add(unsigned* p, unsigned v) { return __hip_atomic_fetch_add(p, v, __ATOMIC_RELAXED, __HIP_MEMORY_SCOPE_AGENT); }
__device__ __forceinline__ unsigned xb_xcc_id() { return (unsigned)__builtin_amdgcn_s_getreg((3 << 11) | 20) & 0xFu; }
#define XB_SPIN(cond, bar) do { unsigned _sp = 0; while (cond) { __builtin_amdgcn_s_sleep(1); \
    if ((++_sp & 255u) == 0u) { if (xb_ld(&(bar)[XB_TMO])) break; if (_sp > XB_SPIN_CAP) { atomicAdd(&(bar)[XB_TMO], 1u); break; } } } } while (0)

struct XcdBarrier {
    unsigned* bar; unsigned x;
    volatile LAS unsigned* st;
};

__device__ __forceinline__ XcdBarrier xcd_barrier_post(unsigned* bar, volatile LAS unsigned* st) {
    XcdBarrier b; b.bar = bar; b.x = xb_xcc_id(); b.st = st;
    if (threadIdx.x == 0) (void)xb_add(&bar[XB_XCNT(b.x)], 1u);
    return b;
}
__device__ __forceinline__ void xcd_barrier_complete(unsigned* bar, unsigned x, unsigned& nloc, unsigned& nx) {
    const unsigned G = gridDim.x * gridDim.y * gridDim.z;
    unsigned sum, cnt, mine, sp = 0u;
    for (;;) {
        sum = 0u; cnt = 0u; mine = 0u;
#pragma unroll
        for (unsigned j = 0; j < 16; ++j) { const unsigned c = xb_ld(&bar[XB_XCNT(j)]); sum += c; cnt += (c > 0u) ? 1u : 0u; mine = (j == x) ? c : mine; }
        if (sum == G) break;
        __builtin_amdgcn_s_sleep(1);
        if ((++sp & 255u) == 0u) { if (xb_ld(&bar[XB_TMO])) break; if (sp > XB_SPIN_CAP) { atomicAdd(&bar[XB_TMO], 1u); break; } }
    }
    nloc = mine > 0u ? mine : 1u; nx = cnt > 0u ? cnt : 1u;
}

__device__ __forceinline__ void xcd_barrier(const XcdBarrier& b) {
    asm volatile("s_waitcnt vmcnt(0)" ::: "memory");
    __syncthreads();
    if (threadIdx.x == 0) {
        unsigned* bar = b.bar;
        __builtin_amdgcn_s_waitcnt(0);
        unsigned nloc = b.st[0], nx = b.st[1];
        if (nloc == 0u) { xcd_barrier_complete(bar, b.x, nloc, nx); b.st[0] = nloc; b.st[1] = nx; }
        const unsigned old = xb_add(&bar[XB_XSUB(b.x)], 1u);
        const unsigned gen = old / nloc;
        if (old + 1u == (gen + 1u) * nloc) {
            __builtin_amdgcn_fence(__ATOMIC_RELEASE, "agent");
            asm volatile("s_waitcnt vmcnt(0)" ::: "memory");
            const unsigned og = xb_add(&bar[XB_TOP], 1u);
            const unsigned tg = og / nx;
            if (og + 1u == (tg + 1u) * nx) xb_add(&bar[XB_TOPGEN], 1u);
            else XB_SPIN(xb_ld(&bar[XB_TOPGEN]) == tg, bar);
            __builtin_amdgcn_fence(__ATOMIC_ACQUIRE, "agent");
            xb_add(&bar[XB_XGEN(b.x)], 1u);
            asm volatile("s_waitcnt vmcnt(0)" ::: "memory");
        } else {
            XB_SPIN(xb_ld(&bar[XB_XGEN(b.x)]) == gen, bar);
            __builtin_amdgcn_fence(__ATOMIC_ACQUIRE, "agent");
            asm volatile("s_waitcnt vmcnt(0)" ::: "memory");
        }
    }
    __syncthreads();
}

#ifndef MK_N_LAUNCHES
#define MK_N_LAUNCHES 1
#endif
constexpr int N_PHASES = 12;

__global__ void __launch_bounds__(NTHR, 2) hybrid_fwd(Args args) {
    extern __shared__ __attribute__((aligned(16))) uchar lds_raw[];
    Frame F;
    F.lds = (LAS uchar*)lds_raw;
    F.tid = threadIdx.x; F.lane = F.tid & 63; F.wave = __builtin_amdgcn_readfirstlane(F.tid >> 6);
    F.G = gridDim.x; F.bid = blockIdx.x;
    F.in = args.in;
    F.out = args.out; F.ws = args.ws;
    uchar* ws = args.ws;
    const int lo = args.ph_lo, hi = args.ph_hi;
    volatile LAS unsigned* MISC = (volatile LAS unsigned*)(F.lds + LDS_BYTES - 256);
    if (F.tid < 64) MISC[F.tid] = 0u;
    __syncthreads();
    XcdBarrier bar; bar.bar = (unsigned*)(args.ws + O_CTL) + CW_BAR; bar.x = 0; bar.st = MISC + 8;
    if (hi - lo > 1) bar = xcd_barrier_post((unsigned*)(args.ws + O_CTL) + CW_BAR, MISC + 8);
#ifndef PHASE_MASK
#define PHASE_MASK 0xFFF
#endif
#define IN(k) (((PHASE_MASK >> (k)) & 1) && lo <= (k) && (k) < hi)
#define OPQ() do { uchar* w_ = args.ws; float* o_ = args.out; asm volatile("" : "+s"(w_), "+s"(o_)); ws = w_; F.ws = w_; F.out = o_; } while (0)
#define SEAM(k) do { OPQ(); if (lo <= (k) && (k) + 1 < hi) { xcd_barrier(bar); } } while (0)
    using pg8::Gemm; using pg8::StaticOrder; using pg8::gemm_phase;

    if (IN(0)) phase0(F);
    SEAM(0);
    if (IN(1)) {
        { Gemm g{(const bf16*)(ws + O_XB), (const bf16*)(ws + O_WIN), NTOK, ZC, DM}; StaticOrder S; S.init(NTOK, ZC, F.G, F.bid);
          EpiRowScale<0> E{(bf16*)(ws + O_Z), ZC, (const float*)(ws + O_RS0), 1.0f};
          gemm_phase<EpiRowScale<0>, StaticOrder, true, true, false>(F.lds, g, S, E); }
        { Gemm g{(const bf16*)(ws + O_MEMB), (const bf16*)(ws + O_WKV), NMROWS, 2048, DM}; StaticOrder S; S.init(NMROWS, 2048, F.G, F.bid);
          EpiRowScale<1> E{(bf16*)(ws + O_KV), 2048, (const float*)(ws + O_RSM), 1.0f};
          gemm_phase<EpiRowScale<1>, StaticOrder, true, true, false>(F.lds, g, S, E); }
    }
    SEAM(1);
    if (IN(2)) phase2(F);
    SEAM(2);
    if (IN(3)) { for (int u = F.bid; u < NB * 4 * 32; u += F.G) mlstm_out_unit(F, u); }
    SEAM(3);
    if (IN(4)) {
        Gemm g{(const bf16*)(ws + O_Y), (const bf16*)(ws + O_WOUT), NTOK, DM, DM}; StaticOrder S; S.init(NTOK, DM, F.G, F.bid);
        EpiRes<true> E{F.in[I_X], F.out, (bf16*)(ws + O_XB), (float*)(ws + O_SS1)};
        gemm_phase<EpiRes<true>, StaticOrder, true, true, false>(F.lds, g, S, E);
    }
    SEAM(4);
    if (IN(5)) {
        Gemm g{(const bf16*)(ws + O_XB), (const bf16*)(ws + O_WQ), NTOK, DM, DM}; StaticOrder S; S.init(NTOK, DM, F.G, F.bid);
        EpiQ E{(bf16*)(ws + O_Q), (const float*)(ws + O_SS1), 0.0625f};
        gemm_phase<EpiQ, StaticOrder, true, true, false>(F.lds, g, S, E);
    }
    SEAM(5);
    if (IN(6)) { for (int u = F.bid; u < NB * 4 * 32; u += F.G) attn_unit(F, u); }
    SEAM(6);
    if (IN(7)) {
        Gemm g{(const bf16*)(ws + O_O), (const bf16*)(ws + O_WO), NTOK, DM, DM}; StaticOrder S; S.init(NTOK, DM, F.G, F.bid);
        EpiRes<false> E{F.out, F.out, (bf16*)(ws + O_XB), nullptr};
        gemm_phase<EpiRes<false>, StaticOrder, true, true, false>(F.lds, g, S, E);
    }
    SEAM(7);
    if (IN(8)) phase8(F);
    SEAM(8);
    if (IN(9)) {
        LAS int* cum; LAS int* cntl; moe_tables(F, cum, cntl);
        MoeOrder S{cum, cntl, (const int*)(ws + O_RIDX), F.G, F.bid, false};
        Gemm g{(const bf16*)(ws + O_XB), (const bf16*)(ws + O_WGU), NTOK, NEXP * 1024, DM};
        EpiGU E{(bf16*)(ws + O_H), (const float*)(ws + O_RS3)};
        gemm_phase<EpiGU, MoeOrder, true, true, true>(F.lds, g, S, E);
    }
    SEAM(9);
    if (IN(10)) {
        LAS int* cum; LAS int* cntl; moe_tables(F, cum, cntl);
        MoeOrder S{cum, cntl, (const int*)(ws + O_RIDX), F.G, F.bid, true};
        Gemm g{(const bf16*)(ws + O_H), (const bf16*)(ws + O_WD), MAXSLOTS, NEXP * 1024, DEXP};
        EpiPlain E{(bf16*)(ws + O_YD), DM};
        gemm_phase<EpiPlain, MoeOrder, true, true, false>(F.lds, g, S, E);
    }
    SEAM(10);
    if (IN(11)) phase11(F);
#undef IN
#undef SEAM
}

extern "C" void kernel_launch(void* const* d_in, const int* in_sizes, int n_in, void* d_out, int out_size, void* d_ws, size_t ws_size, hipStream_t stream) {
    static int grid = 0;
    if (grid == 0) {
        if (n_in != 27 || in_sizes[0] != NTOK * DM || out_size != NTOK * DM || ws_size < WS_NEED) { fprintf(stderr, "kernel_launch: unexpected shapes (n_in %d, in0 %d, out %d, ws %zu); nothing launched\n", n_in, n_in > 0 ? in_sizes[0] : -1, out_size, ws_size); grid = -1; return; }
        int dev = 0, cus = 0, per_cu = 0;
        if (hipGetDevice(&dev) != hipSuccess || hipDeviceGetAttribute(&cus, hipDeviceAttributeMultiprocessorCount, dev) != hipSuccess) { fprintf(stderr, "kernel_launch: device query failed\n"); grid = -1; return; }
        if (hipFuncSetAttribute((const void*)hybrid_fwd, hipFuncAttributeMaxDynamicSharedMemorySize, LDS_BYTES) != hipSuccess) { fprintf(stderr, "kernel_launch: hipFuncSetAttribute failed\n"); grid = -1; return; }
        if (hipOccupancyMaxActiveBlocksPerMultiprocessor(&per_cu, (const void*)hybrid_fwd, NTHR, LDS_BYTES) != hipSuccess || per_cu < 1) { fprintf(stderr, "kernel_launch: occupancy query says %d\n", per_cu); per_cu = 1; }
        (void)hipGetLastError();
        grid = cus * per_cu;
        if (grid > 256) grid = 256;
    }
    if (grid < 0) return;
    (void)hipMemsetAsync((char*)d_ws + O_CTL, 0, CTL_BYTES, stream);
    Args a{};
    for (int i = 0; i < 27; ++i) a.in[i] = (const float*)d_in[i];
    a.out = (float*)d_out; a.ws = (uchar*)d_ws;
#if MK_N_LAUNCHES == 1
    a.ph_lo = 0; a.ph_hi = N_PHASES;
    hipLaunchKernelGGL(hybrid_fwd, dim3(grid), dim3(NTHR), LDS_BYTES, stream, a);
#else
    for (int p = 0; p < N_PHASES; ++p) { a.ph_lo = p; a.ph_hi = p + 1; hipLaunchKernelGGL(hybrid_fwd, dim3(grid), dim3(NTHR), LDS_BYTES, stream, a); }
#endif
}
```

```cpp
#include <hip/hip_runtime.h>
#include <cstdio>
#include <cstdint>
#define MK_N_LAUNCHES 1
namespace pg8 {
#define PG8_LAS __attribute__((address_space(3)))
typedef unsigned short bf16_t;
typedef short bf16x8 __attribute__((ext_vector_type(8)));
typedef float f32x4 __attribute__((ext_vector_type(4)));
typedef unsigned u32x4 __attribute__((ext_vector_type(4)));
typedef unsigned u32x2 __attribute__((ext_vector_type(2)));
constexpr int BM = 256, BK = 64, HALF = 128, HTB = HALF * BK * 2  , STAGE_BYTES = 8 * HTB, NXCD = 8, WGM = 8;

__host__ __device__ __forceinline__ int lds_byte(int r, int c) { const int st = (r >> 4) * 2 + (c >> 5), rr = r & 15, cc = c & 31, ob = rr * 64 + cc * 2; return st * 1024 + (ob ^ (((ob >> 9) & 1) << 5)); }
__host__ __device__ __forceinline__ void stage_rc(int b, int& R, int& C) { const int st = b / 1024, sb = b % 1024, swz = sb ^ (((sb >> 9) & 1) << 5); R = (st >> 1) * 16 + swz / 64; C = (st & 1) * 32 + (swz % 64) / 2; }
__host__ __device__ __forceinline__ int perm32(int rho) { const int n = rho >> 4, i = rho & 15; return 8 * (i >> 2) + 4 * n + (i & 3); }

struct Unit { int pm, pn; const int* ridx; int nvalid; int orow, ocol, ex; };
struct Gemm { const bf16_t* A; const bf16_t* Bt; int M, N, K; };

struct StaticOrder {
    int nM, nN, nwg, G, c;
    __host__ __device__ void init(int M, int N, int G_, int c_) { nM = M / BM; nN = N / BM; nwg = nM * nN; G = G_; c = c_; }
    __host__ __device__ bool next(int i, Unit& u) const {
        const long L = (long)i * G + c; if (L >= nwg) return false;
        int wgid = (int)L; { const int q = nwg / NXCD, r = nwg % NXCD, xcd = wgid % NXCD, off = wgid / NXCD; wgid = (xcd < r ? xcd * (q + 1) : r * (q + 1) + (xcd - r) * q) + off; }
        const int nig = WGM * nN, gid = wgid / nig, fm = gid * WGM, gsz = (nM - fm) < WGM ? (nM - fm) : WGM;
        u.pm = fm + ((wgid % nig) % gsz); u.pn = (wgid % nig) / gsz; u.ridx = nullptr; u.nvalid = 256; u.orow = u.pm; u.ocol = u.pn * BM; u.ex = 0; return true;
    }
};

__device__ __forceinline__ unsigned cvt_pk_bf16(float lo, float hi) { unsigned r; asm volatile("v_cvt_pk_bf16_f32 %0, %1, %2" : "=v"(r) : "v"(lo), "v"(hi)); return r; }

template <class Epi, class Sched, bool ALIGN_EPI, bool SP2, bool GATHER>
__device__ __forceinline__ void gemm_phase(PG8_LAS unsigned char* lds, const Gemm g, const Sched& S, const Epi& E) {
    const int tid = threadIdx.x, wid = __builtin_amdgcn_readfirstlane(tid >> 6), lane = tid & 63, wr = wid >> 2, wc = wid & 3, fr = lane & 15, fq = lane >> 4;
    const int K = g.K, nt = K / BK;
    unsigned voffA[2], voffB[2];
#pragma unroll
    for (int i = 0; i < 2; ++i) { int R, C; stage_rc(tid * 16 + i * 8192, R, C); const int Rb = Epi::PERM ? ((R & ~31) + perm32(R & 31)) : R;
        voffA[i] = (unsigned)(R * K + C) * 2u; voffB[i] = (unsigned)(Rb * K + C) * 2u; }
    const size_t kstep = (size_t)(BK * 2);
    const size_t hstepB = (size_t)HALF * K * 2;
    const size_t hstepA = GATHER ? (size_t)0 : hstepB;
    const size_t tstep = 2 * hstepB;
    const unsigned ldsw = (unsigned)wid * 1024u;
    const int aoff = lds_byte(wr * 64 + fr, fq * 8), boff = lds_byte(wc * 32 + fr, fq * 8);
    unsigned vgC[2][2], vgN[2][2];
#define PG8_SA(b, h) (((b) * 2 + (h)) * HTB)
#define PG8_SB(b, h) ((4 + (b) * 2 + (h)) * HTB)
#define PG8_STAGE(bufoff, gbase, voff) do { _Pragma("unroll") for (int _i = 0; _i < 2; ++_i) \
        __builtin_amdgcn_global_load_lds((const unsigned*)((const char*)(gbase) + (voff)[_i]), (PG8_LAS unsigned*)(lds + (bufoff) + ldsw + _i * 8192), 16, 0, 0); } while (0)
#define PG8_STAGE_A(bufoff, gbase, h, nx) do { if constexpr (GATHER) { unsigned _v[2]; _v[0] = (nx) ? vgN[h][0] : vgC[h][0]; _v[1] = (nx) ? vgN[h][1] : vgC[h][1]; PG8_STAGE(bufoff, gbase, _v); } \
        else { PG8_STAGE(bufoff, (gbase) + (h) * hstepA, voffA); } } while (0)
#define PG8_GOFF(dst, u) do { _Pragma("unroll") for (int _h = 0; _h < 2; ++_h) _Pragma("unroll") for (int _i = 0; _i < 2; ++_i) { int _R, _C; stage_rc(tid * 16 + _i * 8192, _R, _C); int _r = _h * HALF + _R; _r = _r < (u).nvalid ? _r : (u).nvalid - 1; \
        dst[_h][_i] = (unsigned)(u).ridx[_r] * (unsigned)(K * 2) + (unsigned)(_C * 2); } } while (0)
#define PG8_LDA(dst, b, h) do { _Pragma("unroll") for (int m = 0; m < 4; ++m) _Pragma("unroll") for (int k = 0; k < 2; ++k) dst[m][k] = *(const PG8_LAS bf16x8*)(lds + PG8_SA(b, h) + aoff + m * 2048 + k * 1024); } while (0)
#define PG8_LDB(dst, b, h) do { _Pragma("unroll") for (int n = 0; n < 2; ++n) _Pragma("unroll") for (int k = 0; k < 2; ++k) dst[n][k] = *(const PG8_LAS bf16x8*)(lds + PG8_SB(b, h) + boff + n * 2048 + k * 1024); } while (0)
#define PG8_MMA(ai, bj, At, Bt) do { __builtin_amdgcn_s_setprio(1); _Pragma("unroll") for (int m = 0; m < 4; ++m) _Pragma("unroll") for (int n = 0; n < 2; ++n) _Pragma("unroll") for (int k = 0; k < 2; ++k) \
        acc[ai][bj][m][n] = __builtin_amdgcn_mfma_f32_16x16x32_bf16(Bt[n][k], At[m][k], acc[ai][bj][m][n], 0, 0, 0); __builtin_amdgcn_s_setprio(0); } while (0)
#define PG8_WAIT_V(n) asm volatile("s_waitcnt vmcnt(" #n ")" ::: "memory")
#define PG8_WAIT_L(n) asm volatile("s_waitcnt lgkmcnt(" #n ")" ::: "memory")
#define PG8_BAR __builtin_amdgcn_s_barrier()
#define PG8_SCHED __builtin_amdgcn_sched_barrier(0)
    Unit cur, nxt; int ui = 0;
    if (!S.next(0, cur)) return;
    f32x4 acc[2][2][4][2];
#pragma unroll
    for (int a = 0; a < 2; ++a)
#pragma unroll
        for (int b = 0; b < 2; ++b)
#pragma unroll
            for (int m = 0; m < 4; ++m)
#pragma unroll
                for (int n = 0; n < 2; ++n) acc[a][b][m][n] = (f32x4){0.f, 0.f, 0.f, 0.f};
    bf16x8 At[4][2], B0[2][2], B1[2][2];
    const char* cA = GATHER ? (const char*)g.A : (const char*)g.A + (size_t)cur.pm * tstep; const char* cB = (const char*)g.Bt + (size_t)cur.pn * tstep;
    if constexpr (GATHER) { PG8_GOFF(vgC, cur); }
    if constexpr (SP2) {
        PG8_STAGE(PG8_SB(0, 0), cB, voffB); PG8_STAGE(PG8_SB(0, 1), cB + hstepB, voffB); PG8_STAGE_A(PG8_SA(0, 0), cA, 0, false); PG8_STAGE_A(PG8_SA(0, 1), cA, 1, false);
        if (wr == 1) PG8_BAR;
        PG8_WAIT_V(2); PG8_BAR;
        PG8_STAGE(PG8_SB(1, 0), cB + kstep, voffB); PG8_STAGE_A(PG8_SA(1, 0), cA + kstep, 0, false); PG8_STAGE(PG8_SB(1, 1), cB + hstepB + kstep, voffB);
        PG8_WAIT_V(6); PG8_BAR;
    } else {
        PG8_STAGE(PG8_SB(0, 0), cB, voffB); PG8_STAGE_A(PG8_SA(0, 0), cA, 0, false); PG8_STAGE(PG8_SB(0, 1), cB + hstepB, voffB); PG8_STAGE_A(PG8_SA(0, 1), cA, 1, false);
        if (wr == 1) PG8_BAR;
        PG8_WAIT_V(4); PG8_BAR;
        PG8_STAGE(PG8_SB(1, 0), cB + kstep, voffB); PG8_STAGE_A(PG8_SA(1, 0), cA + kstep, 0, false); PG8_STAGE(PG8_SB(1, 1), cB + hstepB + kstep, voffB);
        PG8_WAIT_V(6); PG8_BAR;
    }
    for (;;) {
        const bool has_next = S.next(ui + 1, nxt);
        const char* nA = GATHER ? (const char*)g.A : (has_next ? (const char*)g.A + (size_t)nxt.pm * tstep : cA); const char* nB = has_next ? (const char*)g.Bt + (size_t)nxt.pn * tstep : cB;
        if constexpr (GATHER) { if (has_next) { PG8_GOFF(vgN, nxt); } else {
#pragma unroll
            for (int _h = 0; _h < 2; ++_h) { vgN[_h][0] = vgC[_h][0]; vgN[_h][1] = vgC[_h][1]; } } }
        for (int t = 0; t < nt; t += 2) {
            const bool last = (t == nt - 2);
            const char* a1 = cA + (size_t)(t + 1) * kstep;
            const char* a2 = last ? nA : cA + (size_t)(t + 2) * kstep; const char* b2 = last ? nB : cB + (size_t)(t + 2) * kstep;
            const char* a3 = a2 + kstep; const char* b3 = b2 + kstep;
            if constexpr (SP2) {
            PG8_LDB(B0, 0, 0); PG8_LDB(B1, 0, 1); PG8_SCHED; PG8_LDA(At, 0, 0); PG8_STAGE_A(PG8_SA(1, 1), a1, 1, false);
            PG8_WAIT_V(8); PG8_WAIT_L(0); PG8_BAR; PG8_MMA(0, 0, At, B0); PG8_MMA(0, 1, At, B1); PG8_BAR; PG8_SCHED;
            PG8_LDA(At, 0, 1); PG8_STAGE(PG8_SB(0, 0), b2, voffB); PG8_STAGE(PG8_SB(0, 1), b2 + hstepB, voffB); PG8_STAGE_A(PG8_SA(0, 0), a2, 0, last);
            PG8_WAIT_V(8); PG8_WAIT_L(0); PG8_BAR; PG8_MMA(1, 0, At, B0); PG8_MMA(1, 1, At, B1); PG8_BAR; PG8_SCHED;
            PG8_LDB(B0, 1, 0); PG8_LDB(B1, 1, 1); PG8_SCHED; PG8_LDA(At, 1, 0); PG8_STAGE_A(PG8_SA(0, 1), a2, 1, last);
            PG8_WAIT_V(8); PG8_WAIT_L(0); PG8_BAR; PG8_MMA(0, 0, At, B0); PG8_MMA(0, 1, At, B1); PG8_BAR; PG8_SCHED;
            PG8_LDA(At, 1, 1); PG8_STAGE(PG8_SB(1, 0), b3, voffB); PG8_STAGE(PG8_SB(1, 1), b3 + hstepB, voffB); PG8_STAGE_A(PG8_SA(1, 0), a3, 0, last);
            PG8_WAIT_V(8); PG8_WAIT_L(0); PG8_BAR; PG8_MMA(1, 0, At, B0); PG8_MMA(1, 1, At, B1); PG8_BAR; PG8_SCHED;
            } else {
            PG8_LDB(B0, 0, 0); PG8_SCHED; PG8_LDA(At, 0, 0); PG8_STAGE_A(PG8_SA(1, 1), a1, 1, false);
            PG8_WAIT_L(8); PG8_BAR; PG8_WAIT_L(0); PG8_MMA(0, 0, At, B0); PG8_BAR; PG8_SCHED;
            PG8_LDB(B1, 0, 1); PG8_STAGE(PG8_SB(0, 0), b2, voffB);
            PG8_BAR; PG8_WAIT_L(0); PG8_MMA(0, 1, At, B1); PG8_BAR;
            PG8_LDA(At, 0, 1); PG8_STAGE_A(PG8_SA(0, 0), a2, 0, last);
            PG8_BAR; PG8_WAIT_L(0); PG8_MMA(1, 0, At, B0); PG8_BAR; PG8_SCHED;
            PG8_STAGE(PG8_SB(0, 1), b2 + hstepB, voffB);
            PG8_WAIT_V(6); PG8_BAR; PG8_MMA(1, 1, At, B1); PG8_BAR;
            PG8_LDB(B0, 1, 0); PG8_SCHED; PG8_LDA(At, 1, 0); PG8_STAGE_A(PG8_SA(0, 1), a2, 1, last);
            PG8_WAIT_L(8); PG8_BAR; PG8_WAIT_L(0); PG8_MMA(0, 0, At, B0); PG8_BAR; PG8_SCHED;
            PG8_LDB(B1, 1, 1); PG8_STAGE(PG8_SB(1, 0), b3, voffB);
            PG8_BAR; PG8_WAIT_L(0); PG8_MMA(0, 1, At, B1); PG8_BAR;
            PG8_LDA(At, 1, 1); PG8_STAGE_A(PG8_SA(1, 0), a3, 0, last);
            PG8_BAR; PG8_WAIT_L(0); PG8_MMA(1, 0, At, B0); PG8_BAR; PG8_SCHED;
            PG8_STAGE(PG8_SB(1, 1), b3 + hstepB, voffB);
            PG8_WAIT_V(6); PG8_BAR; PG8_MMA(1, 1, At, B1); PG8_BAR;
            }
        }
        if constexpr (ALIGN_EPI) { if (wr == 0) PG8_BAR; }
        E(acc, cur, wr, wc, fr, fq);
        if (!has_next) break;
#pragma unroll
        for (int a = 0; a < 2; ++a)
#pragma unroll
            for (int b = 0; b < 2; ++b)
#pragma unroll
                for (int m = 0; m < 4; ++m)
#pragma unroll
                    for (int n = 0; n < 2; ++n) acc[a][b][m][n] = (f32x4){0.f, 0.f, 0.f, 0.f};
        cur = nxt; cA = nA; cB = nB; ++ui;
        if constexpr (GATHER) {
#pragma unroll
            for (int _h = 0; _h < 2; ++_h) { vgC[_h][0] = vgN[_h][0]; vgC[_h][1] = vgN[_h][1]; } }
        if constexpr (ALIGN_EPI) { if (wr == 1) PG8_BAR; }
    }
    PG8_WAIT_V(0);
    if constexpr (!ALIGN_EPI) { if (wr == 0) PG8_BAR; }
    PG8_BAR;
#undef PG8_SA
#undef PG8_SB
#undef PG8_STAGE
#undef PG8_STAGE_A
#undef PG8_GOFF
#undef PG8_LDA
#undef PG8_LDB
#undef PG8_MMA
#undef PG8_WAIT_V
#undef PG8_WAIT_L
#undef PG8_BAR
#undef PG8_SCHED
}
}
#define DI __device__ __forceinline__
#define LAS __attribute__((address_space(3)))
typedef unsigned short bf16;
typedef short bf16x8 __attribute__((ext_vector_type(8)));
typedef short s16x4 __attribute__((ext_vector_type(4)));
typedef float f32x4 __attribute__((ext_vector_type(4)));
typedef float f32x2 __attribute__((ext_vector_type(2)));
typedef unsigned u32x4 __attribute__((ext_vector_type(4)));
typedef unsigned u32x2 __attribute__((ext_vector_type(2)));
typedef unsigned char uchar;

constexpr int NB = 16, SEQ = 4096, DM = 1024, NTOK = NB * SEQ;
constexpr int NMEM = 256, NMROWS = NB * NMEM;
constexpr int ZC = 3072;
constexpr int NEXP = 32, DEXP = 512;
constexpr int MAXTILES = 544, MAXSLOTS = MAXTILES * 256;
constexpr float RMS_EPS = 1e-6f, LN_EPS = 1e-5f;
constexpr int NWAVES = 8, NTHR = 512;
constexpr int LDS_BYTES = 163840;

constexpr size_t MiB = 1u << 20;
constexpr size_t O_CTL = 0, CTL_BYTES = 1 * MiB;
constexpr size_t O_RS0 = 1 * MiB, O_RSM = O_RS0 + 256 * 1024, O_RS3 = O_RS0 + 512 * 1024;
constexpr size_t O_GATES = 2 * MiB;
constexpr size_t O_SS1 = 6 * MiB;
constexpr size_t O_TOK = 10 * MiB;
constexpr size_t O_RIDX = 12 * MiB;
constexpr size_t O_NST = 20 * MiB, O_MST = 22 * MiB;
constexpr size_t O_WSB = 23 * MiB;
constexpr size_t O_WIN = 32 * MiB, O_WOUT = 38 * MiB, O_WQ = 40 * MiB, O_WKV = 42 * MiB, O_WO = 46 * MiB, O_WGU = 48 * MiB, O_WD = 112 * MiB;
constexpr size_t O_XB = 160 * MiB;
constexpr size_t O_MEMB = 288 * MiB, O_KV = 296 * MiB;
constexpr size_t O_Z = 320 * MiB;
constexpr size_t O_CST = 704 * MiB;
constexpr size_t O_Y = 840 * MiB;
constexpr size_t O_Q = O_Z, O_O = O_Z + 128 * MiB;
constexpr size_t O_H = O_Z, O_YD = O_Z + 144 * MiB;
constexpr size_t WS_NEED = 968 * MiB;
constexpr int CW_CNT = 0, CW_BAR = 4096;
constexpr int CW_CNT_UNUSED = 0;

#define LDS_WAIT() asm volatile("s_waitcnt lgkmcnt(0)" ::: "memory")
DI unsigned f2bf(float f) { unsigned u = __builtin_bit_cast(unsigned, f); return (u + 0x7fffu + ((u >> 16) & 1u)) >> 16; }
DI unsigned pk2(float lo, float hi) { return pg8::cvt_pk_bf16(lo, hi); }
DI float bf2f(unsigned short h) { return __builtin_bit_cast(float, (unsigned)h << 16); }
DI float bflo(unsigned w) { return __builtin_bit_cast(float, w << 16); }
DI float bfhi(unsigned w) { return __builtin_bit_cast(float, w & 0xffff0000u); }
DI float wave_sum(float v) {
#pragma unroll
    for (int o = 1; o < 64; o <<= 1) v += __shfl_xor(v, o);
    return v;
}
DI float wave_max(float v) {
#pragma unroll
    for (int o = 1; o < 64; o <<= 1) v = fmaxf(v, __shfl_xor(v, o));
    return v;
}
DI float wscan_add(float v, int lane) {
#pragma unroll
    for (int o = 1; o < 64; o <<= 1) { const float u = __shfl_up(v, o); v = (lane >= o) ? v + u : v; }
    return v;
}
DI float wscan_max(float v, int lane) {
#pragma unroll
    for (int o = 1; o < 64; o <<= 1) { const float u = __shfl_up(v, o); v = (lane >= o) ? fmaxf(v, u) : v; }
    return v;
}
DI float wscan_max_rev(float v, int lane) {
#pragma unroll
    for (int o = 1; o < 64; o <<= 1) { const float u = __shfl_down(v, o); v = (lane + o < 64) ? fmaxf(v, u) : v; }
    return v;
}
DI float fast_exp(float x) { return __expf(x); }
DI float sigmoidf_(float x) { return 1.0f / (1.0f + __expf(-x)); }
DI float siluf_(float x) { return x / (1.0f + __expf(-x)); }
DI float gelu_tanh(float x) { const float u = 0.7978845608028654f * (x + 0.044715f * x * x * x); return x / (1.0f + __expf(-2.0f * u)); }
DI float log_sigmoid(float x) { return fminf(x, 0.f) - log1pf(__expf(-fabsf(x))); }

DI unsigned offb(unsigned row, unsigned ch) { return 256u * row + 16u * (ch ^ (((row & 3u) << 2) | ((row >> 2) & 3u))); }
DI bf16x8 frag_row(const LAS uchar* tile, int r0, int kk, int lane) { return *(const LAS bf16x8*)(tile + offb(r0 + (lane & 15), 4 * kk + (lane >> 4))); }
DI bf16x8 frag_tr(const LAS uchar* tile, int k0, int c0, int lane) {
    const unsigned g = lane >> 4, q = (lane & 15) >> 2, p = lane & 3;
    const unsigned ch = (c0 >> 3) + (p >> 1), bo = 8u * (p & 1);
    const s16x4 lo = __builtin_amdgcn_ds_read_tr16_b64_v4i16((LAS s16x4*)(tile + offb(k0 + 8 * g + q, ch) + bo));
    const s16x4 hi = __builtin_amdgcn_ds_read_tr16_b64_v4i16((LAS s16x4*)(tile + offb(k0 + 8 * g + 4 + q, ch) + bo));
    return (bf16x8){lo[0], lo[1], lo[2], lo[3], hi[0], hi[1], hi[2], hi[3]};
}
DI f32x4 mfma16(bf16x8 x, bf16x8 y, f32x4 acc) { return __builtin_amdgcn_mfma_f32_16x16x32_bf16(x, y, acc, 0, 0, 0); }

struct Args { const float* in[27]; float* out; uchar* ws; int ph_lo, ph_hi; };
struct Frame {
    LAS uchar* lds;
    int tid, lane, wave, G, bid;
    const float* const* in;
    float* out; uchar* ws;
};
enum { I_X = 0, I_MEM, I_GMIX, I_WIN, I_CONVW, I_CONVB, I_GATEB, I_GHEAD, I_LNVG, I_LNVB, I_WS, I_BS, I_WOUT, I_GXATTN, I_GMEM, I_WQ, I_WKV, I_WO, I_GMOE, I_WRG, I_BRG, I_WRE, I_BRE, I_WGATE, I_WUP, I_WDOWN, I_GFINAL };
DI void p0_transpose_item(const float* W, int K, int ldw, int scol0, bf16* WT, size_t drow0, const float* gain, LAS float* scr, int k0, int lane) {
#pragma unroll 8
    for (int i = 0; i < 32; ++i) { const int kk = 2 * i + (lane >> 5); float v = W[(size_t)(k0 + kk) * ldw + scol0 + (lane & 31)]; if (gain) v *= gain[k0 + kk]; scr[kk * 33 + (lane & 31)] = v; }
    LDS_WAIT(); asm volatile("" ::: "memory");
    const int c = lane & 7;
#pragma unroll
    for (int j = 0; j < 4; ++j) { const int n = (lane >> 3) + 8 * j; const LAS float* s = scr + (8 * c) * 33 + n;
        u32x4 o; o.x = pk2(s[0 * 33], s[1 * 33]); o.y = pk2(s[2 * 33], s[3 * 33]); o.z = pk2(s[4 * 33], s[5 * 33]); o.w = pk2(s[6 * 33], s[7 * 33]);
        *(u32x4*)(WT + (drow0 + n) * (size_t)K + k0 + 8 * c) = o; }
    LDS_WAIT(); asm volatile("" ::: "memory");
}

DI void phase0(Frame& F) {
    const int gw = F.bid * NWAVES + F.wave, NGW = F.G * NWAVES, lane = F.lane;
    uchar* ws = F.ws;
    {
        LAS float* scr = (LAS float*)(F.lds + F.wave * 16384);
        constexpr int I_IN = 16 * 96, I_SQ = 16 * 32, I_KV = 16 * 64, I_GU = 32 * 16 * 16, I_DN = 32 * 8 * 32;
        constexpr int NITEMS = I_IN + 3 * I_SQ + I_KV + 2 * I_GU + I_DN;
        for (int it = gw; it < NITEMS; it += NGW) {
            int r = it;
            if (r < I_IN) { const int kb = r / 96, nb = r % 96; const int sc = nb * 32 < 2048 ? nb * 32 : nb * 32 + 16;
                p0_transpose_item(F.in[I_WIN], 1024, 3088, sc, (bf16*)(ws + O_WIN), (size_t)nb * 32, F.in[I_GMIX], scr, kb * 64, lane); continue; } r -= I_IN;
            if (r < I_SQ) { const int kb = r / 32, nb = r % 32; p0_transpose_item(F.in[I_WOUT], 1024, 1024, nb * 32, (bf16*)(ws + O_WOUT), (size_t)nb * 32, nullptr, scr, kb * 64, lane); continue; } r -= I_SQ;
            if (r < I_SQ) { const int kb = r / 32, nb = r % 32; p0_transpose_item(F.in[I_WQ], 1024, 1024, nb * 32, (bf16*)(ws + O_WQ), (size_t)nb * 32, F.in[I_GXATTN], scr, kb * 64, lane); continue; } r -= I_SQ;
            if (r < I_KV) { const int kb = r / 64, nb = r % 64; p0_transpose_item(F.in[I_WKV], 1024, 2048, nb * 32, (bf16*)(ws + O_WKV), (size_t)nb * 32, F.in[I_GMEM], scr, kb * 64, lane); continue; } r -= I_KV;
            if (r < I_SQ) { const int kb = r / 32, nb = r % 32; p0_transpose_item(F.in[I_WO], 1024, 1024, nb * 32, (bf16*)(ws + O_WO), (size_t)nb * 32, nullptr, scr, kb * 64, lane); continue; } r -= I_SQ;
            if (r < 2 * I_GU) { const int up = r >= I_GU; if (up) r -= I_GU; const int e = r / 256, q = r % 256, kb = q / 16, nb = q % 16;
                const float* W = F.in[up ? I_WUP : I_WGATE] + (size_t)e * 1024 * 512;
                const size_t drow = (size_t)e * 1024 + 256 * (nb / 4) + (up ? 128 : 0) + (nb % 4) * 32;
                p0_transpose_item(W, 1024, 512, nb * 32, (bf16*)(ws + O_WGU), drow, F.in[I_GMOE], scr, kb * 64, lane); continue; } r -= 2 * I_GU;
            { const int e = r / 256, q = r % 256, kb = q / 32, nb = q % 32;
                p0_transpose_item(F.in[I_WDOWN] + (size_t)e * 512 * 1024, 512, 1024, nb * 32, (bf16*)(ws + O_WD), (size_t)e * 1024 + nb * 32, nullptr, scr, kb * 64, lane); }
        }
        for (int i = F.bid * NTHR + F.tid; i < 4 * 128 * 128 / 2; i += F.G * NTHR) { const f32x2 v = *(const f32x2*)(F.in[I_WS] + 2 * i); ((unsigned*)(ws + O_WSB))[i] = pk2(v.x, v.y); }
    }
    __syncthreads();
    LAS float* wg = (LAS float*)F.lds;
    for (int idx = F.tid; idx < 1024 * 16; idx += NTHR) { const int i = idx >> 4, j = idx & 15; const float v = F.in[I_WIN][(size_t)i * 3088 + 2048 + j] * F.in[I_GMIX][i];
        const int jj = i >> 8, l = (i & 255) >> 2, ii = i & 3, j4 = j >> 2, jr = j & 3; wg[((((jj * 4 + ii) * 4 + j4) * 64 + l) << 2) + jr] = v; }
    __syncthreads();
    {
        bf16* XB = (bf16*)(ws + O_XB); float* rs0 = (float*)(ws + O_RS0); float* gates = (float*)(ws + O_GATES);
        const float gb = F.in[I_GATEB][lane >> 2];
        for (int m = gw; m < NTOK; m += NGW) {
            const f32x4* xr = (const f32x4*)(F.in[I_X] + (size_t)m * DM) + lane;
            f32x4 v[4]; float s = 0.f;
#pragma unroll
            for (int j = 0; j < 4; ++j) { v[j] = xr[64 * j]; s += (v[j].x * v[j].x + v[j].y * v[j].y) + (v[j].z * v[j].z + v[j].w * v[j].w); }
            const float rs = 1.0f / sqrtf(wave_sum(s) * (1.f / DM) + RMS_EPS);
            unsigned long long* o8 = (unsigned long long*)(XB + (size_t)m * DM) + lane;
#pragma unroll
            for (int j = 0; j < 4; ++j) o8[64 * j] = (unsigned long long)pk2(v[j].x, v[j].y) | ((unsigned long long)pk2(v[j].z, v[j].w) << 32);
            float p[16];
#pragma unroll
            for (int j = 0; j < 16; ++j) p[j] = 0.f;
#pragma unroll
            for (int jj = 0; jj < 4; ++jj)
#pragma unroll
                for (int ii = 0; ii < 4; ++ii) { const float xv = v[jj][ii];
#pragma unroll
                    for (int j4 = 0; j4 < 4; ++j4) { const f32x4 w = *(const LAS f32x4*)(wg + ((((jj * 4 + ii) * 4 + j4) * 64 + lane) << 2));
                        p[4 * j4 + 0] += xv * w.x; p[4 * j4 + 1] += xv * w.y; p[4 * j4 + 2] += xv * w.z; p[4 * j4 + 3] += xv * w.w; } }
            float q8[8], q4[4], q2[2], q1;
            { const bool hi = (lane & 32) != 0;
#pragma unroll
              for (int k = 0; k < 8; ++k) { const float send = hi ? p[k] : p[k + 8], keep = hi ? p[k + 8] : p[k]; q8[k] = keep + __shfl_xor(send, 32); } }
            { const bool hi = (lane & 16) != 0;
#pragma unroll
              for (int k = 0; k < 4; ++k) { const float send = hi ? q8[k] : q8[k + 4], keep = hi ? q8[k + 4] : q8[k]; q4[k] = keep + __shfl_xor(send, 16); } }
            { const bool hi = (lane & 8) != 0;
#pragma unroll
              for (int k = 0; k < 2; ++k) { const float send = hi ? q4[k] : q4[k + 2], keep = hi ? q4[k + 2] : q4[k]; q2[k] = keep + __shfl_xor(send, 8); } }
            { const bool hi = (lane & 4) != 0; const float send = hi ? q2[0] : q2[1], keep = hi ? q2[1] : q2[0]; q1 = keep + __shfl_xor(send, 4); }
            q1 += __shfl_xor(q1, 2); q1 += __shfl_xor(q1, 1);
            if ((lane & 3) == 0) gates[(size_t)m * 16 + (lane >> 2)] = q1 * rs + gb;
            if (lane == 0) rs0[m] = rs;
        }
    }
    {
        bf16* MB = (bf16*)(ws + O_MEMB); float* rsm = (float*)(ws + O_RSM);
        for (int m = gw; m < NMROWS; m += NGW) {
            const f32x4* xr = (const f32x4*)(F.in[I_MEM] + (size_t)m * DM) + lane;
            f32x4 v[4]; float s = 0.f;
#pragma unroll
            for (int j = 0; j < 4; ++j) { v[j] = xr[64 * j]; s += (v[j].x * v[j].x + v[j].y * v[j].y) + (v[j].z * v[j].z + v[j].w * v[j].w); }
            const float rs = 1.0f / sqrtf(wave_sum(s) * (1.f / DM) + RMS_EPS);
            unsigned long long* o8 = (unsigned long long*)(MB + (size_t)m * DM) + lane;
#pragma unroll
            for (int j = 0; j < 4; ++j) o8[64 * j] = (unsigned long long)pk2(v[j].x, v[j].y) | ((unsigned long long)pk2(v[j].z, v[j].w) << 32);
            if (lane == 0) rsm[m] = rs;
        }
    }
}
using pg8::Unit;
typedef const f32x4 (&AccRef)[2][2][4][2];

template <int MODE> struct EpiRowScale {
    static constexpr bool PERM = true;
    bf16* O; int ldc; const float* rs; float extra;
    DI void operator()(AccRef acc, const Unit& u, int wr, int wc, int fr, int fq) const {
        const int row0 = u.orow * 256 + wr * 64 + fr, col0 = u.ocol + wc * 32 + 8 * fq;
        const int act = (MODE == 0) ? (u.pn >= 8 ? 2 : (u.pn >= 6 ? 1 : 0)) : 0;
#pragma unroll
        for (int ai = 0; ai < 2; ++ai)
#pragma unroll
            for (int m = 0; m < 4; ++m) { const int row = row0 + ai * 128 + m * 16; const float s = rs[row] * extra; bf16* rowp = O + (size_t)row * ldc + col0;
#pragma unroll
                for (int bj = 0; bj < 2; ++bj) { f32x4 v0 = acc[ai][bj][m][0] * s, v1 = acc[ai][bj][m][1] * s;
                    if (act == 1) {
#pragma unroll
                        for (int j = 0; j < 4; ++j) { v0[j] = sigmoidf_(v0[j]); v1[j] = sigmoidf_(v1[j]); } }
                    else if (act == 2) {
#pragma unroll
                        for (int j = 0; j < 4; ++j) { v0[j] = gelu_tanh(v0[j]); v1[j] = gelu_tanh(v1[j]); } }
                    u32x4 w; w.x = pk2(v0[0], v0[1]); w.y = pk2(v0[2], v0[3]); w.z = pk2(v1[0], v1[1]); w.w = pk2(v1[2], v1[3]);
                    *(u32x4*)(rowp + bj * 128) = w; } }
    }
};
struct EpiQ {
    static constexpr bool PERM = true;
    bf16* O; const float* ssp; float extra;
    DI void operator()(AccRef acc, const Unit& u, int wr, int wc, int fr, int fq) const {
        const int row0 = u.orow * 256 + wr * 64 + fr, col0 = u.ocol + wc * 32 + 8 * fq;
#pragma unroll
        for (int ai = 0; ai < 2; ++ai)
#pragma unroll
            for (int m = 0; m < 4; ++m) { const int row = row0 + ai * 128 + m * 16; const f32x4* sp = (const f32x4*)(ssp + (size_t)row * 16);
                const f32x4 a = sp[0], b = sp[1], c = sp[2], d = sp[3];
                const float ss = (((a.x + a.y) + (a.z + a.w)) + ((b.x + b.y) + (b.z + b.w))) + (((c.x + c.y) + (c.z + c.w)) + ((d.x + d.y) + (d.z + d.w)));
                const float s = extra / sqrtf(ss * (1.f / DM) + RMS_EPS); bf16* rowp = O + (size_t)row * DM + col0;
#pragma unroll
                for (int bj = 0; bj < 2; ++bj) { const f32x4 v0 = acc[ai][bj][m][0] * s, v1 = acc[ai][bj][m][1] * s;
                    u32x4 w; w.x = pk2(v0[0], v0[1]); w.y = pk2(v0[2], v0[3]); w.z = pk2(v1[0], v1[1]); w.w = pk2(v1[2], v1[3]);
                    *(u32x4*)(rowp + bj * 128) = w; } }
    }
};
template <bool SS> struct EpiRes {
    static constexpr bool PERM = false;
    const float* base; float* out; bf16* xb; float* ssp;
    DI void operator()(AccRef acc, const Unit& u, int wr, int wc, int fr, int fq) const {
        const int row0 = u.orow * 256 + wr * 64 + fr, col0 = u.ocol + wc * 32 + 4 * fq;
#pragma unroll
        for (int ai = 0; ai < 2; ++ai)
#pragma unroll
            for (int m = 0; m < 4; ++m) { const int row = row0 + ai * 128 + m * 16; const size_t off = (size_t)row * DM + col0; float q = 0.f;
#pragma unroll
                for (int bj = 0; bj < 2; ++bj)
#pragma unroll
                    for (int n = 0; n < 2; ++n) { const size_t o2 = off + bj * 128 + n * 16; const f32x4 v = *(const f32x4*)(base + o2) + acc[ai][bj][m][n];
                        *(f32x4*)(out + o2) = v; u32x2 w; w.x = pk2(v[0], v[1]); w.y = pk2(v[2], v[3]); *(u32x2*)(xb + o2) = w;
                        if (SS) q += (v[0] * v[0] + v[1] * v[1]) + (v[2] * v[2] + v[3] * v[3]); }
                if (SS) { q += __shfl_xor(q, 16); q += __shfl_xor(q, 32); if (fq == 0) ssp[(size_t)row * 16 + u.pn * 4 + wc] = q; } }
    }
};
struct EpiGU {
    static constexpr bool PERM = true;
    bf16* H; const float* rs3;
    DI void operator()(AccRef acc, const Unit& u, int wr, int wc, int fr, int fq) const {
        const int rl0 = wr * 64 + fr, col0 = u.ocol + wc * 32 + 8 * fq;
#pragma unroll
        for (int ai = 0; ai < 2; ++ai)
#pragma unroll
            for (int m = 0; m < 4; ++m) { const int rl = rl0 + ai * 128 + m * 16; const int rc = rl < u.nvalid ? rl : u.nvalid - 1; const float s = rs3[u.ridx[rc]];
                bf16* rowp = H + (size_t)(u.orow * 256 + rl) * DEXP + col0;
                f32x4 h0, h1;
#pragma unroll
                for (int j = 0; j < 4; ++j) { h0[j] = siluf_(acc[ai][0][m][0][j] * s) * (acc[ai][1][m][0][j] * s); h1[j] = siluf_(acc[ai][0][m][1][j] * s) * (acc[ai][1][m][1][j] * s); }
                u32x4 w; w.x = pk2(h0[0], h0[1]); w.y = pk2(h0[2], h0[3]); w.z = pk2(h1[0], h1[1]); w.w = pk2(h1[2], h1[3]);
                *(u32x4*)rowp = w; }
    }
};
struct EpiPlain {
    static constexpr bool PERM = true;
    bf16* O; int ldc;
    DI void operator()(AccRef acc, const Unit& u, int wr, int wc, int fr, int fq) const {
        const int row0 = u.orow * 256 + wr * 64 + fr, col0 = u.ocol + wc * 32 + 8 * fq;
#pragma unroll
        for (int ai = 0; ai < 2; ++ai)
#pragma unroll
            for (int m = 0; m < 4; ++m) { bf16* rowp = O + (size_t)(row0 + ai * 128 + m * 16) * ldc + col0;
#pragma unroll
                for (int bj = 0; bj < 2; ++bj) { const f32x4 v0 = acc[ai][bj][m][0], v1 = acc[ai][bj][m][1];
                    u32x4 w; w.x = pk2(v0[0], v0[1]); w.y = pk2(v0[2], v0[3]); w.z = pk2(v1[0], v1[1]); w.w = pk2(v1[2], v1[3]);
                    *(u32x4*)(rowp + bj * 128) = w; } }
    }
};
struct MoeOrder {
    const LAS int* cum; const LAS int* cnt; const int* ridx; int G, c; bool down;
    DI bool next(int i, Unit& u) const {
        const int L = i * G + c, T = L >> 2, j = L & 3; if (T >= cum[32]) return false;
        int e = 0;
        for (int k = 1; k < 32; ++k) e += (cum[k] <= T) ? 1 : 0;
        const int mt = T - cum[e];
        u.ex = e; u.orow = T; u.nvalid = min(256, cnt[e] - mt * 256); u.ridx = ridx + (size_t)e * NTOK + mt * 256;
        if (down) { u.pm = T; u.pn = e * 4 + j; u.ocol = 256 * j; } else { u.pm = 0; u.pn = e * 4 + j; u.ocol = 128 * j; }
        return true;
    }
};
#define SFENCE() do { asm volatile("" ::: "memory"); __builtin_amdgcn_sched_barrier(0); } while (0)
DI void build_conv_tile(LAS uchar* tile, const bf16* z, int b, int c, int zcol0, const float* convw, const float* convb, float scale, const LAS float* wrow, int tid) {
    const int dg = tid & 15, sg = tid >> 4;
    float in[8][8];
#pragma unroll
    for (int r = 0; r < 8; ++r) { const int pos = c * 128 + 4 * sg - 2 + r; u32x4 raw = (u32x4){0u, 0u, 0u, 0u};
        if (pos >= 0 && pos < SEQ) raw = *(const u32x4*)(z + (size_t)(b * SEQ + pos) * ZC + zcol0 + 8 * dg);
        in[r][0] = bflo(raw.x); in[r][1] = bfhi(raw.x); in[r][2] = bflo(raw.y); in[r][3] = bfhi(raw.y); in[r][4] = bflo(raw.z); in[r][5] = bfhi(raw.z); in[r][6] = bflo(raw.w); in[r][7] = bfhi(raw.w); }
    float cw[5][8], cb[8];
#pragma unroll
    for (int j = 0; j < 5; ++j) { const f32x4 a = *(const f32x4*)(convw + j * 1024 + zcol0 + 8 * dg), bq = *(const f32x4*)(convw + j * 1024 + zcol0 + 8 * dg + 4);
        cw[j][0] = a.x; cw[j][1] = a.y; cw[j][2] = a.z; cw[j][3] = a.w; cw[j][4] = bq.x; cw[j][5] = bq.y; cw[j][6] = bq.z; cw[j][7] = bq.w; }
    { const f32x4 a = *(const f32x4*)(convb + zcol0 + 8 * dg), bq = *(const f32x4*)(convb + zcol0 + 8 * dg + 4);
        cb[0] = a.x; cb[1] = a.y; cb[2] = a.z; cb[3] = a.w; cb[4] = bq.x; cb[5] = bq.y; cb[6] = bq.z; cb[7] = bq.w; }
#pragma unroll
    for (int rr = 0; rr < 4; ++rr) { const float sc = wrow ? scale * wrow[4 * sg + rr] : scale; float o[8];
#pragma unroll
        for (int i = 0; i < 8; ++i) { float a = cb[i];
#pragma unroll
            for (int j = 0; j < 5; ++j) a += in[rr + j][i] * cw[j][i];
            o[i] = siluf_(a) * sc; }
        u32x4 w; w.x = pk2(o[0], o[1]); w.y = pk2(o[2], o[3]); w.z = pk2(o[4], o[5]); w.w = pk2(o[6], o[7]);
        *(LAS u32x4*)(tile + offb(4 * sg + rr, dg)) = w; }
}
DI void build_copy_tile(LAS uchar* tile, const bf16* src, size_t row0, int ld, int col0, int tid) {
    const int dg = tid & 15, sg = tid >> 4;
#pragma unroll
    for (int rr = 0; rr < 4; ++rr) { const int r = 4 * sg + rr; *(LAS u32x4*)(tile + offb(r, dg)) = *(const u32x4*)(src + (row0 + r) * (size_t)ld + col0 + 8 * dg); }
}

DI void mlstm_scan(Frame& F, int seq) {
    int tid = F.tid, lane = F.lane; const int w = F.wave;
    const int dir = seq & 1, h = (seq >> 1) & 3, b = seq >> 3;
    LAS uchar* T_KW = F.lds; LAS uchar* T_V = F.lds + 32768;
    LAS float* wrow = (LAS float*)(F.lds + 65536);
    LAS float* misc = (LAS float*)(F.lds + 65536 + 1024);
    const bf16* z = (const bf16*)(F.ws + O_Z); const float* gates = (const float*)(F.ws + O_GATES);
    bf16* cst = (bf16*)(F.ws + O_CST); float* nst = (float*)(F.ws + O_NST); float* mst = (float*)(F.ws + O_MST);
    const int d0 = 64 * (w & 1), e0 = 32 * (w >> 1);
    f32x4 acc[4][2], accn[4];
#pragma unroll
    for (int mt = 0; mt < 4; ++mt) { acc[mt][0] = (f32x4){0.f, 0.f, 0.f, 0.f}; acc[mt][1] = (f32x4){0.f, 0.f, 0.f, 0.f}; accn[mt] = (f32x4){0.f, 0.f, 0.f, 0.f}; }
    float mstate = -1e30f;
    const bf16x8 ones = (bf16x8){0x3F80, 0x3F80, 0x3F80, 0x3F80, 0x3F80, 0x3F80, 0x3F80, 0x3F80};
    for (int ci = 0; ci < 32; ++ci) {
        const int c = dir ? 31 - ci : ci, par = ci & 1;
        asm volatile("" : "+v"(tid), "+v"(lane));
        const size_t row0 = (size_t)b * SEQ + c * 128;
        if (w == 0) {
            const int gi = dir * 8 + h, gf = dir * 8 + 4 + h;
            const float ig0 = gates[(row0 + 2 * lane) * 16 + gi], ig1 = gates[(row0 + 2 * lane + 1) * 16 + gi];
            const float lf0 = log_sigmoid(gates[(row0 + 2 * lane) * 16 + gf]), lf1 = log_sigmoid(gates[(row0 + 2 * lane + 1) * 16 + gf]);
            const float incl = wscan_add(lf0 + lf1, lane);
            const float bf0 = incl - lf1, bf1 = incl, Ftot = __shfl(incl, 63);
            const float a0 = dir ? (bf0 - lf0 + ig0) : (Ftot - bf0 + ig0), a1 = dir ? (bf1 - lf1 + ig1) : (Ftot - bf1 + ig1);
            const float mloc = wave_max(fmaxf(a0, a1));
            const float mnew = fmaxf(Ftot + mstate, mloc);
            const float sc_old = __expf(Ftot + mstate - mnew);
            wrow[par * 128 + 2 * lane] = __expf(a0 - mnew); wrow[par * 128 + 2 * lane + 1] = __expf(a1 - mnew);
            if (lane == 0) { misc[par * 8 + 0] = sc_old; mst[seq * 32 + c] = mstate; }
            mstate = mnew;
        }
        __syncthreads();
        {
            bf16* cp = cst + ((size_t)seq * 32 + c) * 16384;
#pragma unroll
            for (int mt = 0; mt < 4; ++mt)
#pragma unroll
                for (int nt = 0; nt < 2; ++nt) { const int d = d0 + 16 * mt + 4 * (lane >> 4), e = e0 + 16 * nt + (lane & 15);
                    u32x2 v; v.x = pk2(acc[mt][nt][0], acc[mt][nt][1]); v.y = pk2(acc[mt][nt][2], acc[mt][nt][3]); *(u32x2*)(cp + e * 128 + d) = v; }
            if (w < 2 && (lane & 15) == 0) {
#pragma unroll
                for (int mt = 0; mt < 4; ++mt) *(f32x4*)(nst + ((size_t)seq * 32 + c) * 128 + d0 + 16 * mt + 4 * (lane >> 4)) = accn[mt]; }
        }
        build_conv_tile(T_KW, z, b, c, 512 + h * 128, F.in[I_CONVW], F.in[I_CONVB], 0.08838834764831845f, wrow + par * 128, tid);
        build_copy_tile(T_V, z, row0, ZC, 1024 + h * 128, tid);
        __syncthreads();
        const float sc_old = misc[par * 8 + 0];
#pragma unroll
        for (int mt = 0; mt < 4; ++mt) { acc[mt][0] *= sc_old; acc[mt][1] *= sc_old; accn[mt] *= sc_old; }
#pragma unroll
        for (int kk = 0; kk < 4; ++kk) {
            bf16x8 X[4], Y[2];
#pragma unroll
            for (int mt = 0; mt < 4; ++mt) X[mt] = frag_tr(T_KW, 32 * kk, d0 + 16 * mt, lane);
#pragma unroll
            for (int nt = 0; nt < 2; ++nt) Y[nt] = frag_tr(T_V, 32 * kk, e0 + 16 * nt, lane);
#pragma unroll
            for (int mt = 0; mt < 4; ++mt) { acc[mt][0] = mfma16(X[mt], Y[0], acc[mt][0]); acc[mt][1] = mfma16(X[mt], Y[1], acc[mt][1]); }
            if (w < 2) {
#pragma unroll
                for (int mt = 0; mt < 4; ++mt) accn[mt] = mfma16(X[mt], ones, accn[mt]); }
            __builtin_amdgcn_sched_barrier(0);
        }
    }
    __syncthreads();
}

DI void gmlp_unit(Frame& F, int unit) {
    int tid = F.tid, lane = F.lane; const int w = F.wave; asm volatile("" : "+v"(tid), "+v"(lane));
    const size_t row0 = (size_t)unit * 128;
    LAS uchar* T_G = F.lds; LAS float* mean = (LAS float*)(F.lds + 131072); LAS float* rstd = mean + 128;
    const bf16* z = (const bf16*)(F.ws + O_Z); bf16* Y = (bf16*)(F.ws + O_Y); const bf16* wsb = (const bf16*)(F.ws + O_WSB);
    for (int r = 16 * w; r < 16 * w + 16; ++r) {
        const u32x4 raw = *(const u32x4*)(z + (row0 + r) * ZC + 2560 + 8 * lane);
        float v[8] = {bflo(raw.x), bfhi(raw.x), bflo(raw.y), bfhi(raw.y), bflo(raw.z), bfhi(raw.z), bflo(raw.w), bfhi(raw.w)};
        float s = 0.f;
#pragma unroll
        for (int i = 0; i < 8; ++i) s += v[i];
        const float mu = wave_sum(s) * (1.f / 512.f); float q = 0.f;
#pragma unroll
        for (int i = 0; i < 8; ++i) { const float dlt = v[i] - mu; q += dlt * dlt; }
        const float var = wave_sum(q) * (1.f / 512.f);
        if (lane == 0) { mean[r] = mu; rstd[r] = 1.0f / sqrtf(var + LN_EPS); }
    }
    __syncthreads();
    for (int g = 0; g < 4; ++g) {
        {
            const int dg = tid & 15, sg = tid >> 4;
            const f32x4 ga = *(const f32x4*)(F.in[I_LNVG] + g * 128 + 8 * dg), gb2 = *(const f32x4*)(F.in[I_LNVG] + g * 128 + 8 * dg + 4);
            const f32x4 ba = *(const f32x4*)(F.in[I_LNVB] + g * 128 + 8 * dg), bb2 = *(const f32x4*)(F.in[I_LNVB] + g * 128 + 8 * dg + 4);
#pragma unroll
            for (int rr = 0; rr < 4; ++rr) { const int r = 4 * sg + rr; const u32x4 raw = *(const u32x4*)(z + (row0 + r) * ZC + 2560 + g * 128 + 8 * dg);
                const float mu = mean[r], rs = rstd[r];
                float o[8] = {bflo(raw.x), bfhi(raw.x), bflo(raw.y), bfhi(raw.y), bflo(raw.z), bfhi(raw.z), bflo(raw.w), bfhi(raw.w)};
                o[0] = (o[0] - mu) * rs * ga.x + ba.x; o[1] = (o[1] - mu) * rs * ga.y + ba.y; o[2] = (o[2] - mu) * rs * ga.z + ba.z; o[3] = (o[3] - mu) * rs * ga.w + ba.w;
                o[4] = (o[4] - mu) * rs * gb2.x + bb2.x; o[5] = (o[5] - mu) * rs * gb2.y + bb2.y; o[6] = (o[6] - mu) * rs * gb2.z + bb2.z; o[7] = (o[7] - mu) * rs * gb2.w + bb2.w;
                u32x4 wv; wv.x = pk2(o[0], o[1]); wv.y = pk2(o[2], o[3]); wv.z = pk2(o[4], o[5]); wv.w = pk2(o[6], o[7]);
                *(LAS u32x4*)(T_G + offb(r, dg)) = wv; }
        }
        __syncthreads();
        f32x4 acc[8];
#pragma unroll
        for (int mt = 0; mt < 8; ++mt) acc[mt] = (f32x4){0.f, 0.f, 0.f, 0.f};
#pragma unroll
        for (int kk = 0; kk < 4; ++kk) {
            const bf16x8 Yw = *(const bf16x8*)(wsb + ((size_t)g * 128 + 16 * w + (lane & 15)) * 128 + 32 * kk + 8 * (lane >> 4));
#pragma unroll
            for (int mt = 0; mt < 8; ++mt) acc[mt] = mfma16(frag_tr(T_G, 32 * kk, 16 * mt, lane), Yw, acc[mt]);
            __builtin_amdgcn_sched_barrier(0);
        }
        const int tl = 16 * w + (lane & 15); const size_t row = row0 + tl; const float bs = F.in[I_BS][g * 128 + tl];
#pragma unroll
        for (int mt = 0; mt < 8; ++mt) { const int d = 16 * mt + 4 * (lane >> 4);
            const u32x2 gu = *(const u32x2*)(z + row * ZC + 2048 + g * 128 + d);
            u32x2 o; o.x = pk2(bflo(gu.x) * (acc[mt][0] + bs), bfhi(gu.x) * (acc[mt][1] + bs)); o.y = pk2(bflo(gu.y) * (acc[mt][2] + bs), bfhi(gu.y) * (acc[mt][3] + bs));
            *(u32x2*)(Y + row * DM + 512 + g * 128 + d) = o; }
        __syncthreads();
    }
}

DI void phase2(Frame& F) {
    if (F.G >= 256) {
        if (F.bid < 128) mlstm_scan(F, F.bid);
        else for (int u = F.bid - 128; u < 512; u += F.G - 128) gmlp_unit(F, u);
    } else {
        for (int s = F.bid; s < 128; s += F.G) mlstm_scan(F, s);
        for (int u = F.bid; u < 512; u += F.G) gmlp_unit(F, u);
    }
}

DI void mlstm_out_unit(Frame& F, int unit) {
    int tid = F.tid, lane = F.lane; const int w = F.wave; asm volatile("" : "+v"(tid), "+v"(lane));
    const int c = unit & 31, h = (unit >> 5) & 3, b = unit >> 7;
    const size_t row0 = (size_t)b * SEQ + c * 128;
    LAS uchar* T_Q = F.lds; LAS uchar* T_K = F.lds + 32768; LAS uchar* T_V = F.lds + 65536; LAS uchar* T_C = F.lds + 98304;
    LAS float* sm = (LAS float*)(F.lds + 131072);
    LAS float* gfa = sm, *gba = sm + 128, *Mfa = sm + 256, *Mba = sm + 384, *sIf = sm + 512, *sIb = sm + 640, *enf = sm + 768, *enb = sm + 896, *nfa = sm + 1024, *nba = sm + 1152, *qnf = sm + 1280, *qnb = sm + 1408;
    const bf16* z = (const bf16*)(F.ws + O_Z); const float* gates = (const float*)(F.ws + O_GATES);
    const bf16* cst = (const bf16*)(F.ws + O_CST); const float* nst = (const float*)(F.ws + O_NST); const float* mst = (const float*)(F.ws + O_MST);
    bf16* Y = (bf16*)(F.ws + O_Y);
    const int sqf = ((b * 4 + h) * 2 + 0) * 32 + c, sqb = ((b * 4 + h) * 2 + 1) * 32 + c;
    if (w == 0) {
        const float mpf = mst[sqf], mpb = mst[sqb];
        const size_t r0 = (row0 + 2 * lane) * 16, r1 = (row0 + 2 * lane + 1) * 16;
        {
            const float ig0 = gates[r0 + h], ig1 = gates[r1 + h], lf0 = log_sigmoid(gates[r0 + 4 + h]), lf1 = log_sigmoid(gates[r1 + 4 + h]);
            const float incl = wscan_add(lf0 + lf1, lane), bf0 = incl - lf1, bf1 = incl;
            const float g0 = ig0 - bf0, g1 = ig1 - bf1;
            const float pin = wscan_max(fmaxf(g0, g1), lane); float pex = __shfl_up(pin, 1); if (lane == 0) pex = -3.0e38f;
            const float M0 = fmaxf(mpf, fmaxf(pex, g0)), M1 = fmaxf(mpf, pin);
            gfa[2 * lane] = g0; gfa[2 * lane + 1] = g1; Mfa[2 * lane] = M0; Mfa[2 * lane + 1] = M1;
            sIf[2 * lane] = __expf(mpf - M0); sIf[2 * lane + 1] = __expf(mpf - M1);
            enf[2 * lane] = __expf(-bf0 - M0); enf[2 * lane + 1] = __expf(-bf1 - M1);
        }
        {
            const float ig0 = gates[r0 + 8 + h], ig1 = gates[r1 + 8 + h], lf0 = log_sigmoid(gates[r0 + 12 + h]), lf1 = log_sigmoid(gates[r1 + 12 + h]);
            const float incl = wscan_add(lf0 + lf1, lane), Ftot = __shfl(incl, 63);
            const float bb0 = Ftot - incl + lf0 + lf1, bb1 = Ftot - incl + lf1;
            const float g0 = ig0 - bb0, g1 = ig1 - bb1;
            const float sin_ = wscan_max_rev(fmaxf(g0, g1), lane); float sex = __shfl_down(sin_, 1); if (lane == 63) sex = -3.0e38f;
            const float M0 = fmaxf(mpb, sin_), M1 = fmaxf(mpb, fmaxf(sex, g1));
            gba[2 * lane] = g0; gba[2 * lane + 1] = g1; Mba[2 * lane] = M0; Mba[2 * lane + 1] = M1;
            sIb[2 * lane] = __expf(mpb - M0); sIb[2 * lane + 1] = __expf(mpb - M1);
            enb[2 * lane] = __expf(-bb0 - M0); enb[2 * lane + 1] = __expf(-bb1 - M1);
        }
    }
    if (tid < 128) { nfa[tid] = nst[(size_t)sqf * 128 + tid]; nba[tid] = nst[(size_t)sqb * 128 + tid]; }
    SFENCE();
    build_conv_tile(T_Q, z, b, c, h * 128, F.in[I_CONVW], F.in[I_CONVB], 1.0f, nullptr, tid);
    SFENCE();
    build_conv_tile(T_K, z, b, c, 512 + h * 128, F.in[I_CONVW], F.in[I_CONVB], 0.08838834764831845f, nullptr, tid);
    SFENCE();
    build_copy_tile(T_V, z, row0, ZC, 1024 + h * 128, tid);
    build_copy_tile(T_C, cst + (size_t)sqf * 16384, 0, 128, 0, tid);
    __syncthreads();
    {
        const int t = tid >> 2, part = tid & 3; float af = 0.f, ab = 0.f;
#pragma unroll
        for (int cc = 0; cc < 4; ++cc) { const u32x4 raw = *(const LAS u32x4*)(T_Q + offb(t, 4 * part + cc)); const int dd = 32 * part + 8 * cc;
            const float qv[8] = {bflo(raw.x), bfhi(raw.x), bflo(raw.y), bfhi(raw.y), bflo(raw.z), bfhi(raw.z), bflo(raw.w), bfhi(raw.w)};
#pragma unroll
            for (int i = 0; i < 8; ++i) { af += qv[i] * nfa[dd + i]; ab += qv[i] * nba[dd + i]; } }
        af += __shfl_xor(af, 1); af += __shfl_xor(af, 2); ab += __shfl_xor(ab, 1); ab += __shfl_xor(ab, 2);
        if (part == 0) { qnf[t] = af; qnb[t] = ab; }
    }
    u32x4 cbreg[4];
    { const int dg = tid & 15, sg = tid >> 4; const bf16* src = cst + (size_t)sqb * 16384;
#pragma unroll
      for (int rr = 0; rr < 4; ++rr) cbreg[rr] = *(const u32x4*)(src + (size_t)(4 * sg + rr) * 128 + 8 * dg); }
    bf16x8 Qf[4];
#pragma unroll
    for (int kk = 0; kk < 4; ++kk) Qf[kk] = frag_row(T_Q, 16 * w, kk, lane);
    f32x4 aS[8];
#pragma unroll
    for (int mt = 0; mt < 8; ++mt) aS[mt] = (f32x4){0.f, 0.f, 0.f, 0.f};
#pragma unroll
    for (int kk = 0; kk < 4; ++kk) {
#pragma unroll
        for (int mt = 0; mt < 8; ++mt) aS[mt] = mfma16(frag_row(T_K, 16 * mt, kk, lane), Qf[kk], aS[mt]);
        __builtin_amdgcn_sched_barrier(0); }
    __syncthreads();
    const int tl = 16 * w + (lane & 15);
    float cf, cb_;
    {
        const float Mf = Mfa[tl], Mb = Mba[tl];
        f32x4 wf[8], wb[8]; float sumf = 0.f, sumb = 0.f;
#pragma unroll
        for (int mt = 0; mt < 8; ++mt) { const int s0 = 16 * mt + 4 * (lane >> 4); const f32x4 gf4 = *(const LAS f32x4*)(gfa + s0), gb4 = *(const LAS f32x4*)(gba + s0);
#pragma unroll
            for (int j = 0; j < 4; ++j) { const int s = s0 + j; const float sv = aS[mt][j];
                const float a = (s <= tl) ? __expf(gf4[j] - Mf) * sv : 0.f, bq = (s >= tl) ? __expf(gb4[j] - Mb) * sv : 0.f;
                wf[mt][j] = a; wb[mt][j] = bq; sumf += a; sumb += bq; } }
        sumf += __shfl_xor(sumf, 16); sumf += __shfl_xor(sumf, 32); sumb += __shfl_xor(sumb, 16); sumb += __shfl_xor(sumb, 32);
        const float sif = sIf[tl], sib = sIb[tl];
        const float denf = sumf + sif * qnf[tl], denb = sumb + sib * qnb[tl];
        const float rf = 1.0f / fmaxf(fabsf(denf), enf[tl]), rb = 1.0f / fmaxf(fabsf(denb), enb[tl]);
        cf = sif * rf; cb_ = sib * rb;
#pragma unroll
        for (int mt = 0; mt < 8; ++mt) { const int s0 = 16 * mt + 4 * (lane >> 4);
            u32x2 v; v.x = pk2(wf[mt][0] * rf + wb[mt][0] * rb, wf[mt][1] * rf + wb[mt][1] * rb); v.y = pk2(wf[mt][2] * rf + wb[mt][2] * rb, wf[mt][3] * rf + wb[mt][3] * rb);
            *(LAS u32x2*)(T_K + offb(tl, s0 >> 3) + (s0 & 7) * 2) = v; }
    }
    f32x4 aO[8], aZ[8];
#pragma unroll
    for (int mt = 0; mt < 8; ++mt) { aO[mt] = (f32x4){0.f, 0.f, 0.f, 0.f}; aZ[mt] = (f32x4){0.f, 0.f, 0.f, 0.f}; }
#pragma unroll
    for (int kk = 0; kk < 4; ++kk) { const bf16x8 Yw = frag_row(T_K, 16 * w, kk, lane);
#pragma unroll
        for (int mt = 0; mt < 8; ++mt) aO[mt] = mfma16(frag_tr(T_V, 32 * kk, 16 * mt, lane), Yw, aO[mt]);
        __builtin_amdgcn_sched_barrier(0); }
#pragma unroll
    for (int kk = 0; kk < 4; ++kk) {
#pragma unroll
        for (int mt = 0; mt < 8; ++mt) aZ[mt] = mfma16(frag_row(T_C, 16 * mt, kk, lane), Qf[kk], aZ[mt]);
        __builtin_amdgcn_sched_barrier(0); }
#pragma unroll
    for (int mt = 0; mt < 8; ++mt) { aO[mt] += aZ[mt] * cf; aZ[mt] = (f32x4){0.f, 0.f, 0.f, 0.f}; }
    __syncthreads();
    { const int dg = tid & 15, sg = tid >> 4;
#pragma unroll
      for (int rr = 0; rr < 4; ++rr) *(LAS u32x4*)(T_C + offb(4 * sg + rr, dg)) = cbreg[rr]; }
    __syncthreads();
#pragma unroll
    for (int kk = 0; kk < 4; ++kk) {
#pragma unroll
        for (int mt = 0; mt < 8; ++mt) aZ[mt] = mfma16(frag_row(T_C, 16 * mt, kk, lane), Qf[kk], aZ[mt]);
        __builtin_amdgcn_sched_barrier(0); }
    float ssq = 0.f;
#pragma unroll
    for (int mt = 0; mt < 8; ++mt) { aO[mt] += aZ[mt] * cb_; ssq += (aO[mt][0] * aO[mt][0] + aO[mt][1] * aO[mt][1]) + (aO[mt][2] * aO[mt][2] + aO[mt][3] * aO[mt][3]); }
    ssq += __shfl_xor(ssq, 16); ssq += __shfl_xor(ssq, 32);
    const float rinv = 1.0f / sqrtf(ssq * (1.f / 128.f) + RMS_EPS);
    const size_t row = row0 + tl;
#pragma unroll
    for (int mt = 0; mt < 8; ++mt) { const int e = 16 * mt + 4 * (lane >> 4);
        const u32x2 og = *(const u32x2*)(z + row * ZC + 1536 + h * 128 + e); const f32x4 gh = *(const f32x4*)(F.in[I_GHEAD] + h * 128 + e);
        u32x2 o; o.x = pk2(bflo(og.x) * aO[mt][0] * rinv * gh.x, bfhi(og.x) * aO[mt][1] * rinv * gh.y); o.y = pk2(bflo(og.y) * aO[mt][2] * rinv * gh.z, bfhi(og.y) * aO[mt][3] * rinv * gh.w);
        *(u32x2*)(Y + row * DM + h * 128 + e) = o; }
    __syncthreads();
}
DI void load_kv_half(LAS uchar* buf, const bf16* kv, int b, int col0, int tid) {
    const int ch = tid & 15, r = tid >> 4;
#pragma unroll
    for (int i = 0; i < 8; ++i) { const int m = r + 32 * i; *(LAS u32x4*)(buf + offb(m, ch)) = *(const u32x4*)(kv + (size_t)(b * NMEM + m) * 2048 + col0 + 8 * ch); }
}
DI void attn_unit(Frame& F, int unit) {
    int tid = F.tid, lane = F.lane; const int w = F.wave; asm volatile("" : "+v"(tid), "+v"(lane));
    const int qb = unit & 31, hd = (unit >> 5) & 3, b = unit >> 7;
    LAS uchar* KV = F.lds; LAS uchar* P0 = F.lds + 65536;
    const bf16* Q = (const bf16*)(F.ws + O_Q); const bf16* kv = (const bf16*)(F.ws + O_KV); bf16* O = (bf16*)(F.ws + O_O);
    const int ql = 16 * w + (lane & 15); const size_t qrow = (size_t)b * SEQ + qb * 128 + ql;
    f32x4 aS[16];
#pragma unroll
    for (int mt = 0; mt < 16; ++mt) aS[mt] = (f32x4){0.f, 0.f, 0.f, 0.f};
    for (int dh = 0; dh < 2; ++dh) {
        __syncthreads();
        load_kv_half(KV, kv, b, hd * 256 + dh * 128, tid);
        bf16x8 Qf[4];
#pragma unroll
        for (int kk = 0; kk < 4; ++kk) Qf[kk] = *(const bf16x8*)(Q + qrow * DM + hd * 256 + dh * 128 + 32 * kk + 8 * (lane >> 4));
        __syncthreads();
#pragma unroll
        for (int kk = 0; kk < 4; ++kk)
#pragma unroll
            for (int mt = 0; mt < 16; ++mt) aS[mt] = mfma16(frag_row(KV, 16 * mt, kk, lane), Qf[kk], aS[mt]);
    }
    float mx = -3.0e38f;
#pragma unroll
    for (int mt = 0; mt < 16; ++mt) mx = fmaxf(mx, fmaxf(fmaxf(aS[mt][0], aS[mt][1]), fmaxf(aS[mt][2], aS[mt][3])));
    mx = fmaxf(mx, __shfl_xor(mx, 16)); mx = fmaxf(mx, __shfl_xor(mx, 32));
    float sum = 0.f;
#pragma unroll
    for (int mt = 0; mt < 16; ++mt) {
        f32x4 p;
#pragma unroll
        for (int j = 0; j < 4; ++j) { p[j] = __expf(aS[mt][j] - mx); sum += p[j]; }
        const int m0 = 16 * mt + 4 * (lane >> 4);
        u32x2 v; v.x = pk2(p[0], p[1]); v.y = pk2(p[2], p[3]);
        *(LAS u32x2*)(P0 + (m0 >> 7) * 32768 + offb(ql, (m0 & 127) >> 3) + (m0 & 7) * 2) = v;
    }
    sum += __shfl_xor(sum, 16); sum += __shfl_xor(sum, 32);
    const float rinv = 1.0f / sum;
    for (int eh = 0; eh < 2; ++eh) {
        __syncthreads();
        load_kv_half(KV, kv, b, 1024 + hd * 256 + eh * 128, tid);
        __syncthreads();
        f32x4 aO[8];
#pragma unroll
        for (int mt = 0; mt < 8; ++mt) aO[mt] = (f32x4){0.f, 0.f, 0.f, 0.f};
#pragma unroll
        for (int kk = 0; kk < 8; ++kk) { const bf16x8 Yp = frag_row(P0 + (kk >> 2) * 32768, 16 * w, kk & 3, lane);
#pragma unroll
            for (int mt = 0; mt < 8; ++mt) aO[mt] = mfma16(frag_tr(KV, 32 * kk, 16 * mt, lane), Yp, aO[mt]); }
#pragma unroll
        for (int mt = 0; mt < 8; ++mt) { const int e = 16 * mt + 4 * (lane >> 4);
            u32x2 o; o.x = pk2(aO[mt][0] * rinv, aO[mt][1] * rinv); o.y = pk2(aO[mt][2] * rinv, aO[mt][3] * rinv);
            *(u32x2*)(O + qrow * DM + hd * 256 + eh * 128 + e) = o; }
    }
    __syncthreads();
}

DI void route_block(Frame& F, int blk) {
    const int tid = F.tid, lane = F.lane, w = F.wave;
    LAS float* wrg = (LAS float*)F.lds;
    LAS float* wre = (LAS float*)(F.lds + 16384);
    LAS int* tokE = (LAS int*)(F.lds + 147456);
    LAS int* tokR = tokE + 512;
    LAS int* wcnt = tokR + 512;
    LAS int* base = wcnt + 256;
    const float* x2 = F.out; float* rs3 = (float*)(F.ws + O_RS3); unsigned* tok = (unsigned*)(F.ws + O_TOK); int* ridx = (int*)(F.ws + O_RIDX);
    unsigned* cnt = (unsigned*)(F.ws + O_CTL) + CW_CNT;
    const float brg0 = F.in[I_BRG][0], brg1 = F.in[I_BRG][1], brg2 = F.in[I_BRG][2], brg3 = F.in[I_BRG][3];
    for (int rl = 32 * w; rl < 32 * w + 32; ++rl) {
        const int m = blk * 256 + rl;
        const f32x4* xr = (const f32x4*)(x2 + (size_t)m * DM) + lane;
        f32x4 v[4]; float s = 0.f;
#pragma unroll
        for (int j = 0; j < 4; ++j) { v[j] = xr[64 * j]; s += (v[j].x * v[j].x + v[j].y * v[j].y) + (v[j].z * v[j].z + v[j].w * v[j].w); }
        const float rs = 1.0f / sqrtf(wave_sum(s) * (1.f / DM) + RMS_EPS);
        f32x4 pg = (f32x4){0.f, 0.f, 0.f, 0.f};
#pragma unroll
        for (int jj = 0; jj < 4; ++jj)
#pragma unroll
            for (int ii = 0; ii < 4; ++ii) pg += *(const LAS f32x4*)(wrg + (((jj * 4 + ii) * 64 + lane) << 2)) * v[jj][ii];
        const float l0 = wave_sum(pg.x) * rs + brg0, l1 = wave_sum(pg.y) * rs + brg1, l2 = wave_sum(pg.z) * rs + brg2, l3 = wave_sum(pg.w) * rs + brg3;
        int gi = 0; float lm = l0;
        if (l1 > lm) { lm = l1; gi = 1; } if (l2 > lm) { lm = l2; gi = 2; } if (l3 > lm) { lm = l3; gi = 3; }
        const float ptop = 1.0f / (__expf(l0 - lm) + __expf(l1 - lm) + __expf(l2 - lm) + __expf(l3 - lm));
        gi = __builtin_amdgcn_readfirstlane(gi);
        f32x4 pa = (f32x4){0.f, 0.f, 0.f, 0.f}, pb = (f32x4){0.f, 0.f, 0.f, 0.f};
        const LAS float* wg = wre + (size_t)gi * (16 * 2 * 64 * 4);
#pragma unroll
        for (int jj = 0; jj < 4; ++jj)
#pragma unroll
            for (int ii = 0; ii < 4; ++ii) { const float xv = v[jj][ii]; pa += *(const LAS f32x4*)(wg + ((((jj * 4 + ii) * 2 + 0) * 64 + lane) << 2)) * xv; pb += *(const LAS f32x4*)(wg + ((((jj * 4 + ii) * 2 + 1) * 64 + lane) << 2)) * xv; }
        float le[8];
        le[0] = wave_sum(pa.x); le[1] = wave_sum(pa.y); le[2] = wave_sum(pa.z); le[3] = wave_sum(pa.w); le[4] = wave_sum(pb.x); le[5] = wave_sum(pb.y); le[6] = wave_sum(pb.z); le[7] = wave_sum(pb.w);
#pragma unroll
        for (int j = 0; j < 8; ++j) le[j] = le[j] * rs + F.in[I_BRE][gi * 8 + j];
        int e0 = 0; float m0 = le[0];
#pragma unroll
        for (int j = 1; j < 8; ++j) if (le[j] > m0) { m0 = le[j]; e0 = j; }
        int e1 = -1; float m1 = -3.0e38f;
#pragma unroll
        for (int j = 0; j < 8; ++j) if (j != e0 && le[j] > m1) { m1 = le[j]; e1 = j; }
        const float t = __expf(m1 - m0), w0 = ptop / (1.0f + t), w1 = ptop * t / (1.0f + t);
        if (lane == 0) { tokE[2 * rl] = gi * 8 + e0; tokE[2 * rl + 1] = gi * 8 + e1; rs3[m] = rs;
            tok[(size_t)m * 8 + 4] = __builtin_bit_cast(unsigned, w0); tok[(size_t)m * 8 + 5] = __builtin_bit_cast(unsigned, w1); }
    }
    __syncthreads();
    {
        const int myE = tokE[tid]; int myR = 0;
        for (int e = 0; e < 32; ++e) { const unsigned long long mk = __ballot(myE == e); if (myE == e) myR = __popcll(mk & ((1ull << lane) - 1ull)); if (lane == 0) wcnt[w * 32 + e] = __popcll(mk); }
        __syncthreads();
        int add = 0;
        for (int ww = 0; ww < w; ++ww) add += wcnt[ww * 32 + myE];
        tokR[tid] = myR + add;
        if (tid < 32) { int tot = 0; for (int ww = 0; ww < 8; ++ww) tot += wcnt[ww * 32 + tid]; base[tid] = (int)__hip_atomic_fetch_add(cnt + tid, (unsigned)tot, __ATOMIC_RELAXED, __HIP_MEMORY_SCOPE_AGENT); }
        __syncthreads();
        const int pos = base[myE] + tokR[tid], m = blk * 256 + (tid >> 1);
        ridx[(size_t)myE * NTOK + pos] = m;
        tok[(size_t)m * 8 + (tid & 1) * 2 + 0] = (unsigned)myE; tok[(size_t)m * 8 + (tid & 1) * 2 + 1] = (unsigned)pos;
    }
    __syncthreads();
}
DI void phase8(Frame& F) {
    LAS float* wrg = (LAS float*)F.lds; LAS float* wre = (LAS float*)(F.lds + 16384);
    const float* gm = F.in[I_GMOE];
    for (int idx = F.tid; idx < 1024 * 4; idx += NTHR) { const int i = idx >> 2, j = idx & 3; const int jj = i >> 8, l = (i & 255) >> 2, ii = i & 3;
        wrg[(((jj * 4 + ii) * 64 + l) << 2) + j] = F.in[I_WRG][idx] * gm[i]; }
    for (int idx = F.tid; idx < 1024 * 32; idx += NTHR) { const int i = idx >> 5, j = idx & 31; const int jj = i >> 8, l = (i & 255) >> 2, ii = i & 3, g = j >> 3, hh = (j & 7) >> 2, jr = j & 3;
        wre[((((g * 16 + (jj * 4 + ii)) * 2 + hh) * 64 + l) << 2) + jr] = F.in[I_WRE][idx] * gm[i]; }
    __syncthreads();
    for (int blk = F.bid; blk < NTOK / 256; blk += F.G) route_block(F, blk);
}

DI void moe_tables(Frame& F, LAS int*& cum, LAS int*& cntl) {
    cum = (LAS int*)(F.lds + 131072); cntl = cum + 64;
    const unsigned* cnt = (const unsigned*)(F.ws + O_CTL) + CW_CNT;
    if (F.tid < 32) cntl[F.tid] = (int)__hip_atomic_load(cnt + F.tid, __ATOMIC_RELAXED, __HIP_MEMORY_SCOPE_AGENT);
    __syncthreads();
    if (F.tid == 0) { int a = 0; for (int e = 0; e < 32; ++e) { cum[e] = a; a += (cntl[e] + 255) >> 8; } cum[32] = a; }
    __syncthreads();
}

DI void phase11(Frame& F) {
    LAS int* cum; LAS int* cntl; moe_tables(F, cum, cntl);
    const int gw = F.bid * NWAVES + F.wave, NGW = F.G * NWAVES, lane = F.lane;
    const unsigned* tok = (const unsigned*)(F.ws + O_TOK); const bf16* YD = (const bf16*)(F.ws + O_YD);
    f32x4 gfin[4];
#pragma unroll
    for (int j = 0; j < 4; ++j) gfin[j] = ((const f32x4*)F.in[I_GFINAL])[lane + 64 * j];
    for (int m = gw; m < NTOK; m += NGW) {
        const u32x4 ti = *(const u32x4*)(tok + (size_t)m * 8); const unsigned tw0 = tok[(size_t)m * 8 + 4], tw1 = tok[(size_t)m * 8 + 5];
        const size_t s0 = (size_t)cum[ti.x] * 256 + ti.y, s1 = (size_t)cum[ti.z] * 256 + ti.w;
        const float w0 = __uint_as_float(tw0), w1 = __uint_as_float(tw1);
        f32x4* xr = (f32x4*)(F.out + (size_t)m * DM) + lane;
        const u32x2* y0 = (const u32x2*)(YD + s0 * DM) + lane; const u32x2* y1 = (const u32x2*)(YD + s1 * DM) + lane;
        f32x4 v[4]; float s = 0.f;
#pragma unroll
        for (int j = 0; j < 4; ++j) { const u32x2 a = y0[64 * j], bq = y1[64 * j];
            f32x4 mo; mo.x = w0 * bflo(a.x) + w1 * bflo(bq.x); mo.y = w0 * bfhi(a.x) + w1 * bfhi(bq.x); mo.z = w0 * bflo(a.y) + w1 * bflo(bq.y); mo.w = w0 * bfhi(a.y) + w1 * bfhi(bq.y);
            v[j] = xr[64 * j] + mo; s += (v[j].x * v[j].x + v[j].y * v[j].y) + (v[j].z * v[j].z + v[j].w * v[j].w); }
        const float rs = 1.0f / sqrtf(wave_sum(s) * (1.f / DM) + RMS_EPS);
#pragma unroll
        for (int j = 0; j < 4; ++j) xr[64 * j] = v[j] * rs * gfin[j];
    }
}
#define GAS __attribute__((address_space(1)))
typedef GAS unsigned gu32;
#define RLX_AGENT __ATOMIC_RELAXED, __HIP_MEMORY_SCOPE_AGENT
#define XB_TMO      128
#define XB_XCNT(j)  (256  + 64 * (j))
#define XB_XSUB(j)  (1280 + 64 * (j))
#define XB_XGEN(j)  (2304 + 64 * (j))
#define XB_TOP      3328
#define XB_TOPGEN   3392
#define XCD_BAR_WORDS 3456
#define XB_SPIN_CAP (1u << 18)

__device__ __forceinline__ unsigned xb_ld(unsigned* p)              { return __hip_atomic_load(p, __ATOMIC_RELAXED, __HIP_MEMORY_SCOPE_AGENT); }
__device__ __forceinline__ unsigned xb_add(unsigned* p, unsigned v) { return __hip_atomic_fetch_add(p, v, __ATOMIC_RELAXED, __HIP_MEMORY_SCOPE_AGENT); }
__device__ __forceinline__ unsigned xb_xcc_id() { return (unsigned)__builtin_amdgcn_s_getreg((3 << 11) | 20) & 0xFu; }
#define XB_SPIN(cond, bar) do { unsigned _sp = 0; while (cond) { __builtin_amdgcn_s_sleep(1); \
    if ((++_sp & 255u) == 0u) { if (xb_ld(&(bar)[XB_TMO])) break; if (_sp > XB_SPIN_CAP) { atomicAdd(&(bar)[XB_TMO], 1u); break; } } } } while (0)

struct XcdBarrier {
    unsigned* bar; unsigned x;
    volatile LAS unsigned* st;
};

__device__ __forceinline__ XcdBarrier xcd_barrier_post(unsigned* bar, volatile LAS unsigned* st) {
    XcdBarrier b; b.bar = bar; b.x = xb_xcc_id(); b.st = st;
    if (threadIdx.x == 0) (void)xb_add(&bar[XB_XCNT(b.x)], 1u);
    return b;
}
__device__ __forceinline__ void xcd_barrier_complete(unsigned* bar, unsigned x, unsigned& nloc, unsigned& nx) {
    const unsigned G = gridDim.x * gridDim.y * gridDim.z;
    unsigned sum, cnt, mine, sp = 0u;
    for (;;) {
        sum = 0u; cnt = 0u; mine = 0u;
#pragma unroll
        for (unsigned j = 0; j < 16; ++j) { const unsigned c = xb_ld(&bar[XB_XCNT(j)]); sum += c; cnt += (c > 0u) ? 1u : 0u; mine = (j == x) ? c : mine; }
        if (sum == G) break;
        __builtin_amdgcn_s_sleep(1);
        if ((++sp & 255u) == 0u) { if (xb_ld(&bar[XB_TMO])) break; if (sp > XB_SPIN_CAP) { atomicAdd(&bar[XB_TMO], 1u); break; } }
    }
    nloc = mine > 0u ? mine : 1u; nx = cnt > 0u ? cnt : 1u;
}

__device__ __forceinline__ void xcd_barrier(const XcdBarrier& b) {
    asm volatile("s_waitcnt vmcnt(0)" ::: "memory");
    __syncthreads();
    if (threadIdx.x == 0) {
        unsigned* bar = b.bar;
        __builtin_amdgcn_s_waitcnt(0);
        unsigned nloc = b.st[0], nx = b.st[1];
        if (nloc == 0u) { xcd_barrier_complete(bar, b.x, nloc, nx); b.st[0] = nloc; b.st[1] = nx; }
        const unsigned old = xb_add(&bar[XB_XSUB(b.x)], 1u);
        const unsigned gen = old / nloc;
        if (old + 1u == (gen + 1u) * nloc) {
            __builtin_amdgcn_fence(__ATOMIC_RELEASE, "agent");
            asm volatile("s_waitcnt vmcnt(0)" ::: "memory");
            const unsigned og = xb_add(&bar[XB_TOP], 1u);
            const unsigned tg = og / nx;
            if (og + 1u == (tg + 1u) * nx) xb_add(&bar[XB_TOPGEN], 1u);
            else XB_SPIN(xb_ld(&bar[XB_TOPGEN]) == tg, bar);
            __builtin_amdgcn_fence(__ATOMIC_ACQUIRE, "agent");
            xb_add(&bar[XB_XGEN(b.x)], 1u);
            asm volatile("s_waitcnt vmcnt(0)" ::: "memory");
        } else {
            XB_SPIN(xb_ld(&bar[XB_XGEN(b.x)]) == gen, bar);
            __builtin_amdgcn_fence(__ATOMIC_ACQUIRE, "agent");
            asm volatile("s_waitcnt vmcnt(0)" ::: "memory");
        }
    }
    __syncthreads();
}

#ifndef MK_N_LAUNCHES
#define MK_N_LAUNCHES 1
#endif
constexpr int N_PHASES = 12;

__global__ void __launch_bounds__(NTHR, 2) hybrid_fwd(Args args) {
    extern __shared__ __attribute__((aligned(16))) uchar lds_raw[];
    Frame F;
    F.lds = (LAS uchar*)lds_raw;
    F.tid = threadIdx.x; F.lane = F.tid & 63; F.wave = __builtin_amdgcn_readfirstlane(F.tid >> 6);
    F.G = gridDim.x; F.bid = blockIdx.x;
    F.in = args.in;
    F.out = args.out; F.ws = args.ws;
    uchar* ws = args.ws;
    const int lo = args.ph_lo, hi = args.ph_hi;
    volatile LAS unsigned* MISC = (volatile LAS unsigned*)(F.lds + LDS_BYTES - 256);
    if (F.tid < 64) MISC[F.tid] = 0u;
    __syncthreads();
    XcdBarrier bar; bar.bar = (unsigned*)(args.ws + O_CTL) + CW_BAR; bar.x = 0; bar.st = MISC + 8;
    if (hi - lo > 1) bar = xcd_barrier_post((unsigned*)(args.ws + O_CTL) + CW_BAR, MISC + 8);
#ifndef PHASE_MASK
#define PHASE_MASK 0xFFF
#endif
#define IN(k) (((PHASE_MASK >> (k)) & 1) && lo <= (k) && (k) < hi)
#define OPQ() do { uchar* w_ = args.ws; float* o_ = args.out; asm volatile("" : "+s"(w_), "+s"(o_)); ws = w_; F.ws = w_; F.out = o_; } while (0)
#define SEAM(k) do { OPQ(); if (lo <= (k) && (k) + 1 < hi) { xcd_barrier(bar); } } while (0)
    using pg8::Gemm; using pg8::StaticOrder; using pg8::gemm_phase;

    if (IN(0)) phase0(F);
    SEAM(0);
    if (IN(1)) {
        { Gemm g{(const bf16*)(ws + O_XB), (const bf16*)(ws + O_WIN), NTOK, ZC, DM}; StaticOrder S; S.init(NTOK, ZC, F.G, F.bid);
          EpiRowScale<0> E{(bf16*)(ws + O_Z), ZC, (const float*)(ws + O_RS0), 1.0f};
          gemm_phase<EpiRowScale<0>, StaticOrder, true, true, false>(F.lds, g, S, E); }
        { Gemm g{(const bf16*)(ws + O_MEMB), (const bf16*)(ws + O_WKV), NMROWS, 2048, DM}; StaticOrder S; S.init(NMROWS, 2048, F.G, F.bid);
          EpiRowScale<1> E{(bf16*)(ws + O_KV), 2048, (const float*)(ws + O_RSM), 1.0f};
          gemm_phase<EpiRowScale<1>, StaticOrder, true, true, false>(F.lds, g, S, E); }
    }
    SEAM(1);
    if (IN(2)) phase2(F);
    SEAM(2);
    if (IN(3)) { for (int u = F.bid; u < NB * 4 * 32; u += F.G) mlstm_out_unit(F, u); }
    SEAM(3);
    if (IN(4)) {
        Gemm g{(const bf16*)(ws + O_Y), (const bf16*)(ws + O_WOUT), NTOK, DM, DM}; StaticOrder S; S.init(NTOK, DM, F.G, F.bid);
        EpiRes<true> E{F.in[I_X], F.out, (bf16*)(ws + O_XB), (float*)(ws + O_SS1)};
        gemm_phase<EpiRes<true>, StaticOrder, true, true, false>(F.lds, g, S, E);
    }
    SEAM(4);
    if (IN(5)) {
        Gemm g{(const bf16*)(ws + O_XB), (const bf16*)(ws + O_WQ), NTOK, DM, DM}; StaticOrder S; S.init(NTOK, DM, F.G, F.bid);
        EpiQ E{(bf16*)(ws + O_Q), (const float*)(ws + O_SS1), 0.0625f};
        gemm_phase<EpiQ, StaticOrder, true, true, false>(F.lds, g, S, E);
    }
    SEAM(5);
    if (IN(6)) { for (int u = F.bid; u < NB * 4 * 32; u += F.G) attn_unit(F, u); }
    SEAM(6);
    if (IN(7)) {
        Gemm g{(const bf16*)(ws + O_O), (const bf16*)(ws + O_WO), NTOK, DM, DM}; StaticOrder S; S.init(NTOK, DM, F.G, F.bid);
        EpiRes<false> E{F.out, F.out, (bf16*)(ws + O_XB), nullptr};
        gemm_phase<EpiRes<false>, StaticOrder, true, true, false>(F.lds, g, S, E);
    }
    SEAM(7);
    if (IN(8)) phase8(F);
    SEAM(8);
    if (IN(9)) {
        LAS int* cum; LAS int* cntl; moe_tables(F, cum, cntl);
        MoeOrder S{cum, cntl, (const int*)(ws + O_RIDX), F.G, F.bid, false};
        Gemm g{(const bf16*)(ws + O_XB), (const bf16*)(ws + O_WGU), NTOK, NEXP * 1024, DM};
        EpiGU E{(bf16*)(ws + O_H), (const float*)(ws + O_RS3)};
        gemm_phase<EpiGU, MoeOrder, true, true, true>(F.lds, g, S, E);
    }
    SEAM(9);
    if (IN(10)) {
        LAS int* cum; LAS int* cntl; moe_tables(F, cum, cntl);
        MoeOrder S{cum, cntl, (const int*)(ws + O_RIDX), F.G, F.bid, true};
        Gemm g{(const bf16*)(ws + O_H), (const bf16*)(ws + O_WD), MAXSLOTS, NEXP * 1024, DEXP};
        EpiPlain E{(bf16*)(ws + O_YD), DM};
        gemm_phase<EpiPlain, MoeOrder, true, true, false>(F.lds, g, S, E);
    }
    SEAM(10);
    if (IN(11)) phase11(F);
#undef IN
#undef SEAM
}

extern "C" void kernel_launch(void* const* d_in, const int* in_sizes, int n_in, void* d_out, int out_size, void* d_ws, size_t ws_size, hipStream_t stream) {
    static int grid = 0;
    if (grid == 0) {
        if (n_in != 27 || in_sizes[0] != NTOK * DM || out_size != NTOK * DM || ws_size < WS_NEED) { fprintf(stderr, "kernel_launch: unexpected shapes (n_in %d, in0 %d, out %d, ws %zu); nothing launched\n", n_in, n_in > 0 ? in_sizes[0] : -1, out_size, ws_size); grid = -1; return; }
        int dev = 0, cus = 0, per_cu = 0;
        if (hipGetDevice(&dev) != hipSuccess || hipDeviceGetAttribute(&cus, hipDeviceAttributeMultiprocessorCount, dev) != hipSuccess) { fprintf(stderr, "kernel_launch: device query failed\n"); grid = -1; return; }
        if (hipFuncSetAttribute((const void*)hybrid_fwd, hipFuncAttributeMaxDynamicSharedMemorySize, LDS_BYTES) != hipSuccess) { fprintf(stderr, "kernel_launch: hipFuncSetAttribute failed\n"); grid = -1; return; }
        if (hipOccupancyMaxActiveBlocksPerMultiprocessor(&per_cu, (const void*)hybrid_fwd, NTHR, LDS_BYTES) != hipSuccess || per_cu < 1) { fprintf(stderr, "kernel_launch: occupancy query says %d\n", per_cu); per_cu = 1; }
        (void)hipGetLastError();
        grid = cus * per_cu;
        if (grid > 256) grid = 256;
    }
    if (grid < 0) return;
    (void)hipMemsetAsync((char*)d_ws + O_CTL, 0, CTL_BYTES, stream);
    Args a{};
    for (int i = 0; i < 27; ++i) a.in[i] = (const float*)d_in[i];
    a.out = (float*)d_out; a.ws = (uchar*)d_ws;
#if MK_N_LAUNCHES == 1
    a.ph_lo = 0; a.ph_hi = N_PHASES;
    hipLaunchKernelGGL(hybrid_fwd, dim3(grid), dim3(NTHR), LDS_BYTES, stream, a);
#else
    for (int p = 0; p < N_PHASES; ++p) { a.ph_lo = p; a.ph_hi = p + 1; hipLaunchKernelGGL(hybrid_fwd, dim3(grid), dim3(NTHR), LDS_BYTES, stream, a); }
#endif
}
```

```cpp
#include <hip/hip_runtime.h>
#include <cstdio>
#include <cstdint>
#define MK_N_LAUNCHES 1
namespace pg8 {
#define PG8_LAS __attribute__((address_space(3)))
typedef unsigned short bf16_t;
typedef short bf16x8 __attribute__((ext_vector_type(8)));
typedef float f32x4 __attribute__((ext_vector_type(4)));
typedef unsigned u32x4 __attribute__((ext_vector_type(4)));
typedef unsigned u32x2 __attribute__((ext_vector_type(2)));
constexpr int BM = 256, BK = 64, HALF = 128, HTB = HALF * BK * 2  , STAGE_BYTES = 8 * HTB, NXCD = 8, WGM = 16;

__host__ __device__ __forceinline__ int lds_byte(int r, int c) { const int st = (r >> 4) * 2 + (c >> 5), rr = r & 15, cc = c & 31, ob = rr * 64 + cc * 2; return st * 1024 + (ob ^ (((ob >> 9) & 1) << 5)); }
__host__ __device__ __forceinline__ void stage_rc(int b, int& R, int& C) { const int st = b / 1024, sb = b % 1024, swz = sb ^ (((sb >> 9) & 1) << 5); R = (st >> 1) * 16 + swz / 64; C = (st & 1) * 32 + (swz % 64) / 2; }
__host__ __device__ __forceinline__ int perm32(int rho) { const int n = rho >> 4, i = rho & 15; return 8 * (i >> 2) + 4 * n + (i & 3); }

struct Unit { int pm, pn; const int* ridx; int nvalid; int orow, ocol, ex; };
struct Gemm { const bf16_t* A; const bf16_t* Bt; int M, N, K; int scale_a, scale_b; };

struct StaticOrder {
    int nM, nN, nwg, G, c;
    __host__ __device__ void init(int M, int N, int G_, int c_) { nM = M / BM; nN = N / BM; nwg = nM * nN; G = G_; c = c_; }
    __host__ __device__ bool next(int i, Unit& u) const {
        const long L = (long)i * G + c; if (L >= nwg) return false;
        int wgid = (int)L; { const int q = nwg / NXCD, r = nwg % NXCD, xcd = wgid % NXCD, off = wgid / NXCD; wgid = (xcd < r ? xcd * (q + 1) : r * (q + 1) + (xcd - r) * q) + off; }
        const int nig = WGM * nN, gid = wgid / nig, fm = gid * WGM, gsz = (nM - fm) < WGM ? (nM - fm) : WGM;
        u.pm = fm + ((wgid % nig) % gsz); u.pn = (wgid % nig) / gsz; u.ridx = nullptr; u.nvalid = 256; u.orow = u.pm; u.ocol = u.pn * BM; u.ex = 0; return true;
    }
};

__device__ __forceinline__ unsigned cvt_pk_bf16(float lo, float hi) { unsigned r; asm("v_cvt_pk_bf16_f32 %0, %1, %2" : "=v"(r) : "v"(lo), "v"(hi)); return r; }

template <class Epi, class Sched, bool ALIGN_EPI, bool SP2, bool GATHER, bool FP8 = false>
__device__ __forceinline__ void gemm_phase(PG8_LAS unsigned char* lds, const Gemm g, const Sched& S, const Epi& E) {
    const int tid = threadIdx.x, wid = __builtin_amdgcn_readfirstlane(tid >> 6), lane = tid & 63, wr = wid >> 2, wc = wid & 3, fr = lane & 15, fq = lane >> 4;
    const int K = FP8 ? g.K / 2 : g.K, nt = K / BK;
    unsigned voffA[2], voffB[2];
#pragma unroll
    for (int i = 0; i < 2; ++i) { int R, C; stage_rc(tid * 16 + i * 8192, R, C); const int Rb = Epi::PERM ? ((R & ~31) + perm32(R & 31)) : R;
        voffA[i] = (unsigned)(R * K + C) * 2u; voffB[i] = (unsigned)(Rb * K + C) * 2u; }
    const size_t kstep = (size_t)(BK * 2);
    const size_t hstepB = (size_t)HALF * K * 2;
    const size_t hstepA = GATHER ? (size_t)0 : hstepB;
    const size_t tstep = 2 * hstepB;
    const unsigned ldsw = (unsigned)wid * 1024u;
    const int aoff = lds_byte(wr * 64 + fr, fq * 8), boff = lds_byte(wc * 32 + fr, fq * 8);
    unsigned vgC[2][2], vgN[2][2];
#define PG8_SA(b, h) (((b) * 2 + (h)) * HTB)
#define PG8_SB(b, h) ((4 + (b) * 2 + (h)) * HTB)
#define PG8_STAGE(bufoff, gbase, voff) do { _Pragma("unroll") for (int _i = 0; _i < 2; ++_i) \
        __builtin_amdgcn_global_load_lds((const unsigned*)((const char*)(gbase) + (voff)[_i]), (PG8_LAS unsigned*)(lds + (bufoff) + ldsw + _i * 8192), 16, 0, 0); } while (0)
#define PG8_STAGE_A(bufoff, gbase, h, nx) do { if constexpr (GATHER) { unsigned _v[2]; _v[0] = (nx) ? vgN[h][0] : vgC[h][0]; _v[1] = (nx) ? vgN[h][1] : vgC[h][1]; PG8_STAGE(bufoff, gbase, _v); } \
        else { PG8_STAGE(bufoff, (gbase) + (h) * hstepA, voffA); } } while (0)
#define PG8_GOFF(dst, u) do { _Pragma("unroll") for (int _h = 0; _h < 2; ++_h) _Pragma("unroll") for (int _i = 0; _i < 2; ++_i) { int _R, _C; stage_rc(tid * 16 + _i * 8192, _R, _C); int _r = _h * HALF + _R; _r = _r < (u).nvalid ? _r : (u).nvalid - 1; \
        dst[_h][_i] = (unsigned)(u).ridx[_r] * (unsigned)(K * 2) + (unsigned)(_C * 2); } } while (0)
#define PG8_CAT(lo, hi) __builtin_shufflevector(lo, hi, 0, 1, 2, 3, 4, 5, 6, 7)
#define PG8_LDA(dst, b, h) do { _Pragma("unroll") for (int m = 0; m < 4; ++m) { if constexpr (FP8) { dst##8[m] = PG8_CAT(*(const PG8_LAS i32x4_*)(lds + PG8_SA(b, h) + aoff + m * 2048), *(const PG8_LAS i32x4_*)(lds + PG8_SA(b, h) + aoff + m * 2048 + 1024)); } \
        else { _Pragma("unroll") for (int k = 0; k < 2; ++k) dst[m][k] = *(const PG8_LAS bf16x8*)(lds + PG8_SA(b, h) + aoff + m * 2048 + k * 1024); } } } while (0)
#define PG8_LDB(dst, b, h) do { _Pragma("unroll") for (int n = 0; n < 2; ++n) { if constexpr (FP8) { dst##8[n] = PG8_CAT(*(const PG8_LAS i32x4_*)(lds + PG8_SB(b, h) + boff + n * 2048), *(const PG8_LAS i32x4_*)(lds + PG8_SB(b, h) + boff + n * 2048 + 1024)); } \
        else { _Pragma("unroll") for (int k = 0; k < 2; ++k) dst[n][k] = *(const PG8_LAS bf16x8*)(lds + PG8_SB(b, h) + boff + n * 2048 + k * 1024); } } } while (0)
#define PG8_MMA(ai, bj, At, Bt) do { __builtin_amdgcn_s_setprio(1); _Pragma("unroll") for (int m = 0; m < 4; ++m) _Pragma("unroll") for (int n = 0; n < 2; ++n) { \
        if constexpr (FP8) { asm volatile("v_mfma_scale_f32_16x16x128_f8f6f4 %0, %1, %2, %0, %3, %4 op_sel_hi:[0,0,0]" : "+v"(acc[ai][bj][m][n]) : "v"(Bt##8[n]), "v"(At##8[m]), "v"(scb_), "v"(sca_)); } \
        else { _Pragma("unroll") for (int k = 0; k < 2; ++k) acc[ai][bj][m][n] = __builtin_amdgcn_mfma_f32_16x16x32_bf16(Bt[n][k], At[m][k], acc[ai][bj][m][n], 0, 0, 0); } } \
        if constexpr (FP8) { asm volatile("s_nop 15\n\ts_nop 3" ::: "memory"); } \
        __builtin_amdgcn_s_setprio(0); } while (0)
#define PG8_WAIT_V(n) asm volatile("s_waitcnt vmcnt(" #n ")" ::: "memory")
#define PG8_WAIT_L(n) asm volatile("s_waitcnt lgkmcnt(" #n ")" ::: "memory")
#define PG8_BAR __builtin_amdgcn_s_barrier()
#define PG8_SCHED __builtin_amdgcn_sched_barrier(0)
    Unit cur, nxt; int ui = 0;
    if (!S.next(0, cur)) return;
    f32x4 acc[2][2][4][2];
#pragma unroll
    for (int a = 0; a < 2; ++a)
#pragma unroll
        for (int b = 0; b < 2; ++b)
#pragma unroll
            for (int m = 0; m < 4; ++m)
#pragma unroll
                for (int n = 0; n < 2; ++n) acc[a][b][m][n] = (f32x4){0.f, 0.f, 0.f, 0.f};
    typedef int i32x8_ __attribute__((ext_vector_type(8))); typedef int i32x4_ __attribute__((ext_vector_type(4)));
    int sca_ = g.scale_a, scb_ = g.scale_b; asm volatile("" : "+v"(sca_), "+v"(scb_));
    bf16x8 At[4][2], B0[2][2], B1[2][2]; i32x8_ At8[4], B08[2], B18[2];
    const char* cA = GATHER ? (const char*)g.A : (const char*)g.A + (size_t)cur.pm * tstep; const char* cB = (const char*)g.Bt + (size_t)cur.pn * tstep;
    if constexpr (GATHER) { PG8_GOFF(vgC, cur); }
    if constexpr (SP2) {
        PG8_STAGE(PG8_SB(0, 0), cB, voffB); PG8_STAGE(PG8_SB(0, 1), cB + hstepB, voffB); PG8_STAGE_A(PG8_SA(0, 0), cA, 0, false); PG8_STAGE_A(PG8_SA(0, 1), cA, 1, false);
        if (wr == 1) PG8_BAR;
        PG8_WAIT_V(2); PG8_BAR;
        PG8_STAGE(PG8_SB(1, 0), cB + kstep, voffB); PG8_STAGE_A(PG8_SA(1, 0), cA + kstep, 0, false); PG8_STAGE(PG8_SB(1, 1), cB + hstepB + kstep, voffB);
        PG8_WAIT_V(6); PG8_BAR;
    } else {
        PG8_STAGE(PG8_SB(0, 0), cB, voffB); PG8_STAGE_A(PG8_SA(0, 0), cA, 0, false); PG8_STAGE(PG8_SB(0, 1), cB + hstepB, voffB); PG8_STAGE_A(PG8_SA(0, 1), cA, 1, false);
        if (wr == 1) PG8_BAR;
        PG8_WAIT_V(4); PG8_BAR;
        PG8_STAGE(PG8_SB(1, 0), cB + kstep, voffB); PG8_STAGE_A(PG8_SA(1, 0), cA + kstep, 0, false); PG8_STAGE(PG8_SB(1, 1), cB + hstepB + kstep, voffB);
        PG8_WAIT_V(6); PG8_BAR;
    }
    for (;;) {
        const bool has_next = S.next(ui + 1, nxt);
        const char* nA = GATHER ? (const char*)g.A : (has_next ? (const char*)g.A + (size_t)nxt.pm * tstep : cA); const char* nB = has_next ? (const char*)g.Bt + (size_t)nxt.pn * tstep : cB;
        if constexpr (GATHER) { if (has_next) { PG8_GOFF(vgN, nxt); } else {
#pragma unroll
            for (int _h = 0; _h < 2; ++_h) { vgN[_h][0] = vgC[_h][0]; vgN[_h][1] = vgC[_h][1]; } } }
#pragma unroll 1
        for (int t = 0; t < nt; t += 2) {
            const bool last = (t == nt - 2);
            const char* a1 = cA + (size_t)(t + 1) * kstep;
            const char* a2 = last ? nA : cA + (size_t)(t + 2) * kstep; const char* b2 = last ? nB : cB + (size_t)(t + 2) * kstep;
            const char* a3 = a2 + kstep; const char* b3 = b2 + kstep;
            if constexpr (SP2) {
            PG8_LDB(B0, 0, 0); PG8_LDB(B1, 0, 1); PG8_SCHED; PG8_LDA(At, 0, 0); PG8_STAGE_A(PG8_SA(1, 1), a1, 1, false);
            PG8_WAIT_V(8); PG8_WAIT_L(0); PG8_BAR; PG8_MMA(0, 0, At, B0); PG8_MMA(0, 1, At, B1); PG8_BAR; PG8_SCHED;
            PG8_LDA(At, 0, 1); PG8_STAGE(PG8_SB(0, 0), b2, voffB); PG8_STAGE(PG8_SB(0, 1), b2 + hstepB, voffB); PG8_STAGE_A(PG8_SA(0, 0), a2, 0, last);
            PG8_WAIT_V(8); PG8_WAIT_L(0); PG8_BAR; PG8_MMA(1, 0, At, B0); PG8_MMA(1, 1, At, B1); PG8_BAR; PG8_SCHED;
            PG8_LDB(B0, 1, 0); PG8_LDB(B1, 1, 1); PG8_SCHED; PG8_LDA(At, 1, 0); PG8_STAGE_A(PG8_SA(0, 1), a2, 1, last);
            PG8_WAIT_V(8); PG8_WAIT_L(0); PG8_BAR; PG8_MMA(0, 0, At, B0); PG8_MMA(0, 1, At, B1); PG8_BAR; PG8_SCHED;
            PG8_LDA(At, 1, 1); PG8_STAGE(PG8_SB(1, 0), b3, voffB); PG8_STAGE(PG8_SB(1, 1), b3 + hstepB, voffB); PG8_STAGE_A(PG8_SA(1, 0), a3, 0, last);
            PG8_WAIT_V(8); PG8_WAIT_L(0); PG8_BAR; PG8_MMA(1, 0, At, B0); PG8_MMA(1, 1, At, B1); PG8_BAR; PG8_SCHED;
            } else {
            PG8_LDB(B0, 0, 0); PG8_SCHED; PG8_LDA(At, 0, 0); PG8_STAGE_A(PG8_SA(1, 1), a1, 1, false);
            PG8_WAIT_L(8); PG8_BAR; PG8_WAIT_L(0); PG8_MMA(0, 0, At, B0); PG8_BAR; PG8_SCHED;
            PG8_LDB(B1, 0, 1); PG8_STAGE(PG8_SB(0, 0), b2, voffB);
            PG8_BAR; PG8_WAIT_L(0); PG8_MMA(0, 1, At, B1); PG8_BAR;
            PG8_LDA(At, 0, 1); PG8_STAGE_A(PG8_SA(0, 0), a2, 0, last);
            PG8_BAR; PG8_WAIT_L(0); PG8_MMA(1, 0, At, B0); PG8_BAR; PG8_SCHED;
            PG8_STAGE(PG8_SB(0, 1), b2 + hstepB, voffB);
            PG8_WAIT_V(6); PG8_BAR; PG8_MMA(1, 1, At, B1); PG8_BAR;
            PG8_LDB(B0, 1, 0); PG8_SCHED; PG8_LDA(At, 1, 0); PG8_STAGE_A(PG8_SA(0, 1), a2, 1, last);
            PG8_WAIT_L(8); PG8_BAR; PG8_WAIT_L(0); PG8_MMA(0, 0, At, B0); PG8_BAR; PG8_SCHED;
            PG8_LDB(B1, 1, 1); PG8_STAGE(PG8_SB(1, 0), b3, voffB);
            PG8_BAR; PG8_WAIT_L(0); PG8_MMA(0, 1, At, B1); PG8_BAR;
            PG8_LDA(At, 1, 1); PG8_STAGE_A(PG8_SA(1, 0), a3, 0, last);
            PG8_BAR; PG8_WAIT_L(0); PG8_MMA(1, 0, At, B0); PG8_BAR; PG8_SCHED;
            PG8_STAGE(PG8_SB(1, 1), b3 + hstepB, voffB);
            PG8_WAIT_V(6); PG8_BAR; PG8_MMA(1, 1, At, B1); PG8_BAR;
            }
        }
        if constexpr (ALIGN_EPI) { if (wr == 0) PG8_BAR; }
        E(acc, cur, wr, wc, fr, fq);
        if (!has_next) break;
#pragma unroll
        for (int a = 0; a < 2; ++a)
#pragma unroll
            for (int b = 0; b < 2; ++b)
#pragma unroll
                for (int m = 0; m < 4; ++m)
#pragma unroll
                    for (int n = 0; n < 2; ++n) acc[a][b][m][n] = (f32x4){0.f, 0.f, 0.f, 0.f};
        cur = nxt; cA = nA; cB = nB; ++ui;
        if constexpr (GATHER) {
#pragma unroll
            for (int _h = 0; _h < 2; ++_h) { vgC[_h][0] = vgN[_h][0]; vgC[_h][1] = vgN[_h][1]; } }
        if constexpr (ALIGN_EPI) { if (wr == 1) PG8_BAR; }
    }
    PG8_WAIT_V(0);
    if constexpr (!ALIGN_EPI) { if (wr == 0) PG8_BAR; }
    PG8_BAR;
#undef PG8_SA
#undef PG8_SB
#undef PG8_STAGE
#undef PG8_STAGE_A
#undef PG8_GOFF
#undef PG8_LDA
#undef PG8_CAT
#undef PG8_LDB
#undef PG8_MMA
#undef PG8_WAIT_V
#undef PG8_WAIT_L
#undef PG8_BAR
#undef PG8_SCHED
}
}
#define DI __device__ __forceinline__
#define LAS __attribute__((address_space(3)))
typedef unsigned short bf16;
typedef short bf16x8 __attribute__((ext_vector_type(8)));
typedef short s16x4 __attribute__((ext_vector_type(4)));
typedef float f32x4 __attribute__((ext_vector_type(4)));
typedef float f32x2 __attribute__((ext_vector_type(2)));
typedef unsigned u32x4 __attribute__((ext_vector_type(4)));
typedef unsigned u32x2 __attribute__((ext_vector_type(2)));
typedef unsigned char uchar;

constexpr int NB = 16, SEQ = 4096, DM = 1024, NTOK = NB * SEQ;
constexpr int NMEM = 256, NMROWS = NB * NMEM;
constexpr int ZC = 3072;
constexpr int NEXP = 32, DEXP = 512;
constexpr int MAXTILES = 544, MAXSLOTS = MAXTILES * 256;
constexpr float RMS_EPS = 1e-6f, LN_EPS = 1e-5f;
constexpr int NWAVES = 8, NTHR = 512;
constexpr int LDS_BYTES = 163840;

constexpr size_t MiB = 1u << 20;
constexpr size_t O_CTL = 0, CTL_BYTES = 64 * 1024;
constexpr size_t O_RS0 = 1 * MiB, O_RSM = O_RS0 + 256 * 1024, O_RS3 = O_RS0 + 512 * 1024;
constexpr size_t O_GATES = 2 * MiB;
constexpr size_t O_SS1 = 6 * MiB;
constexpr size_t O_TOK = 10 * MiB;
constexpr size_t O_RIDX = 12 * MiB;
constexpr size_t O_NST = 20 * MiB, O_MST = 22 * MiB;
constexpr size_t O_WSB = 23 * MiB;
constexpr size_t O_WRH = 24 * MiB, O_WRL = O_WRH + 128 * 1024;
constexpr size_t O_WIN = 32 * MiB, O_WOUT = 38 * MiB, O_WQ = 40 * MiB, O_WKV = 42 * MiB, O_WO = 46 * MiB, O_WGU = 48 * MiB, O_WD = 112 * MiB;
constexpr size_t O_XB = 160 * MiB;
constexpr size_t O_MEMB = 288 * MiB, O_KV = 296 * MiB;
constexpr size_t O_Z = 320 * MiB;
constexpr size_t O_ZQ = 448 * MiB, O_ZK = 512 * MiB, O_ZV = 576 * MiB, O_ZO = 640 * MiB;
constexpr int ZG = 1024;
constexpr size_t O_CST = 704 * MiB;
constexpr size_t O_Y = 840 * MiB;
constexpr size_t O_Q = O_Z, O_O = O_Z + 128 * MiB;
constexpr size_t O_H = O_Z, O_YD = O_Z + 144 * MiB;
constexpr size_t O_WGU8 = O_WGU, O_WD8 = O_WGU + 32 * MiB;
constexpr size_t O_X1F8 = 576 * MiB;
constexpr size_t O_X2F8 = O_Y;
constexpr int SC_ONE = 0x7F7F7F7F, SC_W = 0x7A7A7A7A;
constexpr size_t WS_NEED = 968 * MiB;
constexpr int CW_CNT = 0, CW_BAR = 4096;
constexpr int CW_CNT_UNUSED = 0;

#define LDS_WAIT() asm volatile("s_waitcnt lgkmcnt(0)" ::: "memory")
DI unsigned f2bf(float f) { unsigned u = __builtin_bit_cast(unsigned, f); return (u + 0x7fffu + ((u >> 16) & 1u)) >> 16; }
DI unsigned pk2(float lo, float hi) { return pg8::cvt_pk_bf16(lo, hi); }
DI unsigned pk4_fp8(float a, float b, float c, float d) { int t = __builtin_amdgcn_cvt_pk_fp8_f32(a, b, 0, false); t = __builtin_amdgcn_cvt_pk_fp8_f32(c, d, t, true); return (unsigned)t; }
DI float bf2f(unsigned short h) { return __builtin_bit_cast(float, (unsigned)h << 16); }
DI float bflo(unsigned w) { return __builtin_bit_cast(float, w << 16); }
DI float bfhi(unsigned w) { return __builtin_bit_cast(float, w & 0xffff0000u); }
#define DPP_F(old, src, ctrl, rm) __builtin_bit_cast(float, __builtin_amdgcn_update_dpp(__builtin_bit_cast(int, (float)(old)), __builtin_bit_cast(int, (float)(src)), ctrl, rm, 0xF, false))
DI float wave_sum(float v) {
    v += DPP_F(0.f, v, 0xB1, 0xF); v += DPP_F(0.f, v, 0x4E, 0xF); v += DPP_F(0.f, v, 0x141, 0xF); v += DPP_F(0.f, v, 0x140, 0xF);
    v += DPP_F(0.f, v, 0x142, 0xA); v += DPP_F(0.f, v, 0x143, 0xC);
    return __builtin_bit_cast(float, __builtin_amdgcn_readlane(__builtin_bit_cast(int, v), 63));
}
DI float wave_max(float v) {
    v = fmaxf(v, DPP_F(v, v, 0xB1, 0xF)); v = fmaxf(v, DPP_F(v, v, 0x4E, 0xF)); v = fmaxf(v, DPP_F(v, v, 0x141, 0xF)); v = fmaxf(v, DPP_F(v, v, 0x140, 0xF));
    v = fmaxf(v, DPP_F(v, v, 0x142, 0xA)); v = fmaxf(v, DPP_F(v, v, 0x143, 0xC));
    return __builtin_bit_cast(float, __builtin_amdgcn_readlane(__builtin_bit_cast(int, v), 63));
}
DI float wscan_add(float v, int lane) {
#pragma unroll
    for (int o = 1; o < 64; o <<= 1) { const float u = __shfl_up(v, o); v = (lane >= o) ? v + u : v; }
    return v;
}
DI float wscan_max(float v, int lane) {
#pragma unroll
    for (int o = 1; o < 64; o <<= 1) { const float u = __shfl_up(v, o); v = (lane >= o) ? fmaxf(v, u) : v; }
    return v;
}
DI float wscan_max_rev(float v, int lane) {
#pragma unroll
    for (int o = 1; o < 64; o <<= 1) { const float u = __shfl_down(v, o); v = (lane + o < 64) ? fmaxf(v, u) : v; }
    return v;
}
DI float fast_exp(float x) { return __expf(x); }
DI float sigmoidf_(float x) { return __builtin_amdgcn_rcpf(1.0f + __expf(-x)); }
DI float siluf_(float x) { return x * __builtin_amdgcn_rcpf(1.0f + __expf(-x)); }
DI float gelu_tanh(float x) { const float u = 0.7978845608028654f * (x + 0.044715f * x * x * x); return x * __builtin_amdgcn_rcpf(1.0f + __expf(-2.0f * u)); }
DI float log_sigmoid(float x) { return fminf(x, 0.f) - __logf(1.0f + __expf(-fabsf(x))); }

DI unsigned offb(unsigned row, unsigned ch) { return 256u * row + 16u * (ch ^ (((row & 3u) << 2) | ((row >> 2) & 3u))); }
DI bf16x8 frag_row(const LAS uchar* tile, int r0, int kk, int lane) { return *(const LAS bf16x8*)(tile + offb(r0 + (lane & 15), 4 * kk + (lane >> 4))); }
DI bf16x8 frag_tr(const LAS uchar* tile, int k0, int c0, int lane) {
    const unsigned g = lane >> 4, q = (lane & 15) >> 2, p = lane & 3;
    const unsigned ch = (c0 >> 3) + (p >> 1), bo = 8u * (p & 1);
    const s16x4 lo = __builtin_amdgcn_ds_read_tr16_b64_v4i16((LAS s16x4*)(tile + offb(k0 + 8 * g + q, ch) + bo));
    const s16x4 hi = __builtin_amdgcn_ds_read_tr16_b64_v4i16((LAS s16x4*)(tile + offb(k0 + 8 * g + 4 + q, ch) + bo));
    return (bf16x8){lo[0], lo[1], lo[2], lo[3], hi[0], hi[1], hi[2], hi[3]};
}
DI f32x4 mfma16(bf16x8 x, bf16x8 y, f32x4 acc) { return __builtin_amdgcn_mfma_f32_16x16x32_bf16(x, y, acc, 0, 0, 0); }

#if defined(__HIP_DEVICE_COMPILE__)
#define GASK __attribute__((address_space(1)))
#else
#define GASK
#endif
struct Args { const GASK float* in[27]; GASK float* out; GASK uchar* ws; int ph_lo, ph_hi; };
struct Frame {
    LAS uchar* lds;
    int tid, lane, wave, G, bid;
    const GASK float* const* in;
    float* out; uchar* ws;
};
#define GAS __attribute__((address_space(1)))
#define INP(i) ((const float*)F.in[i])
enum { I_X = 0, I_MEM, I_GMIX, I_WIN, I_CONVW, I_CONVB, I_GATEB, I_GHEAD, I_LNVG, I_LNVB, I_WS, I_BS, I_WOUT, I_GXATTN, I_GMEM, I_WQ, I_WKV, I_WO, I_GMOE, I_WRG, I_BRG, I_WRE, I_BRE, I_WGATE, I_WUP, I_WDOWN, I_GFINAL };
struct P0Item { const float* W; const float* gain; bf16* WT; size_t drow0; int K, ldw, scol0, k0, f8; };
DI void p0_decode(Frame& F, int it, P0Item& I) {
    uchar* ws = F.ws;
    constexpr int I_IN = 16 * 96, I_SQ = 16 * 32, I_KV = 16 * 64, I_GU = 32 * 16 * 16;
    int r = it;
    if (r < I_IN) { const int kb = r / 96, nb = r % 96; I = P0Item{INP(I_WIN), INP(I_GMIX), (bf16*)(ws + O_WIN), (size_t)nb * 32, 1024, 3088, nb * 32 < 2048 ? nb * 32 : nb * 32 + 16, kb * 64, 0}; return; } r -= I_IN;
    if (r < I_SQ) { const int kb = r / 32, nb = r % 32; I = P0Item{INP(I_WOUT), nullptr, (bf16*)(ws + O_WOUT), (size_t)nb * 32, 1024, 1024, nb * 32, kb * 64, 0}; return; } r -= I_SQ;
    if (r < I_SQ) { const int kb = r / 32, nb = r % 32; I = P0Item{INP(I_WQ), INP(I_GXATTN), (bf16*)(ws + O_WQ), (size_t)nb * 32, 1024, 1024, nb * 32, kb * 64, 1}; return; } r -= I_SQ;
    if (r < I_KV) { const int kb = r / 64, nb = r % 64; I = P0Item{INP(I_WKV), INP(I_GMEM), (bf16*)(ws + O_WKV), (size_t)nb * 32, 1024, 2048, nb * 32, kb * 64, 0}; return; } r -= I_KV;
    if (r < I_SQ) { const int kb = r / 32, nb = r % 32; I = P0Item{INP(I_WO), nullptr, (bf16*)(ws + O_WO), (size_t)nb * 32, 1024, 1024, nb * 32, kb * 64, 1}; return; } r -= I_SQ;
    if (r < 2 * I_GU) { const int up = r >= I_GU; if (up) r -= I_GU; const int e = r / 256, q = r % 256, kb = q / 16, nb = q % 16;
        I = P0Item{INP(up ? I_WUP : I_WGATE) + (size_t)e * 1024 * 512, INP(I_GMOE), (bf16*)(ws + O_WGU8), (size_t)e * 1024 + 256 * (nb / 4) + (up ? 128 : 0) + (nb % 4) * 32, 1024, 512, nb * 32, kb * 64, 1}; return; } r -= 2 * I_GU;
    { const int e = r / 256, q = r % 256, kb = q / 32, nb = q % 32;
        I = P0Item{INP(I_WDOWN) + (size_t)e * 512 * 1024, nullptr, (bf16*)(ws + O_WD8), (size_t)e * 1024 + nb * 32, 512, 1024, nb * 32, kb * 64, 1}; }
}
DI void p0_item_load(const P0Item& I, float (&tv)[32], int lane) {
#pragma unroll
    for (int i = 0; i < 32; ++i) { const int kk = 2 * i + (lane >> 5); tv[i] = *(const GAS float*)(I.W + (size_t)(I.k0 + kk) * I.ldw + I.scol0 + (lane & 31)); }
}
DI void p0_item_store(const P0Item& I, float (&tv)[32], LAS float* scr, int lane) {
    if (I.gain) {
#pragma unroll
        for (int i = 0; i < 32; ++i) tv[i] *= I.gain[I.k0 + 2 * i + (lane >> 5)]; }
#pragma unroll
    for (int i = 0; i < 32; ++i) { const int kk = 2 * i + (lane >> 5); scr[kk * 33 + (lane & 31)] = tv[i]; }
    LDS_WAIT(); asm volatile("" ::: "memory");
    if (I.f8) {
        const int c = lane & 3;
#pragma unroll
        for (int j = 0; j < 2; ++j) { const int n = (lane >> 2) + 16 * j; const LAS float* s = scr + (16 * c) * 33 + n;
            u32x4 o; o.x = pk4_fp8(32.f * s[0 * 33], 32.f * s[1 * 33], 32.f * s[2 * 33], 32.f * s[3 * 33]); o.y = pk4_fp8(32.f * s[4 * 33], 32.f * s[5 * 33], 32.f * s[6 * 33], 32.f * s[7 * 33]);
            o.z = pk4_fp8(32.f * s[8 * 33], 32.f * s[9 * 33], 32.f * s[10 * 33], 32.f * s[11 * 33]); o.w = pk4_fp8(32.f * s[12 * 33], 32.f * s[13 * 33], 32.f * s[14 * 33], 32.f * s[15 * 33]);
            *(GAS u32x4*)((uchar*)I.WT + (I.drow0 + n) * (size_t)I.K + I.k0 + 16 * c) = o; }
    } else {
    const int c = lane & 7;
#pragma unroll
    for (int j = 0; j < 4; ++j) { const int n = (lane >> 3) + 8 * j; const LAS float* s = scr + (8 * c) * 33 + n;
        u32x4 o; o.x = pk2(s[0 * 33], s[1 * 33]); o.y = pk2(s[2 * 33], s[3 * 33]); o.z = pk2(s[4 * 33], s[5 * 33]); o.w = pk2(s[6 * 33], s[7 * 33]);
        *(GAS u32x4*)(I.WT + (I.drow0 + n) * (size_t)I.K + I.k0 + 8 * c) = o; }
    }
    LDS_WAIT(); asm volatile("" ::: "memory");
}

DI void phase0(Frame& F) {
    const int gw = F.bid * NWAVES + F.wave, NGW = F.G * NWAVES, lane = F.lane;
    uchar* ws = F.ws;
    {
        LAS float* scr = (LAS float*)(F.lds + F.wave * 16384);
        constexpr int NITEMS = 16 * 96 + 3 * 16 * 32 + 16 * 64 + 2 * 32 * 16 * 16 + 32 * 8 * 32;
        P0Item cur, nxt; float tvA[32], tvB[32];
        int it = gw;
        if (it < NITEMS) { p0_decode(F, it, cur); p0_item_load(cur, tvA, lane); }
        while (it < NITEMS) {
            if (it + NGW < NITEMS) { p0_decode(F, it + NGW, nxt); p0_item_load(nxt, tvB, lane); }
            p0_item_store(cur, tvA, scr, lane);
            it += NGW; if (it >= NITEMS) break;
            if (it + NGW < NITEMS) { p0_decode(F, it + NGW, cur); p0_item_load(cur, tvA, lane); }
            p0_item_store(nxt, tvB, scr, lane);
            it += NGW;
        }
        for (int i = F.bid * NTHR + F.tid; i < 48 * 1024; i += F.G * NTHR) { const int n = i >> 10, k = i & 1023; float v = 0.f;
            if (n < 4) v = INP(I_WRG)[k * 4 + n] * INP(I_GMOE)[k]; else if (n >= 16) v = INP(I_WRE)[k * 32 + (n - 16)] * INP(I_GMOE)[k];
            const unsigned h = f2bf(v); const float hf = __builtin_bit_cast(float, h << 16);
            ((bf16*)(ws + O_WRH))[i] = (bf16)h; ((bf16*)(ws + O_WRL))[i] = (bf16)f2bf(v - hf); }
        for (int i = F.bid * NTHR + F.tid; i < 4 * 128 * 128 / 2; i += F.G * NTHR) { const f32x2 v = *(const GAS f32x2*)(INP(I_WS) + 2 * i); ((unsigned*)(ws + O_WSB))[i] = pk2(v.x, v.y); }
    }
    __syncthreads();
    LAS float* wg = (LAS float*)F.lds;
    for (int idx = F.tid; idx < 1024 * 16; idx += NTHR) { const int i = idx >> 4, j = idx & 15; const float v = INP(I_WIN)[(size_t)i * 3088 + 2048 + j] * INP(I_GMIX)[i];
        const int jj = i >> 8, l = (i & 255) >> 2, ii = i & 3, j4 = j >> 2, jr = j & 3; wg[((((jj * 4 + ii) * 4 + j4) * 64 + l) << 2) + jr] = v; }
    __syncthreads();
    {
        bf16* XB = (bf16*)(ws + O_XB); float* rs0 = (float*)(ws + O_RS0); float* gates = (float*)(ws + O_GATES);
        const float gb = INP(I_GATEB)[lane >> 2];
        f32x4 nx[4];
        if (gw < NTOK) { const f32x4* xr0 = (const f32x4*)(INP(I_X) + (size_t)gw * DM) + lane;
#pragma unroll
            for (int j = 0; j < 4; ++j) nx[j] = xr0[64 * j]; }
        for (int m = gw; m < NTOK; m += NGW) {
            f32x4 v[4]; float s = 0.f;
#pragma unroll
            for (int j = 0; j < 4; ++j) { v[j] = nx[j]; s += (v[j].x * v[j].x + v[j].y * v[j].y) + (v[j].z * v[j].z + v[j].w * v[j].w); }
            if (m + NGW < NTOK) { const f32x4* xr1 = (const f32x4*)(INP(I_X) + (size_t)(m + NGW) * DM) + lane;
#pragma unroll
                for (int j = 0; j < 4; ++j) nx[j] = xr1[64 * j]; }
            const float rs = 1.0f / sqrtf(wave_sum(s) * (1.f / DM) + RMS_EPS);
            unsigned long long* o8 = (unsigned long long*)(XB + (size_t)m * DM) + lane;
#pragma unroll
            for (int j = 0; j < 4; ++j) o8[64 * j] = (unsigned long long)pk2(v[j].x, v[j].y) | ((unsigned long long)pk2(v[j].z, v[j].w) << 32);
            float p[16];
#pragma unroll
            for (int j = 0; j < 16; ++j) p[j] = 0.f;
#pragma unroll
            for (int jj = 0; jj < 4; ++jj)
#pragma unroll
                for (int ii = 0; ii < 4; ++ii) { const float xv = v[jj][ii];
#pragma unroll
                    for (int j4 = 0; j4 < 4; ++j4) { const f32x4 w = *(const LAS f32x4*)(wg + ((((jj * 4 + ii) * 4 + j4) * 64 + lane) << 2));
                        p[4 * j4 + 0] += xv * w.x; p[4 * j4 + 1] += xv * w.y; p[4 * j4 + 2] += xv * w.z; p[4 * j4 + 3] += xv * w.w; } }
            float q8[8], q4[4], q2[2], q1;
            { const bool hi = (lane & 32) != 0;
#pragma unroll
              for (int k = 0; k < 8; ++k) { const float send = hi ? p[k] : p[k + 8], keep = hi ? p[k + 8] : p[k]; q8[k] = keep + __shfl_xor(send, 32); } }
            { const bool hi = (lane & 16) != 0;
#pragma unroll
              for (int k = 0; k < 4; ++k) { const float send = hi ? q8[k] : q8[k + 4], keep = hi ? q8[k + 4] : q8[k]; q4[k] = keep + __shfl_xor(send, 16); } }
            { const bool hi = (lane & 8) != 0;
#pragma unroll
              for (int k = 0; k < 2; ++k) { const float send = hi ? q4[k] : q4[k + 2], keep = hi ? q4[k + 2] : q4[k]; q2[k] = keep + __shfl_xor(send, 8); } }
            { const bool hi = (lane & 4) != 0; const float send = hi ? q2[0] : q2[1], keep = hi ? q2[1] : q2[0]; q1 = keep + __shfl_xor(send, 4); }
            q1 += __shfl_xor(q1, 2); q1 += __shfl_xor(q1, 1);
            if ((lane & 3) == 0) gates[(size_t)m * 16 + (lane >> 2)] = q1 * rs + gb;
            if (lane == 0) rs0[m] = rs;
        }
    }
    {
        bf16* MB = (bf16*)(ws + O_MEMB); float* rsm = (float*)(ws + O_RSM);
        for (int m = gw; m < NMROWS; m += NGW) {
            const f32x4* xr = (const f32x4*)(INP(I_MEM) + (size_t)m * DM) + lane;
            f32x4 v[4]; float s = 0.f;
#pragma unroll
            for (int j = 0; j < 4; ++j) { v[j] = xr[64 * j]; s += (v[j].x * v[j].x + v[j].y * v[j].y) + (v[j].z * v[j].z + v[j].w * v[j].w); }
            const float rs = 1.0f / sqrtf(wave_sum(s) * (1.f / DM) + RMS_EPS);
            unsigned long long* o8 = (unsigned long long*)(MB + (size_t)m * DM) + lane;
#pragma unroll
            for (int j = 0; j < 4; ++j) o8[64 * j] = (unsigned long long)pk2(v[j].x, v[j].y) | ((unsigned long long)pk2(v[j].z, v[j].w) << 32);
            if (lane == 0) rsm[m] = rs;
        }
    }
}
using pg8::Unit;
typedef const f32x4 (&AccRef)[2][2][4][2];

template <int MODE> struct EpiRowScale {
    static constexpr bool PERM = true;
    bf16* O; int ldc; const float* rs; float extra;
    DI void operator()(AccRef acc, const Unit& u, int wr, int wc, int fr, int fq) const {
        const int row0 = u.orow * 256 + wr * 64 + fr, col0 = u.ocol + wc * 32 + 8 * fq;
        const int act = (MODE == 0) ? (u.pn >= 8 ? 2 : (u.pn >= 6 ? 1 : 0)) : 0;
        float sc[2][4];
#pragma unroll
        for (int ai = 0; ai < 2; ++ai)
#pragma unroll
            for (int m = 0; m < 4; ++m) sc[ai][m] = *(const GAS float*)(rs + row0 + ai * 128 + m * 16);
#pragma unroll
        for (int ai = 0; ai < 2; ++ai)
#pragma unroll
            for (int m = 0; m < 4; ++m) { const int row = row0 + ai * 128 + m * 16; const float s = sc[ai][m] * extra;
#pragma unroll
                for (int bj = 0; bj < 2; ++bj) { f32x4 v0 = acc[ai][bj][m][0] * s, v1 = acc[ai][bj][m][1] * s;
                    if (act == 1) {
#pragma unroll
                        for (int j = 0; j < 4; ++j) { v0[j] = sigmoidf_(v0[j]); v1[j] = sigmoidf_(v1[j]); } }
                    else if (act == 2) {
#pragma unroll
                        for (int j = 0; j < 4; ++j) { v0[j] = gelu_tanh(v0[j]); v1[j] = gelu_tanh(v1[j]); } }
                    u32x4 w; w.x = pk2(v0[0], v0[1]); w.y = pk2(v0[2], v0[3]); w.z = pk2(v1[0], v1[1]); w.w = pk2(v1[2], v1[3]);
                    bf16* dst;
                    if (MODE == 0) {
                        if (u.pn < 8) dst = O + (size_t)(64 * MiB / 2) * (u.pn >> 1) + (size_t)(128 * MiB / 2) + ((size_t)((row >> 12) * 4 + (u.pn & 1) * 2 + bj) * SEQ + (row & (SEQ - 1))) * 128 + wc * 32 + 8 * fq;
                        else dst = O + (size_t)row * ZG + (u.pn - 8) * 256 + bj * 128 + wc * 32 + 8 * fq;
                    } else dst = O + (size_t)row * ldc + col0 + bj * 128;
                    *(GAS u32x4*)dst = w; } }
    }
};
struct EpiQ {
    static constexpr bool PERM = true;
    bf16* O; const float* ssp; float extra;
    DI void operator()(AccRef acc, const Unit& u, int wr, int wc, int fr, int fq) const {
        const int row0 = u.orow * 256 + wr * 64 + fr, col0 = u.ocol + wc * 32 + 8 * fq;
        float sc[2][4];
#pragma unroll
        for (int ai = 0; ai < 2; ++ai) { f32x4 p[4][4];
#pragma unroll
            for (int m = 0; m < 4; ++m) { const GAS f32x4* sp = (const GAS f32x4*)(ssp + (size_t)(row0 + ai * 128 + m * 16) * 16);
                p[m][0] = sp[0]; p[m][1] = sp[1]; p[m][2] = sp[2]; p[m][3] = sp[3]; }
#pragma unroll
            for (int m = 0; m < 4; ++m) { const f32x4 a = p[m][0], b = p[m][1], c = p[m][2], d = p[m][3];
                const float ss = (((a.x + a.y) + (a.z + a.w)) + ((b.x + b.y) + (b.z + b.w))) + (((c.x + c.y) + (c.z + c.w)) + ((d.x + d.y) + (d.z + d.w)));
                sc[ai][m] = extra / sqrtf(ss * (1.f / DM) + RMS_EPS); } }
#pragma unroll
        for (int ai = 0; ai < 2; ++ai)
#pragma unroll
            for (int m = 0; m < 4; ++m) { const int row = row0 + ai * 128 + m * 16; const float s = sc[ai][m]; bf16* rowp = O + (size_t)row * DM + col0;
#pragma unroll
                for (int bj = 0; bj < 2; ++bj) { const f32x4 v0 = acc[ai][bj][m][0] * s, v1 = acc[ai][bj][m][1] * s;
                    u32x4 w; w.x = pk2(v0[0], v0[1]); w.y = pk2(v0[2], v0[3]); w.z = pk2(v1[0], v1[1]); w.w = pk2(v1[2], v1[3]);
                    *(GAS u32x4*)(rowp + bj * 128) = w; } }
    }
};
template <bool BASE_BF16, bool SS, bool F8> struct EpiRes {
    static constexpr bool PERM = true;
    const float* base; bf16* xb; float* ssp; uchar* x8;
    DI void operator()(AccRef acc, const Unit& u, int wr, int wc, int fr, int fq) const {
        static_assert(BASE_BF16, "the residual base is the bf16 stream itself");
        const int row0 = u.orow * 256 + wr * 64 + fr, col0 = u.ocol + wc * 32 + 8 * fq;
        u32x4 bs[2][4][2];
#pragma unroll
        for (int ai = 0; ai < 2; ++ai)
#pragma unroll
            for (int m = 0; m < 4; ++m) { const size_t off = (size_t)(row0 + ai * 128 + m * 16) * DM + col0;
#pragma unroll
                for (int bj = 0; bj < 2; ++bj) bs[ai][m][bj] = *(const GAS u32x4*)(xb + off + bj * 128); }
#pragma unroll
        for (int ai = 0; ai < 2; ++ai)
#pragma unroll
            for (int m = 0; m < 4; ++m) { const int row = row0 + ai * 128 + m * 16; const size_t off = (size_t)row * DM + col0; float q = 0.f;
#pragma unroll
                for (int bj = 0; bj < 2; ++bj) { const u32x4 b4 = bs[ai][m][bj];
                    const f32x4 v0 = (f32x4){bflo(b4.x), bfhi(b4.x), bflo(b4.y), bfhi(b4.y)} + acc[ai][bj][m][0], v1 = (f32x4){bflo(b4.z), bfhi(b4.z), bflo(b4.w), bfhi(b4.w)} + acc[ai][bj][m][1];
                    u32x4 w; w.x = pk2(v0[0], v0[1]); w.y = pk2(v0[2], v0[3]); w.z = pk2(v1[0], v1[1]); w.w = pk2(v1[2], v1[3]);
                    *(GAS u32x4*)(xb + off + bj * 128) = w;
                    if (F8) { u32x2 w8; w8.x = pk4_fp8(v0[0], v0[1], v0[2], v0[3]); w8.y = pk4_fp8(v1[0], v1[1], v1[2], v1[3]); *(GAS u32x2*)(x8 + off + bj * 128) = w8; }
                    if (SS) q += ((v0[0] * v0[0] + v0[1] * v0[1]) + (v0[2] * v0[2] + v0[3] * v0[3])) + ((v1[0] * v1[0] + v1[1] * v1[1]) + (v1[2] * v1[2] + v1[3] * v1[3])); }
                if (SS) { q += __shfl_xor(q, 16); q += __shfl_xor(q, 32); if (fq == 0) *(GAS float*)(ssp + (size_t)row * 16 + u.pn * 4 + wc) = q; } }
    }
};
struct EpiGU {
    static constexpr bool PERM = true;
    bf16* H; const float* rs3;
    DI void operator()(AccRef acc, const Unit& u, int wr, int wc, int fr, int fq) const {
        const int rl0 = wr * 64 + fr, col0 = u.ocol + wc * 32 + 8 * fq;
        int tk[2][4]; float sc[2][4];
#pragma unroll
        for (int ai = 0; ai < 2; ++ai)
#pragma unroll
            for (int m = 0; m < 4; ++m) { const int rl = rl0 + ai * 128 + m * 16; const int rc = rl < u.nvalid ? rl : u.nvalid - 1; tk[ai][m] = *(const GAS int*)(u.ridx + rc); }
#pragma unroll
        for (int ai = 0; ai < 2; ++ai)
#pragma unroll
            for (int m = 0; m < 4; ++m) sc[ai][m] = *(const GAS float*)(rs3 + tk[ai][m]);
#pragma unroll
        for (int ai = 0; ai < 2; ++ai)
#pragma unroll
            for (int m = 0; m < 4; ++m) { const int rl = rl0 + ai * 128 + m * 16; const float s = sc[ai][m];
                uchar* rowp = (uchar*)H + (size_t)(u.orow * 256 + rl) * DEXP + col0;
                f32x4 h0, h1;
#pragma unroll
                for (int j = 0; j < 4; ++j) { h0[j] = siluf_(acc[ai][0][m][0][j] * s) * (acc[ai][1][m][0][j] * s); h1[j] = siluf_(acc[ai][0][m][1][j] * s) * (acc[ai][1][m][1][j] * s); }
                u32x2 w; w.x = pk4_fp8(h0[0], h0[1], h0[2], h0[3]); w.y = pk4_fp8(h1[0], h1[1], h1[2], h1[3]);
                *(GAS u32x2*)rowp = w; }
    }
};
struct EpiPlain {
    static constexpr bool PERM = true;
    bf16* O; int ldc;
    DI void operator()(AccRef acc, const Unit& u, int wr, int wc, int fr, int fq) const {
        const int row0 = u.orow * 256 + wr * 64 + fr, col0 = u.ocol + wc * 32 + 8 * fq;
#pragma unroll
        for (int ai = 0; ai < 2; ++ai)
#pragma unroll
            for (int m = 0; m < 4; ++m) { bf16* rowp = O + (size_t)(row0 + ai * 128 + m * 16) * ldc + col0;
#pragma unroll
                for (int bj = 0; bj < 2; ++bj) { const f32x4 v0 = acc[ai][bj][m][0], v1 = acc[ai][bj][m][1];
                    u32x4 w; w.x = pk2(v0[0], v0[1]); w.y = pk2(v0[2], v0[3]); w.z = pk2(v1[0], v1[1]); w.w = pk2(v1[2], v1[3]);
                    *(GAS u32x4*)(rowp + bj * 128) = w; } }
    }
};
struct MoeOrder {
    const LAS int* cum; const LAS int* cnt; const int* ridx; int G, c; bool down;
    DI bool next(int i, Unit& u) const {
        const int L = i * G + c, T = L >> 2, j = L & 3; if (T >= __builtin_amdgcn_readfirstlane(cum[32])) return false;
        int e = 0;
        for (int k = 1; k < 32; ++k) e += (__builtin_amdgcn_readfirstlane(cum[k]) <= T) ? 1 : 0;
        const int mt = T - __builtin_amdgcn_readfirstlane(cum[e]);
        u.ex = e; u.orow = T; u.nvalid = min(256, __builtin_amdgcn_readfirstlane(cnt[e]) - mt * 256); u.ridx = ridx + (size_t)e * NTOK + mt * 256;
        if (down) { u.pm = T; u.pn = e * 4 + j; u.ocol = 256 * j; } else { u.pm = 0; u.pn = e * 4 + j; u.ocol = 128 * j; }
        return true;
    }
};
#define SFENCE() do { asm volatile("" ::: "memory"); __builtin_amdgcn_sched_barrier(0); } while (0)
DI void conv_issue(u32x4 (&raw)[8], const bf16* src, int c, int tid) {
    const int dg = tid & 15, sg = tid >> 4;
#pragma unroll
    for (int r = 0; r < 8; ++r) { const int pos = c * 128 + 4 * sg - 2 + r; raw[r] = (u32x4){0u, 0u, 0u, 0u};
        if (pos >= 0 && pos < SEQ) raw[r] = *(const GAS u32x4*)(src + (size_t)pos * 128 + 8 * dg); }
}
DI void conv_build(LAS uchar* tile, const u32x4 (&raw)[8], int zcol0, const float* convw, const float* convb, float scale, int tid) {
    const int dg = tid & 15, sg = tid >> 4;
    f32x2 cw[5][4], cb[4];
#pragma unroll
    for (int j = 0; j < 5; ++j) { const f32x4 a = *(const GAS f32x4*)(convw + j * 1024 + zcol0 + 8 * dg), bq = *(const GAS f32x4*)(convw + j * 1024 + zcol0 + 8 * dg + 4);
        cw[j][0] = (f32x2){a.x, a.y}; cw[j][1] = (f32x2){a.z, a.w}; cw[j][2] = (f32x2){bq.x, bq.y}; cw[j][3] = (f32x2){bq.z, bq.w}; }
    { const f32x4 a = *(const GAS f32x4*)(convb + zcol0 + 8 * dg), bq = *(const GAS f32x4*)(convb + zcol0 + 8 * dg + 4);
        cb[0] = (f32x2){a.x, a.y}; cb[1] = (f32x2){a.z, a.w}; cb[2] = (f32x2){bq.x, bq.y}; cb[3] = (f32x2){bq.z, bq.w}; }
    f32x2 in[8][4];
#pragma unroll
    for (int r = 0; r < 8; ++r) { in[r][0] = (f32x2){bflo(raw[r].x), bfhi(raw[r].x)}; in[r][1] = (f32x2){bflo(raw[r].y), bfhi(raw[r].y)}; in[r][2] = (f32x2){bflo(raw[r].z), bfhi(raw[r].z)}; in[r][3] = (f32x2){bflo(raw[r].w), bfhi(raw[r].w)}; }
#pragma unroll
    for (int rr = 0; rr < 4; ++rr) { unsigned ow[4];
#pragma unroll
        for (int i = 0; i < 4; ++i) { f32x2 a = cb[i];
#pragma unroll
            for (int j = 0; j < 5; ++j) a = __builtin_elementwise_fma(in[rr + j][i], cw[j][i], a);
            ow[i] = pk2(siluf_(a.x) * scale, siluf_(a.y) * scale); }
        *(LAS u32x4*)(tile + offb(4 * sg + rr, dg)) = (u32x4){ow[0], ow[1], ow[2], ow[3]}; }
}
DI void build_copy_tile(LAS uchar* tile, const bf16* src, size_t row0, int ld, int col0, int tid) {
    const int dg = tid & 15, sg = tid >> 4;
#pragma unroll
    for (int rr = 0; rr < 4; ++rr) { const int r = 4 * sg + rr; *(LAS u32x4*)(tile + offb(r, dg)) = *(const GAS u32x4*)(src + (row0 + r) * (size_t)ld + col0 + 8 * dg); }
}

DI void scan_issue(u32x4 (&kr)[6], u32x4 (&vr)[4], const bf16* zk, const bf16* zv, int c, int dh, int tid) {
    const int dg = tid & 7, sg = tid >> 3;
#pragma unroll
    for (int r = 0; r < 6; ++r) { const int pos = c * 128 + 2 * sg - 2 + r; kr[r] = (u32x4){0u, 0u, 0u, 0u};
        if (pos >= 0 && pos < SEQ) kr[r] = *(const GAS u32x4*)(zk + (size_t)pos * 128 + 64 * dh + 8 * dg); }
    const int dg2 = tid & 15, sg2 = tid >> 4;
#pragma unroll
    for (int rr = 0; rr < 4; ++rr) vr[rr] = *(const GAS u32x4*)(zv + (size_t)(c * 128 + 4 * sg2 + rr) * 128 + 8 * dg2);
}
DI void scan_build(LAS uchar* TKW, LAS uchar* TV, const u32x4 (&kr)[6], const u32x4 (&vr)[4], const float (&cw)[5][8], const float (&cb)[8], const LAS float* alog, float mnew, int tid) {
    const int dg = tid & 7, sg = tid >> 3;
    float in[6][8];
#pragma unroll
    for (int r = 0; r < 6; ++r) { in[r][0] = bflo(kr[r].x); in[r][1] = bfhi(kr[r].x); in[r][2] = bflo(kr[r].y); in[r][3] = bfhi(kr[r].y); in[r][4] = bflo(kr[r].z); in[r][5] = bfhi(kr[r].z); in[r][6] = bflo(kr[r].w); in[r][7] = bfhi(kr[r].w); }
#pragma unroll
    for (int rr = 0; rr < 2; ++rr) { const float sc = 0.08838834764831845f * __expf(alog[2 * sg + rr] - mnew); float o[8];
#pragma unroll
        for (int i = 0; i < 8; ++i) { float a = cb[i];
#pragma unroll
            for (int j = 0; j < 5; ++j) a += in[rr + j][i] * cw[j][i];
            o[i] = siluf_(a) * sc; }
        u32x4 wv; wv.x = pk2(o[0], o[1]); wv.y = pk2(o[2], o[3]); wv.z = pk2(o[4], o[5]); wv.w = pk2(o[6], o[7]);
        *(LAS u32x4*)(TKW + offb(2 * sg + rr, dg)) = wv; }
    const int dg2 = tid & 15, sg2 = tid >> 4;
#pragma unroll
    for (int rr = 0; rr < 4; ++rr) *(LAS u32x4*)(TV + offb(4 * sg2 + rr, dg2)) = vr[rr];
}
DI void scan_gate_pre(float ig0, float ig1, float fp0, float fp1, int dir, LAS float* al, LAS float* Fv, LAS float* Mv, int lane) {
    const float lf0 = log_sigmoid(fp0), lf1 = log_sigmoid(fp1);
    const float incl = wscan_add(lf0 + lf1, lane);
    const float bf0 = incl - lf1, bf1 = incl, Ftot = __shfl(incl, 63);
    const float a0 = dir ? (bf0 - lf0 + ig0) : (Ftot - bf0 + ig0), a1 = dir ? (bf1 - lf1 + ig1) : (Ftot - bf1 + ig1);
    const float mloc = wave_max(fmaxf(a0, a1));
    al[2 * lane] = a0; al[2 * lane + 1] = a1;
    if (lane == 0) { *Fv = Ftot; *Mv = mloc; }
}
DI void mlstm_scan(Frame& F, int wgid) {
    int tid = F.tid, lane = F.lane; const int w = F.wave;
    const int seq = wgid >> 1, dh = wgid & 1;
    const int dir = seq & 1, h = (seq >> 1) & 3, b = seq >> 3;
    LAS float* AL = (LAS float*)(F.lds + 131072);
    LAS float* FV = AL + 32 * 128; LAS float* MV = FV + 32; LAS float* SC = MV + 32; LAS float* MN = SC + 32; LAS float* MP = MN + 32;
    const float* gates = (const float*)(F.ws + O_GATES);
    const size_t hoff = (size_t)(b * 4 + h) * SEQ * 128;
    const bf16* zk = (const bf16*)(F.ws + O_ZK) + hoff; const bf16* zv = (const bf16*)(F.ws + O_ZV) + hoff;
    float* mst = (float*)(F.ws + O_MST);
    float cw[5][8], cb[8];
    { const int ch0 = 512 + h * 128 + 64 * dh + 8 * (tid & 7);
#pragma unroll
      for (int j = 0; j < 5; ++j) { const f32x4 a = *(const GAS f32x4*)(INP(I_CONVW) + j * 1024 + ch0), bq = *(const GAS f32x4*)(INP(I_CONVW) + j * 1024 + ch0 + 4);
          cw[j][0] = a.x; cw[j][1] = a.y; cw[j][2] = a.z; cw[j][3] = a.w; cw[j][4] = bq.x; cw[j][5] = bq.y; cw[j][6] = bq.z; cw[j][7] = bq.w; }
      const f32x4 a = *(const GAS f32x4*)(INP(I_CONVB) + ch0), bq = *(const GAS f32x4*)(INP(I_CONVB) + ch0 + 4);
      cb[0] = a.x; cb[1] = a.y; cb[2] = a.z; cb[3] = a.w; cb[4] = bq.x; cb[5] = bq.y; cb[6] = bq.z; cb[7] = bq.w; }
    f32x4 acc[4], accn = (f32x4){0.f, 0.f, 0.f, 0.f};
#pragma unroll
    for (int mt = 0; mt < 4; ++mt) acc[mt] = (f32x4){0.f, 0.f, 0.f, 0.f};
    const bf16x8 ones = (bf16x8){0x3F80, 0x3F80, 0x3F80, 0x3F80, 0x3F80, 0x3F80, 0x3F80, 0x3F80};
    const int gi = dir * 8 + h, gf = dir * 8 + 4 + h;
#define SCAN_C(ci) (dir ? 31 - (ci) : (ci))
#pragma unroll 1
    for (int q = 0; q < 4; ++q) { const int ci = w + 8 * q; const size_t r_ = ((size_t)b * SEQ + SCAN_C(ci) * 128 + 2 * lane) * 16;
        scan_gate_pre(gates[r_ + gi], gates[r_ + 16 + gi], gates[r_ + gf], gates[r_ + 16 + gf], dir, AL + ci * 128, FV + ci, MV + ci, lane); }
    __syncthreads();
    if (tid == 0) { float m = -1e30f;
#pragma unroll 1
        for (int ci = 0; ci < 32; ++ci) { MP[ci] = m; const float fm = FV[ci] + m, mn = fmaxf(fm, MV[ci]); SC[ci] = __expf(fm - mn); MN[ci] = mn; m = mn; } }
    __syncthreads();
    if (dh == 0 && tid < 32) mst[seq * 32 + SCAN_C(tid)] = MP[tid];
    unsigned aK[4][2], aV[2];
    { const unsigned g = lane >> 4, q = (lane & 15) >> 2, p = lane & 3, bo = 8u * (p & 1);
#pragma unroll
      for (int mt = 0; mt < 4; ++mt) { aK[mt][0] = offb(8 * g + q, 2 * mt + (p >> 1)) + bo; aK[mt][1] = offb(8 * g + 4 + q, 2 * mt + (p >> 1)) + bo; }
      aV[0] = offb(8 * g + q, 2 * w + (p >> 1)) + bo; aV[1] = offb(8 * g + 4 + q, 2 * w + (p >> 1)) + bo; }
#define FRAG_PRE(tile, o0, o1, kk) ({ const s16x4 lo_ = __builtin_amdgcn_ds_read_tr16_b64_v4i16((LAS s16x4*)((tile) + (o0) + 8192 * (kk))); const s16x4 hi_ = __builtin_amdgcn_ds_read_tr16_b64_v4i16((LAS s16x4*)((tile) + (o1) + 8192 * (kk))); (bf16x8){lo_[0], lo_[1], lo_[2], lo_[3], hi_[0], hi_[1], hi_[2], hi_[3]}; })
    u32x4 krA[6], vrA[4], krB[6], vrB[4];
    scan_issue(krB, vrB, zk, zv, SCAN_C(0), dh, tid);
    scan_issue(krA, vrA, zk, zv, SCAN_C(1), dh, tid);
    __syncthreads();
    scan_build(F.lds, F.lds + 32768, krB, vrB, cw, cb, AL, MN[0], tid);
    scan_issue(krB, vrB, zk, zv, SCAN_C(2), dh, tid);
    __syncthreads();
#define SCAN_ITER(ci, KRN, VRN) do { \
        const int c = SCAN_C(ci); \
        asm volatile("" : "+v"(tid), "+v"(lane)); \
        GASK uchar* wsl_ = (GASK uchar*)F.ws; asm volatile("" : "+s"(wsl_)); \
        const bf16* zk = (const bf16*)((uchar*)wsl_ + O_ZK) + hoff; const bf16* zv = (const bf16*)((uchar*)wsl_ + O_ZV) + hoff; bf16* cst = (bf16*)((uchar*)wsl_ + O_CST); float* nst = (float*)((uchar*)wsl_ + O_NST); \
        LAS uchar* TKW = F.lds + ((ci) & 1) * 65536; LAS uchar* TV = TKW + 32768; \
        { bf16* cp = cst + ((size_t)seq * 32 + c) * 16384; \
          _Pragma("unroll") for (int mt = 0; mt < 4; ++mt) { const int d = 64 * dh + 16 * mt + 4 * (lane >> 4), e = 16 * w + (lane & 15); \
              u32x2 v; v.x = pk2(acc[mt][0], acc[mt][1]); v.y = pk2(acc[mt][2], acc[mt][3]); *(GAS u32x2*)(cp + e * 128 + d) = v; } \
          if (w < 4 && (lane & 15) == 0) *(GAS f32x4*)(nst + ((size_t)seq * 32 + c) * 128 + 64 * dh + 16 * w + 4 * (lane >> 4)) = accn; } \
        if ((ci) + 1 < 32) { \
            scan_build(F.lds + (((ci) + 1) & 1) * 65536, F.lds + (((ci) + 1) & 1) * 65536 + 32768, KRN, VRN, cw, cb, AL + ((ci) + 1) * 128, MN[(ci) + 1], tid); \
            if ((ci) + 3 < 32) scan_issue(KRN, VRN, zk, zv, SCAN_C((ci) + 3), dh, tid); } \
        const float sc_old = SC[(ci)]; \
        _Pragma("unroll") for (int mt = 0; mt < 4; ++mt) acc[mt] *= sc_old; \
        accn *= sc_old; \
        _Pragma("unroll") for (int kk = 0; kk < 4; ++kk) { \
            const bf16x8 Yf = FRAG_PRE(TV, aV[0], aV[1], kk); \
            _Pragma("unroll") for (int mt = 0; mt < 4; ++mt) acc[mt] = mfma16(FRAG_PRE(TKW, aK[mt][0], aK[mt][1], kk), Yf, acc[mt]); \
            if (w < 4) accn = mfma16(FRAG_PRE(TKW, aV[0], aV[1], kk), ones, accn); \
            __builtin_amdgcn_sched_barrier(0); } \
        __syncthreads(); } while (0)
    for (int c2 = 0; c2 < 32; c2 += 2) { SCAN_ITER(c2, krA, vrA); SCAN_ITER(c2 + 1, krB, vrB); }
#undef SCAN_ITER
#undef FRAG_PRE
#undef SCAN_C
}

DI void gmlp_phase(Frame& F) {
    const int w = F.wave;
    const bf16* z = (const bf16*)(F.ws + O_Z); bf16* Y = (bf16*)(F.ws + O_Y); const bf16* wsb = (const bf16*)(F.ws + O_WSB);
    float lg[8], lb[8];
    { const f32x4 a = *(const GAS f32x4*)(INP(I_LNVG) + 8 * F.lane), bq = *(const GAS f32x4*)(INP(I_LNVG) + 8 * F.lane + 4), c = *(const GAS f32x4*)(INP(I_LNVB) + 8 * F.lane), d = *(const GAS f32x4*)(INP(I_LNVB) + 8 * F.lane + 4);
      lg[0] = a.x; lg[1] = a.y; lg[2] = a.z; lg[3] = a.w; lg[4] = bq.x; lg[5] = bq.y; lg[6] = bq.z; lg[7] = bq.w; lb[0] = c.x; lb[1] = c.y; lb[2] = c.z; lb[3] = c.w; lb[4] = d.x; lb[5] = d.y; lb[6] = d.z; lb[7] = d.w; }
    for (int unit = F.bid; unit < 512; unit += F.G) {
        int tid = F.tid, lane = F.lane; asm volatile("" : "+v"(tid), "+v"(lane));
        const size_t row0 = (size_t)unit * 128;
        u32x4 raw[16];
#pragma unroll
        for (int i = 0; i < 16; ++i) raw[i] = *(const GAS u32x4*)(z + (row0 + 16 * w + i) * ZG + 512 + 8 * lane);
#pragma unroll
        for (int i = 0; i < 16; ++i) { const int r = 16 * w + i;
            float v[8] = {bflo(raw[i].x), bfhi(raw[i].x), bflo(raw[i].y), bfhi(raw[i].y), bflo(raw[i].z), bfhi(raw[i].z), bflo(raw[i].w), bfhi(raw[i].w)};
            float s = 0.f;
#pragma unroll
            for (int q = 0; q < 8; ++q) s += v[q];
            const float mu = wave_sum(s) * (1.f / 512.f); float qq = 0.f;
#pragma unroll
            for (int q = 0; q < 8; ++q) { v[q] -= mu; qq += v[q] * v[q]; }
            const float rs = 1.0f / sqrtf(wave_sum(qq) * (1.f / 512.f) + LN_EPS);
#pragma unroll
            for (int q = 0; q < 8; ++q) v[q] = v[q] * rs * lg[q] + lb[q];
            u32x4 wv; wv.x = pk2(v[0], v[1]); wv.y = pk2(v[2], v[3]); wv.z = pk2(v[4], v[5]); wv.w = pk2(v[6], v[7]);
            *(LAS u32x4*)(F.lds + (lane >> 4) * 32768 + offb(r, lane & 15)) = wv; }
        __syncthreads();
        const int tl = 16 * w + (lane & 15); const size_t row = row0 + tl;
        bf16x8 Yw[2][4]; u32x2 gu[2][8];
#define GM_ISSUE(g, sl) do { _Pragma("unroll") for (int kk = 0; kk < 4; ++kk) Yw[sl][kk] = *(const GAS bf16x8*)(wsb + ((size_t)(g) * 128 + tl) * 128 + 32 * kk + 8 * (lane >> 4)); \
        _Pragma("unroll") for (int mt = 0; mt < 8; ++mt) gu[sl][mt] = *(const GAS u32x2*)(z + row * ZG + (g) * 128 + 16 * mt + 4 * (lane >> 4)); } while (0)
        GM_ISSUE(0, 0);
#pragma unroll
        for (int g = 0; g < 4; ++g) {
            const int sl = g & 1;
            if (g < 3) GM_ISSUE(g + 1, sl ^ 1);
            const LAS uchar* T_G = F.lds + g * 32768;
            f32x4 acc[8];
#pragma unroll
            for (int mt = 0; mt < 8; ++mt) acc[mt] = (f32x4){0.f, 0.f, 0.f, 0.f};
#pragma unroll
            for (int kk = 0; kk < 4; ++kk) {
#pragma unroll
                for (int mt = 0; mt < 8; ++mt) acc[mt] = mfma16(frag_tr(T_G, 32 * kk, 16 * mt, lane), Yw[sl][kk], acc[mt]);
                __builtin_amdgcn_sched_barrier(0); }
            const float bs = INP(I_BS)[g * 128 + tl];
#pragma unroll
            for (int mt = 0; mt < 8; ++mt) { const int d = 16 * mt + 4 * (lane >> 4); const u32x2 gv2 = gu[sl][mt];
                u32x2 o; o.x = pk2(bflo(gv2.x) * (acc[mt][0] + bs), bfhi(gv2.x) * (acc[mt][1] + bs)); o.y = pk2(bflo(gv2.y) * (acc[mt][2] + bs), bfhi(gv2.y) * (acc[mt][3] + bs));
                *(GAS u32x2*)(Y + row * DM + 512 + g * 128 + d) = o; }
        }
#undef GM_ISSUE
        __syncthreads();
    }
}

DI void phase2(Frame& F) {
    for (int s = F.bid; s < 256; s += F.G) mlstm_scan(F, s);
    gmlp_phase(F);
}

DI void mlstm_out_phase(Frame& F) {
  constexpr int NU3 = NB * 4 * 32;
  const int w = F.wave;
  u32x4 qraw[8];
  if (F.bid < NU3) { const int u0 = F.bid; const size_t ho = (size_t)(u0 >> 5) * SEQ * 128;
      conv_issue(qraw, (const bf16*)(F.ws + O_ZQ) + ho, u0 & 31, F.tid); }
  for (int unit = F.bid; unit < NU3; unit += F.G) {
    int tid = F.tid, lane = F.lane; asm volatile("" : "+v"(tid), "+v"(lane));
    const int c = unit & 31, h = (unit >> 5) & 3, b = unit >> 7;
    const size_t row0 = (size_t)b * SEQ + c * 128;
    LAS uchar* T_Q = F.lds; LAS uchar* T_K = F.lds + 32768; LAS uchar* T_V = F.lds + 65536; LAS uchar* T_C = F.lds + 98304;
    LAS float* sm = (LAS float*)(F.lds + 131072);
    LAS float* gfa = sm, *gba = sm + 128, *Mfa = sm + 256, *Mba = sm + 384, *sIf = sm + 512, *sIb = sm + 640, *enf = sm + 768, *enb = sm + 896, *nfa = sm + 1024, *nba = sm + 1152, *qnf = sm + 1280, *qnb = sm + 1408;
    const size_t hoff = (size_t)(b * 4 + h) * SEQ * 128;
    const bf16* zq = (const bf16*)(F.ws + O_ZQ) + hoff; const bf16* zk = (const bf16*)(F.ws + O_ZK) + hoff; const bf16* zv = (const bf16*)(F.ws + O_ZV) + hoff; const bf16* zo = (const bf16*)(F.ws + O_ZO) + hoff;
    const float* gates = (const float*)(F.ws + O_GATES);
    const bf16* cst = (const bf16*)(F.ws + O_CST); const float* nst = (const float*)(F.ws + O_NST); const float* mst = (const float*)(F.ws + O_MST);
    bf16* Y = (bf16*)(F.ws + O_Y);
    const int sqf = ((b * 4 + h) * 2 + 0) * 32 + c, sqb = ((b * 4 + h) * 2 + 1) * 32 + c;
    if (w < 2) {
        const float mpf = mst[sqf], mpb = mst[sqb];
        const size_t r0 = (row0 + 2 * lane) * 16, r1 = (row0 + 2 * lane + 1) * 16;
        if (w == 0) {
            const float ig0 = gates[r0 + h], ig1 = gates[r1 + h], lf0 = log_sigmoid(gates[r0 + 4 + h]), lf1 = log_sigmoid(gates[r1 + 4 + h]);
            const float incl = wscan_add(lf0 + lf1, lane), bf0 = incl - lf1, bf1 = incl;
            const float g0 = ig0 - bf0, g1 = ig1 - bf1;
            const float pin = wscan_max(fmaxf(g0, g1), lane); float pex = __shfl_up(pin, 1); if (lane == 0) pex = -3.0e38f;
            const float M0 = fmaxf(mpf, fmaxf(pex, g0)), M1 = fmaxf(mpf, pin);
            gfa[2 * lane] = g0; gfa[2 * lane + 1] = g1; Mfa[2 * lane] = M0; Mfa[2 * lane + 1] = M1;
            sIf[2 * lane] = __expf(mpf - M0); sIf[2 * lane + 1] = __expf(mpf - M1);
            enf[2 * lane] = __expf(-bf0 - M0); enf[2 * lane + 1] = __expf(-bf1 - M1);
        }
        else {
            const float ig0 = gates[r0 + 8 + h], ig1 = gates[r1 + 8 + h], lf0 = log_sigmoid(gates[r0 + 12 + h]), lf1 = log_sigmoid(gates[r1 + 12 + h]);
            const float incl = wscan_add(lf0 + lf1, lane), Ftot = __shfl(incl, 63);
            const float bb0 = Ftot - incl + lf0 + lf1, bb1 = Ftot - incl + lf1;
            const float g0 = ig0 - bb0, g1 = ig1 - bb1;
            const float sin_ = wscan_max_rev(fmaxf(g0, g1), lane); float sex = __shfl_down(sin_, 1); if (lane == 63) sex = -3.0e38f;
            const float M0 = fmaxf(mpb, sin_), M1 = fmaxf(mpb, fmaxf(sex, g1));
            gba[2 * lane] = g0; gba[2 * lane + 1] = g1; Mba[2 * lane] = M0; Mba[2 * lane + 1] = M1;
            sIb[2 * lane] = __expf(mpb - M0); sIb[2 * lane + 1] = __expf(mpb - M1);
            enb[2 * lane] = __expf(-bb0 - M0); enb[2 * lane + 1] = __expf(-bb1 - M1);
        }
    }
    if (tid < 128) { nfa[tid] = nst[(size_t)sqf * 128 + tid]; nba[tid] = nst[(size_t)sqb * 128 + tid]; }
    u32x4 kraw[8]; conv_issue(kraw, zk, c, tid);
    conv_build(T_Q, qraw, h * 128, INP(I_CONVW), INP(I_CONVB), 1.0f, tid);
    conv_build(T_K, kraw, 512 + h * 128, INP(I_CONVW), INP(I_CONVB), 0.08838834764831845f, tid);
    build_copy_tile(T_V, zv, (size_t)c * 128, 128, 0, tid);
    build_copy_tile(T_C, cst + (size_t)sqf * 16384, 0, 128, 0, tid);
    __syncthreads();
    {
        const int t = tid >> 2, part = tid & 3; float af = 0.f, ab = 0.f;
#pragma unroll
        for (int cc = 0; cc < 4; ++cc) { const u32x4 raw = *(const LAS u32x4*)(T_Q + offb(t, 4 * part + cc)); const int dd = 32 * part + 8 * cc;
            const float qv[8] = {bflo(raw.x), bfhi(raw.x), bflo(raw.y), bfhi(raw.y), bflo(raw.z), bfhi(raw.z), bflo(raw.w), bfhi(raw.w)};
#pragma unroll
            for (int i = 0; i < 8; ++i) { af += qv[i] * nfa[dd + i]; ab += qv[i] * nba[dd + i]; } }
        af += __shfl_xor(af, 1); af += __shfl_xor(af, 2); ab += __shfl_xor(ab, 1); ab += __shfl_xor(ab, 2);
        if (part == 0) { qnf[t] = af; qnb[t] = ab; }
    }
    u32x4 cbreg[4];
    { const int dg = tid & 15, sg = tid >> 4; const bf16* src = cst + (size_t)sqb * 16384;
#pragma unroll
      for (int rr = 0; rr < 4; ++rr) cbreg[rr] = *(const GAS u32x4*)(src + (size_t)(4 * sg + rr) * 128 + 8 * dg); }
    bf16x8 Qf[4];
#pragma unroll
    for (int kk = 0; kk < 4; ++kk) Qf[kk] = frag_row(T_Q, 16 * w, kk, lane);
    f32x4 aS[8];
#pragma unroll
    for (int mt = 0; mt < 8; ++mt) aS[mt] = (f32x4){0.f, 0.f, 0.f, 0.f};
#pragma unroll
    for (int kk = 0; kk < 4; ++kk) {
#pragma unroll
        for (int mt = 0; mt < 8; ++mt) aS[mt] = mfma16(frag_row(T_K, 16 * mt, kk, lane), Qf[kk], aS[mt]);
        __builtin_amdgcn_sched_barrier(0); }
    __syncthreads();
    const int tl = 16 * w + (lane & 15);
    float cf, cb_;
    {
        const float Mf = Mfa[tl], Mb = Mba[tl];
        f32x4 wf[8], wb[8]; float sumf = 0.f, sumb = 0.f;
#pragma unroll
        for (int mt = 0; mt < 8; ++mt) { const int s0 = 16 * mt + 4 * (lane >> 4); const f32x4 gf4 = *(const LAS f32x4*)(gfa + s0), gb4 = *(const LAS f32x4*)(gba + s0);
#pragma unroll
            for (int j = 0; j < 4; ++j) { const int s = s0 + j; const float sv = aS[mt][j];
                const float a = (s <= tl) ? __expf(gf4[j] - Mf) * sv : 0.f, bq = (s >= tl) ? __expf(gb4[j] - Mb) * sv : 0.f;
                wf[mt][j] = a; wb[mt][j] = bq; sumf += a; sumb += bq; } }
        sumf += __shfl_xor(sumf, 16); sumf += __shfl_xor(sumf, 32); sumb += __shfl_xor(sumb, 16); sumb += __shfl_xor(sumb, 32);
        const float sif = sIf[tl], sib = sIb[tl];
        const float denf = sumf + sif * qnf[tl], denb = sumb + sib * qnb[tl];
        const float rf = 1.0f / fmaxf(fabsf(denf), enf[tl]), rb = 1.0f / fmaxf(fabsf(denb), enb[tl]);
        cf = sif * rf; cb_ = sib * rb;
#pragma unroll
        for (int mt = 0; mt < 8; ++mt) { const int s0 = 16 * mt + 4 * (lane >> 4);
            u32x2 v; v.x = pk2(wf[mt][0] * rf + wb[mt][0] * rb, wf[mt][1] * rf + wb[mt][1] * rb); v.y = pk2(wf[mt][2] * rf + wb[mt][2] * rb, wf[mt][3] * rf + wb[mt][3] * rb);
            *(LAS u32x2*)(T_K + offb(tl, s0 >> 3) + (s0 & 7) * 2) = v; }
    }
    { const int nu = unit + F.G;
      if (nu < NU3) { const size_t ho = (size_t)(nu >> 5) * SEQ * 128; conv_issue(qraw, (const bf16*)(F.ws + O_ZQ) + ho, nu & 31, tid); } }
    f32x4 aO[8], aZ[8];
#pragma unroll
    for (int mt = 0; mt < 8; ++mt) { aO[mt] = (f32x4){0.f, 0.f, 0.f, 0.f}; aZ[mt] = (f32x4){0.f, 0.f, 0.f, 0.f}; }
#pragma unroll
    for (int kk = 0; kk < 4; ++kk) { const bf16x8 Yw = frag_row(T_K, 16 * w, kk, lane);
#pragma unroll
        for (int mt = 0; mt < 8; ++mt) aO[mt] = mfma16(frag_tr(T_V, 32 * kk, 16 * mt, lane), Yw, aO[mt]);
        __builtin_amdgcn_sched_barrier(0); }
#pragma unroll
    for (int kk = 0; kk < 4; ++kk) {
#pragma unroll
        for (int mt = 0; mt < 8; ++mt) aZ[mt] = mfma16(frag_row(T_C, 16 * mt, kk, lane), Qf[kk], aZ[mt]);
        __builtin_amdgcn_sched_barrier(0); }
#pragma unroll
    for (int mt = 0; mt < 8; ++mt) { aO[mt] += aZ[mt] * cf; aZ[mt] = (f32x4){0.f, 0.f, 0.f, 0.f}; }
    __syncthreads();
    { const int dg = tid & 15, sg = tid >> 4;
#pragma unroll
      for (int rr = 0; rr < 4; ++rr) *(LAS u32x4*)(T_C + offb(4 * sg + rr, dg)) = cbreg[rr]; }
    __syncthreads();
#pragma unroll
    for (int kk = 0; kk < 4; ++kk) {
#pragma unroll
        for (int mt = 0; mt < 8; ++mt) aZ[mt] = mfma16(frag_row(T_C, 16 * mt, kk, lane), Qf[kk], aZ[mt]);
        __builtin_amdgcn_sched_barrier(0); }
    u32x2 og[8];
#pragma unroll
    for (int mt = 0; mt < 8; ++mt) og[mt] = *(const GAS u32x2*)(zo + (size_t)(c * 128 + 16 * w + (lane & 15)) * 128 + 16 * mt + 4 * (lane >> 4));
    float ssq = 0.f;
#pragma unroll
    for (int mt = 0; mt < 8; ++mt) { aO[mt] += aZ[mt] * cb_; ssq += (aO[mt][0] * aO[mt][0] + aO[mt][1] * aO[mt][1]) + (aO[mt][2] * aO[mt][2] + aO[mt][3] * aO[mt][3]); }
    ssq += __shfl_xor(ssq, 16); ssq += __shfl_xor(ssq, 32);
    const float rinv = 1.0f / sqrtf(ssq * (1.f / 128.f) + RMS_EPS);
    const size_t row = row0 + tl;
#pragma unroll
    for (int mt = 0; mt < 8; ++mt) { const int e = 16 * mt + 4 * (lane >> 4);
        const u32x2 ogv = og[mt]; const f32x4 gh = *(const GAS f32x4*)(INP(I_GHEAD) + h * 128 + e);
        u32x2 o; o.x = pk2(bflo(ogv.x) * aO[mt][0] * rinv * gh.x, bfhi(ogv.x) * aO[mt][1] * rinv * gh.y); o.y = pk2(bflo(ogv.y) * aO[mt][2] * rinv * gh.z, bfhi(ogv.y) * aO[mt][3] * rinv * gh.w);
        *(GAS u32x2*)(Y + row * DM + h * 128 + e) = o; }
    __syncthreads();
  }
}
DI void kv_dma(LAS uchar* buf, const bf16* kv, int b, int col0, int w, int lane) {
#pragma unroll
    for (int i = 0; i < 8; ++i) { const int r = 32 * w + 4 * i + (lane >> 4); const int f = ((r & 3) << 2) | ((r >> 2) & 3);
        const bf16* src = kv + (size_t)(b * NMEM + r) * 2048 + col0 + 8 * ((lane & 15) ^ f);
        __builtin_amdgcn_global_load_lds((const unsigned*)src, (LAS unsigned*)(buf + 256 * (32 * w + 4 * i)), 16, 0, 0); }
}
#define DMA_WAIT() asm volatile("s_waitcnt vmcnt(0)" ::: "memory")
DI bf16x8 frag_tr_perm(const LAS uchar* tile, int k0, int c0, int lane) {
    const unsigned g = lane >> 4, q = (lane & 15) >> 2, p = lane & 3;
    const unsigned ch = (c0 >> 3) + (p >> 1), bo = 8u * (p & 1);
    const s16x4 lo = __builtin_amdgcn_ds_read_tr16_b64_v4i16((LAS s16x4*)(tile + offb(k0 + 4 * g + q, ch) + bo));
    const s16x4 hi = __builtin_amdgcn_ds_read_tr16_b64_v4i16((LAS s16x4*)(tile + offb(k0 + 16 + 4 * g + q, ch) + bo));
    return (bf16x8){lo[0], lo[1], lo[2], lo[3], hi[0], hi[1], hi[2], hi[3]};
}
DI void attn_phase(Frame& F) {
    const int w = F.wave;
    constexpr int NU = NB * 4 * 16;
    const bf16* Q = (const bf16*)(F.ws + O_Q); const bf16* kv = (const bf16*)(F.ws + O_KV); uchar* O = F.ws + O_O;
    LAS uchar* B0 = F.lds; LAS uchar* B1 = F.lds + 65536;
    if (F.bid < NU) { const int u0 = F.bid; kv_dma(B0, kv, u0 >> 6, ((u0 >> 4) & 3) * 256, w, F.lane); }
    DMA_WAIT(); __syncthreads();
    for (int unit = F.bid; unit < NU; unit += F.G) {
        int tid = F.tid, lane = F.lane; asm volatile("" : "+v"(tid), "+v"(lane));
        const int qb = unit & 15, hd = (unit >> 4) & 3, b = unit >> 6;
        const int nu = unit + F.G;
        const size_t qrow0 = (size_t)b * SEQ + qb * 256 + 32 * w + (lane & 15);
        f32x4 aS[2][16];
#pragma unroll
        for (int tb = 0; tb < 2; ++tb)
#pragma unroll
            for (int mt = 0; mt < 16; ++mt) aS[tb][mt] = (f32x4){0.f, 0.f, 0.f, 0.f};
        bf16x8 Qc[2], Qn[2];
#pragma unroll
        for (int tb = 0; tb < 2; ++tb) Qn[tb] = *(const GAS bf16x8*)(Q + (qrow0 + 16 * tb) * DM + hd * 256 + 8 * (lane >> 4));
#pragma unroll
        for (int dh = 0; dh < 2; ++dh) {
            const LAS uchar* KB = dh ? B1 : B0;
            if (dh == 0) kv_dma(B1, kv, b, hd * 256 + 128, w, lane);
            else kv_dma(B0, kv, b, 1024 + hd * 256, w, lane);
#pragma unroll
            for (int kk = 0; kk < 4; ++kk) { const int st = dh * 4 + kk;
                Qc[0] = Qn[0]; Qc[1] = Qn[1];
                if (st < 7) {
#pragma unroll
                    for (int tb = 0; tb < 2; ++tb) Qn[tb] = *(const GAS bf16x8*)(Q + (qrow0 + 16 * tb) * DM + hd * 256 + 32 * (st + 1) + 8 * (lane >> 4)); }
#pragma unroll
                for (int mh = 0; mh < 4; ++mh) {
#pragma unroll
                    for (int mq = 0; mq < 4; ++mq) { const int mt = 4 * mh + mq; const bf16x8 X = frag_row(KB, 16 * mt, kk, lane);
                        aS[0][mt] = mfma16(X, Qc[0], aS[0][mt]); aS[1][mt] = mfma16(X, Qc[1], aS[1][mt]); }
                    __builtin_amdgcn_sched_barrier(0); } }
            DMA_WAIT(); __syncthreads();
        }
        bf16x8 Pf[2][8]; float rinv[2];
#pragma unroll
        for (int tb = 0; tb < 2; ++tb) {
            float mx = -3.0e38f;
#pragma unroll
            for (int mt = 0; mt < 16; ++mt) mx = fmaxf(mx, fmaxf(fmaxf(aS[tb][mt][0], aS[tb][mt][1]), fmaxf(aS[tb][mt][2], aS[tb][mt][3])));
            mx = fmaxf(mx, __shfl_xor(mx, 16)); mx = fmaxf(mx, __shfl_xor(mx, 32));
            float sum = 0.f;
#pragma unroll
            for (int s = 0; s < 8; ++s) { f32x4 p0, p1;
#pragma unroll
                for (int j = 0; j < 4; ++j) { p0[j] = __expf(aS[tb][2 * s][j] - mx); p1[j] = __expf(aS[tb][2 * s + 1][j] - mx); sum += p0[j] + p1[j]; }
                u32x4 pk; pk.x = pk2(p0[0], p0[1]); pk.y = pk2(p0[2], p0[3]); pk.z = pk2(p1[0], p1[1]); pk.w = pk2(p1[2], p1[3]);
                Pf[tb][s] = __builtin_bit_cast(bf16x8, pk); }
            sum += __shfl_xor(sum, 16); sum += __shfl_xor(sum, 32);
            rinv[tb] = 1.0f / sum;
        }
#pragma unroll
        for (int eh = 0; eh < 2; ++eh) {
            const LAS uchar* VB = eh ? B1 : B0;
            if (eh == 0) kv_dma(B1, kv, b, 1024 + hd * 256 + 128, w, lane);
            else if (nu < NU) kv_dma(B0, kv, nu >> 6, ((nu >> 4) & 3) * 256, w, lane);
            f32x4 aO[2][8];
#pragma unroll
            for (int tb = 0; tb < 2; ++tb)
#pragma unroll
                for (int mt = 0; mt < 8; ++mt) aO[tb][mt] = (f32x4){0.f, 0.f, 0.f, 0.f};
#pragma unroll
            for (int s = 0; s < 8; ++s) {
#pragma unroll
                for (int mh = 0; mh < 2; ++mh) {
#pragma unroll
                    for (int mq = 0; mq < 4; ++mq) { const int mt = 4 * mh + mq; const bf16x8 X = frag_tr_perm(VB, 32 * s, 16 * mt, lane);
                        aO[0][mt] = mfma16(X, Pf[0][s], aO[0][mt]); aO[1][mt] = mfma16(X, Pf[1][s], aO[1][mt]); }
                    __builtin_amdgcn_sched_barrier(0); } }
#pragma unroll
            for (int tb = 0; tb < 2; ++tb)
#pragma unroll
                for (int mt = 0; mt < 8; ++mt) { const int e = 16 * mt + 4 * (lane >> 4); const float ri = rinv[tb];
                    *(GAS unsigned*)(O + (qrow0 + 16 * tb) * DM + hd * 256 + eh * 128 + e) = pk4_fp8(aO[tb][mt][0] * ri, aO[tb][mt][1] * ri, aO[tb][mt][2] * ri, aO[tb][mt][3] * ri); }
            DMA_WAIT(); __syncthreads();
        }
    }
}

DI void route_block(Frame& F, int blk) {
    const int tid = F.tid, lane = F.lane, w = F.wave;
    LAS float* lg = (LAS float*)F.lds + (size_t)w * (32 * 48);
    LAS int* tokE = (LAS int*)(F.lds + 147456);
    LAS int* tokR = tokE + 512;
    LAS int* wcnt = tokR + 512;
    LAS int* base = wcnt + 256;
    const bf16* x2 = (const bf16*)(F.ws + O_XB); float* rs3 = (float*)(F.ws + O_RS3); unsigned* tok = (unsigned*)(F.ws + O_TOK); int* ridx = (int*)(F.ws + O_RIDX);
    const bf16* wrh = (const bf16*)(F.ws + O_WRH); const bf16* wrl = (const bf16*)(F.ws + O_WRL);
    unsigned* cnt = (unsigned*)(F.ws + O_CTL) + CW_CNT;
    const int r16 = lane & 15, g4 = lane >> 4;
    const size_t row0 = (size_t)blk * 256 + 32 * w;
    f32x4 acc[3][2];
#pragma unroll
    for (int nb = 0; nb < 3; ++nb) { acc[nb][0] = (f32x4){0.f, 0.f, 0.f, 0.f}; acc[nb][1] = (f32x4){0.f, 0.f, 0.f, 0.f}; }
    float ss0 = 0.f, ss1 = 0.f;
    bf16x8 Yn[2], Xhn[3], Xln[3];
#define RT_LOAD(kk) do { _Pragma("unroll") for (int rb = 0; rb < 2; ++rb) Yn[rb] = *(const GAS bf16x8*)(x2 + (row0 + 16 * rb + r16) * DM + 32 * (kk) + 8 * g4); \
        _Pragma("unroll") for (int nb = 0; nb < 3; ++nb) { Xhn[nb] = *(const GAS bf16x8*)(wrh + (size_t)(16 * nb + r16) * 1024 + 32 * (kk) + 8 * g4); Xln[nb] = *(const GAS bf16x8*)(wrl + (size_t)(16 * nb + r16) * 1024 + 32 * (kk) + 8 * g4); } } while (0)
    RT_LOAD(0);
    for (int kk = 0; kk < 32; ++kk) {
        bf16x8 Y[2], Xh[3], Xl[3];
        Y[0] = Yn[0]; Y[1] = Yn[1];
#pragma unroll
        for (int nb = 0; nb < 3; ++nb) { Xh[nb] = Xhn[nb]; Xl[nb] = Xln[nb]; }
        if (kk + 1 < 32) RT_LOAD(kk + 1);
        { float xf[2][8];
#pragma unroll
          for (int rb = 0; rb < 2; ++rb) {
#pragma unroll
            for (int j = 0; j < 8; ++j) xf[rb][j] = bf2f((unsigned short)Y[rb][j]);
            u32x2 o8; o8.x = pk4_fp8(xf[rb][0], xf[rb][1], xf[rb][2], xf[rb][3]); o8.y = pk4_fp8(xf[rb][4], xf[rb][5], xf[rb][6], xf[rb][7]);
            *(GAS u32x2*)((uchar*)F.ws + O_X2F8 + (row0 + 16 * rb + r16) * DM + 32 * kk + 8 * g4) = o8; } }
#pragma unroll
        for (int j = 0; j < 8; ++j) { const float a = bf2f((unsigned short)Y[0][j]), c = bf2f((unsigned short)Y[1][j]); ss0 += a * a; ss1 += c * c; }
#pragma unroll
        for (int nb = 0; nb < 3; ++nb)
#pragma unroll
            for (int rb = 0; rb < 2; ++rb) { acc[nb][rb] = mfma16(Xh[nb], Y[rb], acc[nb][rb]); acc[nb][rb] = mfma16(Xl[nb], Y[rb], acc[nb][rb]); }
    }
#undef RT_LOAD
    ss0 += __shfl_xor(ss0, 16); ss0 += __shfl_xor(ss0, 32); ss1 += __shfl_xor(ss1, 16); ss1 += __shfl_xor(ss1, 32);
    const float rsA = 1.0f / sqrtf(ss0 * (1.f / DM) + RMS_EPS), rsB = 1.0f / sqrtf(ss1 * (1.f / DM) + RMS_EPS);
#pragma unroll
    for (int nb = 0; nb < 3; ++nb)
#pragma unroll
        for (int rb = 0; rb < 2; ++rb) { const float rs = rb ? rsB : rsA;
            *(LAS f32x4*)(lg + (16 * rb + r16) * 48 + 16 * nb + 4 * g4) = acc[nb][rb] * rs; }
    if (g4 == 0) { rs3[row0 + r16] = rsA; rs3[row0 + 16 + r16] = rsB; }
    LDS_WAIT(); asm volatile("" ::: "memory");
    if (lane < 32) {
        const LAS float* L = lg + lane * 48; const int rl = 32 * w + lane; const size_t m = row0 + lane;
        float l4[4];
#pragma unroll
        for (int j = 0; j < 4; ++j) l4[j] = L[j] + INP(I_BRG)[j];
        int gi = 0; float lm = l4[0];
#pragma unroll
        for (int j = 1; j < 4; ++j) if (l4[j] > lm) { lm = l4[j]; gi = j; }
        const float ptop = 1.0f / (__expf(l4[0] - lm) + __expf(l4[1] - lm) + __expf(l4[2] - lm) + __expf(l4[3] - lm));
        float le[8];
#pragma unroll
        for (int j = 0; j < 8; ++j) le[j] = L[16 + gi * 8 + j] + INP(I_BRE)[gi * 8 + j];
        int e0 = 0; float m0 = le[0];
#pragma unroll
        for (int j = 1; j < 8; ++j) if (le[j] > m0) { m0 = le[j]; e0 = j; }
        int e1 = -1; float m1 = -3.0e38f;
#pragma unroll
        for (int j = 0; j < 8; ++j) if (j != e0 && le[j] > m1) { m1 = le[j]; e1 = j; }
        const float t = __expf(m1 - m0), w0 = ptop / (1.0f + t), w1 = ptop * t / (1.0f + t);
        tokE[2 * rl] = gi * 8 + e0; tokE[2 * rl + 1] = gi * 8 + e1;
        tok[m * 8 + 4] = __float_as_uint(w0); tok[m * 8 + 5] = __float_as_uint(w1);
    }
    __syncthreads();
    {
        const int myE = tokE[tid]; int myR = 0;
        for (int e = 0; e < 32; ++e) { const unsigned long long mk = __ballot(myE == e); if (myE == e) myR = __popcll(mk & ((1ull << lane) - 1ull)); if (lane == 0) wcnt[w * 32 + e] = __popcll(mk); }
        __syncthreads();
        int add = 0;
        for (int ww = 0; ww < w; ++ww) add += wcnt[ww * 32 + myE];
        tokR[tid] = myR + add;
        if (tid < 32) { int tot = 0; for (int ww = 0; ww < 8; ++ww) tot += wcnt[ww * 32 + tid]; base[tid] = (int)__hip_atomic_fetch_add(cnt + tid, (unsigned)tot, __ATOMIC_RELAXED, __HIP_MEMORY_SCOPE_AGENT); }
        __syncthreads();
        const int pos = base[myE] + tokR[tid], m = blk * 256 + (tid >> 1);
        ridx[(size_t)myE * NTOK + pos] = m;
        tok[(size_t)m * 8 + (tid & 1) * 2 + 0] = (unsigned)myE; tok[(size_t)m * 8 + (tid & 1) * 2 + 1] = (unsigned)pos;
    }
    __syncthreads();
}
DI void phase8(Frame& F) {
    for (int blk = F.bid; blk < NTOK / 256; blk += F.G) route_block(F, blk);
}

DI void moe_tables(Frame& F, LAS int*& cum, LAS int*& cntl) {
    cum = (LAS int*)(F.lds + 131072); cntl = cum + 64;
    const unsigned* cnt = (const unsigned*)(F.ws + O_CTL) + CW_CNT;
    if (F.tid < 32) cntl[F.tid] = (int)__hip_atomic_load(cnt + F.tid, __ATOMIC_RELAXED, __HIP_MEMORY_SCOPE_AGENT);
    __syncthreads();
    if (F.tid == 0) { int a = 0; for (int e = 0; e < 32; ++e) { cum[e] = a; a += (cntl[e] + 255) >> 8; } cum[32] = a; }
    __syncthreads();
}

DI void phase11(Frame& F) {
    LAS int* cum; LAS int* cntl; moe_tables(F, cum, cntl);
    const int gw = F.bid * NWAVES + F.wave, NGW = F.G * NWAVES, lane = F.lane;
    const unsigned* tok = (const unsigned*)(F.ws + O_TOK); const bf16* YD = (const bf16*)(F.ws + O_YD);
    f32x4 gfin[4];
#pragma unroll
    for (int j = 0; j < 4; ++j) gfin[j] = ((const f32x4*)INP(I_GFINAL))[lane + 64 * j];
    for (int m0 = gw; m0 < NTOK; m0 += 4 * NGW) {
        u32x4 ti[4]; unsigned tw0[4], tw1[4];
#pragma unroll
        for (int q = 0; q < 4; ++q) { const int m = m0 + q * NGW; ti[q] = *(const GAS u32x4*)(tok + (size_t)m * 8); tw0[q] = tok[(size_t)m * 8 + 4]; tw1[q] = tok[(size_t)m * 8 + 5]; }
        u32x2 xv[4][4]; u32x2 ya[4][4], yb[4][4];
#pragma unroll
        for (int q = 0; q < 4; ++q) { const int m = m0 + q * NGW;
            const size_t s0 = (size_t)cum[ti[q].x] * 256 + ti[q].y, s1 = (size_t)cum[ti[q].z] * 256 + ti[q].w;
            const u32x2* xr = (const u32x2*)((const bf16*)(F.ws + O_XB) + (size_t)m * DM) + lane;
            const u32x2* y0 = (const u32x2*)(YD + s0 * DM) + lane; const u32x2* y1 = (const u32x2*)(YD + s1 * DM) + lane;
#pragma unroll
            for (int j = 0; j < 4; ++j) { xv[q][j] = xr[64 * j]; ya[q][j] = y0[64 * j]; yb[q][j] = y1[64 * j]; } }
#pragma unroll
        for (int q = 0; q < 4; ++q) { const int m = m0 + q * NGW;
            const float w0 = __uint_as_float(tw0[q]), w1 = __uint_as_float(tw1[q]);
            f32x4* xr = (f32x4*)(F.out + (size_t)m * DM) + lane;
            f32x4 v[4]; float s = 0.f;
#pragma unroll
            for (int j = 0; j < 4; ++j) { const u32x2 a = ya[q][j], bq = yb[q][j];
                f32x4 mo; mo.x = w0 * bflo(a.x) + w1 * bflo(bq.x); mo.y = w0 * bfhi(a.x) + w1 * bfhi(bq.x); mo.z = w0 * bflo(a.y) + w1 * bflo(bq.y); mo.w = w0 * bfhi(a.y) + w1 * bfhi(bq.y);
                v[j] = (f32x4){bflo(xv[q][j].x), bfhi(xv[q][j].x), bflo(xv[q][j].y), bfhi(xv[q][j].y)} + mo; s += (v[j].x * v[j].x + v[j].y * v[j].y) + (v[j].z * v[j].z + v[j].w * v[j].w); }
            const float rs = 1.0f / sqrtf(wave_sum(s) * (1.f / DM) + RMS_EPS);
#pragma unroll
            for (int j = 0; j < 4; ++j) xr[64 * j] = v[j] * rs * gfin[j]; }
    }
}
typedef GAS unsigned gu32;
#define RLX_AGENT __ATOMIC_RELAXED, __HIP_MEMORY_SCOPE_AGENT
#define XB_TMO      128
#define XB_XCNT(j)  (256  + 64 * (j))
#define XB_XSUB(j)  (1280 + 64 * (j))
#define XB_XGEN(j)  (2304 + 64 * (j))
#define XB_TOP      3328
#define XB_TOPGEN   3392
#define XCD_BAR_WORDS 3456
#define XB_SPIN_CAP (1u << 18)

__device__ __forceinline__ unsigned xb_ld(unsigned* p)              { return __hip_atomic_load(p, __ATOMIC_RELAXED, __HIP_MEMORY_SCOPE_AGENT); }
__device__ __forceinline__ unsigned xb_add(unsigned* p, unsigned v) { return __hip_atomic_fetch_add(p, v, __ATOMIC_RELAXED, __HIP_MEMORY_SCOPE_AGENT); }
__device__ __forceinline__ unsigned xb_xcc_id() { return (unsigned)__builtin_amdgcn_s_getreg((3 << 11) | 20) & 0xFu; }
#define XB_SPIN(cond, bar) do { unsigned _sp = 0; while (cond) { __builtin_amdgcn_s_sleep(1); \
    if ((++_sp & 255u) == 0u) { if (xb_ld(&(bar)[XB_TMO])) break; if (_sp > XB_SPIN_CAP) { atomicAdd(&(bar)[XB_TMO], 1u); break; } } } } while (0)

struct XcdBarrier {
    unsigned* bar; unsigned x;
    volatile LAS unsigned* st;
};

__device__ __forceinline__ XcdBarrier xcd_barrier_post(unsigned* bar, volatile LAS unsigned* st) {
    XcdBarrier b; b.bar = bar; b.x = xb_xcc_id(); b.st = st;
    if (threadIdx.x == 0) (void)xb_add(&bar[XB_XCNT(b.x)], 1u);
    return b;
}
__device__ __forceinline__ void xcd_barrier_complete(unsigned* bar, unsigned x, unsigned& nloc, unsigned& nx) {
    const unsigned G = gridDim.x * gridDim.y * gridDim.z;
    unsigned sum, cnt, mine, sp = 0u;
    for (;;) {
        sum = 0u; cnt = 0u; mine = 0u;
#pragma unroll
        for (unsigned j = 0; j < 16; ++j) { const unsigned c = xb_ld(&bar[XB_XCNT(j)]); sum += c; cnt += (c > 0u) ? 1u : 0u; mine = (j == x) ? c : mine; }
        if (sum == G) break;
        __builtin_amdgcn_s_sleep(1);
        if ((++sp & 255u) == 0u) { if (xb_ld(&bar[XB_TMO])) break; if (sp > XB_SPIN_CAP) { atomicAdd(&bar[XB_TMO], 1u); break; } }
    }
    nloc = mine > 0u ? mine : 1u; nx = cnt > 0u ? cnt : 1u;
}

__device__ __forceinline__ void xcd_barrier(const XcdBarrier& b) {
    asm volatile("s_waitcnt vmcnt(0)" ::: "memory");
    __syncthreads();
    if (threadIdx.x == 0) {
        unsigned* bar = b.bar;
        __builtin_amdgcn_s_waitcnt(0);
        unsigned nloc = b.st[0], nx = b.st[1];
        if (nloc == 0u) { xcd_barrier_complete(bar, b.x, nloc, nx); b.st[0] = nloc; b.st[1] = nx; }
        const unsigned old = xb_add(&bar[XB_XSUB(b.x)], 1u);
        const unsigned gen = old / nloc;
        if (old + 1u == (gen + 1u) * nloc) {
            __builtin_amdgcn_fence(__ATOMIC_RELEASE, "agent");
            asm volatile("s_waitcnt vmcnt(0)" ::: "memory");
            const unsigned og = xb_add(&bar[XB_TOP], 1u);
            const unsigned tg = og / nx;
            if (og + 1u == (tg + 1u) * nx) xb_add(&bar[XB_TOPGEN], 1u);
            else XB_SPIN(xb_ld(&bar[XB_TOPGEN]) == tg, bar);
            __builtin_amdgcn_fence(__ATOMIC_ACQUIRE, "agent");
            xb_add(&bar[XB_XGEN(b.x)], 1u);
            asm volatile("s_waitcnt vmcnt(0)" ::: "memory");
        } else {
            XB_SPIN(xb_ld(&bar[XB_XGEN(b.x)]) == gen, bar);
            __builtin_amdgcn_fence(__ATOMIC_ACQUIRE, "agent");
            asm volatile("s_waitcnt vmcnt(0)" ::: "memory");
        }
    }
    __syncthreads();
}

#ifndef MK_N_LAUNCHES
#define MK_N_LAUNCHES 1
#endif
constexpr int N_PHASES = 12;

__global__ void __launch_bounds__(NTHR, 2) hybrid_fwd(Args args) {
    extern __shared__ __attribute__((aligned(16))) uchar lds_raw[];
    Frame F;
    F.lds = (LAS uchar*)lds_raw;
    F.tid = threadIdx.x; F.lane = F.tid & 63; F.wave = __builtin_amdgcn_readfirstlane(F.tid >> 6);
    F.G = gridDim.x; F.bid = blockIdx.x;
    F.in = args.in;
    F.out = (float*)args.out; F.ws = (uchar*)args.ws;
    uchar* ws = (uchar*)args.ws;
    const int lo = args.ph_lo, hi = args.ph_hi;
    volatile LAS unsigned* MISC = (volatile LAS unsigned*)(F.lds + LDS_BYTES - 256);
    if (F.tid < 64) MISC[F.tid] = 0u;
    __syncthreads();
    XcdBarrier bar; bar.bar = (unsigned*)((uchar*)args.ws + O_CTL) + CW_BAR; bar.x = 0; bar.st = MISC + 8;
    if (hi - lo > 1) bar = xcd_barrier_post((unsigned*)((uchar*)args.ws + O_CTL) + CW_BAR, MISC + 8);
#ifndef PHASE_MASK
#define PHASE_MASK 0xFFF
#endif
#ifndef DOUBLE_MASK
#define DOUBLE_MASK 0
#endif
#define IN(k) (((PHASE_MASK >> (k)) & 1) && lo <= (k) && (k) < hi)
#define REP(k) for (int rep_ = 0; rep_ < 1 + ((DOUBLE_MASK >> (k)) & 1); ++rep_)
#if defined(__HIP_DEVICE_COMPILE__)
#define ASSUME_GLOBAL(p) __builtin_assume(!__builtin_amdgcn_is_shared((const void*)(p)) && !__builtin_amdgcn_is_private((const void*)(p)))
#else
#define ASSUME_GLOBAL(p) ((void)0)
#endif
#define OPQ() do { GASK uchar* w_ = args.ws; GASK float* o_ = args.out; asm volatile("" : "+s"(w_), "+s"(o_)); ws = (uchar*)w_; F.ws = ws; F.out = (float*)o_; } while (0)
#define SEAM(k) do { OPQ(); if (lo <= (k) && (k) + 1 < hi) { xcd_barrier(bar); } } while (0)
    using pg8::Gemm; using pg8::StaticOrder; using pg8::gemm_phase;
#ifndef TSEL
#define TSEL (-1)
#endif
    unsigned long long tq0 = 0, tq1 = 0;
#define TQ0(k) do { if ((k) == TSEL) tq0 = __builtin_amdgcn_s_memrealtime(); } while (0)
#define TQ1(k) do { if ((k) == TSEL) tq1 = __builtin_amdgcn_s_memrealtime(); } while (0)

    TQ0(0);
    if (IN(0)) REP(0) phase0(F);
    SEAM(0); TQ1(0);
    TQ0(1);
    if (IN(1)) REP(1) {
        { Gemm g{(const bf16*)(ws + O_XB), (const bf16*)(ws + O_WIN), NTOK, ZC, DM}; StaticOrder S; S.init(NTOK, ZC, F.G, F.bid);
          EpiRowScale<0> E{(bf16*)(ws + O_Z), ZG, (const float*)(ws + O_RS0), 1.0f};
          gemm_phase<EpiRowScale<0>, StaticOrder, true, true, false>(F.lds, g, S, E); }
        { Gemm g{(const bf16*)(ws + O_MEMB), (const bf16*)(ws + O_WKV), NMROWS, 2048, DM}; StaticOrder S; S.init(NMROWS, 2048, F.G, F.bid);
          EpiRowScale<1> E{(bf16*)(ws + O_KV), 2048, (const float*)(ws + O_RSM), 1.0f};
          gemm_phase<EpiRowScale<1>, StaticOrder, true, true, false>(F.lds, g, S, E); }
    }
    SEAM(1); TQ1(1);
    TQ0(2);
    if (IN(2)) REP(2) phase2(F);
    SEAM(2); TQ1(2);
    TQ0(3);
    if (IN(3)) REP(3) mlstm_out_phase(F);
    SEAM(3); TQ1(3);
    TQ0(4);
    if (IN(4)) REP(4) {
        Gemm g{(const bf16*)(ws + O_Y), (const bf16*)(ws + O_WOUT), NTOK, DM, DM}; StaticOrder S; S.init(NTOK, DM, F.G, F.bid);
        EpiRes<true, true, true> E{nullptr, (bf16*)(ws + O_XB), (float*)(ws + O_SS1), ws + O_X1F8};
        gemm_phase<EpiRes<true, true, true>, StaticOrder, true, true, false>(F.lds, g, S, E);
    }
    SEAM(4); TQ1(4);
    TQ0(5);
    if (IN(5)) REP(5) {
        Gemm g{(const bf16*)(ws + O_X1F8), (const bf16*)(ws + O_WQ), NTOK, DM, DM, SC_ONE, SC_W}; StaticOrder S; S.init(NTOK, DM, F.G, F.bid);
        EpiQ E{(bf16*)(ws + O_Q), (const float*)(ws + O_SS1), 0.0625f};
        gemm_phase<EpiQ, StaticOrder, true, true, false, true>(F.lds, g, S, E);
    }
    SEAM(5); TQ1(5);
    TQ0(6);
    if (IN(6)) REP(6) attn_phase(F);
    SEAM(6); TQ1(6);
    TQ0(7);
    if (IN(7)) REP(7) {
        Gemm g{(const bf16*)(ws + O_O), (const bf16*)(ws + O_WO), NTOK, DM, DM, SC_ONE, SC_W}; StaticOrder S; S.init(NTOK, DM, F.G, F.bid);
        EpiRes<true, false, false> E{nullptr, (bf16*)(ws + O_XB), nullptr, nullptr};
        gemm_phase<EpiRes<true, false, false>, StaticOrder, true, true, false, true>(F.lds, g, S, E);
    }
    SEAM(7); TQ1(7);
    TQ0(8);
    if (IN(8)) REP(8) phase8(F);
    SEAM(8); TQ1(8);
    TQ0(9);
    if (IN(9)) REP(9) {
        LAS int* cum; LAS int* cntl; moe_tables(F, cum, cntl);
        MoeOrder S{cum, cntl, (const int*)(ws + O_RIDX), F.G, F.bid, false};
        Gemm g{(const bf16*)(ws + O_X2F8), (const bf16*)(ws + O_WGU8), NTOK, NEXP * 1024, DM, SC_ONE, SC_W};
        EpiGU E{(bf16*)(ws + O_H), (const float*)(ws + O_RS3)};
        gemm_phase<EpiGU, MoeOrder, true, true, true, true>(F.lds, g, S, E);
    }
    SEAM(9); TQ1(9);
    TQ0(10);
    if (IN(10)) REP(10) {
        LAS int* cum; LAS int* cntl; moe_tables(F, cum, cntl);
        MoeOrder S{cum, cntl, (const int*)(ws + O_RIDX), F.G, F.bid, true};
        Gemm g{(const bf16*)(ws + O_H), (const bf16*)(ws + O_WD8), MAXSLOTS, NEXP * 1024, DEXP, SC_ONE, SC_W};
        EpiPlain E{(bf16*)(ws + O_YD), DM};
        gemm_phase<EpiPlain, MoeOrder, true, true, false, true>(F.lds, g, S, E);
    }
    SEAM(10); TQ1(10);
    TQ0(11);
    if (IN(11)) REP(11) phase11(F);
    TQ1(11);
    if (TSEL >= 0 && F.bid == 0 && F.tid == 0) { const unsigned long long tgt = __builtin_amdgcn_s_memrealtime() + 4ull * (tq1 - tq0); while (__builtin_amdgcn_s_memrealtime() < tgt) __builtin_amdgcn_s_sleep(16); }
#undef IN
#undef SEAM
}

extern "C" void kernel_launch(void* const* d_in, const int* in_sizes, int n_in, void* d_out, int out_size, void* d_ws, size_t ws_size, hipStream_t stream) {
    static int grid = 0;
    if (grid == 0) {
        if (n_in != 27 || in_sizes[0] != NTOK * DM || out_size != NTOK * DM || ws_size < WS_NEED) { fprintf(stderr, "kernel_launch: unexpected shapes (n_in %d, in0 %d, out %d, ws %zu); nothing launched\n", n_in, n_in > 0 ? in_sizes[0] : -1, out_size, ws_size); grid = -1; return; }
        int dev = 0, cus = 0, per_cu = 0;
        if (hipGetDevice(&dev) != hipSuccess || hipDeviceGetAttribute(&cus, hipDeviceAttributeMultiprocessorCount, dev) != hipSuccess) { fprintf(stderr, "kernel_launch: device query failed\n"); grid = -1; return; }
        if (hipFuncSetAttribute((const void*)hybrid_fwd, hipFuncAttributeMaxDynamicSharedMemorySize, LDS_BYTES) != hipSuccess) { fprintf(stderr, "kernel_launch: hipFuncSetAttribute failed\n"); grid = -1; return; }
        if (hipOccupancyMaxActiveBlocksPerMultiprocessor(&per_cu, (const void*)hybrid_fwd, NTHR, LDS_BYTES) != hipSuccess || per_cu < 1) { fprintf(stderr, "kernel_launch: occupancy query says %d\n", per_cu); per_cu = 1; }
        (void)hipGetLastError();
        grid = cus * per_cu;
        if (grid > 256) grid = 256;
    }
    if (grid < 0) return;
    (void)hipMemsetAsync((char*)d_ws + O_CTL, 0, CTL_BYTES, stream);
    Args a{};
    for (int i = 0; i < 27; ++i) a.in[i] = (const GASK float*)d_in[i];
    a.out = (GASK float*)d_out; a.ws = (GASK uchar*)d_ws;
#if MK_N_LAUNCHES == 1
    a.ph_lo = 0; a.ph_hi = N_PHASES;
    hipLaunchKernelGGL(hybrid_fwd, dim3(grid), dim3(NTHR), LDS_BYTES, stream, a);
#else
    for (int p = 0; p < N_PHASES; ++p) { a.ph_lo = p; a.ph_hi = p + 1; hipLaunchKernelGGL(hybrid_fwd, dim3(grid), dim3(NTHR), LDS_BYTES, stream, a); }
#endif
}
```

```cpp
#include <hip/hip_runtime.h>
#include <cstdio>
#include <cstdint>
#define MK_N_LAUNCHES 1
#define DOUBLE_MASK 0
namespace pg8 {
#define PG8_LAS __attribute__((address_space(3)))
typedef unsigned short bf16_t;
typedef short bf16x8 __attribute__((ext_vector_type(8)));
typedef float f32x4 __attribute__((ext_vector_type(4)));
typedef unsigned u32x4 __attribute__((ext_vector_type(4)));
typedef unsigned u32x2 __attribute__((ext_vector_type(2)));
constexpr int BM = 256, BK = 64, HALF = 128, HTB = HALF * BK * 2  , STAGE_BYTES = 8 * HTB, NXCD = 8, WGM = 16;

__host__ __device__ __forceinline__ int lds_byte(int r, int c) { const int st = (r >> 4) * 2 + (c >> 5), rr = r & 15, cc = c & 31, ob = rr * 64 + cc * 2; return st * 1024 + (ob ^ (((ob >> 9) & 1) << 5)); }
__host__ __device__ __forceinline__ void stage_rc(int b, int& R, int& C) { const int st = b / 1024, sb = b % 1024, swz = sb ^ (((sb >> 9) & 1) << 5); R = (st >> 1) * 16 + swz / 64; C = (st & 1) * 32 + (swz % 64) / 2; }
__host__ __device__ __forceinline__ int perm32(int rho) { const int n = rho >> 4, i = rho & 15; return 8 * (i >> 2) + 4 * n + (i & 3); }

struct Unit { int pm, pn; const int* ridx; int nvalid; int orow, ocol, ex; };
struct Gemm { const bf16_t* A; const bf16_t* Bt; int M, N, K; int scale_a, scale_b; int krep = 1; };

struct StaticOrder {
    int nM, nN, nwg, G, c;
    __host__ __device__ void init(int M, int N, int G_, int c_) { nM = M / BM; nN = N / BM; nwg = nM * nN; G = G_; c = c_; }
    __host__ __device__ bool next(int i, Unit& u) const {
        const long L = (long)i * G + c; if (L >= nwg) return false;
        int wgid = (int)L; { const int q = nwg / NXCD, r = nwg % NXCD, xcd = wgid % NXCD, off = wgid / NXCD; wgid = (xcd < r ? xcd * (q + 1) : r * (q + 1) + (xcd - r) * q) + off; }
        const int nig = WGM * nN, gid = wgid / nig, fm = gid * WGM, gsz = (nM - fm) < WGM ? (nM - fm) : WGM;
        u.pm = fm + ((wgid % nig) % gsz); u.pn = (wgid % nig) / gsz; u.ridx = nullptr; u.nvalid = 256; u.orow = u.pm; u.ocol = u.pn * BM; u.ex = 0; return true;
    }
};

__device__ __forceinline__ unsigned cvt_pk_bf16(float lo, float hi) { unsigned r; asm("v_cvt_pk_bf16_f32 %0, %1, %2" : "=v"(r) : "v"(lo), "v"(hi)); return r; }

template <class Epi, class Sched, bool ALIGN_EPI, bool SP2, bool GATHER, bool FP8 = false>
__device__ __forceinline__ void gemm_phase(PG8_LAS unsigned char* lds, const Gemm g, const Sched& S, const Epi& E) {
    const int tid = threadIdx.x, wid = __builtin_amdgcn_readfirstlane(tid >> 6), lane = tid & 63, wr = wid >> 2, wc = wid & 3, fr = lane & 15, fq = lane >> 4;
    const int K = FP8 ? g.K / 2 : g.K, nt = K / BK;
    unsigned voffA[2], voffB[2];
#pragma unroll
    for (int i = 0; i < 2; ++i) { int R, C; stage_rc(tid * 16 + i * 8192, R, C); const int Rb = Epi::PERM ? ((R & ~31) + perm32(R & 31)) : R;
        voffA[i] = (unsigned)(R * K + C) * 2u; voffB[i] = (unsigned)(Rb * K + C) * 2u; }
    const size_t kstep = (size_t)(BK * 2);
    const size_t hstepB = (size_t)HALF * K * 2;
    const size_t hstepA = GATHER ? (size_t)0 : hstepB;
    const size_t tstep = 2 * hstepB;
    const unsigned ldsw = (unsigned)wid * 1024u;
    const int aoff = lds_byte(wr * 64 + fr, fq * 8), boff = lds_byte(wc * 32 + fr, fq * 8);
    unsigned vgC[2][2], vgN[2][2];
#define PG8_SA(b, h) (((b) * 2 + (h)) * HTB)
#define PG8_SB(b, h) ((4 + (b) * 2 + (h)) * HTB)
#define PG8_STAGE(bufoff, gbase, voff) do { _Pragma("unroll") for (int _i = 0; _i < 2; ++_i) \
        __builtin_amdgcn_global_load_lds((const unsigned*)((const char*)(gbase) + (voff)[_i]), (PG8_LAS unsigned*)(lds + (bufoff) + ldsw + _i * 8192), 16, 0, 0); } while (0)
#define PG8_STAGE_A(bufoff, gbase, h, nx) do { if constexpr (GATHER) { unsigned _v[2]; _v[0] = (nx) ? vgN[h][0] : vgC[h][0]; _v[1] = (nx) ? vgN[h][1] : vgC[h][1]; PG8_STAGE(bufoff, gbase, _v); } \
        else { PG8_STAGE(bufoff, (gbase) + (h) * hstepA, voffA); } } while (0)
#define PG8_GOFF(dst, u) do { _Pragma("unroll") for (int _h = 0; _h < 2; ++_h) _Pragma("unroll") for (int _i = 0; _i < 2; ++_i) { int _R, _C; stage_rc(tid * 16 + _i * 8192, _R, _C); int _r = _h * HALF + _R; _r = _r < (u).nvalid ? _r : (u).nvalid - 1; \
        dst[_h][_i] = (unsigned)(u).ridx[_r] * (unsigned)(K * 2) + (unsigned)(_C * 2); } } while (0)
#define PG8_CAT(lo, hi) __builtin_shufflevector(lo, hi, 0, 1, 2, 3, 4, 5, 6, 7)
#define PG8_LDA(dst, b, h) do { _Pragma("unroll") for (int m = 0; m < 4; ++m) { if constexpr (FP8) { dst##8[m] = PG8_CAT(*(const PG8_LAS i32x4_*)(lds + PG8_SA(b, h) + aoff + m * 2048), *(const PG8_LAS i32x4_*)(lds + PG8_SA(b, h) + aoff + m * 2048 + 1024)); } \
        else { _Pragma("unroll") for (int k = 0; k < 2; ++k) dst[m][k] = *(const PG8_LAS bf16x8*)(lds + PG8_SA(b, h) + aoff + m * 2048 + k * 1024); } } } while (0)
#define PG8_LDB(dst, b, h) do { _Pragma("unroll") for (int n = 0; n < 2; ++n) { if constexpr (FP8) { dst##8[n] = PG8_CAT(*(const PG8_LAS i32x4_*)(lds + PG8_SB(b, h) + boff + n * 2048), *(const PG8_LAS i32x4_*)(lds + PG8_SB(b, h) + boff + n * 2048 + 1024)); } \
        else { _Pragma("unroll") for (int k = 0; k < 2; ++k) dst[n][k] = *(const PG8_LAS bf16x8*)(lds + PG8_SB(b, h) + boff + n * 2048 + k * 1024); } } } while (0)
#define PG8_MMA(ai, bj, At, Bt) do { __builtin_amdgcn_s_setprio(1); _Pragma("unroll") for (int m = 0; m < 4; ++m) _Pragma("unroll") for (int n = 0; n < 2; ++n) { \
        if constexpr (FP8) { asm volatile("v_mfma_scale_f32_16x16x128_f8f6f4 %0, %1, %2, %0, %3, %4 op_sel_hi:[0,0,0]" : "+v"(acc[ai][bj][m][n]) : "v"(Bt##8[n]), "v"(At##8[m]), "v"(scb_), "v"(sca_)); } \
        else { _Pragma("unroll") for (int k = 0; k < 2; ++k) acc[ai][bj][m][n] = __builtin_amdgcn_mfma_f32_16x16x32_bf16(Bt[n][k], At[m][k], acc[ai][bj][m][n], 0, 0, 0); } } \
        if constexpr (FP8) { asm volatile("s_nop 15\n\ts_nop 3" ::: "memory"); } \
        __builtin_amdgcn_s_setprio(0); } while (0)
#define PG8_WAIT_V(n) asm volatile("s_waitcnt vmcnt(" #n ")" ::: "memory")
#define PG8_WAIT_L(n) asm volatile("s_waitcnt lgkmcnt(" #n ")" ::: "memory")
#define PG8_BAR __builtin_amdgcn_s_barrier()
#define PG8_SCHED __builtin_amdgcn_sched_barrier(0)
    Unit cur, nxt; int ui = 0;
#ifdef TPROBE
    unsigned long long tp_mark = 0, tp_sum = 0;
#define PG8_TP_MARK(k) do { if (TPROBE == (k) || ((k) == 1 && TPROBE == 2)) tp_mark = __builtin_amdgcn_s_memrealtime(); } while (0)
#define PG8_TP_END(k) do { if (TPROBE == (k)) { tp_sum += __builtin_amdgcn_s_memrealtime() - tp_mark; tp_mark = 0; } } while (0)
#define PG8_TP_FIRST do { if ((TPROBE == 1 || TPROBE == 3) && tp_mark != 0) { tp_sum += __builtin_amdgcn_s_memrealtime() - tp_mark; tp_mark = 0; } } while (0)
#else
#define PG8_TP_MARK(k) ((void)0)
#define PG8_TP_END(k) ((void)0)
#define PG8_TP_FIRST ((void)0)
#endif
    if (!S.next(0, cur)) return;
    PG8_TP_MARK(6);
    f32x4 acc[2][2][4][2];
#pragma unroll
    for (int a = 0; a < 2; ++a)
#pragma unroll
        for (int b = 0; b < 2; ++b)
#pragma unroll
            for (int m = 0; m < 4; ++m)
#pragma unroll
                for (int n = 0; n < 2; ++n) acc[a][b][m][n] = (f32x4){0.f, 0.f, 0.f, 0.f};
    typedef int i32x8_ __attribute__((ext_vector_type(8))); typedef int i32x4_ __attribute__((ext_vector_type(4)));
    int sca_ = g.scale_a, scb_ = g.scale_b; asm volatile("" : "+v"(sca_), "+v"(scb_));
    bf16x8 At[4][2], B0[2][2], B1[2][2]; i32x8_ At8[4], B08[2], B18[2];
    const char* cA = GATHER ? (const char*)g.A : (const char*)g.A + (size_t)cur.pm * tstep; const char* cB = (const char*)g.Bt + (size_t)cur.pn * tstep;
    if constexpr (GATHER) { PG8_GOFF(vgC, cur); }
    if constexpr (SP2) {
        PG8_STAGE(PG8_SB(0, 0), cB, voffB); PG8_STAGE(PG8_SB(0, 1), cB + hstepB, voffB); PG8_STAGE_A(PG8_SA(0, 0), cA, 0, false); PG8_STAGE_A(PG8_SA(0, 1), cA, 1, false);
        if (wr == 1) PG8_BAR;
        PG8_WAIT_V(2); PG8_BAR;
        PG8_STAGE(PG8_SB(1, 0), cB + kstep, voffB); PG8_STAGE_A(PG8_SA(1, 0), cA + kstep, 0, false); PG8_STAGE(PG8_SB(1, 1), cB + hstepB + kstep, voffB);
        PG8_WAIT_V(6); PG8_BAR;
    } else {
        PG8_STAGE(PG8_SB(0, 0), cB, voffB); PG8_STAGE_A(PG8_SA(0, 0), cA, 0, false); PG8_STAGE(PG8_SB(0, 1), cB + hstepB, voffB); PG8_STAGE_A(PG8_SA(0, 1), cA, 1, false);
        if (wr == 1) PG8_BAR;
        PG8_WAIT_V(4); PG8_BAR;
        PG8_STAGE(PG8_SB(1, 0), cB + kstep, voffB); PG8_STAGE_A(PG8_SA(1, 0), cA + kstep, 0, false); PG8_STAGE(PG8_SB(1, 1), cB + hstepB + kstep, voffB);
        PG8_WAIT_V(6); PG8_BAR;
    }
    for (;;) {
        const bool has_next = S.next(ui + 1, nxt);
        const char* nA = GATHER ? (const char*)g.A : (has_next ? (const char*)g.A + (size_t)nxt.pm * tstep : cA); const char* nB = has_next ? (const char*)g.Bt + (size_t)nxt.pn * tstep : cB;
        if constexpr (GATHER) { if (has_next) { PG8_GOFF(vgN, nxt); } else {
#pragma unroll
            for (int _h = 0; _h < 2; ++_h) { vgN[_h][0] = vgC[_h][0]; vgN[_h][1] = vgC[_h][1]; } } }
        PG8_TP_MARK(5);
#ifdef KREP_PROBE
        const int ntt = nt * g.krep;
#pragma unroll 1
        for (int tt = 0; tt < ntt; tt += 2) {
            const int t = tt & (nt - 1), t2 = (t + 2) & (nt - 1);
            const bool last = (tt == ntt - 2);
            const char* a1 = cA + (size_t)(t + 1) * kstep;
            const char* a2 = last ? nA : cA + (size_t)t2 * kstep; const char* b2 = last ? nB : cB + (size_t)t2 * kstep;
#else
#pragma unroll 1
        for (int t = 0; t < nt; t += 2) {
            const bool last = (t == nt - 2);
            const char* a1 = cA + (size_t)(t + 1) * kstep;
            const char* a2 = last ? nA : cA + (size_t)(t + 2) * kstep; const char* b2 = last ? nB : cB + (size_t)(t + 2) * kstep;
#endif
            const char* a3 = a2 + kstep; const char* b3 = b2 + kstep;
            if constexpr (SP2) {
            PG8_LDB(B0, 0, 0); PG8_LDB(B1, 0, 1); PG8_SCHED; PG8_LDA(At, 0, 0); PG8_STAGE_A(PG8_SA(1, 1), a1, 1, false);
            PG8_WAIT_V(8); PG8_WAIT_L(0); PG8_BAR; PG8_TP_FIRST; PG8_MMA(0, 0, At, B0); PG8_MMA(0, 1, At, B1); PG8_BAR; PG8_SCHED;
            PG8_LDA(At, 0, 1); PG8_STAGE(PG8_SB(0, 0), b2, voffB); PG8_STAGE(PG8_SB(0, 1), b2 + hstepB, voffB); PG8_STAGE_A(PG8_SA(0, 0), a2, 0, last);
            PG8_WAIT_V(8); PG8_WAIT_L(0); PG8_BAR; PG8_MMA(1, 0, At, B0); PG8_MMA(1, 1, At, B1); PG8_BAR; PG8_SCHED;
            PG8_LDB(B0, 1, 0); PG8_LDB(B1, 1, 1); PG8_SCHED; PG8_LDA(At, 1, 0); PG8_STAGE_A(PG8_SA(0, 1), a2, 1, last);
            PG8_WAIT_V(8); PG8_WAIT_L(0); PG8_BAR; PG8_MMA(0, 0, At, B0); PG8_MMA(0, 1, At, B1); PG8_BAR; PG8_SCHED;
            PG8_LDA(At, 1, 1); PG8_STAGE(PG8_SB(1, 0), b3, voffB); PG8_STAGE(PG8_SB(1, 1), b3 + hstepB, voffB); PG8_STAGE_A(PG8_SA(1, 0), a3, 0, last);
            PG8_WAIT_V(8); PG8_WAIT_L(0); PG8_BAR; PG8_MMA(1, 0, At, B0); PG8_MMA(1, 1, At, B1); PG8_BAR; PG8_SCHED;
            } else {
            PG8_LDB(B0, 0, 0); PG8_SCHED; PG8_LDA(At, 0, 0); PG8_STAGE_A(PG8_SA(1, 1), a1, 1, false);
            PG8_WAIT_L(8); PG8_BAR; PG8_WAIT_L(0); PG8_MMA(0, 0, At, B0); PG8_BAR; PG8_SCHED;
            PG8_LDB(B1, 0, 1); PG8_STAGE(PG8_SB(0, 0), b2, voffB);
            PG8_BAR; PG8_WAIT_L(0); PG8_MMA(0, 1, At, B1); PG8_BAR;
            PG8_LDA(At, 0, 1); PG8_STAGE_A(PG8_SA(0, 0), a2, 0, last);
            PG8_BAR; PG8_WAIT_L(0); PG8_MMA(1, 0, At, B0); PG8_BAR; PG8_SCHED;
            PG8_STAGE(PG8_SB(0, 1), b2 + hstepB, voffB);
            PG8_WAIT_V(6); PG8_BAR; PG8_MMA(1, 1, At, B1); PG8_BAR;
            PG8_LDB(B0, 1, 0); PG8_SCHED; PG8_LDA(At, 1, 0); PG8_STAGE_A(PG8_SA(0, 1), a2, 1, last);
            PG8_WAIT_L(8); PG8_BAR; PG8_WAIT_L(0); PG8_MMA(0, 0, At, B0); PG8_BAR; PG8_SCHED;
            PG8_LDB(B1, 1, 1); PG8_STAGE(PG8_SB(1, 0), b3, voffB);
            PG8_BAR; PG8_WAIT_L(0); PG8_MMA(0, 1, At, B1); PG8_BAR;
            PG8_LDA(At, 1, 1); PG8_STAGE_A(PG8_SA(1, 0), a3, 0, last);
            PG8_BAR; PG8_WAIT_L(0); PG8_MMA(1, 0, At, B0); PG8_BAR; PG8_SCHED;
            PG8_STAGE(PG8_SB(1, 1), b3 + hstepB, voffB);
            PG8_WAIT_V(6); PG8_BAR; PG8_MMA(1, 1, At, B1); PG8_BAR;
            }
        }
        PG8_TP_END(5);
        PG8_TP_MARK(1);
        if constexpr (ALIGN_EPI) { if (wr == 0) PG8_BAR; }
        PG8_TP_MARK(4);
        E(acc, cur, wr, wc, fr, fq);
        PG8_TP_END(2); PG8_TP_END(4); PG8_TP_MARK(3);
        if (!has_next) break;
#pragma unroll
        for (int a = 0; a < 2; ++a)
#pragma unroll
            for (int b = 0; b < 2; ++b)
#pragma unroll
                for (int m = 0; m < 4; ++m)
#pragma unroll
                    for (int n = 0; n < 2; ++n) acc[a][b][m][n] = (f32x4){0.f, 0.f, 0.f, 0.f};
        cur = nxt; cA = nA; cB = nB; ++ui;
        if constexpr (GATHER) {
#pragma unroll
            for (int _h = 0; _h < 2; ++_h) { vgC[_h][0] = vgN[_h][0]; vgC[_h][1] = vgN[_h][1]; } }
        if constexpr (ALIGN_EPI) { if (wr == 1) PG8_BAR; }
    }
    PG8_WAIT_V(0);
    if constexpr (!ALIGN_EPI) { if (wr == 0) PG8_BAR; }
    PG8_BAR;
    PG8_TP_END(6);
#ifdef TPROBE
    if (tid == 0) { volatile PG8_LAS unsigned long long* tp = (volatile PG8_LAS unsigned long long*)(lds + 163840 - 256 + 128); *tp = *tp + tp_sum; }
#endif
#undef PG8_TP_MARK
#undef PG8_TP_END
#undef PG8_TP_FIRST
#undef PG8_SA
#undef PG8_SB
#undef PG8_STAGE
#undef PG8_STAGE_A
#undef PG8_GOFF
#undef PG8_LDA
#undef PG8_CAT
#undef PG8_LDB
#undef PG8_MMA
#undef PG8_WAIT_V
#undef PG8_WAIT_L
#undef PG8_BAR
#undef PG8_SCHED
}
}
#define DI __device__ __forceinline__
#define LAS __attribute__((address_space(3)))
typedef unsigned short bf16;
typedef short bf16x8 __attribute__((ext_vector_type(8)));
typedef short s16x4 __attribute__((ext_vector_type(4)));
typedef float f32x4 __attribute__((ext_vector_type(4)));
typedef float f32x2 __attribute__((ext_vector_type(2)));
typedef unsigned u32x4 __attribute__((ext_vector_type(4)));
typedef unsigned u32x2 __attribute__((ext_vector_type(2)));
typedef unsigned char uchar;

constexpr int NB = 16, SEQ = 4096, DM = 1024, NTOK = NB * SEQ;
constexpr int NMEM = 256, NMROWS = NB * NMEM;
constexpr int ZC = 3072;
constexpr int NEXP = 32, DEXP = 512;
constexpr int MAXTILES = 544, MAXSLOTS = MAXTILES * 256;
constexpr float RMS_EPS = 1e-6f, LN_EPS = 1e-5f;
constexpr int NWAVES = 8, NTHR = 512;
constexpr int LDS_BYTES = 163840;

constexpr size_t MiB = 1u << 20;
constexpr size_t O_CTL = 0, CTL_BYTES = 64 * 1024;
constexpr size_t O_RS0 = 1 * MiB, O_RSM = O_RS0 + 256 * 1024, O_RS3 = O_RS0 + 512 * 1024;
constexpr size_t O_GATES = 2 * MiB;
constexpr size_t O_SS1 = 6 * MiB;
constexpr size_t O_TOK = 10 * MiB;
constexpr size_t O_RIDX = 12 * MiB;
constexpr size_t O_NST = 20 * MiB, O_MST = 22 * MiB;
constexpr size_t O_WSB = 23 * MiB;
constexpr size_t O_WRH = 24 * MiB, O_WRL = O_WRH + 128 * 1024;
constexpr size_t O_WIN = 32 * MiB, O_WOUT = 38 * MiB, O_WQ = 40 * MiB, O_WKV = 42 * MiB, O_WO = 46 * MiB, O_WGU = 48 * MiB, O_WD = 112 * MiB;
constexpr size_t O_XB = 160 * MiB;
constexpr size_t O_MEMB = 288 * MiB, O_KV = 296 * MiB;
constexpr size_t O_Z = 320 * MiB;
constexpr size_t O_ZQ = 448 * MiB, O_ZK = 512 * MiB, O_ZV = 576 * MiB, O_ZO = 640 * MiB;
constexpr int ZG = 1024;
constexpr size_t O_CST = 704 * MiB;
constexpr size_t O_Y = 840 * MiB;
constexpr size_t O_Q = O_Z, O_O = O_Z + 128 * MiB;
constexpr size_t O_H = O_Z, O_YD = O_Z + 144 * MiB;
constexpr size_t O_WGU8 = O_WGU, O_WD8 = O_WGU + 32 * MiB;
constexpr size_t O_X1F8 = 576 * MiB;
constexpr size_t O_X2F8 = O_Y;
constexpr int SC_ONE = 0x7F7F7F7F, SC_W = 0x7A7A7A7A;
constexpr size_t WS_NEED = 968 * MiB;
constexpr int CW_CNT = 0, CW_BAR = 4096;
constexpr int CW_CNT_UNUSED = 0;

#define LDS_WAIT() asm volatile("s_waitcnt lgkmcnt(0)" ::: "memory")
DI unsigned f2bf(float f) { unsigned u = __builtin_bit_cast(unsigned, f); return (u + 0x7fffu + ((u >> 16) & 1u)) >> 16; }
DI unsigned pk2(float lo, float hi) { return pg8::cvt_pk_bf16(lo, hi); }
DI unsigned pk4_fp8(float a, float b, float c, float d) { int t = __builtin_amdgcn_cvt_pk_fp8_f32(a, b, 0, false); t = __builtin_amdgcn_cvt_pk_fp8_f32(c, d, t, true); return (unsigned)t; }
DI float bf2f(unsigned short h) { return __builtin_bit_cast(float, (unsigned)h << 16); }
DI float bflo(unsigned w) { return __builtin_bit_cast(float, w << 16); }
DI float bfhi(unsigned w) { return __builtin_bit_cast(float, w & 0xffff0000u); }
#define DPP_F(old, src, ctrl, rm) __builtin_bit_cast(float, __builtin_amdgcn_update_dpp(__builtin_bit_cast(int, (float)(old)), __builtin_bit_cast(int, (float)(src)), ctrl, rm, 0xF, false))
DI float wave_sum(float v) {
    v += DPP_F(0.f, v, 0xB1, 0xF); v += DPP_F(0.f, v, 0x4E, 0xF); v += DPP_F(0.f, v, 0x141, 0xF); v += DPP_F(0.f, v, 0x140, 0xF);
    v += DPP_F(0.f, v, 0x142, 0xA); v += DPP_F(0.f, v, 0x143, 0xC);
    return __builtin_bit_cast(float, __builtin_amdgcn_readlane(__builtin_bit_cast(int, v), 63));
}
DI float wave_max(float v) {
    v = fmaxf(v, DPP_F(v, v, 0xB1, 0xF)); v = fmaxf(v, DPP_F(v, v, 0x4E, 0xF)); v = fmaxf(v, DPP_F(v, v, 0x141, 0xF)); v = fmaxf(v, DPP_F(v, v, 0x140, 0xF));
    v = fmaxf(v, DPP_F(v, v, 0x142, 0xA)); v = fmaxf(v, DPP_F(v, v, 0x143, 0xC));
    return __builtin_bit_cast(float, __builtin_amdgcn_readlane(__builtin_bit_cast(int, v), 63));
}
DI float wscan_add(float v, int lane) {
#pragma unroll
    for (int o = 1; o < 64; o <<= 1) { const float u = __shfl_up(v, o); v = (lane >= o) ? v + u : v; }
    return v;
}
DI float wscan_max(float v, int lane) {
#pragma unroll
    for (int o = 1; o < 64; o <<= 1) { const float u = __shfl_up(v, o); v = (lane >= o) ? fmaxf(v, u) : v; }
    return v;
}
DI float wscan_max_rev(float v, int lane) {
#pragma unroll
    for (int o = 1; o < 64; o <<= 1) { const float u = __shfl_down(v, o); v = (lane + o < 64) ? fmaxf(v, u) : v; }
    return v;
}
DI float fast_exp(float x) { return __expf(x); }
DI float sigmoidf_(float x) { return __builtin_amdgcn_rcpf(1.0f + __expf(-x)); }
DI float siluf_(float x) { return x * __builtin_amdgcn_rcpf(1.0f + __expf(-x)); }
DI float gelu_tanh(float x) { const float u = 0.7978845608028654f * (x + 0.044715f * x * x * x); return x * __builtin_amdgcn_rcpf(1.0f + __expf(-2.0f * u)); }
DI float log_sigmoid(float x) { return fminf(x, 0.f) - __logf(1.0f + __expf(-fabsf(x))); }

DI unsigned offb(unsigned row, unsigned ch) { return 256u * row + 16u * (ch ^ (((row & 3u) << 2) | ((row >> 2) & 3u))); }
DI bf16x8 frag_row(const LAS uchar* tile, int r0, int kk, int lane) { return *(const LAS bf16x8*)(tile + offb(r0 + (lane & 15), 4 * kk + (lane >> 4))); }
DI bf16x8 frag_tr(const LAS uchar* tile, int k0, int c0, int lane) {
    const unsigned g = lane >> 4, q = (lane & 15) >> 2, p = lane & 3;
    const unsigned ch = (c0 >> 3) + (p >> 1), bo = 8u * (p & 1);
    const s16x4 lo = __builtin_amdgcn_ds_read_tr16_b64_v4i16((LAS s16x4*)(tile + offb(k0 + 8 * g + q, ch) + bo));
    const s16x4 hi = __builtin_amdgcn_ds_read_tr16_b64_v4i16((LAS s16x4*)(tile + offb(k0 + 8 * g + 4 + q, ch) + bo));
    return (bf16x8){lo[0], lo[1], lo[2], lo[3], hi[0], hi[1], hi[2], hi[3]};
}
DI f32x4 mfma16(bf16x8 x, bf16x8 y, f32x4 acc) { return __builtin_amdgcn_mfma_f32_16x16x32_bf16(x, y, acc, 0, 0, 0); }

#if defined(__HIP_DEVICE_COMPILE__)
#define GASK __attribute__((address_space(1)))
#else
#define GASK
#endif
struct Args { const GASK float* in[27]; GASK float* out; GASK uchar* ws; int ph_lo, ph_hi; };
struct Frame {
    LAS uchar* lds;
    int tid, lane, wave, G, bid;
    const GASK float* const* in;
    float* out; uchar* ws;
};
#define GAS __attribute__((address_space(1)))
#define INP(i) ((const float*)F.in[i])
enum { I_X = 0, I_MEM, I_GMIX, I_WIN, I_CONVW, I_CONVB, I_GATEB, I_GHEAD, I_LNVG, I_LNVB, I_WS, I_BS, I_WOUT, I_GXATTN, I_GMEM, I_WQ, I_WKV, I_WO, I_GMOE, I_WRG, I_BRG, I_WRE, I_BRE, I_WGATE, I_WUP, I_WDOWN, I_GFINAL };
struct P0Item { const float* W; const float* gain; bf16* WT; size_t drow0; int K, ldw, scol0, k0, f8; };
DI void p0_decode(Frame& F, int it, P0Item& I) {
    uchar* ws = F.ws;
    constexpr int I_IN = 16 * 96, I_SQ = 16 * 32, I_KV = 16 * 64, I_GU = 32 * 16 * 16;
    int r = it;
    if (r < I_IN) { const int kb = r / 96, nb = r % 96; I = P0Item{INP(I_WIN), INP(I_GMIX), (bf16*)(ws + O_WIN), (size_t)nb * 32, 1024, 3088, nb * 32 < 2048 ? nb * 32 : nb * 32 + 16, kb * 64, 0}; return; } r -= I_IN;
    if (r < I_SQ) { const int kb = r / 32, nb = r % 32; I = P0Item{INP(I_WOUT), nullptr, (bf16*)(ws + O_WOUT), (size_t)nb * 32, 1024, 1024, nb * 32, kb * 64, 0}; return; } r -= I_SQ;
    if (r < I_SQ) { const int kb = r / 32, nb = r % 32; I = P0Item{INP(I_WQ), INP(I_GXATTN), (bf16*)(ws + O_WQ), (size_t)nb * 32, 1024, 1024, nb * 32, kb * 64, 1}; return; } r -= I_SQ;
    if (r < I_KV) { const int kb = r / 64, nb = r % 64; I = P0Item{INP(I_WKV), INP(I_GMEM), (bf16*)(ws + O_WKV), (size_t)nb * 32, 1024, 2048, nb * 32, kb * 64, 0}; return; } r -= I_KV;
    if (r < I_SQ) { const int kb = r / 32, nb = r % 32; I = P0Item{INP(I_WO), nullptr, (bf16*)(ws + O_WO), (size_t)nb * 32, 1024, 1024, nb * 32, kb * 64, 1}; return; } r -= I_SQ;
    if (r < 2 * I_GU) { const int up = r >= I_GU; if (up) r -= I_GU; const int e = r / 256, q = r % 256, kb = q / 16, nb = q % 16;
        I = P0Item{INP(up ? I_WUP : I_WGATE) + (size_t)e * 1024 * 512, INP(I_GMOE), (bf16*)(ws + O_WGU8), (size_t)e * 1024 + 256 * (nb / 4) + (up ? 128 : 0) + (nb % 4) * 32, 1024, 512, nb * 32, kb * 64, 1}; return; } r -= 2 * I_GU;
    { const int e = r / 256, q = r % 256, kb = q / 32, nb = q % 32;
        I = P0Item{INP(I_WDOWN) + (size_t)e * 512 * 1024, nullptr, (bf16*)(ws + O_WD8), (size_t)e * 1024 + nb * 32, 512, 1024, nb * 32, kb * 64, 1}; }
}
DI void p0_item_load(const P0Item& I, float (&tv)[32], int lane) {
#pragma unroll
    for (int i = 0; i < 32; ++i) { const int kk = 2 * i + (lane >> 5); tv[i] = *(const GAS float*)(I.W + (size_t)(I.k0 + kk) * I.ldw + I.scol0 + (lane & 31)); }
}
DI void p0_item_store(const P0Item& I, float (&tv)[32], LAS float* scr, int lane) {
    if (I.gain) {
#pragma unroll
        for (int i = 0; i < 32; ++i) tv[i] *= I.gain[I.k0 + 2 * i + (lane >> 5)]; }
#pragma unroll
    for (int i = 0; i < 32; ++i) { const int kk = 2 * i + (lane >> 5); scr[kk * 33 + (lane & 31)] = tv[i]; }
    LDS_WAIT(); asm volatile("" ::: "memory");
    if (I.f8) {
        const int c = lane & 3;
#pragma unroll
        for (int j = 0; j < 2; ++j) { const int n = (lane >> 2) + 16 * j; const LAS float* s = scr + (16 * c) * 33 + n;
            u32x4 o; o.x = pk4_fp8(32.f * s[0 * 33], 32.f * s[1 * 33], 32.f * s[2 * 33], 32.f * s[3 * 33]); o.y = pk4_fp8(32.f * s[4 * 33], 32.f * s[5 * 33], 32.f * s[6 * 33], 32.f * s[7 * 33]);
            o.z = pk4_fp8(32.f * s[8 * 33], 32.f * s[9 * 33], 32.f * s[10 * 33], 32.f * s[11 * 33]); o.w = pk4_fp8(32.f * s[12 * 33], 32.f * s[13 * 33], 32.f * s[14 * 33], 32.f * s[15 * 33]);
            *(GAS u32x4*)((uchar*)I.WT + (I.drow0 + n) * (size_t)I.K + I.k0 + 16 * c) = o; }
    } else {
    const int c = lane & 7;
#pragma unroll
    for (int j = 0; j < 4; ++j) { const int n = (lane >> 3) + 8 * j; const LAS float* s = scr + (8 * c) * 33 + n;
        u32x4 o; o.x = pk2(s[0 * 33], s[1 * 33]); o.y = pk2(s[2 * 33], s[3 * 33]); o.z = pk2(s[4 * 33], s[5 * 33]); o.w = pk2(s[6 * 33], s[7 * 33]);
        *(GAS u32x4*)(I.WT + (I.drow0 + n) * (size_t)I.K + I.k0 + 8 * c) = o; }
    }
    LDS_WAIT(); asm volatile("" ::: "memory");
}

DI void phase0(Frame& F) {
    const int gw = F.bid * NWAVES + F.wave, NGW = F.G * NWAVES, lane = F.lane;
    uchar* ws = F.ws;
    {
        LAS float* scr = (LAS float*)(F.lds + F.wave * 16384);
        constexpr int NITEMS = 16 * 96 + 3 * 16 * 32 + 16 * 64 + 2 * 32 * 16 * 16 + 32 * 8 * 32;
        P0Item cur, nxt; float tvA[32], tvB[32];
        int it = gw;
        if (it < NITEMS) { p0_decode(F, it, cur); p0_item_load(cur, tvA, lane); }
        while (it < NITEMS) {
            if (it + NGW < NITEMS) { p0_decode(F, it + NGW, nxt); p0_item_load(nxt, tvB, lane); }
            p0_item_store(cur, tvA, scr, lane);
            it += NGW; if (it >= NITEMS) break;
            if (it + NGW < NITEMS) { p0_decode(F, it + NGW, cur); p0_item_load(cur, tvA, lane); }
            p0_item_store(nxt, tvB, scr, lane);
            it += NGW;
        }
        for (int i = F.bid * NTHR + F.tid; i < 48 * 1024; i += F.G * NTHR) { const int n = i >> 10, k = i & 1023; float v = 0.f;
            if (n < 4) v = INP(I_WRG)[k * 4 + n] * INP(I_GMOE)[k]; else if (n >= 16) v = INP(I_WRE)[k * 32 + (n - 16)] * INP(I_GMOE)[k];
            const unsigned h = f2bf(v); const float hf = __builtin_bit_cast(float, h << 16);
            ((bf16*)(ws + O_WRH))[i] = (bf16)h; ((bf16*)(ws + O_WRL))[i] = (bf16)f2bf(v - hf); }
        for (int i = F.bid * NTHR + F.tid; i < 4 * 128 * 128 / 2; i += F.G * NTHR) { const f32x2 v = *(const GAS f32x2*)(INP(I_WS) + 2 * i); ((unsigned*)(ws + O_WSB))[i] = pk2(v.x, v.y); }
    }
    __syncthreads();
    LAS float* wg = (LAS float*)F.lds;
    for (int idx = F.tid; idx < 1024 * 16; idx += NTHR) { const int i = idx >> 4, j = idx & 15; const float v = INP(I_WIN)[(size_t)i * 3088 + 2048 + j] * INP(I_GMIX)[i];
        const int jj = i >> 8, l = (i & 255) >> 2, ii = i & 3, j4 = j >> 2, jr = j & 3; wg[((((jj * 4 + ii) * 4 + j4) * 64 + l) << 2) + jr] = v; }
    __syncthreads();
    {
        bf16* XB = (bf16*)(ws + O_XB); float* rs0 = (float*)(ws + O_RS0); float* gates = (float*)(ws + O_GATES);
        const float gb = INP(I_GATEB)[lane >> 2];
        f32x4 nx[4];
        if (gw < NTOK) { const f32x4* xr0 = (const f32x4*)(INP(I_X) + (size_t)gw * DM) + lane;
#pragma unroll
            for (int j = 0; j < 4; ++j) nx[j] = xr0[64 * j]; }
        for (int m = gw; m < NTOK; m += NGW) {
            f32x4 v[4]; float s = 0.f;
#pragma unroll
            for (int j = 0; j < 4; ++j) { v[j] = nx[j]; s += (v[j].x * v[j].x + v[j].y * v[j].y) + (v[j].z * v[j].z + v[j].w * v[j].w); }
            if (m + NGW < NTOK) { const f32x4* xr1 = (const f32x4*)(INP(I_X) + (size_t)(m + NGW) * DM) + lane;
#pragma unroll
                for (int j = 0; j < 4; ++j) nx[j] = xr1[64 * j]; }
            const float rs = 1.0f / sqrtf(wave_sum(s) * (1.f / DM) + RMS_EPS);
            unsigned long long* o8 = (unsigned long long*)(XB + (size_t)m * DM) + lane;
#pragma unroll
            for (int j = 0; j < 4; ++j) o8[64 * j] = (unsigned long long)pk2(v[j].x, v[j].y) | ((unsigned long long)pk2(v[j].z, v[j].w) << 32);
            float p[16];
#pragma unroll
            for (int j = 0; j < 16; ++j) p[j] = 0.f;
#pragma unroll
            for (int jj = 0; jj < 4; ++jj)
#pragma unroll
                for (int ii = 0; ii < 4; ++ii) { const float xv = v[jj][ii];
#pragma unroll
                    for (int j4 = 0; j4 < 4; ++j4) { const f32x4 w = *(const LAS f32x4*)(wg + ((((jj * 4 + ii) * 4 + j4) * 64 + lane) << 2));
                        p[4 * j4 + 0] += xv * w.x; p[4 * j4 + 1] += xv * w.y; p[4 * j4 + 2] += xv * w.z; p[4 * j4 + 3] += xv * w.w; } }
            float q8[8], q4[4], q2[2], q1;
            { const bool hi = (lane & 32) != 0;
#pragma unroll
              for (int k = 0; k < 8; ++k) { const float send = hi ? p[k] : p[k + 8], keep = hi ? p[k + 8] : p[k]; q8[k] = keep + __shfl_xor(send, 32); } }
            { const bool hi = (lane & 16) != 0;
#pragma unroll
              for (int k = 0; k < 4; ++k) { const float send = hi ? q8[k] : q8[k + 4], keep = hi ? q8[k + 4] : q8[k]; q4[k] = keep + __shfl_xor(send, 16); } }
            { const bool hi = (lane & 8) != 0;
#pragma unroll
              for (int k = 0; k < 2; ++k) { const float send = hi ? q4[k] : q4[k + 2], keep = hi ? q4[k + 2] : q4[k]; q2[k] = keep + __shfl_xor(send, 8); } }
            { const bool hi = (lane & 4) != 0; const float send = hi ? q2[0] : q2[1], keep = hi ? q2[1] : q2[0]; q1 = keep + __shfl_xor(send, 4); }
            q1 += __shfl_xor(q1, 2); q1 += __shfl_xor(q1, 1);
            if ((lane & 3) == 0) gates[(size_t)m * 16 + (lane >> 2)] = q1 * rs + gb;
            if (lane == 0) rs0[m] = rs;
        }
    }
    {
        bf16* MB = (bf16*)(ws + O_MEMB); float* rsm = (float*)(ws + O_RSM);
        for (int m = gw; m < NMROWS; m += NGW) {
            const f32x4* xr = (const f32x4*)(INP(I_MEM) + (size_t)m * DM) + lane;
            f32x4 v[4]; float s = 0.f;
#pragma unroll
            for (int j = 0; j < 4; ++j) { v[j] = xr[64 * j]; s += (v[j].x * v[j].x + v[j].y * v[j].y) + (v[j].z * v[j].z + v[j].w * v[j].w); }
            const float rs = 1.0f / sqrtf(wave_sum(s) * (1.f / DM) + RMS_EPS);
            unsigned long long* o8 = (unsigned long long*)(MB + (size_t)m * DM) + lane;
#pragma unroll
            for (int j = 0; j < 4; ++j) o8[64 * j] = (unsigned long long)pk2(v[j].x, v[j].y) | ((unsigned long long)pk2(v[j].z, v[j].w) << 32);
            if (lane == 0) rsm[m] = rs;
        }
    }
}
using pg8::Unit;
typedef const f32x4 (&AccRef)[2][2][4][2];

template <int MODE> struct EpiRowScale {
    static constexpr bool PERM = true;
    bf16* O; int ldc; const float* rs; float extra;
    DI void operator()(AccRef acc, const Unit& u, int wr, int wc, int fr, int fq) const {
        const int row0 = u.orow * 256 + wr * 64 + fr, col0 = u.ocol + wc * 32 + 8 * fq;
        const int act = (MODE == 0) ? (u.pn >= 8 ? 2 : (u.pn >= 6 ? 1 : 0)) : 0;
        float sc[2][4];
#pragma unroll
        for (int ai = 0; ai < 2; ++ai)
#pragma unroll
            for (int m = 0; m < 4; ++m) sc[ai][m] = *(const GAS float*)(rs + row0 + ai * 128 + m * 16);
#pragma unroll
        for (int ai = 0; ai < 2; ++ai)
#pragma unroll
            for (int m = 0; m < 4; ++m) { const int row = row0 + ai * 128 + m * 16; const float s = sc[ai][m] * extra;
#pragma unroll
                for (int bj = 0; bj < 2; ++bj) { f32x4 v0 = acc[ai][bj][m][0] * s, v1 = acc[ai][bj][m][1] * s;
                    if (act == 1) {
#pragma unroll
                        for (int j = 0; j < 4; ++j) { v0[j] = sigmoidf_(v0[j]); v1[j] = sigmoidf_(v1[j]); } }
                    else if (act == 2) {
#pragma unroll
                        for (int j = 0; j < 4; ++j) { v0[j] = gelu_tanh(v0[j]); v1[j] = gelu_tanh(v1[j]); } }
                    u32x4 w; w.x = pk2(v0[0], v0[1]); w.y = pk2(v0[2], v0[3]); w.z = pk2(v1[0], v1[1]); w.w = pk2(v1[2], v1[3]);
                    bf16* dst;
                    if (MODE == 0) {
                        if (u.pn < 8) dst = O + (size_t)(64 * MiB / 2) * (u.pn >> 1) + (size_t)(128 * MiB / 2) + ((size_t)((row >> 12) * 4 + (u.pn & 1) * 2 + bj) * SEQ + (row & (SEQ - 1))) * 128 + wc * 32 + 8 * fq;
                        else dst = O + (size_t)row * ZG + (u.pn - 8) * 256 + bj * 128 + wc * 32 + 8 * fq;
                    } else dst = O + (size_t)row * ldc + col0 + bj * 128;
                    *(GAS u32x4*)dst = w; } }
    }
};
struct EpiQ {
    static constexpr bool PERM = true;
    bf16* O; const float* ssp; float extra;
    DI void operator()(AccRef acc, const Unit& u, int wr, int wc, int fr, int fq) const {
        const int row0 = u.orow * 256 + wr * 64 + fr, col0 = u.ocol + wc * 32 + 8 * fq;
        float sc[2][4];
#pragma unroll
        for (int ai = 0; ai < 2; ++ai) { f32x4 p[4][4];
#pragma unroll
            for (int m = 0; m < 4; ++m) { const GAS f32x4* sp = (const GAS f32x4*)(ssp + (size_t)(row0 + ai * 128 + m * 16) * 16);
                p[m][0] = sp[0]; p[m][1] = sp[1]; p[m][2] = sp[2]; p[m][3] = sp[3]; }
#pragma unroll
            for (int m = 0; m < 4; ++m) { const f32x4 a = p[m][0], b = p[m][1], c = p[m][2], d = p[m][3];
                const float ss = (((a.x + a.y) + (a.z + a.w)) + ((b.x + b.y) + (b.z + b.w))) + (((c.x + c.y) + (c.z + c.w)) + ((d.x + d.y) + (d.z + d.w)));
                sc[ai][m] = extra / sqrtf(ss * (1.f / DM) + RMS_EPS); } }
#pragma unroll
        for (int ai = 0; ai < 2; ++ai)
#pragma unroll
            for (int m = 0; m < 4; ++m) { const int row = row0 + ai * 128 + m * 16; const float s = sc[ai][m]; bf16* rowp = O + (size_t)row * DM + col0;
#pragma unroll
                for (int bj = 0; bj < 2; ++bj) { const f32x4 v0 = acc[ai][bj][m][0] * s, v1 = acc[ai][bj][m][1] * s;
                    u32x4 w; w.x = pk2(v0[0], v0[1]); w.y = pk2(v0[2], v0[3]); w.z = pk2(v1[0], v1[1]); w.w = pk2(v1[2], v1[3]);
                    *(GAS u32x4*)(rowp + bj * 128) = w; } }
    }
};
template <bool BASE_BF16, bool SS, bool F8> struct EpiRes {
    static constexpr bool PERM = true;
    const float* base; bf16* xb; float* ssp; uchar* x8;
    DI void operator()(AccRef acc, const Unit& u, int wr, int wc, int fr, int fq) const {
        static_assert(BASE_BF16, "the residual base is the bf16 stream itself");
        const int row0 = u.orow * 256 + wr * 64 + fr, col0 = u.ocol + wc * 32 + 8 * fq;
        u32x4 bs[2][4][2];
#pragma unroll
        for (int ai = 0; ai < 2; ++ai)
#pragma unroll
            for (int m = 0; m < 4; ++m) { const size_t off = (size_t)(row0 + ai * 128 + m * 16) * DM + col0;
#pragma unroll
                for (int bj = 0; bj < 2; ++bj) bs[ai][m][bj] = *(const GAS u32x4*)(xb + off + bj * 128); }
#pragma unroll
        for (int ai = 0; ai < 2; ++ai)
#pragma unroll
            for (int m = 0; m < 4; ++m) { const int row = row0 + ai * 128 + m * 16; const size_t off = (size_t)row * DM + col0; float q = 0.f;
#pragma unroll
                for (int bj = 0; bj < 2; ++bj) { const u32x4 b4 = bs[ai][m][bj];
                    const f32x4 v0 = (f32x4){bflo(b4.x), bfhi(b4.x), bflo(b4.y), bfhi(b4.y)} + acc[ai][bj][m][0], v1 = (f32x4){bflo(b4.z), bfhi(b4.z), bflo(b4.w), bfhi(b4.w)} + acc[ai][bj][m][1];
                    u32x4 w; w.x = pk2(v0[0], v0[1]); w.y = pk2(v0[2], v0[3]); w.z = pk2(v1[0], v1[1]); w.w = pk2(v1[2], v1[3]);
                    *(GAS u32x4*)(xb + off + bj * 128) = w;
                    if (F8) { u32x2 w8; w8.x = pk4_fp8(v0[0], v0[1], v0[2], v0[3]); w8.y = pk4_fp8(v1[0], v1[1], v1[2], v1[3]); *(GAS u32x2*)(x8 + off + bj * 128) = w8; }
                    if (SS) q += ((v0[0] * v0[0] + v0[1] * v0[1]) + (v0[2] * v0[2] + v0[3] * v0[3])) + ((v1[0] * v1[0] + v1[1] * v1[1]) + (v1[2] * v1[2] + v1[3] * v1[3])); }
                if (SS) { q += __shfl_xor(q, 16); q += __shfl_xor(q, 32); if (fq == 0) *(GAS float*)(ssp + (size_t)row * 16 + u.pn * 4 + wc) = q; } }
    }
};
struct EpiGU {
    static constexpr bool PERM = true;
    bf16* H; const float* rs3;
    DI void operator()(AccRef acc, const Unit& u, int wr, int wc, int fr, int fq) const {
        const int rl0 = wr * 64 + fr, col0 = u.ocol + wc * 32 + 8 * fq;
        int tk[2][4]; float sc[2][4];
#pragma unroll
        for (int ai = 0; ai < 2; ++ai)
#pragma unroll
            for (int m = 0; m < 4; ++m) { const int rl = rl0 + ai * 128 + m * 16; const int rc = rl < u.nvalid ? rl : u.nvalid - 1; tk[ai][m] = *(const GAS int*)(u.ridx + rc); }
#pragma unroll
        for (int ai = 0; ai < 2; ++ai)
#pragma unroll
            for (int m = 0; m < 4; ++m) sc[ai][m] = *(const GAS float*)(rs3 + tk[ai][m]);
#pragma unroll
        for (int ai = 0; ai < 2; ++ai)
#pragma unroll
            for (int m = 0; m < 4; ++m) { const int rl = rl0 + ai * 128 + m * 16; const float s = sc[ai][m];
                uchar* rowp = (uchar*)H + (size_t)(u.orow * 256 + rl) * DEXP + col0;
                f32x4 h0, h1;
#pragma unroll
                for (int j = 0; j < 4; ++j) { h0[j] = siluf_(acc[ai][0][m][0][j] * s) * (acc[ai][1][m][0][j] * s); h1[j] = siluf_(acc[ai][0][m][1][j] * s) * (acc[ai][1][m][1][j] * s); }
                u32x2 w; w.x = pk4_fp8(h0[0], h0[1], h0[2], h0[3]); w.y = pk4_fp8(h1[0], h1[1], h1[2], h1[3]);
                *(GAS u32x2*)rowp = w; }
    }
};
struct EpiPlain {
    static constexpr bool PERM = true;
    bf16* O; int ldc;
    DI void operator()(AccRef acc, const Unit& u, int wr, int wc, int fr, int fq) const {
        const int row0 = u.orow * 256 + wr * 64 + fr, col0 = u.ocol + wc * 32 + 8 * fq;
#pragma unroll
        for (int ai = 0; ai < 2; ++ai)
#pragma unroll
            for (int m = 0; m < 4; ++m) { bf16* rowp = O + (size_t)(row0 + ai * 128 + m * 16) * ldc + col0;
#pragma unroll
                for (int bj = 0; bj < 2; ++bj) { const f32x4 v0 = acc[ai][bj][m][0], v1 = acc[ai][bj][m][1];
                    u32x4 w; w.x = pk2(v0[0], v0[1]); w.y = pk2(v0[2], v0[3]); w.z = pk2(v1[0], v1[1]); w.w = pk2(v1[2], v1[3]);
                    *(GAS u32x4*)(rowp + bj * 128) = w; } }
    }
};
struct MoeOrder {
    const LAS int* cum; const LAS int* cnt; const int* ridx; int G, c; bool down;
    DI bool next(int i, Unit& u) const {
        const int L = i * G + c, T = L >> 2, j = L & 3; if (T >= __builtin_amdgcn_readfirstlane(cum[32])) return false;
        int e = 0;
        for (int k = 1; k < 32; ++k) e += (__builtin_amdgcn_readfirstlane(cum[k]) <= T) ? 1 : 0;
        const int mt = T - __builtin_amdgcn_readfirstlane(cum[e]);
        u.ex = e; u.orow = T; u.nvalid = min(256, __builtin_amdgcn_readfirstlane(cnt[e]) - mt * 256); u.ridx = ridx + (size_t)e * NTOK + mt * 256;
        if (down) { u.pm = T; u.pn = e * 4 + j; u.ocol = 256 * j; } else { u.pm = 0; u.pn = e * 4 + j; u.ocol = 128 * j; }
        return true;
    }
};
#define SFENCE() do { asm volatile("" ::: "memory"); __builtin_amdgcn_sched_barrier(0); } while (0)
DI void conv_issue(u32x4 (&raw)[8], const bf16* src, int c, int tid) {
    const int dg = tid & 15, sg = tid >> 4;
#pragma unroll
    for (int r = 0; r < 8; ++r) { const int pos = c * 128 + 4 * sg - 2 + r; raw[r] = (u32x4){0u, 0u, 0u, 0u};
        if (pos >= 0 && pos < SEQ) raw[r] = *(const GAS u32x4*)(src + (size_t)pos * 128 + 8 * dg); }
}
DI void conv_build(LAS uchar* tile, const u32x4 (&raw)[8], int zcol0, const float* convw, const float* convb, float scale, int tid) {
    const int dg = tid & 15, sg = tid >> 4;
    f32x2 cw[5][4], cb[4];
#pragma unroll
    for (int j = 0; j < 5; ++j) { const f32x4 a = *(const GAS f32x4*)(convw + j * 1024 + zcol0 + 8 * dg), bq = *(const GAS f32x4*)(convw + j * 1024 + zcol0 + 8 * dg + 4);
        cw[j][0] = (f32x2){a.x, a.y}; cw[j][1] = (f32x2){a.z, a.w}; cw[j][2] = (f32x2){bq.x, bq.y}; cw[j][3] = (f32x2){bq.z, bq.w}; }
    { const f32x4 a = *(const GAS f32x4*)(convb + zcol0 + 8 * dg), bq = *(const GAS f32x4*)(convb + zcol0 + 8 * dg + 4);
        cb[0] = (f32x2){a.x, a.y}; cb[1] = (f32x2){a.z, a.w}; cb[2] = (f32x2){bq.x, bq.y}; cb[3] = (f32x2){bq.z, bq.w}; }
    f32x2 in[8][4];
#pragma unroll
    for (int r = 0; r < 8; ++r) { in[r][0] = (f32x2){bflo(raw[r].x), bfhi(raw[r].x)}; in[r][1] = (f32x2){bflo(raw[r].y), bfhi(raw[r].y)}; in[r][2] = (f32x2){bflo(raw[r].z), bfhi(raw[r].z)}; in[r][3] = (f32x2){bflo(raw[r].w), bfhi(raw[r].w)}; }
#pragma unroll
    for (int rr = 0; rr < 4; ++rr) { unsigned ow[4];
#pragma unroll
        for (int i = 0; i < 4; ++i) { f32x2 a = cb[i];
#pragma unroll
            for (int j = 0; j < 5; ++j) a = __builtin_elementwise_fma(in[rr + j][i], cw[j][i], a);
            ow[i] = pk2(siluf_(a.x) * scale, siluf_(a.y) * scale); }
        *(LAS u32x4*)(tile + offb(4 * sg + rr, dg)) = (u32x4){ow[0], ow[1], ow[2], ow[3]}; }
}
DI void build_copy_tile(LAS uchar* tile, const bf16* src, size_t row0, int ld, int col0, int tid) {
    const int dg = tid & 15, sg = tid >> 4;
#pragma unroll
    for (int rr = 0; rr < 4; ++rr) { const int r = 4 * sg + rr; *(LAS u32x4*)(tile + offb(r, dg)) = *(const GAS u32x4*)(src + (row0 + r) * (size_t)ld + col0 + 8 * dg); }
}

DI void scan_issue(u32x4 (&kr)[6], u32x4 (&vr)[4], const bf16* zk, const bf16* zv, int c, int dh, int tid) {
    const int dg = tid & 7, sg = tid >> 3;
#pragma unroll
    for (int r = 0; r < 6; ++r) { const int pos = c * 128 + 2 * sg - 2 + r; kr[r] = (u32x4){0u, 0u, 0u, 0u};
        if (pos >= 0 && pos < SEQ) kr[r] = *(const GAS u32x4*)(zk + (size_t)pos * 128 + 64 * dh + 8 * dg); }
    const int dg2 = tid & 15, sg2 = tid >> 4;
#pragma unroll
    for (int rr = 0; rr < 4; ++rr) vr[rr] = *(const GAS u32x4*)(zv + (size_t)(c * 128 + 4 * sg2 + rr) * 128 + 8 * dg2);
}
DI void scan_build(LAS uchar* TKW, LAS uchar* TV, const u32x4 (&kr)[6], const u32x4 (&vr)[4], const float (&cw)[5][8], const float (&cb)[8], const LAS float* alog, float mnew, int tid) {
    const int dg = tid & 7, sg = tid >> 3;
    float in[6][8];
#pragma unroll
    for (int r = 0; r < 6; ++r) { in[r][0] = bflo(kr[r].x); in[r][1] = bfhi(kr[r].x); in[r][2] = bflo(kr[r].y); in[r][3] = bfhi(kr[r].y); in[r][4] = bflo(kr[r].z); in[r][5] = bfhi(kr[r].z); in[r][6] = bflo(kr[r].w); in[r][7] = bfhi(kr[r].w); }
#pragma unroll
    for (int rr = 0; rr < 2; ++rr) { const float sc = 0.08838834764831845f * __expf(alog[2 * sg + rr] - mnew); float o[8];
#pragma unroll
        for (int i = 0; i < 8; ++i) { float a = cb[i];
#pragma unroll
            for (int j = 0; j < 5; ++j) a += in[rr + j][i] * cw[j][i];
            o[i] = siluf_(a) * sc; }
        u32x4 wv; wv.x = pk2(o[0], o[1]); wv.y = pk2(o[2], o[3]); wv.z = pk2(o[4], o[5]); wv.w = pk2(o[6], o[7]);
        *(LAS u32x4*)(TKW + offb(2 * sg + rr, dg)) = wv; }
    const int dg2 = tid & 15, sg2 = tid >> 4;
#pragma unroll
    for (int rr = 0; rr < 4; ++rr) *(LAS u32x4*)(TV + offb(4 * sg2 + rr, dg2)) = vr[rr];
}
DI void scan_gate_pre(float ig0, float ig1, float fp0, float fp1, int dir, LAS float* al, LAS float* Fv, LAS float* Mv, int lane) {
    const float lf0 = log_sigmoid(fp0), lf1 = log_sigmoid(fp1);
    const float incl = wscan_add(lf0 + lf1, lane);
    const float bf0 = incl - lf1, bf1 = incl, Ftot = __shfl(incl, 63);
    const float a0 = dir ? (bf0 - lf0 + ig0) : (Ftot - bf0 + ig0), a1 = dir ? (bf1 - lf1 + ig1) : (Ftot - bf1 + ig1);
    const float mloc = wave_max(fmaxf(a0, a1));
    al[2 * lane] = a0; al[2 * lane + 1] = a1;
    if (lane == 0) { *Fv = Ftot; *Mv = mloc; }
}
DI void mlstm_scan(Frame& F, int wgid) {
    int tid = F.tid, lane = F.lane; const int w = F.wave;
    const int seq = wgid >> 1, dh = wgid & 1;
    const int dir = seq & 1, h = (seq >> 1) & 3, b = seq >> 3;
    LAS float* AL = (LAS float*)(F.lds + 131072);
    LAS float* FV = AL + 32 * 128; LAS float* MV = FV + 32; LAS float* SC = MV + 32; LAS float* MN = SC + 32; LAS float* MP = MN + 32;
    const float* gates = (const float*)(F.ws + O_GATES);
    const size_t hoff = (size_t)(b * 4 + h) * SEQ * 128;
    const bf16* zk = (const bf16*)(F.ws + O_ZK) + hoff; const bf16* zv = (const bf16*)(F.ws + O_ZV) + hoff;
    float* mst = (float*)(F.ws + O_MST);
    float cw[5][8], cb[8];
    { const int ch0 = 512 + h * 128 + 64 * dh + 8 * (tid & 7);
#pragma unroll
      for (int j = 0; j < 5; ++j) { const f32x4 a = *(const GAS f32x4*)(INP(I_CONVW) + j * 1024 + ch0), bq = *(const GAS f32x4*)(INP(I_CONVW) + j * 1024 + ch0 + 4);
          cw[j][0] = a.x; cw[j][1] = a.y; cw[j][2] = a.z; cw[j][3] = a.w; cw[j][4] = bq.x; cw[j][5] = bq.y; cw[j][6] = bq.z; cw[j][7] = bq.w; }
      const f32x4 a = *(const GAS f32x4*)(INP(I_CONVB) + ch0), bq = *(const GAS f32x4*)(INP(I_CONVB) + ch0 + 4);
      cb[0] = a.x; cb[1] = a.y; cb[2] = a.z; cb[3] = a.w; cb[4] = bq.x; cb[5] = bq.y; cb[6] = bq.z; cb[7] = bq.w; }
    f32x4 acc[4], accn = (f32x4){0.f, 0.f, 0.f, 0.f};
#pragma unroll
    for (int mt = 0; mt < 4; ++mt) acc[mt] = (f32x4){0.f, 0.f, 0.f, 0.f};
    const bf16x8 ones = (bf16x8){0x3F80, 0x3F80, 0x3F80, 0x3F80, 0x3F80, 0x3F80, 0x3F80, 0x3F80};
    const int gi = dir * 8 + h, gf = dir * 8 + 4 + h;
#define SCAN_C(ci) (dir ? 31 - (ci) : (ci))
#pragma unroll 1
    for (int q = 0; q < 4; ++q) { const int ci = w + 8 * q; const size_t r_ = ((size_t)b * SEQ + SCAN_C(ci) * 128 + 2 * lane) * 16;
        scan_gate_pre(gates[r_ + gi], gates[r_ + 16 + gi], gates[r_ + gf], gates[r_ + 16 + gf], dir, AL + ci * 128, FV + ci, MV + ci, lane); }
    __syncthreads();
    if (tid == 0) { float m = -1e30f;
#pragma unroll 1
        for (int ci = 0; ci < 32; ++ci) { MP[ci] = m; const float fm = FV[ci] + m, mn = fmaxf(fm, MV[ci]); SC[ci] = __expf(fm - mn); MN[ci] = mn; m = mn; } }
    __syncthreads();
    if (dh == 0 && tid < 32) mst[seq * 32 + SCAN_C(tid)] = MP[tid];
    unsigned aK[4][2], aV[2];
    { const unsigned g = lane >> 4, q = (lane & 15) >> 2, p = lane & 3, bo = 8u * (p & 1);
#pragma unroll
      for (int mt = 0; mt < 4; ++mt) { aK[mt][0] = offb(8 * g + q, 2 * mt + (p >> 1)) + bo; aK[mt][1] = offb(8 * g + 4 + q, 2 * mt + (p >> 1)) + bo; }
      aV[0] = offb(8 * g + q, 2 * w + (p >> 1)) + bo; aV[1] = offb(8 * g + 4 + q, 2 * w + (p >> 1)) + bo; }
#define FRAG_PRE(tile, o0, o1, kk) ({ const s16x4 lo_ = __builtin_amdgcn_ds_read_tr16_b64_v4i16((LAS s16x4*)((tile) + (o0) + 8192 * (kk))); const s16x4 hi_ = __builtin_amdgcn_ds_read_tr16_b64_v4i16((LAS s16x4*)((tile) + (o1) + 8192 * (kk))); (bf16x8){lo_[0], lo_[1], lo_[2], lo_[3], hi_[0], hi_[1], hi_[2], hi_[3]}; })
    u32x4 krA[6], vrA[4], krB[6], vrB[4];
    scan_issue(krB, vrB, zk, zv, SCAN_C(0), dh, tid);
    scan_issue(krA, vrA, zk, zv, SCAN_C(1), dh, tid);
    __syncthreads();
    scan_build(F.lds, F.lds + 32768, krB, vrB, cw, cb, AL, MN[0], tid);
    scan_issue(krB, vrB, zk, zv, SCAN_C(2), dh, tid);
    __syncthreads();
#define SCAN_ITER(ci, KRN, VRN) do { \
        const int c = SCAN_C(ci); \
        asm volatile("" : "+v"(tid), "+v"(lane)); \
        GASK uchar* wsl_ = (GASK uchar*)F.ws; asm volatile("" : "+s"(wsl_)); \
        const bf16* zk = (const bf16*)((uchar*)wsl_ + O_ZK) + hoff; const bf16* zv = (const bf16*)((uchar*)wsl_ + O_ZV) + hoff; bf16* cst = (bf16*)((uchar*)wsl_ + O_CST); float* nst = (float*)((uchar*)wsl_ + O_NST); \
        LAS uchar* TKW = F.lds + ((ci) & 1) * 65536; LAS uchar* TV = TKW + 32768; \
        { bf16* cp = cst + ((size_t)seq * 32 + c) * 16384; \
          _Pragma("unroll") for (int mt = 0; mt < 4; ++mt) { const int d = 64 * dh + 16 * mt + 4 * (lane >> 4), e = 16 * w + (lane & 15); \
              u32x2 v; v.x = pk2(acc[mt][0], acc[mt][1]); v.y = pk2(acc[mt][2], acc[mt][3]); *(GAS u32x2*)(cp + e * 128 + d) = v; } \
          if (w < 4 && (lane & 15) == 0) *(GAS f32x4*)(nst + ((size_t)seq * 32 + c) * 128 + 64 * dh + 16 * w + 4 * (lane >> 4)) = accn; } \
        if ((ci) + 1 < 32) { \
            scan_build(F.lds + (((ci) + 1) & 1) * 65536, F.lds + (((ci) + 1) & 1) * 65536 + 32768, KRN, VRN, cw, cb, AL + ((ci) + 1) * 128, MN[(ci) + 1], tid); \
            if ((ci) + 3 < 32) scan_issue(KRN, VRN, zk, zv, SCAN_C((ci) + 3), dh, tid); } \
        const float sc_old = SC[(ci)]; \
        _Pragma("unroll") for (int mt = 0; mt < 4; ++mt) acc[mt] *= sc_old; \
        accn *= sc_old; \
        _Pragma("unroll") for (int kk = 0; kk < 4; ++kk) { \
            const bf16x8 Yf = FRAG_PRE(TV, aV[0], aV[1], kk); \
            _Pragma("unroll") for (int mt = 0; mt < 4; ++mt) acc[mt] = mfma16(FRAG_PRE(TKW, aK[mt][0], aK[mt][1], kk), Yf, acc[mt]); \
            if (w < 4) accn = mfma16(FRAG_PRE(TKW, aV[0], aV[1], kk), ones, accn); \
            __builtin_amdgcn_sched_barrier(0); } \
        __syncthreads(); } while (0)
    for (int c2 = 0; c2 < 32; c2 += 2) { SCAN_ITER(c2, krA, vrA); SCAN_ITER(c2 + 1, krB, vrB); }
#undef SCAN_ITER
#undef FRAG_PRE
#undef SCAN_C
}

DI void gmlp_phase(Frame& F) {
    const int w = F.wave;
    const bf16* z = (const bf16*)(F.ws + O_Z); bf16* Y = (bf16*)(F.ws + O_Y); const bf16* wsb = (const bf16*)(F.ws + O_WSB);
    float lg[8], lb[8];
    { const f32x4 a = *(const GAS f32x4*)(INP(I_LNVG) + 8 * F.lane), bq = *(const GAS f32x4*)(INP(I_LNVG) + 8 * F.lane + 4), c = *(const GAS f32x4*)(INP(I_LNVB) + 8 * F.lane), d = *(const GAS f32x4*)(INP(I_LNVB) + 8 * F.lane + 4);
      lg[0] = a.x; lg[1] = a.y; lg[2] = a.z; lg[3] = a.w; lg[4] = bq.x; lg[5] = bq.y; lg[6] = bq.z; lg[7] = bq.w; lb[0] = c.x; lb[1] = c.y; lb[2] = c.z; lb[3] = c.w; lb[4] = d.x; lb[5] = d.y; lb[6] = d.z; lb[7] = d.w; }
    for (int unit = F.bid; unit < 512; unit += F.G) {
        int tid = F.tid, lane = F.lane; asm volatile("" : "+v"(tid), "+v"(lane));
        const size_t row0 = (size_t)unit * 128;
        u32x4 raw[16];
#pragma unroll
        for (int i = 0; i < 16; ++i) raw[i] = *(const GAS u32x4*)(z + (row0 + 16 * w + i) * ZG + 512 + 8 * lane);
#pragma unroll
        for (int i = 0; i < 16; ++i) { const int r = 16 * w + i;
            float v[8] = {bflo(raw[i].x), bfhi(raw[i].x), bflo(raw[i].y), bfhi(raw[i].y), bflo(raw[i].z), bfhi(raw[i].z), bflo(raw[i].w), bfhi(raw[i].w)};
            float s = 0.f;
#pragma unroll
            for (int q = 0; q < 8; ++q) s += v[q];
            const float mu = wave_sum(s) * (1.f / 512.f); float qq = 0.f;
#pragma unroll
            for (int q = 0; q < 8; ++q) { v[q] -= mu; qq += v[q] * v[q]; }
            const float rs = 1.0f / sqrtf(wave_sum(qq) * (1.f / 512.f) + LN_EPS);
#pragma unroll
            for (int q = 0; q < 8; ++q) v[q] = v[q] * rs * lg[q] + lb[q];
            u32x4 wv; wv.x = pk2(v[0], v[1]); wv.y = pk2(v[2], v[3]); wv.z = pk2(v[4], v[5]); wv.w = pk2(v[6], v[7]);
            *(LAS u32x4*)(F.lds + (lane >> 4) * 32768 + offb(r, lane & 15)) = wv; }
        __syncthreads();
        const int tl = 16 * w + (lane & 15); const size_t row = row0 + tl;
        bf16x8 Yw[2][4]; u32x2 gu[2][8];
#define GM_ISSUE(g, sl) do { _Pragma("unroll") for (int kk = 0; kk < 4; ++kk) Yw[sl][kk] = *(const GAS bf16x8*)(wsb + ((size_t)(g) * 128 + tl) * 128 + 32 * kk + 8 * (lane >> 4)); \
        _Pragma("unroll") for (int mt = 0; mt < 8; ++mt) gu[sl][mt] = *(const GAS u32x2*)(z + row * ZG + (g) * 128 + 16 * mt + 4 * (lane >> 4)); } while (0)
        GM_ISSUE(0, 0);
#pragma unroll
        for (int g = 0; g < 4; ++g) {
            const int sl = g & 1;
            if (g < 3) GM_ISSUE(g + 1, sl ^ 1);
            const LAS uchar* T_G = F.lds + g * 32768;
            f32x4 acc[8];
#pragma unroll
            for (int mt = 0; mt < 8; ++mt) acc[mt] = (f32x4){0.f, 0.f, 0.f, 0.f};
#pragma unroll
            for (int kk = 0; kk < 4; ++kk) {
#pragma unroll
                for (int mt = 0; mt < 8; ++mt) acc[mt] = mfma16(frag_tr(T_G, 32 * kk, 16 * mt, lane), Yw[sl][kk], acc[mt]);
                __builtin_amdgcn_sched_barrier(0); }
            const float bs = INP(I_BS)[g * 128 + tl];
#pragma unroll
            for (int mt = 0; mt < 8; ++mt) { const int d = 16 * mt + 4 * (lane >> 4); const u32x2 gv2 = gu[sl][mt];
                u32x2 o; o.x = pk2(bflo(gv2.x) * (acc[mt][0] + bs), bfhi(gv2.x) * (acc[mt][1] + bs)); o.y = pk2(bflo(gv2.y) * (acc[mt][2] + bs), bfhi(gv2.y) * (acc[mt][3] + bs));
                *(GAS u32x2*)(Y + row * DM + 512 + g * 128 + d) = o; }
        }
#undef GM_ISSUE
        __syncthreads();
    }
}

DI void phase2(Frame& F) {
    for (int s = F.bid; s < 256; s += F.G) mlstm_scan(F, s);
    gmlp_phase(F);
}

DI void mlstm_out_phase(Frame& F) {
  constexpr int NU3 = NB * 4 * 32;
  const int w = F.wave;
  u32x4 qraw[8];
  if (F.bid < NU3) { const int u0 = F.bid; const size_t ho = (size_t)(u0 >> 5) * SEQ * 128;
      conv_issue(qraw, (const bf16*)(F.ws + O_ZQ) + ho, u0 & 31, F.tid); }
  for (int unit = F.bid; unit < NU3; unit += F.G) {
    int tid = F.tid, lane = F.lane; asm volatile("" : "+v"(tid), "+v"(lane));
    const int c = unit & 31, h = (unit >> 5) & 3, b = unit >> 7;
    const size_t row0 = (size_t)b * SEQ + c * 128;
    LAS uchar* T_Q = F.lds; LAS uchar* T_K = F.lds + 32768; LAS uchar* T_V = F.lds + 65536; LAS uchar* T_C = F.lds + 98304;
    LAS float* sm = (LAS float*)(F.lds + 131072);
    LAS float* gfa = sm, *gba = sm + 128, *Mfa = sm + 256, *Mba = sm + 384, *sIf = sm + 512, *sIb = sm + 640, *enf = sm + 768, *enb = sm + 896, *nfa = sm + 1024, *nba = sm + 1152, *qnf = sm + 1280, *qnb = sm + 1408;
    const size_t hoff = (size_t)(b * 4 + h) * SEQ * 128;
    const bf16* zq = (const bf16*)(F.ws + O_ZQ) + hoff; const bf16* zk = (const bf16*)(F.ws + O_ZK) + hoff; const bf16* zv = (const bf16*)(F.ws + O_ZV) + hoff; const bf16* zo = (const bf16*)(F.ws + O_ZO) + hoff;
    const float* gates = (const float*)(F.ws + O_GATES);
    const bf16* cst = (const bf16*)(F.ws + O_CST); const float* nst = (const float*)(F.ws + O_NST); const float* mst = (const float*)(F.ws + O_MST);
    bf16* Y = (bf16*)(F.ws + O_Y);
    const int sqf = ((b * 4 + h) * 2 + 0) * 32 + c, sqb = ((b * 4 + h) * 2 + 1) * 32 + c;
    if (w < 2) {
        const float mpf = mst[sqf], mpb = mst[sqb];
        const size_t r0 = (row0 + 2 * lane) * 16, r1 = (row0 + 2 * lane + 1) * 16;
        if (w == 0) {
            const float ig0 = gates[r0 + h], ig1 = gates[r1 + h], lf0 = log_sigmoid(gates[r0 + 4 + h]), lf1 = log_sigmoid(gates[r1 + 4 + h]);
            const float incl = wscan_add(lf0 + lf1, lane), bf0 = incl - lf1, bf1 = incl;
            const float g0 = ig0 - bf0, g1 = ig1 - bf1;
            const float pin = wscan_max(fmaxf(g0, g1), lane); float pex = __shfl_up(pin, 1); if (lane == 0) pex = -3.0e38f;
            const float M0 = fmaxf(mpf, fmaxf(pex, g0)), M1 = fmaxf(mpf, pin);
            gfa[2 * lane] = g0; gfa[2 * lane + 1] = g1; Mfa[2 * lane] = M0; Mfa[2 * lane + 1] = M1;
            sIf[2 * lane] = __expf(mpf - M0); sIf[2 * lane + 1] = __expf(mpf - M1);
            enf[2 * lane] = __expf(-bf0 - M0); enf[2 * lane + 1] = __expf(-bf1 - M1);
        }
        else {
            const float ig0 = gates[r0 + 8 + h], ig1 = gates[r1 + 8 + h], lf0 = log_sigmoid(gates[r0 + 12 + h]), lf1 = log_sigmoid(gates[r1 + 12 + h]);
            const float incl = wscan_add(lf0 + lf1, lane), Ftot = __shfl(incl, 63);
            const float bb0 = Ftot - incl + lf0 + lf1, bb1 = Ftot - incl + lf1;
            const float g0 = ig0 - bb0, g1 = ig1 - bb1;
            const float sin_ = wscan_max_rev(fmaxf(g0, g1), lane); float sex = __shfl_down(sin_, 1); if (lane == 63) sex = -3.0e38f;
            const float M0 = fmaxf(mpb, sin_), M1 = fmaxf(mpb, fmaxf(sex, g1));
            gba[2 * lane] = g0; gba[2 * lane + 1] = g1; Mba[2 * lane] = M0; Mba[2 * lane + 1] = M1;
            sIb[2 * lane] = __expf(mpb - M0); sIb[2 * lane + 1] = __expf(mpb - M1);
            enb[2 * lane] = __expf(-bb0 - M0); enb[2 * lane + 1] = __expf(-bb1 - M1);
        }
    }
    if (tid < 128) { nfa[tid] = nst[(size_t)sqf * 128 + tid]; nba[tid] = nst[(size_t)sqb * 128 + tid]; }
    u32x4 kraw[8]; conv_issue(kraw, zk, c, tid);
    conv_build(T_Q, qraw, h * 128, INP(I_CONVW), INP(I_CONVB), 1.0f, tid);
    conv_build(T_K, kraw, 512 + h * 128, INP(I_CONVW), INP(I_CONVB), 0.08838834764831845f, tid);
    build_copy_tile(T_V, zv, (size_t)c * 128, 128, 0, tid);
    build_copy_tile(T_C, cst + (size_t)sqf * 16384, 0, 128, 0, tid);
    __syncthreads();
    {
        const int t = tid >> 2, part = tid & 3; float af = 0.f, ab = 0.f;
#pragma unroll
        for (int cc = 0; cc < 4; ++cc) { const u32x4 raw = *(const LAS u32x4*)(T_Q + offb(t, 4 * part + cc)); const int dd = 32 * part + 8 * cc;
            const float qv[8] = {bflo(raw.x), bfhi(raw.x), bflo(raw.y), bfhi(raw.y), bflo(raw.z), bfhi(raw.z), bflo(raw.w), bfhi(raw.w)};
#pragma unroll
            for (int i = 0; i < 8; ++i) { af += qv[i] * nfa[dd + i]; ab += qv[i] * nba[dd + i]; } }
        af += __shfl_xor(af, 1); af += __shfl_xor(af, 2); ab += __shfl_xor(ab, 1); ab += __shfl_xor(ab, 2);
        if (part == 0) { qnf[t] = af; qnb[t] = ab; }
    }
    u32x4 cbreg[4];
    { const int dg = tid & 15, sg = tid >> 4; const bf16* src = cst + (size_t)sqb * 16384;
#pragma unroll
      for (int rr = 0; rr < 4; ++rr) cbreg[rr] = *(const GAS u32x4*)(src + (size_t)(4 * sg + rr) * 128 + 8 * dg); }
    bf16x8 Qf[4];
#pragma unroll
    for (int kk = 0; kk < 4; ++kk) Qf[kk] = frag_row(T_Q, 16 * w, kk, lane);
    f32x4 aS[8];
#pragma unroll
    for (int mt = 0; mt < 8; ++mt) aS[mt] = (f32x4){0.f, 0.f, 0.f, 0.f};
#pragma unroll
    for (int kk = 0; kk < 4; ++kk) {
#pragma unroll
        for (int mt = 0; mt < 8; ++mt) aS[mt] = mfma16(frag_row(T_K, 16 * mt, kk, lane), Qf[kk], aS[mt]);
        __builtin_amdgcn_sched_barrier(0); }
    __syncthreads();
    const int tl = 16 * w + (lane & 15);
    float cf, cb_;
    {
        const float Mf = Mfa[tl], Mb = Mba[tl];
        f32x4 wf[8], wb[8]; float sumf = 0.f, sumb = 0.f;
#pragma unroll
        for (int mt = 0; mt < 8; ++mt) { const int s0 = 16 * mt + 4 * (lane >> 4); const f32x4 gf4 = *(const LAS f32x4*)(gfa + s0), gb4 = *(const LAS f32x4*)(gba + s0);
#pragma unroll
            for (int j = 0; j < 4; ++j) { const int s = s0 + j; const float sv = aS[mt][j];
                const float a = (s <= tl) ? __expf(gf4[j] - Mf) * sv : 0.f, bq = (s >= tl) ? __expf(gb4[j] - Mb) * sv : 0.f;
                wf[mt][j] = a; wb[mt][j] = bq; sumf += a; sumb += bq; } }
        sumf += __shfl_xor(sumf, 16); sumf += __shfl_xor(sumf, 32); sumb += __shfl_xor(sumb, 16); sumb += __shfl_xor(sumb, 32);
        const float sif = sIf[tl], sib = sIb[tl];
        const float denf = sumf + sif * qnf[tl], denb = sumb + sib * qnb[tl];
        const float rf = 1.0f / fmaxf(fabsf(denf), enf[tl]), rb = 1.0f / fmaxf(fabsf(denb), enb[tl]);
        cf = sif * rf; cb_ = sib * rb;
#pragma unroll
        for (int mt = 0; mt < 8; ++mt) { const int s0 = 16 * mt + 4 * (lane >> 4);
            u32x2 v; v.x = pk2(wf[mt][0] * rf + wb[mt][0] * rb, wf[mt][1] * rf + wb[mt][1] * rb); v.y = pk2(wf[mt][2] * rf + wb[mt][2] * rb, wf[mt][3] * rf + wb[mt][3] * rb);
            *(LAS u32x2*)(T_K + offb(tl, s0 >> 3) + (s0 & 7) * 2) = v; }
    }
    { const int nu = unit + F.G;
      if (nu < NU3) { const size_t ho = (size_t)(nu >> 5) * SEQ * 128; conv_issue(qraw, (const bf16*)(F.ws + O_ZQ) + ho, nu & 31, tid); } }
    f32x4 aO[8], aZ[8];
#pragma unroll
    for (int mt = 0; mt < 8; ++mt) { aO[mt] = (f32x4){0.f, 0.f, 0.f, 0.f}; aZ[mt] = (f32x4){0.f, 0.f, 0.f, 0.f}; }
#pragma unroll
    for (int kk = 0; kk < 4; ++kk) { const bf16x8 Yw = frag_row(T_K, 16 * w, kk, lane);
#pragma unroll
        for (int mt = 0; mt < 8; ++mt) aO[mt] = mfma16(frag_tr(T_V, 32 * kk, 16 * mt, lane), Yw, aO[mt]);
        __builtin_amdgcn_sched_barrier(0); }
#pragma unroll
    for (int kk = 0; kk < 4; ++kk) {
#pragma unroll
        for (int mt = 0; mt < 8; ++mt) aZ[mt] = mfma16(frag_row(T_C, 16 * mt, kk, lane), Qf[kk], aZ[mt]);
        __builtin_amdgcn_sched_barrier(0); }
#pragma unroll
    for (int mt = 0; mt < 8; ++mt) { aO[mt] += aZ[mt] * cf; aZ[mt] = (f32x4){0.f, 0.f, 0.f, 0.f}; }
    __syncthreads();
    { const int dg = tid & 15, sg = tid >> 4;
#pragma unroll
      for (int rr = 0; rr < 4; ++rr) *(LAS u32x4*)(T_C + offb(4 * sg + rr, dg)) = cbreg[rr]; }
    __syncthreads();
#pragma unroll
    for (int kk = 0; kk < 4; ++kk) {
#pragma unroll
        for (int mt = 0; mt < 8; ++mt) aZ[mt] = mfma16(frag_row(T_C, 16 * mt, kk, lane), Qf[kk], aZ[mt]);
        __builtin_amdgcn_sched_barrier(0); }
    u32x2 og[8];
#pragma unroll
    for (int mt = 0; mt < 8; ++mt) og[mt] = *(const GAS u32x2*)(zo + (size_t)(c * 128 + 16 * w + (lane & 15)) * 128 + 16 * mt + 4 * (lane >> 4));
    float ssq = 0.f;
#pragma unroll
    for (int mt = 0; mt < 8; ++mt) { aO[mt] += aZ[mt] * cb_; ssq += (aO[mt][0] * aO[mt][0] + aO[mt][1] * aO[mt][1]) + (aO[mt][2] * aO[mt][2] + aO[mt][3] * aO[mt][3]); }
    ssq += __shfl_xor(ssq, 16); ssq += __shfl_xor(ssq, 32);
    const float rinv = 1.0f / sqrtf(ssq * (1.f / 128.f) + RMS_EPS);
    const size_t row = row0 + tl;
#pragma unroll
    for (int mt = 0; mt < 8; ++mt) { const int e = 16 * mt + 4 * (lane >> 4);
        const u32x2 ogv = og[mt]; const f32x4 gh = *(const GAS f32x4*)(INP(I_GHEAD) + h * 128 + e);
        u32x2 o; o.x = pk2(bflo(ogv.x) * aO[mt][0] * rinv * gh.x, bfhi(ogv.x) * aO[mt][1] * rinv * gh.y); o.y = pk2(bflo(ogv.y) * aO[mt][2] * rinv * gh.z, bfhi(ogv.y) * aO[mt][3] * rinv * gh.w);
        *(GAS u32x2*)(Y + row * DM + h * 128 + e) = o; }
    __syncthreads();
  }
}
DI void kv_dma(LAS uchar* buf, const bf16* kv, int b, int col0, int w, int lane) {
#pragma unroll
    for (int i = 0; i < 8; ++i) { const int r = 32 * w + 4 * i + (lane >> 4); const int f = ((r & 3) << 2) | ((r >> 2) & 3);
        const bf16* src = kv + (size_t)(b * NMEM + r) * 2048 + col0 + 8 * ((lane & 15) ^ f);
        __builtin_amdgcn_global_load_lds((const unsigned*)src, (LAS unsigned*)(buf + 256 * (32 * w + 4 * i)), 16, 0, 0); }
}
#define DMA_WAIT() asm volatile("s_waitcnt vmcnt(0)" ::: "memory")
DI bf16x8 frag_tr_perm(const LAS uchar* tile, int k0, int c0, int lane) {
    const unsigned g = lane >> 4, q = (lane & 15) >> 2, p = lane & 3;
    const unsigned ch = (c0 >> 3) + (p >> 1), bo = 8u * (p & 1);
    const s16x4 lo = __builtin_amdgcn_ds_read_tr16_b64_v4i16((LAS s16x4*)(tile + offb(k0 + 4 * g + q, ch) + bo));
    const s16x4 hi = __builtin_amdgcn_ds_read_tr16_b64_v4i16((LAS s16x4*)(tile + offb(k0 + 16 + 4 * g + q, ch) + bo));
    return (bf16x8){lo[0], lo[1], lo[2], lo[3], hi[0], hi[1], hi[2], hi[3]};
}
DI void attn_phase(Frame& F) {
    const int w = F.wave;
    constexpr int NU = NB * 4 * 16;
    const bf16* Q = (const bf16*)(F.ws + O_Q); const bf16* kv = (const bf16*)(F.ws + O_KV); uchar* O = F.ws + O_O;
    LAS uchar* B0 = F.lds; LAS uchar* B1 = F.lds + 65536;
    if (F.bid < NU) { const int u0 = F.bid; kv_dma(B0, kv, u0 >> 6, ((u0 >> 4) & 3) * 256, w, F.lane); }
    DMA_WAIT(); __syncthreads();
    for (int unit = F.bid; unit < NU; unit += F.G) {
        int tid = F.tid, lane = F.lane; asm volatile("" : "+v"(tid), "+v"(lane));
        const int qb = unit & 15, hd = (unit >> 4) & 3, b = unit >> 6;
        const int nu = unit + F.G;
        const size_t qrow0 = (size_t)b * SEQ + qb * 256 + 32 * w + (lane & 15);
        f32x4 aS[2][16];
#pragma unroll
        for (int tb = 0; tb < 2; ++tb)
#pragma unroll
            for (int mt = 0; mt < 16; ++mt) aS[tb][mt] = (f32x4){0.f, 0.f, 0.f, 0.f};
        bf16x8 Qc[2], Qn[2];
#pragma unroll
        for (int tb = 0; tb < 2; ++tb) Qn[tb] = *(const GAS bf16x8*)(Q + (qrow0 + 16 * tb) * DM + hd * 256 + 8 * (lane >> 4));
#pragma unroll
        for (int dh = 0; dh < 2; ++dh) {
            const LAS uchar* KB = dh ? B1 : B0;
            if (dh == 0) kv_dma(B1, kv, b, hd * 256 + 128, w, lane);
            else kv_dma(B0, kv, b, 1024 + hd * 256, w, lane);
#pragma unroll
            for (int kk = 0; kk < 4; ++kk) { const int st = dh * 4 + kk;
                Qc[0] = Qn[0]; Qc[1] = Qn[1];
                if (st < 7) {
#pragma unroll
                    for (int tb = 0; tb < 2; ++tb) Qn[tb] = *(const GAS bf16x8*)(Q + (qrow0 + 16 * tb) * DM + hd * 256 + 32 * (st + 1) + 8 * (lane >> 4)); }
#pragma unroll
                for (int mh = 0; mh < 4; ++mh) {
#pragma unroll
                    for (int mq = 0; mq < 4; ++mq) { const int mt = 4 * mh + mq; const bf16x8 X = frag_row(KB, 16 * mt, kk, lane);
                        aS[0][mt] = mfma16(X, Qc[0], aS[0][mt]); aS[1][mt] = mfma16(X, Qc[1], aS[1][mt]); }
                    __builtin_amdgcn_sched_barrier(0); } }
            DMA_WAIT(); __syncthreads();
        }
        bf16x8 Pf[2][8]; float rinv[2];
#pragma unroll
        for (int tb = 0; tb < 2; ++tb) {
            float mx = -3.0e38f;
#pragma unroll
            for (int mt = 0; mt < 16; ++mt) mx = fmaxf(mx, fmaxf(fmaxf(aS[tb][mt][0], aS[tb][mt][1]), fmaxf(aS[tb][mt][2], aS[tb][mt][3])));
            mx = fmaxf(mx, __shfl_xor(mx, 16)); mx = fmaxf(mx, __shfl_xor(mx, 32));
            float sum = 0.f;
#pragma unroll
            for (int s = 0; s < 8; ++s) { f32x4 p0, p1;
#pragma unroll
                for (int j = 0; j < 4; ++j) { p0[j] = __expf(aS[tb][2 * s][j] - mx); p1[j] = __expf(aS[tb][2 * s + 1][j] - mx); sum += p0[j] + p1[j]; }
                u32x4 pk; pk.x = pk2(p0[0], p0[1]); pk.y = pk2(p0[2], p0[3]); pk.z = pk2(p1[0], p1[1]); pk.w = pk2(p1[2], p1[3]);
                Pf[tb][s] = __builtin_bit_cast(bf16x8, pk); }
            sum += __shfl_xor(sum, 16); sum += __shfl_xor(sum, 32);
            rinv[tb] = 1.0f / sum;
        }
#pragma unroll
        for (int eh = 0; eh < 2; ++eh) {
            const LAS uchar* VB = eh ? B1 : B0;
            if (eh == 0) kv_dma(B1, kv, b, 1024 + hd * 256 + 128, w, lane);
            else if (nu < NU) kv_dma(B0, kv, nu >> 6, ((nu >> 4) & 3) * 256, w, lane);
            f32x4 aO[2][8];
#pragma unroll
            for (int tb = 0; tb < 2; ++tb)
#pragma unroll
                for (int mt = 0; mt < 8; ++mt) aO[tb][mt] = (f32x4){0.f, 0.f, 0.f, 0.f};
#pragma unroll
            for (int s = 0; s < 8; ++s) {
#pragma unroll
                for (int mh = 0; mh < 2; ++mh) {
#pragma unroll
                    for (int mq = 0; mq < 4; ++mq) { const int mt = 4 * mh + mq; const bf16x8 X = frag_tr_perm(VB, 32 * s, 16 * mt, lane);
                        aO[0][mt] = mfma16(X, Pf[0][s], aO[0][mt]); aO[1][mt] = mfma16(X, Pf[1][s], aO[1][mt]); }
                    __builtin_amdgcn_sched_barrier(0); } }
#pragma unroll
            for (int tb = 0; tb < 2; ++tb)
#pragma unroll
                for (int mt = 0; mt < 8; ++mt) { const int e = 16 * mt + 4 * (lane >> 4); const float ri = rinv[tb];
                    *(GAS unsigned*)(O + (qrow0 + 16 * tb) * DM + hd * 256 + eh * 128 + e) = pk4_fp8(aO[tb][mt][0] * ri, aO[tb][mt][1] * ri, aO[tb][mt][2] * ri, aO[tb][mt][3] * ri); }
            DMA_WAIT(); __syncthreads();
        }
    }
}

DI void route_block(Frame& F, int blk) {
    const int tid = F.tid, lane = F.lane, w = F.wave;
    LAS float* lg = (LAS float*)F.lds + (size_t)w * (32 * 48);
    LAS int* tokE = (LAS int*)(F.lds + 147456);
    LAS int* tokR = tokE + 512;
    LAS int* wcnt = tokR + 512;
    LAS int* base = wcnt + 256;
    const bf16* x2 = (const bf16*)(F.ws + O_XB); float* rs3 = (float*)(F.ws + O_RS3); unsigned* tok = (unsigned*)(F.ws + O_TOK); int* ridx = (int*)(F.ws + O_RIDX);
    const bf16* wrh = (const bf16*)(F.ws + O_WRH); const bf16* wrl = (const bf16*)(F.ws + O_WRL);
    unsigned* cnt = (unsigned*)(F.ws + O_CTL) + CW_CNT;
    const int r16 = lane & 15, g4 = lane >> 4;
    const size_t row0 = (size_t)blk * 256 + 32 * w;
    f32x4 acc[3][2];
#pragma unroll
    for (int nb = 0; nb < 3; ++nb) { acc[nb][0] = (f32x4){0.f, 0.f, 0.f, 0.f}; acc[nb][1] = (f32x4){0.f, 0.f, 0.f, 0.f}; }
    float ss0 = 0.f, ss1 = 0.f;
    bf16x8 Yn[2], Xhn[3], Xln[3];
#define RT_LOAD(kk) do { _Pragma("unroll") for (int rb = 0; rb < 2; ++rb) Yn[rb] = *(const GAS bf16x8*)(x2 + (row0 + 16 * rb + r16) * DM + 32 * (kk) + 8 * g4); \
        _Pragma("unroll") for (int nb = 0; nb < 3; ++nb) { Xhn[nb] = *(const GAS bf16x8*)(wrh + (size_t)(16 * nb + r16) * 1024 + 32 * (kk) + 8 * g4); Xln[nb] = *(const GAS bf16x8*)(wrl + (size_t)(16 * nb + r16) * 1024 + 32 * (kk) + 8 * g4); } } while (0)
    RT_LOAD(0);
    for (int kk = 0; kk < 32; ++kk) {
        bf16x8 Y[2], Xh[3], Xl[3];
        Y[0] = Yn[0]; Y[1] = Yn[1];
#pragma unroll
        for (int nb = 0; nb < 3; ++nb) { Xh[nb] = Xhn[nb]; Xl[nb] = Xln[nb]; }
        if (kk + 1 < 32) RT_LOAD(kk + 1);
        { float xf[2][8];
#pragma unroll
          for (int rb = 0; rb < 2; ++rb) {
#pragma unroll
            for (int j = 0; j < 8; ++j) xf[rb][j] = bf2f((unsigned short)Y[rb][j]);
            u32x2 o8; o8.x = pk4_fp8(xf[rb][0], xf[rb][1], xf[rb][2], xf[rb][3]); o8.y = pk4_fp8(xf[rb][4], xf[rb][5], xf[rb][6], xf[rb][7]);
            *(GAS u32x2*)((uchar*)F.ws + O_X2F8 + (row0 + 16 * rb + r16) * DM + 32 * kk + 8 * g4) = o8; } }
#pragma unroll
        for (int j = 0; j < 8; ++j) { const float a = bf2f((unsigned short)Y[0][j]), c = bf2f((unsigned short)Y[1][j]); ss0 += a * a; ss1 += c * c; }
#pragma unroll
        for (int nb = 0; nb < 3; ++nb)
#pragma unroll
            for (int rb = 0; rb < 2; ++rb) { acc[nb][rb] = mfma16(Xh[nb], Y[rb], acc[nb][rb]); acc[nb][rb] = mfma16(Xl[nb], Y[rb], acc[nb][rb]); }
    }
#undef RT_LOAD
    ss0 += __shfl_xor(ss0, 16); ss0 += __shfl_xor(ss0, 32); ss1 += __shfl_xor(ss1, 16); ss1 += __shfl_xor(ss1, 32);
    const float rsA = 1.0f / sqrtf(ss0 * (1.f / DM) + RMS_EPS), rsB = 1.0f / sqrtf(ss1 * (1.f / DM) + RMS_EPS);
#pragma unroll
    for (int nb = 0; nb < 3; ++nb)
#pragma unroll
        for (int rb = 0; rb < 2; ++rb) { const float rs = rb ? rsB : rsA;
            *(LAS f32x4*)(lg + (16 * rb + r16) * 48 + 16 * nb + 4 * g4) = acc[nb][rb] * rs; }
    if (g4 == 0) { rs3[row0 + r16] = rsA; rs3[row0 + 16 + r16] = rsB; }
    LDS_WAIT(); asm volatile("" ::: "memory");
    if (lane < 32) {
        const LAS float* L = lg + lane * 48; const int rl = 32 * w + lane; const size_t m = row0 + lane;
        float l4[4];
#pragma unroll
        for (int j = 0; j < 4; ++j) l4[j] = L[j] + INP(I_BRG)[j];
        int gi = 0; float lm = l4[0];
#pragma unroll
        for (int j = 1; j < 4; ++j) if (l4[j] > lm) { lm = l4[j]; gi = j; }
        const float ptop = 1.0f / (__expf(l4[0] - lm) + __expf(l4[1] - lm) + __expf(l4[2] - lm) + __expf(l4[3] - lm));
        float le[8];
#pragma unroll
        for (int j = 0; j < 8; ++j) le[j] = L[16 + gi * 8 + j] + INP(I_BRE)[gi * 8 + j];
        int e0 = 0; float m0 = le[0];
#pragma unroll
        for (int j = 1; j < 8; ++j) if (le[j] > m0) { m0 = le[j]; e0 = j; }
        int e1 = -1; float m1 = -3.0e38f;
#pragma unroll
        for (int j = 0; j < 8; ++j) if (j != e0 && le[j] > m1) { m1 = le[j]; e1 = j; }
        const float t = __expf(m1 - m0), w0 = ptop / (1.0f + t), w1 = ptop * t / (1.0f + t);
        tokE[2 * rl] = gi * 8 + e0; tokE[2 * rl + 1] = gi * 8 + e1;
        tok[m * 8 + 4] = __float_as_uint(w0); tok[m * 8 + 5] = __float_as_uint(w1);
    }
    __syncthreads();
    {
        const int myE = tokE[tid]; int myR = 0;
        for (int e = 0; e < 32; ++e) { const unsigned long long mk = __ballot(myE == e); if (myE == e) myR = __popcll(mk & ((1ull << lane) - 1ull)); if (lane == 0) wcnt[w * 32 + e] = __popcll(mk); }
        __syncthreads();
        int add = 0;
        for (int ww = 0; ww < w; ++ww) add += wcnt[ww * 32 + myE];
        tokR[tid] = myR + add;
        if (tid < 32) { int tot = 0; for (int ww = 0; ww < 8; ++ww) tot += wcnt[ww * 32 + tid]; base[tid] = (int)__hip_atomic_fetch_add(cnt + tid, (unsigned)tot, __ATOMIC_RELAXED, __HIP_MEMORY_SCOPE_AGENT); }
        __syncthreads();
        const int pos = base[myE] + tokR[tid], m = blk * 256 + (tid >> 1);
        ridx[(size_t)myE * NTOK + pos] = m;
        tok[(size_t)m * 8 + (tid & 1) * 2 + 0] = (unsigned)myE; tok[(size_t)m * 8 + (tid & 1) * 2 + 1] = (unsigned)pos;
    }
    __syncthreads();
}
DI void phase8(Frame& F) {
    for (int blk = F.bid; blk < NTOK / 256; blk += F.G) route_block(F, blk);
}

DI void moe_tables(Frame& F, LAS int*& cum, LAS int*& cntl) {
    cum = (LAS int*)(F.lds + 131072); cntl = cum + 64;
    const unsigned* cnt = (const unsigned*)(F.ws + O_CTL) + CW_CNT;
    if (F.tid < 32) cntl[F.tid] = (int)__hip_atomic_load(cnt + F.tid, __ATOMIC_RELAXED, __HIP_MEMORY_SCOPE_AGENT);
    __syncthreads();
    if (F.tid == 0) { int a = 0; for (int e = 0; e < 32; ++e) { cum[e] = a; a += (cntl[e] + 255) >> 8; } cum[32] = a; }
    __syncthreads();
}

DI void phase11(Frame& F) {
    LAS int* cum; LAS int* cntl; moe_tables(F, cum, cntl);
    const int gw = F.bid * NWAVES + F.wave, NGW = F.G * NWAVES, lane = F.lane;
    const unsigned* tok = (const unsigned*)(F.ws + O_TOK); const bf16* YD = (const bf16*)(F.ws + O_YD);
    f32x4 gfin[4];
#pragma unroll
    for (int j = 0; j < 4; ++j) gfin[j] = ((const f32x4*)INP(I_GFINAL))[lane + 64 * j];
    for (int m0 = gw; m0 < NTOK; m0 += 4 * NGW) {
        u32x4 ti[4]; unsigned tw0[4], tw1[4];
#pragma unroll
        for (int q = 0; q < 4; ++q) { const int m = m0 + q * NGW; ti[q] = *(const GAS u32x4*)(tok + (size_t)m * 8); tw0[q] = tok[(size_t)m * 8 + 4]; tw1[q] = tok[(size_t)m * 8 + 5]; }
        u32x2 xv[4][4]; u32x2 ya[4][4], yb[4][4];
#pragma unroll
        for (int q = 0; q < 4; ++q) { const int m = m0 + q * NGW;
            const size_t s0 = (size_t)cum[ti[q].x] * 256 + ti[q].y, s1 = (size_t)cum[ti[q].z] * 256 + ti[q].w;
            const u32x2* xr = (const u32x2*)((const bf16*)(F.ws + O_XB) + (size_t)m * DM) + lane;
            const u32x2* y0 = (const u32x2*)(YD + s0 * DM) + lane; const u32x2* y1 = (const u32x2*)(YD + s1 * DM) + lane;
#pragma unroll
            for (int j = 0; j < 4; ++j) { xv[q][j] = xr[64 * j]; ya[q][j] = y0[64 * j]; yb[q][j] = y1[64 * j]; } }
#pragma unroll
        for (int q = 0; q < 4; ++q) { const int m = m0 + q * NGW;
            const float w0 = __uint_as_float(tw0[q]), w1 = __uint_as_float(tw1[q]);
            f32x4* xr = (f32x4*)(F.out + (size_t)m * DM) + lane;
            f32x4 v[4]; float s = 0.f;
#pragma unroll
            for (int j = 0; j < 4; ++j) { const u32x2 a = ya[q][j], bq = yb[q][j];
                f32x4 mo; mo.x = w0 * bflo(a.x) + w1 * bflo(bq.x); mo.y = w0 * bfhi(a.x) + w1 * bfhi(bq.x); mo.z = w0 * bflo(a.y) + w1 * bflo(bq.y); mo.w = w0 * bfhi(a.y) + w1 * bfhi(bq.y);
                v[j] = (f32x4){bflo(xv[q][j].x), bfhi(xv[q][j].x), bflo(xv[q][j].y), bfhi(xv[q][j].y)} + mo; s += (v[j].x * v[j].x + v[j].y * v[j].y) + (v[j].z * v[j].z + v[j].w * v[j].w); }
            const float rs = 1.0f / sqrtf(wave_sum(s) * (1.f / DM) + RMS_EPS);
#pragma unroll
            for (int j = 0; j < 4; ++j) xr[64 * j] = v[j] * rs * gfin[j]; }
    }
}
typedef GAS unsigned gu32;
#define RLX_AGENT __ATOMIC_RELAXED, __HIP_MEMORY_SCOPE_AGENT
#define XB_TMO      128
#define XB_XCNT(j)  (256  + 64 * (j))
#define XB_XSUB(j)  (1280 + 64 * (j))
#define XB_XGEN(j)  (2304 + 64 * (j))
#define XB_TOP      3328
#define XB_TOPGEN   3392
#define XCD_BAR_WORDS 3456
#define XB_SPIN_CAP (1u << 18)

__device__ __forceinline__ unsigned xb_ld(unsigned* p)              { return __hip_atomic_load(p, __ATOMIC_RELAXED, __HIP_MEMORY_SCOPE_AGENT); }
__device__ __forceinline__ unsigned xb_add(unsigned* p, unsigned v) { return __hip_atomic_fetch_add(p, v, __ATOMIC_RELAXED, __HIP_MEMORY_SCOPE_AGENT); }
__device__ __forceinline__ unsigned xb_xcc_id() { return (unsigned)__builtin_amdgcn_s_getreg((3 << 11) | 20) & 0xFu; }
#define XB_SPIN(cond, bar) do { unsigned _sp = 0; while (cond) { __builtin_amdgcn_s_sleep(1); \
    if ((++_sp & 255u) == 0u) { if (xb_ld(&(bar)[XB_TMO])) break; if (_sp > XB_SPIN_CAP) { atomicAdd(&(bar)[XB_TMO], 1u); break; } } } } while (0)

struct XcdBarrier {
    unsigned* bar; unsigned x;
    volatile LAS unsigned* st;
};

__device__ __forceinline__ XcdBarrier xcd_barrier_post(unsigned* bar, volatile LAS unsigned* st) {
    XcdBarrier b; b.bar = bar; b.x = xb_xcc_id(); b.st = st;
    if (threadIdx.x == 0) (void)xb_add(&bar[XB_XCNT(b.x)], 1u);
    return b;
}
__device__ __forceinline__ void xcd_barrier_complete(unsigned* bar, unsigned x, unsigned& nloc, unsigned& nx) {
    const unsigned G = gridDim.x * gridDim.y * gridDim.z;
    unsigned sum, cnt, mine, sp = 0u;
    for (;;) {
        sum = 0u; cnt = 0u; mine = 0u;
#pragma unroll
        for (unsigned j = 0; j < 16; ++j) { const unsigned c = xb_ld(&bar[XB_XCNT(j)]); sum += c; cnt += (c > 0u) ? 1u : 0u; mine = (j == x) ? c : mine; }
        if (sum == G) break;
        __builtin_amdgcn_s_sleep(1);
        if ((++sp & 255u) == 0u) { if (xb_ld(&bar[XB_TMO])) break; if (sp > XB_SPIN_CAP) { atomicAdd(&bar[XB_TMO], 1u); break; } }
    }
    nloc = mine > 0u ? mine : 1u; nx = cnt > 0u ? cnt : 1u;
}

__device__ __forceinline__ void xcd_barrier(const XcdBarrier& b) {
    asm volatile("s_waitcnt vmcnt(0)" ::: "memory");
    __syncthreads();
    if (threadIdx.x == 0) {
        unsigned* bar = b.bar;
        __builtin_amdgcn_s_waitcnt(0);
        unsigned nloc = b.st[0], nx = b.st[1];
        if (nloc == 0u) { xcd_barrier_complete(bar, b.x, nloc, nx); b.st[0] = nloc; b.st[1] = nx; }
        const unsigned old = xb_add(&bar[XB_XSUB(b.x)], 1u);
        const unsigned gen = old / nloc;
        if (old + 1u == (gen + 1u) * nloc) {
            __builtin_amdgcn_fence(__ATOMIC_RELEASE, "agent");
            asm volatile("s_waitcnt vmcnt(0)" ::: "memory");
            const unsigned og = xb_add(&bar[XB_TOP], 1u);
            const unsigned tg = og / nx;
            if (og + 1u == (tg + 1u) * nx) xb_add(&bar[XB_TOPGEN], 1u);
            else XB_SPIN(xb_ld(&bar[XB_TOPGEN]) == tg, bar);
            __builtin_amdgcn_fence(__ATOMIC_ACQUIRE, "agent");
            xb_add(&bar[XB_XGEN(b.x)], 1u);
            asm volatile("s_waitcnt vmcnt(0)" ::: "memory");
        } else {
            XB_SPIN(xb_ld(&bar[XB_XGEN(b.x)]) == gen, bar);
            __builtin_amdgcn_fence(__ATOMIC_ACQUIRE, "agent");
            asm volatile("s_waitcnt vmcnt(0)" ::: "memory");
        }
    }
    __syncthreads();
}

#ifndef MK_N_LAUNCHES
#define MK_N_LAUNCHES 1
#define DOUBLE_MASK 0
#endif
constexpr int N_PHASES = 12;

DI int xcd_major(int bid, int G) { return (G & 7) == 0 ? (bid & 7) * (G >> 3) + (bid >> 3) : bid; }

__global__ void __launch_bounds__(NTHR, 2) hybrid_fwd(Args args) {
    extern __shared__ __attribute__((aligned(16))) uchar lds_raw[];
    Frame F;
    F.lds = (LAS uchar*)lds_raw;
    F.tid = threadIdx.x; F.lane = F.tid & 63; F.wave = __builtin_amdgcn_readfirstlane(F.tid >> 6);
    F.G = gridDim.x; F.bid = blockIdx.x;
    F.in = args.in;
    F.out = (float*)args.out; F.ws = (uchar*)args.ws;
    uchar* ws = (uchar*)args.ws;
    const int lo = args.ph_lo, hi = args.ph_hi;
    volatile LAS unsigned* MISC = (volatile LAS unsigned*)(F.lds + LDS_BYTES - 256);
    if (F.tid < 64) MISC[F.tid] = 0u;
    __syncthreads();
    XcdBarrier bar; bar.bar = (unsigned*)((uchar*)args.ws + O_CTL) + CW_BAR; bar.x = 0; bar.st = MISC + 8;
    if (hi - lo > 1) bar = xcd_barrier_post((unsigned*)((uchar*)args.ws + O_CTL) + CW_BAR, MISC + 8);
#ifndef PHASE_MASK
#define PHASE_MASK 0xFFF
#endif
#ifndef DOUBLE_MASK
#define DOUBLE_MASK 0
#endif
#define IN(k) (((PHASE_MASK >> (k)) & 1) && lo <= (k) && (k) < hi)
#define REP(k) for (int rep_ = 0; rep_ < 1 + ((DOUBLE_MASK >> (k)) & 1); ++rep_)
#if defined(__HIP_DEVICE_COMPILE__)
#define ASSUME_GLOBAL(p) __builtin_assume(!__builtin_amdgcn_is_shared((const void*)(p)) && !__builtin_amdgcn_is_private((const void*)(p)))
#else
#define ASSUME_GLOBAL(p) ((void)0)
#endif
#define OPQ() do { GASK uchar* w_ = args.ws; GASK float* o_ = args.out; asm volatile("" : "+s"(w_), "+s"(o_)); ws = (uchar*)w_; F.ws = ws; F.out = (float*)o_; } while (0)
#define SEAM(k) do { OPQ(); if (lo <= (k) && (k) + 1 < hi) { xcd_barrier(bar); } } while (0)
    using pg8::Gemm; using pg8::StaticOrder; using pg8::gemm_phase;
#ifndef TSEL
#define TSEL (-1)
#endif
    unsigned long long tq0 = 0, tq1 = 0;
#ifdef TPROBE
#define TQ0(k) do { if ((k) == TSEL) { if (F.tid == 0) *(volatile LAS unsigned long long*)(F.lds + LDS_BYTES - 256 + 128) = 0ull; } } while (0)
#define TQ1(k) do { if ((k) == TSEL) { tq0 = 0; tq1 = *(volatile LAS unsigned long long*)(F.lds + LDS_BYTES - 256 + 128); } } while (0)
#else
#define TQ0(k) do { if ((k) == TSEL) tq0 = __builtin_amdgcn_s_memrealtime(); } while (0)
#define TQ1(k) do { if ((k) == TSEL) tq1 = __builtin_amdgcn_s_memrealtime(); } while (0)
#endif

    TQ0(0);
    if (IN(0)) REP(0) phase0(F);
    SEAM(0); TQ1(0);
    TQ0(1);
    if (IN(1)) REP(1) {
        { Gemm g{(const bf16*)(ws + O_XB), (const bf16*)(ws + O_WIN), NTOK, ZC, DM}; StaticOrder S; S.init(NTOK, ZC, F.G, F.bid);
          EpiRowScale<0> E{(bf16*)(ws + O_Z), ZG, (const float*)(ws + O_RS0), 1.0f};
          gemm_phase<EpiRowScale<0>, StaticOrder, true, true, false>(F.lds, g, S, E); }
        { Gemm g{(const bf16*)(ws + O_MEMB), (const bf16*)(ws + O_WKV), NMROWS, 2048, DM}; StaticOrder S; S.init(NMROWS, 2048, F.G, F.bid);
          EpiRowScale<1> E{(bf16*)(ws + O_KV), 2048, (const float*)(ws + O_RSM), 1.0f};
          gemm_phase<EpiRowScale<1>, StaticOrder, true, true, false>(F.lds, g, S, E); }
    }
    SEAM(1); TQ1(1);
    TQ0(2);
    if (IN(2)) REP(2) phase2(F);
    SEAM(2); TQ1(2);
    TQ0(3);
    if (IN(3)) REP(3) mlstm_out_phase(F);
    SEAM(3); TQ1(3);
    TQ0(4);
    if (IN(4)) REP(4) {
        Gemm g{(const bf16*)(ws + O_Y), (const bf16*)(ws + O_WOUT), NTOK, DM, DM}; StaticOrder S; S.init(NTOK, DM, F.G, F.bid);
        EpiRes<true, true, true> E{nullptr, (bf16*)(ws + O_XB), (float*)(ws + O_SS1), ws + O_X1F8};
        gemm_phase<EpiRes<true, true, true>, StaticOrder, true, true, false>(F.lds, g, S, E);
    }
    SEAM(4); TQ1(4);
    TQ0(5);
    if (IN(5)) REP(5) {
        Gemm g{(const bf16*)(ws + O_X1F8), (const bf16*)(ws + O_WQ), NTOK, DM, DM, SC_ONE, SC_W}; StaticOrder S; S.init(NTOK, DM, F.G, F.bid);
        EpiQ E{(bf16*)(ws + O_Q), (const float*)(ws + O_SS1), 0.0625f};
#if defined(KREP_PROBE) && KREP_PROBE == 5
        g.krep = 2; g.scale_a = 0x7E7E7E7E;
#endif
        gemm_phase<EpiQ, StaticOrder, true, true, false, true>(F.lds, g, S, E);
    }
    SEAM(5); TQ1(5);
    TQ0(6);
    if (IN(6)) REP(6) attn_phase(F);
    SEAM(6); TQ1(6);
    TQ0(7);
    if (IN(7)) REP(7) {
        Gemm g{(const bf16*)(ws + O_O), (const bf16*)(ws + O_WO), NTOK, DM, DM, SC_ONE, SC_W}; StaticOrder S; S.init(NTOK, DM, F.G, F.bid);
        EpiRes<true, false, false> E{nullptr, (bf16*)(ws + O_XB), nullptr, nullptr};
#if defined(KREP_PROBE) && KREP_PROBE == 7
        g.krep = 2; g.scale_a = 0x7E7E7E7E;
#endif
        gemm_phase<EpiRes<true, false, false>, StaticOrder, true, true, false, true>(F.lds, g, S, E);
    }
    SEAM(7); TQ1(7);
    TQ0(8);
    if (IN(8)) REP(8) phase8(F);
    SEAM(8); TQ1(8);
    TQ0(9);
    if (IN(9)) REP(9) {
        LAS int* cum; LAS int* cntl; moe_tables(F, cum, cntl);
        MoeOrder S{cum, cntl, (const int*)(ws + O_RIDX), F.G, xcd_major(F.bid, F.G), false};
        Gemm g{(const bf16*)(ws + O_X2F8), (const bf16*)(ws + O_WGU8), NTOK, NEXP * 1024, DM, SC_ONE, SC_W};
        EpiGU E{(bf16*)(ws + O_H), (const float*)(ws + O_RS3)};
#if defined(KREP_PROBE) && KREP_PROBE == 9
        g.krep = 2; g.scale_a = 0x7E7E7E7E;
#endif
        gemm_phase<EpiGU, MoeOrder, true, true, true, true>(F.lds, g, S, E);
    }
    SEAM(9); TQ1(9);
    TQ0(10);
    if (IN(10)) REP(10) {
        LAS int* cum; LAS int* cntl; moe_tables(F, cum, cntl);
        MoeOrder S{cum, cntl, (const int*)(ws + O_RIDX), F.G, xcd_major(F.bid, F.G), true};
        Gemm g{(const bf16*)(ws + O_H), (const bf16*)(ws + O_WD8), MAXSLOTS, NEXP * 1024, DEXP, SC_ONE, SC_W};
        EpiPlain E{(bf16*)(ws + O_YD), DM};
#if defined(KREP_PROBE) && KREP_PROBE == 10
        g.krep = 2; g.scale_a = 0x7E7E7E7E;
#endif
        gemm_phase<EpiPlain, MoeOrder, true, true, false, true>(F.lds, g, S, E);
    }
    SEAM(10); TQ1(10);
    TQ0(11);
    if (IN(11)) REP(11) phase11(F);
    TQ1(11);
    if (TSEL >= 0 && F.bid == 0 && F.tid == 0) { const unsigned long long tgt = __builtin_amdgcn_s_memrealtime() + 4ull * (tq1 - tq0); while (__builtin_amdgcn_s_memrealtime() < tgt) __builtin_amdgcn_s_sleep(16); }
#undef IN
#undef SEAM
}

extern "C" void kernel_launch(void* const* d_in, const int* in_sizes, int n_in, void* d_out, int out_size, void* d_ws, size_t ws_size, hipStream_t stream) {
    static int grid = 0;
    if (grid == 0) {
        if (n_in != 27 || in_sizes[0] != NTOK * DM || out_size != NTOK * DM || ws_size < WS_NEED) { fprintf(stderr, "kernel_launch: unexpected shapes (n_in %d, in0 %d, out %d, ws %zu); nothing launched\n", n_in, n_in > 0 ? in_sizes[0] : -1, out_size, ws_size); grid = -1; return; }
        int dev = 0, cus = 0, per_cu = 0;
        if (hipGetDevice(&dev) != hipSuccess || hipDeviceGetAttribute(&cus, hipDeviceAttributeMultiprocessorCount, dev) != hipSuccess) { fprintf(stderr, "kernel_launch: device query failed\n"); grid = -1; return; }
        if (hipFuncSetAttribute((const void*)hybrid_fwd, hipFuncAttributeMaxDynamicSharedMemorySize, LDS_BYTES) != hipSuccess) { fprintf(stderr, "kernel_launch: hipFuncSetAttribute failed\n"); grid = -1; return; }
        if (hipOccupancyMaxActiveBlocksPerMultiprocessor(&per_cu, (const void*)hybrid_fwd, NTHR, LDS_BYTES) != hipSuccess || per_cu < 1) { fprintf(stderr, "kernel_launch: occupancy query says %d\n", per_cu); per_cu = 1; }
        (void)hipGetLastError();
        grid = cus * per_cu;
        if (grid > 256) grid = 256;
    }
    if (grid < 0) return;
    (void)hipMemsetAsync((char*)d_ws + O_CTL, 0, CTL_BYTES, stream);
    Args a{};
    for (int i = 0; i < 27; ++i) a.in[i] = (const GASK float*)d_in[i];
    a.out = (GASK float*)d_out; a.ws = (GASK uchar*)d_ws;
#if MK_N_LAUNCHES == 1
    a.ph_lo = 0; a.ph_hi = N_PHASES;
    hipLaunchKernelGGL(hybrid_fwd, dim3(grid), dim3(NTHR), LDS_BYTES, stream, a);
#else
    for (int p = 0; p < N_PHASES; ++p) { a.ph_lo = p; a.ph_hi = p + 1; hipLaunchKernelGGL(hybrid_fwd, dim3(grid), dim3(NTHR), LDS_BYTES, stream, a); }
#endif
}
```

```cpp
#include <hip/hip_runtime.h>
#include <cstdio>
#include <cstdint>
#define MK_N_LAUNCHES 1
#define DOUBLE_MASK 0
namespace pg8 {
#define PG8_LAS __attribute__((address_space(3)))
typedef unsigned short bf16_t;
typedef short bf16x8 __attribute__((ext_vector_type(8)));
typedef float f32x4 __attribute__((ext_vector_type(4)));
typedef unsigned u32x4 __attribute__((ext_vector_type(4)));
typedef unsigned u32x2 __attribute__((ext_vector_type(2)));
constexpr int BM = 256, BK = 64, HALF = 128, HTB = HALF * BK * 2  , STAGE_BYTES = 8 * HTB, NXCD = 8, WGM = 16;

__host__ __device__ __forceinline__ int lds_byte(int r, int c) { const int st = (r >> 4) * 2 + (c >> 5), rr = r & 15, cc = c & 31, ob = rr * 64 + cc * 2; return st * 1024 + (ob ^ (((ob >> 9) & 1) << 5)); }
__host__ __device__ __forceinline__ void stage_rc(int b, int& R, int& C) { const int st = b / 1024, sb = b % 1024, swz = sb ^ (((sb >> 9) & 1) << 5); R = (st >> 1) * 16 + swz / 64; C = (st & 1) * 32 + (swz % 64) / 2; }
__host__ __device__ __forceinline__ int perm32(int rho) { const int n = rho >> 4, i = rho & 15; return 8 * (i >> 2) + 4 * n + (i & 3); }

struct Unit { int pm, pn; const int* ridx; int nvalid; int orow, ocol, ex; };
struct Gemm { const bf16_t* A; const bf16_t* Bt; int M, N, K; int scale_a, scale_b; int krep = 1; };

struct StaticOrder {
    int nM, nN, nwg, G, c;
    __host__ __device__ void init(int M, int N, int G_, int c_) { nM = M / BM; nN = N / BM; nwg = nM * nN; G = G_; c = c_; }
    __host__ __device__ bool next(int i, Unit& u) const {
        const long L = (long)i * G + c; if (L >= nwg) return false;
        int wgid = (int)L; { const int q = nwg / NXCD, r = nwg % NXCD, xcd = wgid % NXCD, off = wgid / NXCD; wgid = (xcd < r ? xcd * (q + 1) : r * (q + 1) + (xcd - r) * q) + off; }
        const int nig = WGM * nN, gid = wgid / nig, fm = gid * WGM, gsz = (nM - fm) < WGM ? (nM - fm) : WGM;
        u.pm = fm + ((wgid % nig) % gsz); u.pn = (wgid % nig) / gsz; u.ridx = nullptr; u.nvalid = 256; u.orow = u.pm; u.ocol = u.pn * BM; u.ex = 0; return true;
    }
};

__device__ __forceinline__ unsigned cvt_pk_bf16(float lo, float hi) { unsigned r; asm("v_cvt_pk_bf16_f32 %0, %1, %2" : "=v"(r) : "v"(lo), "v"(hi)); return r; }

template <class Epi, class Sched, bool ALIGN_EPI, bool SP2, bool GATHER, bool FP8 = false>
__device__ __forceinline__ void gemm_phase(PG8_LAS unsigned char* lds, const Gemm g, const Sched& S, const Epi& E) {
    const int tid = threadIdx.x, wid = __builtin_amdgcn_readfirstlane(tid >> 6), lane = tid & 63, wr = wid >> 2, wc = wid & 3, fr = lane & 15, fq = lane >> 4;
    const int K = FP8 ? g.K / 2 : g.K, nt = K / BK;
    unsigned voffA[2], voffB[2];
#pragma unroll
    for (int i = 0; i < 2; ++i) { int R, C; stage_rc(tid * 16 + i * 8192, R, C); const int Rb = Epi::PERM ? ((R & ~31) + perm32(R & 31)) : R;
        voffA[i] = (unsigned)(R * K + C) * 2u; voffB[i] = (unsigned)(Rb * K + C) * 2u; }
    const size_t kstep = (size_t)(BK * 2);
    const size_t hstepB = (size_t)HALF * K * 2;
    const size_t hstepA = GATHER ? (size_t)0 : hstepB;
    const size_t tstep = 2 * hstepB;
    const unsigned ldsw = (unsigned)wid * 1024u;
    const int aoff = lds_byte(wr * 64 + fr, fq * 8), boff = lds_byte(wc * 32 + fr, fq * 8);
    unsigned vgC[2][2], vgN[2][2];
#define PG8_SA(b, h) (((b) * 2 + (h)) * HTB)
#define PG8_SB(b, h) ((4 + (b) * 2 + (h)) * HTB)
#define PG8_STAGE(bufoff, gbase, voff) do { _Pragma("unroll") for (int _i = 0; _i < 2; ++_i) \
        __builtin_amdgcn_global_load_lds((const unsigned*)((const char*)(gbase) + (voff)[_i]), (PG8_LAS unsigned*)(lds + (bufoff) + ldsw + _i * 8192), 16, 0, 0); } while (0)
#define PG8_STAGE_A(bufoff, gbase, h, nx) do { if constexpr (GATHER) { unsigned _v[2]; _v[0] = (nx) ? vgN[h][0] : vgC[h][0]; _v[1] = (nx) ? vgN[h][1] : vgC[h][1]; PG8_STAGE(bufoff, gbase, _v); } \
        else { PG8_STAGE(bufoff, (gbase) + (h) * hstepA, voffA); } } while (0)
#define PG8_GOFF(dst, u) do { _Pragma("unroll") for (int _h = 0; _h < 2; ++_h) _Pragma("unroll") for (int _i = 0; _i < 2; ++_i) { int _R, _C; stage_rc(tid * 16 + _i * 8192, _R, _C); int _r = _h * HALF + _R; _r = _r < (u).nvalid ? _r : (u).nvalid - 1; \
        dst[_h][_i] = (unsigned)(u).ridx[_r] * (unsigned)(K * 2) + (unsigned)(_C * 2); } } while (0)
#define PG8_CAT(lo, hi) __builtin_shufflevector(lo, hi, 0, 1, 2, 3, 4, 5, 6, 7)
#define PG8_LDA(dst, b, h) do { _Pragma("unroll") for (int m = 0; m < 4; ++m) { if constexpr (FP8) { dst##8[m] = PG8_CAT(*(const PG8_LAS i32x4_*)(lds + PG8_SA(b, h) + aoff + m * 2048), *(const PG8_LAS i32x4_*)(lds + PG8_SA(b, h) + aoff + m * 2048 + 1024)); } \
        else { _Pragma("unroll") for (int k = 0; k < 2; ++k) dst[m][k] = *(const PG8_LAS bf16x8*)(lds + PG8_SA(b, h) + aoff + m * 2048 + k * 1024); } } } while (0)
#define PG8_LDB(dst, b, h) do { _Pragma("unroll") for (int n = 0; n < 2; ++n) { if constexpr (FP8) { dst##8[n] = PG8_CAT(*(const PG8_LAS i32x4_*)(lds + PG8_SB(b, h) + boff + n * 2048), *(const PG8_LAS i32x4_*)(lds + PG8_SB(b, h) + boff + n * 2048 + 1024)); } \
        else { _Pragma("unroll") for (int k = 0; k < 2; ++k) dst[n][k] = *(const PG8_LAS bf16x8*)(lds + PG8_SB(b, h) + boff + n * 2048 + k * 1024); } } } while (0)
#define PG8_MMA(ai, bj, At, Bt) do { __builtin_amdgcn_s_setprio(1); _Pragma("unroll") for (int m = 0; m < 4; ++m) _Pragma("unroll") for (int n = 0; n < 2; ++n) { \
        if constexpr (FP8) { asm volatile("v_mfma_scale_f32_16x16x128_f8f6f4 %0, %1, %2, %0, %3, %4 op_sel_hi:[0,0,0]" : "+v"(acc[ai][bj][m][n]) : "v"(Bt##8[n]), "v"(At##8[m]), "v"(scb_), "v"(sca_)); } \
        else { _Pragma("unroll") for (int k = 0; k < 2; ++k) acc[ai][bj][m][n] = __builtin_amdgcn_mfma_f32_16x16x32_bf16(Bt[n][k], At[m][k], acc[ai][bj][m][n], 0, 0, 0); } } \
        if constexpr (FP8) { asm volatile("s_nop 15\n\ts_nop 3" ::: "memory"); } \
        __builtin_amdgcn_s_setprio(0); } while (0)
#define PG8_WAIT_V(n) asm volatile("s_waitcnt vmcnt(" #n ")" ::: "memory")
#define PG8_WAIT_L(n) asm volatile("s_waitcnt lgkmcnt(" #n ")" ::: "memory")
#define PG8_BAR __builtin_amdgcn_s_barrier()
#define PG8_SCHED __builtin_amdgcn_sched_barrier(0)
    Unit cur, nxt; int ui = 0;
#if defined(TPROBE) && TPROBE <= 6
    volatile PG8_LAS unsigned long long* tpv = (volatile PG8_LAS unsigned long long*)(lds + 163840 - 256 + 128);
#define PG8_TP_MARK(k) do { if (FP8 && (TPROBE == (k) || ((k) == 1 && TPROBE == 2)) && tid == 0) tpv[1] = __builtin_amdgcn_s_memrealtime(); } while (0)
#define PG8_TP_END(k) do { if (FP8 && TPROBE == (k) && tid == 0) { tpv[0] = tpv[0] + (__builtin_amdgcn_s_memrealtime() - tpv[1]); tpv[1] = 0ull; } } while (0)
#define PG8_TP_FIRST do { if (FP8 && (TPROBE == 1 || TPROBE == 3) && tid == 0) { const unsigned long long m_ = tpv[1]; if (m_ != 0ull) { tpv[0] = tpv[0] + (__builtin_amdgcn_s_memrealtime() - m_); tpv[1] = 0ull; } } } while (0)
#else
#define PG8_TP_MARK(k) ((void)0)
#define PG8_TP_END(k) ((void)0)
#define PG8_TP_FIRST ((void)0)
#endif
    if (!S.next(0, cur)) return;
    PG8_TP_MARK(6);
    f32x4 acc[2][2][4][2];
#pragma unroll
    for (int a = 0; a < 2; ++a)
#pragma unroll
        for (int b = 0; b < 2; ++b)
#pragma unroll
            for (int m = 0; m < 4; ++m)
#pragma unroll
                for (int n = 0; n < 2; ++n) acc[a][b][m][n] = (f32x4){0.f, 0.f, 0.f, 0.f};
    typedef int i32x8_ __attribute__((ext_vector_type(8))); typedef int i32x4_ __attribute__((ext_vector_type(4)));
    int sca_ = g.scale_a, scb_ = g.scale_b; asm volatile("" : "+v"(sca_), "+v"(scb_));
    bf16x8 At[4][2], B0[2][2], B1[2][2]; i32x8_ At8[4], B08[2], B18[2];
    const char* cA = GATHER ? (const char*)g.A : (const char*)g.A + (size_t)cur.pm * tstep; const char* cB = (const char*)g.Bt + (size_t)cur.pn * tstep;
    if constexpr (GATHER) { PG8_GOFF(vgC, cur); }
    if constexpr (SP2) {
        PG8_STAGE(PG8_SB(0, 0), cB, voffB); PG8_STAGE(PG8_SB(0, 1), cB + hstepB, voffB); PG8_STAGE_A(PG8_SA(0, 0), cA, 0, false); PG8_STAGE_A(PG8_SA(0, 1), cA, 1, false);
        if (wr == 1) PG8_BAR;
        PG8_WAIT_V(2); PG8_BAR;
        PG8_STAGE(PG8_SB(1, 0), cB + kstep, voffB); PG8_STAGE_A(PG8_SA(1, 0), cA + kstep, 0, false); PG8_STAGE(PG8_SB(1, 1), cB + hstepB + kstep, voffB);
        PG8_WAIT_V(6); PG8_BAR;
    } else {
        PG8_STAGE(PG8_SB(0, 0), cB, voffB); PG8_STAGE_A(PG8_SA(0, 0), cA, 0, false); PG8_STAGE(PG8_SB(0, 1), cB + hstepB, voffB); PG8_STAGE_A(PG8_SA(0, 1), cA, 1, false);
        if (wr == 1) PG8_BAR;
        PG8_WAIT_V(4); PG8_BAR;
        PG8_STAGE(PG8_SB(1, 0), cB + kstep, voffB); PG8_STAGE_A(PG8_SA(1, 0), cA + kstep, 0, false); PG8_STAGE(PG8_SB(1, 1), cB + hstepB + kstep, voffB);
        PG8_WAIT_V(6); PG8_BAR;
    }
    for (;;) {
        const bool has_next = S.next(ui + 1, nxt);
        const char* nA = GATHER ? (const char*)g.A : (has_next ? (const char*)g.A + (size_t)nxt.pm * tstep : cA); const char* nB = has_next ? (const char*)g.Bt + (size_t)nxt.pn * tstep : cB;
        if constexpr (GATHER) { if (has_next) { PG8_GOFF(vgN, nxt); } else {
#pragma unroll
            for (int _h = 0; _h < 2; ++_h) { vgN[_h][0] = vgC[_h][0]; vgN[_h][1] = vgC[_h][1]; } } }
        PG8_TP_MARK(5);
#ifdef KREP_PROBE
        const int ntt = nt * g.krep;
#pragma unroll 1
        for (int tt = 0; tt < ntt; tt += 2) {
            const int t = tt & (nt - 1), t2 = (t + 2) & (nt - 1);
            const bool last = (tt == ntt - 2);
            const char* a1 = cA + (size_t)(t + 1) * kstep;
            const char* a2 = last ? nA : cA + (size_t)t2 * kstep; const char* b2 = last ? nB : cB + (size_t)t2 * kstep;
#else
#pragma unroll 1
        for (int t = 0; t < nt; t += 2) {
            const bool last = (t == nt - 2);
            const char* a1 = cA + (size_t)(t + 1) * kstep;
            const char* a2 = last ? nA : cA + (size_t)(t + 2) * kstep; const char* b2 = last ? nB : cB + (size_t)(t + 2) * kstep;
#endif
            const char* a3 = a2 + kstep; const char* b3 = b2 + kstep;
            if constexpr (SP2) {
            PG8_LDB(B0, 0, 0); PG8_LDB(B1, 0, 1); PG8_SCHED; PG8_LDA(At, 0, 0); PG8_STAGE_A(PG8_SA(1, 1), a1, 1, false);
            PG8_WAIT_V(8); PG8_WAIT_L(0); PG8_BAR; PG8_TP_FIRST; PG8_MMA(0, 0, At, B0); PG8_MMA(0, 1, At, B1); PG8_BAR; PG8_SCHED;
            PG8_LDA(At, 0, 1); PG8_STAGE(PG8_SB(0, 0), b2, voffB); PG8_STAGE(PG8_SB(0, 1), b2 + hstepB, voffB); PG8_STAGE_A(PG8_SA(0, 0), a2, 0, last);
            PG8_WAIT_V(8); PG8_WAIT_L(0); PG8_BAR; PG8_MMA(1, 0, At, B0); PG8_MMA(1, 1, At, B1); PG8_BAR; PG8_SCHED;
            PG8_LDB(B0, 1, 0); PG8_LDB(B1, 1, 1); PG8_SCHED; PG8_LDA(At, 1, 0); PG8_STAGE_A(PG8_SA(0, 1), a2, 1, last);
            PG8_WAIT_V(8); PG8_WAIT_L(0); PG8_BAR; PG8_MMA(0, 0, At, B0); PG8_MMA(0, 1, At, B1); PG8_BAR; PG8_SCHED;
            PG8_LDA(At, 1, 1); PG8_STAGE(PG8_SB(1, 0), b3, voffB); PG8_STAGE(PG8_SB(1, 1), b3 + hstepB, voffB); PG8_STAGE_A(PG8_SA(1, 0), a3, 0, last);
            PG8_WAIT_V(8); PG8_WAIT_L(0); PG8_BAR; PG8_MMA(1, 0, At, B0); PG8_MMA(1, 1, At, B1); PG8_BAR; PG8_SCHED;
            } else {
            PG8_LDB(B0, 0, 0); PG8_SCHED; PG8_LDA(At, 0, 0); PG8_STAGE_A(PG8_SA(1, 1), a1, 1, false);
            PG8_WAIT_L(8); PG8_BAR; PG8_WAIT_L(0); PG8_MMA(0, 0, At, B0); PG8_BAR; PG8_SCHED;
            PG8_LDB(B1, 0, 1); PG8_STAGE(PG8_SB(0, 0), b2, voffB);
            PG8_BAR; PG8_WAIT_L(0); PG8_MMA(0, 1, At, B1); PG8_BAR;
            PG8_LDA(At, 0, 1); PG8_STAGE_A(PG8_SA(0, 0), a2, 0, last);
            PG8_BAR; PG8_WAIT_L(0); PG8_MMA(1, 0, At, B0); PG8_BAR; PG8_SCHED;
            PG8_STAGE(PG8_SB(0, 1), b2 + hstepB, voffB);
            PG8_WAIT_V(6); PG8_BAR; PG8_MMA(1, 1, At, B1); PG8_BAR;
            PG8_LDB(B0, 1, 0); PG8_SCHED; PG8_LDA(At, 1, 0); PG8_STAGE_A(PG8_SA(0, 1), a2, 1, last);
            PG8_WAIT_L(8); PG8_BAR; PG8_WAIT_L(0); PG8_MMA(0, 0, At, B0); PG8_BAR; PG8_SCHED;
            PG8_LDB(B1, 1, 1); PG8_STAGE(PG8_SB(1, 0), b3, voffB);
            PG8_BAR; PG8_WAIT_L(0); PG8_MMA(0, 1, At, B1); PG8_BAR;
            PG8_LDA(At, 1, 1); PG8_STAGE_A(PG8_SA(1, 0), a3, 0, last);
            PG8_BAR; PG8_WAIT_L(0); PG8_MMA(1, 0, At, B0); PG8_BAR; PG8_SCHED;
            PG8_STAGE(PG8_SB(1, 1), b3 + hstepB, voffB);
            PG8_WAIT_V(6); PG8_BAR; PG8_MMA(1, 1, At, B1); PG8_BAR;
            }
        }
        PG8_TP_END(5);
        PG8_TP_MARK(1);
        if constexpr (ALIGN_EPI) { if (wr == 0) PG8_BAR; }
        PG8_TP_MARK(4);
        E(acc, cur, wr, wc, fr, fq);
        PG8_TP_END(2); PG8_TP_END(4); PG8_TP_MARK(3);
        if (!has_next) break;
#pragma unroll
        for (int a = 0; a < 2; ++a)
#pragma unroll
            for (int b = 0; b < 2; ++b)
#pragma unroll
                for (int m = 0; m < 4; ++m)
#pragma unroll
                    for (int n = 0; n < 2; ++n) acc[a][b][m][n] = (f32x4){0.f, 0.f, 0.f, 0.f};
        cur = nxt; cA = nA; cB = nB; ++ui;
        if constexpr (GATHER) {
#pragma unroll
            for (int _h = 0; _h < 2; ++_h) { vgC[_h][0] = vgN[_h][0]; vgC[_h][1] = vgN[_h][1]; } }
        if constexpr (ALIGN_EPI) { if (wr == 1) PG8_BAR; }
    }
    PG8_WAIT_V(0);
    if constexpr (!ALIGN_EPI) { if (wr == 0) PG8_BAR; }
    PG8_BAR;
    PG8_TP_END(6);
#undef PG8_TP_MARK
#undef PG8_TP_END
#undef PG8_TP_FIRST
#undef PG8_SA
#undef PG8_SB
#undef PG8_STAGE
#undef PG8_STAGE_A
#undef PG8_GOFF
#undef PG8_LDA
#undef PG8_CAT
#undef PG8_LDB
#undef PG8_MMA
#undef PG8_WAIT_V
#undef PG8_WAIT_L
#undef PG8_BAR
#undef PG8_SCHED
}
}
#define DI __device__ __forceinline__
#define LAS __attribute__((address_space(3)))
typedef unsigned short bf16;
typedef short bf16x8 __attribute__((ext_vector_type(8)));
typedef short s16x4 __attribute__((ext_vector_type(4)));
typedef float f32x4 __attribute__((ext_vector_type(4)));
typedef float f32x2 __attribute__((ext_vector_type(2)));
typedef unsigned u32x4 __attribute__((ext_vector_type(4)));
typedef unsigned u32x2 __attribute__((ext_vector_type(2)));
typedef unsigned char uchar;

constexpr int NB = 16, SEQ = 4096, DM = 1024, NTOK = NB * SEQ;
constexpr int NMEM = 256, NMROWS = NB * NMEM;
constexpr int ZC = 3072;
constexpr int NEXP = 32, DEXP = 512;
constexpr int MAXTILES = 544, MAXSLOTS = MAXTILES * 256;
constexpr float RMS_EPS = 1e-6f, LN_EPS = 1e-5f;
constexpr int NWAVES = 8, NTHR = 512;
constexpr int LDS_BYTES = 163840;

constexpr size_t MiB = 1u << 20;
constexpr size_t O_CTL = 0, CTL_BYTES = 64 * 1024;
constexpr size_t O_RS0 = 1 * MiB, O_RSM = O_RS0 + 256 * 1024, O_RS3 = O_RS0 + 512 * 1024;
constexpr size_t O_GATES = 2 * MiB;
constexpr size_t O_SS1 = 6 * MiB;
constexpr size_t O_TOK = 10 * MiB;
constexpr size_t O_RIDX = 12 * MiB;
constexpr size_t O_NST = 20 * MiB, O_MST = 22 * MiB;
constexpr size_t O_WSB = 23 * MiB;
constexpr size_t O_WRH = 24 * MiB, O_WRL = O_WRH + 128 * 1024;
constexpr size_t O_WIN = 32 * MiB, O_WOUT = 38 * MiB, O_WQ = 40 * MiB, O_WKV = 42 * MiB, O_WO = 46 * MiB, O_WGU = 48 * MiB, O_WD = 112 * MiB;
constexpr size_t O_XB = 160 * MiB;
constexpr size_t O_MEMB = 288 * MiB, O_KV = 296 * MiB;
constexpr size_t O_Z = 320 * MiB;
constexpr size_t O_ZQ = 448 * MiB, O_ZK = 512 * MiB, O_ZV = 576 * MiB, O_ZO = 640 * MiB;
constexpr int ZG = 1024;
constexpr size_t O_CST = 704 * MiB;
constexpr size_t O_Y = 840 * MiB;
constexpr size_t O_Q = O_Z, O_O = O_Z + 128 * MiB;
constexpr size_t O_H = O_Z, O_YD = O_Z + 144 * MiB;
constexpr size_t O_WGU8 = O_WGU, O_WD8 = O_WGU + 32 * MiB;
constexpr size_t O_X1F8 = 576 * MiB;
constexpr size_t O_X2F8 = O_Y;
constexpr int SC_ONE = 0x7F7F7F7F, SC_W = 0x7A7A7A7A;
constexpr size_t WS_NEED = 968 * MiB;
constexpr int CW_CNT = 0, CW_BAR = 4096;
constexpr int CW_CNT_UNUSED = 0;

#define LDS_WAIT() asm volatile("s_waitcnt lgkmcnt(0)" ::: "memory")
DI unsigned f2bf(float f) { unsigned u = __builtin_bit_cast(unsigned, f); return (u + 0x7fffu + ((u >> 16) & 1u)) >> 16; }
DI unsigned pk2(float lo, float hi) { return pg8::cvt_pk_bf16(lo, hi); }
DI unsigned pk4_fp8(float a, float b, float c, float d) { int t = __builtin_amdgcn_cvt_pk_fp8_f32(a, b, 0, false); t = __builtin_amdgcn_cvt_pk_fp8_f32(c, d, t, true); return (unsigned)t; }
DI float bf2f(unsigned short h) { return __builtin_bit_cast(float, (unsigned)h << 16); }
DI float bflo(unsigned w) { return __builtin_bit_cast(float, w << 16); }
DI float bfhi(unsigned w) { return __builtin_bit_cast(float, w & 0xffff0000u); }
#define DPP_F(old, src, ctrl, rm) __builtin_bit_cast(float, __builtin_amdgcn_update_dpp(__builtin_bit_cast(int, (float)(old)), __builtin_bit_cast(int, (float)(src)), ctrl, rm, 0xF, false))
DI float wave_sum(float v) {
    v += DPP_F(0.f, v, 0xB1, 0xF); v += DPP_F(0.f, v, 0x4E, 0xF); v += DPP_F(0.f, v, 0x141, 0xF); v += DPP_F(0.f, v, 0x140, 0xF);
    v += DPP_F(0.f, v, 0x142, 0xA); v += DPP_F(0.f, v, 0x143, 0xC);
    return __builtin_bit_cast(float, __builtin_amdgcn_readlane(__builtin_bit_cast(int, v), 63));
}
DI float wave_max(float v) {
    v = fmaxf(v, DPP_F(v, v, 0xB1, 0xF)); v = fmaxf(v, DPP_F(v, v, 0x4E, 0xF)); v = fmaxf(v, DPP_F(v, v, 0x141, 0xF)); v = fmaxf(v, DPP_F(v, v, 0x140, 0xF));
    v = fmaxf(v, DPP_F(v, v, 0x142, 0xA)); v = fmaxf(v, DPP_F(v, v, 0x143, 0xC));
    return __builtin_bit_cast(float, __builtin_amdgcn_readlane(__builtin_bit_cast(int, v), 63));
}
DI float wscan_add(float v, int lane) {
#pragma unroll
    for (int o = 1; o < 64; o <<= 1) { const float u = __shfl_up(v, o); v = (lane >= o) ? v + u : v; }
    return v;
}
DI float wscan_max(float v, int lane) {
#pragma unroll
    for (int o = 1; o < 64; o <<= 1) { const float u = __shfl_up(v, o); v = (lane >= o) ? fmaxf(v, u) : v; }
    return v;
}
DI float wscan_max_rev(float v, int lane) {
#pragma unroll
    for (int o = 1; o < 64; o <<= 1) { const float u = __shfl_down(v, o); v = (lane + o < 64) ? fmaxf(v, u) : v; }
    return v;
}
DI float fast_exp(float x) { return __expf(x); }
DI float sigmoidf_(float x) { return __builtin_amdgcn_rcpf(1.0f + __expf(-x)); }
DI float siluf_(float x) { return x * __builtin_amdgcn_rcpf(1.0f + __expf(-x)); }
DI float gelu_tanh(float x) { const float u = 0.7978845608028654f * (x + 0.044715f * x * x * x); return x * __builtin_amdgcn_rcpf(1.0f + __expf(-2.0f * u)); }
DI float log_sigmoid(float x) { return fminf(x, 0.f) - __logf(1.0f + __expf(-fabsf(x))); }

DI unsigned offb(unsigned row, unsigned ch) { return 256u * row + 16u * (ch ^ (((row & 3u) << 2) | ((row >> 2) & 3u))); }
DI bf16x8 frag_row(const LAS uchar* tile, int r0, int kk, int lane) { return *(const LAS bf16x8*)(tile + offb(r0 + (lane & 15), 4 * kk + (lane >> 4))); }
DI bf16x8 frag_tr(const LAS uchar* tile, int k0, int c0, int lane) {
    const unsigned g = lane >> 4, q = (lane & 15) >> 2, p = lane & 3;
    const unsigned ch = (c0 >> 3) + (p >> 1), bo = 8u * (p & 1);
    const s16x4 lo = __builtin_amdgcn_ds_read_tr16_b64_v4i16((LAS s16x4*)(tile + offb(k0 + 8 * g + q, ch) + bo));
    const s16x4 hi = __builtin_amdgcn_ds_read_tr16_b64_v4i16((LAS s16x4*)(tile + offb(k0 + 8 * g + 4 + q, ch) + bo));
    return (bf16x8){lo[0], lo[1], lo[2], lo[3], hi[0], hi[1], hi[2], hi[3]};
}
DI f32x4 mfma16(bf16x8 x, bf16x8 y, f32x4 acc) { return __builtin_amdgcn_mfma_f32_16x16x32_bf16(x, y, acc, 0, 0, 0); }

#if defined(__HIP_DEVICE_COMPILE__)
#define GASK __attribute__((address_space(1)))
#else
#define GASK
#endif
struct Args { const GASK float* in[27]; GASK float* out; GASK uchar* ws; int ph_lo, ph_hi; };
struct Frame {
    LAS uchar* lds;
    int tid, lane, wave, G, bid;
    const GASK float* const* in;
    float* out; uchar* ws;
};
#define GAS __attribute__((address_space(1)))
#define INP(i) ((const float*)F.in[i])
enum { I_X = 0, I_MEM, I_GMIX, I_WIN, I_CONVW, I_CONVB, I_GATEB, I_GHEAD, I_LNVG, I_LNVB, I_WS, I_BS, I_WOUT, I_GXATTN, I_GMEM, I_WQ, I_WKV, I_WO, I_GMOE, I_WRG, I_BRG, I_WRE, I_BRE, I_WGATE, I_WUP, I_WDOWN, I_GFINAL };
DI int xcd_major(int bid, int G) { return (G & 7) == 0 ? (bid & 7) * (G >> 3) + (bid >> 3) : bid; }

struct P0Item { const float* W; const float* gain; bf16* WT; size_t drow0; int K, ldw, scol0, k0, f8; };
DI void p0_decode(Frame& F, int it, P0Item& I) {
    uchar* ws = F.ws;
    constexpr int I_IN = 16 * 96, I_SQ = 16 * 32, I_KV = 16 * 64, I_GU = 32 * 16 * 16;
    int r = it;
    if (r < I_IN) { const int kb = r / 96, nb = r % 96; I = P0Item{INP(I_WIN), INP(I_GMIX), (bf16*)(ws + O_WIN), (size_t)nb * 32, 1024, 3088, nb * 32 < 2048 ? nb * 32 : nb * 32 + 16, kb * 64, 0}; return; } r -= I_IN;
    if (r < I_SQ) { const int kb = r / 32, nb = r % 32; I = P0Item{INP(I_WOUT), nullptr, (bf16*)(ws + O_WOUT), (size_t)nb * 32, 1024, 1024, nb * 32, kb * 64, 0}; return; } r -= I_SQ;
    if (r < I_SQ) { const int kb = r / 32, nb = r % 32; I = P0Item{INP(I_WQ), INP(I_GXATTN), (bf16*)(ws + O_WQ), (size_t)nb * 32, 1024, 1024, nb * 32, kb * 64, 1}; return; } r -= I_SQ;
    if (r < I_KV) { const int kb = r / 64, nb = r % 64; I = P0Item{INP(I_WKV), INP(I_GMEM), (bf16*)(ws + O_WKV), (size_t)nb * 32, 1024, 2048, nb * 32, kb * 64, 0}; return; } r -= I_KV;
    if (r < I_SQ) { const int kb = r / 32, nb = r % 32; I = P0Item{INP(I_WO), nullptr, (bf16*)(ws + O_WO), (size_t)nb * 32, 1024, 1024, nb * 32, kb * 64, 1}; return; } r -= I_SQ;
    if (r < 2 * I_GU) { const int up = r >= I_GU; if (up) r -= I_GU; const int e = r / 256, q = r % 256, kb = q / 16, nb = q % 16;
        I = P0Item{INP(up ? I_WUP : I_WGATE) + (size_t)e * 1024 * 512, INP(I_GMOE), (bf16*)(ws + O_WGU8), (size_t)e * 1024 + 256 * (nb / 4) + (up ? 128 : 0) + (nb % 4) * 32, 1024, 512, nb * 32, kb * 64, 1}; return; } r -= 2 * I_GU;
    { const int e = r / 256, q = r % 256, kb = q / 32, nb = q % 32;
        I = P0Item{INP(I_WDOWN) + (size_t)e * 512 * 1024, nullptr, (bf16*)(ws + O_WD8), (size_t)e * 1024 + nb * 32, 512, 1024, nb * 32, kb * 64, 1}; }
}
DI void p0_item_load(const P0Item& I, float (&tv)[32], int lane) {
#pragma unroll
    for (int i = 0; i < 32; ++i) { const int kk = 2 * i + (lane >> 5); tv[i] = *(const GAS float*)(I.W + (size_t)(I.k0 + kk) * I.ldw + I.scol0 + (lane & 31)); }
}
DI void p0_item_store(const P0Item& I, float (&tv)[32], LAS float* scr, int lane) {
    if (I.gain) {
#pragma unroll
        for (int i = 0; i < 32; ++i) tv[i] *= I.gain[I.k0 + 2 * i + (lane >> 5)]; }
#pragma unroll
    for (int i = 0; i < 32; ++i) { const int kk = 2 * i + (lane >> 5); scr[kk * 33 + (lane & 31)] = tv[i]; }
    LDS_WAIT(); asm volatile("" ::: "memory");
    if (I.f8) {
        const int c = lane & 3;
#pragma unroll
        for (int j = 0; j < 2; ++j) { const int n = (lane >> 2) + 16 * j; const LAS float* s = scr + (16 * c) * 33 + n;
            u32x4 o; o.x = pk4_fp8(32.f * s[0 * 33], 32.f * s[1 * 33], 32.f * s[2 * 33], 32.f * s[3 * 33]); o.y = pk4_fp8(32.f * s[4 * 33], 32.f * s[5 * 33], 32.f * s[6 * 33], 32.f * s[7 * 33]);
            o.z = pk4_fp8(32.f * s[8 * 33], 32.f * s[9 * 33], 32.f * s[10 * 33], 32.f * s[11 * 33]); o.w = pk4_fp8(32.f * s[12 * 33], 32.f * s[13 * 33], 32.f * s[14 * 33], 32.f * s[15 * 33]);
            *(GAS u32x4*)((uchar*)I.WT + (I.drow0 + n) * (size_t)I.K + I.k0 + 16 * c) = o; }
    } else {
    const int c = lane & 7;
#pragma unroll
    for (int j = 0; j < 4; ++j) { const int n = (lane >> 3) + 8 * j; const LAS float* s = scr + (8 * c) * 33 + n;
        u32x4 o; o.x = pk2(s[0 * 33], s[1 * 33]); o.y = pk2(s[2 * 33], s[3 * 33]); o.z = pk2(s[4 * 33], s[5 * 33]); o.w = pk2(s[6 * 33], s[7 * 33]);
        *(GAS u32x4*)(I.WT + (I.drow0 + n) * (size_t)I.K + I.k0 + 8 * c) = o; }
    }
    LDS_WAIT(); asm volatile("" ::: "memory");
}

#ifndef P0A_REP
#define P0A_REP 1
#endif
#ifndef P0C_REP
#define P0C_REP 1
#endif
DI void phase0(Frame& F) {
    const int gw = F.bid * NWAVES + F.wave, NGW = F.G * NWAVES, lane = F.lane;
    uchar* ws = F.ws;
    for (int r_ = 0; r_ < P0A_REP; ++r_) {
        LAS float* scr = (LAS float*)(F.lds + F.wave * 16384);
        constexpr int NITEMS = 16 * 96 + 3 * 16 * 32 + 16 * 64 + 2 * 32 * 16 * 16 + 32 * 8 * 32;
        P0Item cur, nxt; float tvA[32], tvB[32];
        int it = gw;
        if (it < NITEMS) { p0_decode(F, it, cur); p0_item_load(cur, tvA, lane); }
        while (it < NITEMS) {
            if (it + NGW < NITEMS) { p0_decode(F, it + NGW, nxt); p0_item_load(nxt, tvB, lane); }
            p0_item_store(cur, tvA, scr, lane);
            it += NGW; if (it >= NITEMS) break;
            if (it + NGW < NITEMS) { p0_decode(F, it + NGW, cur); p0_item_load(cur, tvA, lane); }
            p0_item_store(nxt, tvB, scr, lane);
            it += NGW;
        }
        for (int i = F.bid * NTHR + F.tid; i < 48 * 1024; i += F.G * NTHR) { const int n = i >> 10, k = i & 1023; float v = 0.f;
            if (n < 4) v = INP(I_WRG)[k * 4 + n] * INP(I_GMOE)[k]; else if (n >= 16) v = INP(I_WRE)[k * 32 + (n - 16)] * INP(I_GMOE)[k];
            const unsigned h = f2bf(v); const float hf = __builtin_bit_cast(float, h << 16);
            ((bf16*)(ws + O_WRH))[i] = (bf16)h; ((bf16*)(ws + O_WRL))[i] = (bf16)f2bf(v - hf); }
        for (int i = F.bid * NTHR + F.tid; i < 4 * 128 * 128 / 2; i += F.G * NTHR) { const f32x2 v = *(const GAS f32x2*)(INP(I_WS) + 2 * i); ((unsigned*)(ws + O_WSB))[i] = pk2(v.x, v.y); }
    }
    __syncthreads();
    LAS float* wg = (LAS float*)F.lds;
    for (int idx = F.tid; idx < 1024 * 16; idx += NTHR) { const int i = idx >> 4, j = idx & 15; const float v = INP(I_WIN)[(size_t)i * 3088 + 2048 + j] * INP(I_GMIX)[i];
        const int jj = i >> 8, l = (i & 255) >> 2, ii = i & 3, j4 = j >> 2, jr = j & 3; wg[((((jj * 4 + ii) * 4 + j4) * 64 + l) << 2) + jr] = v; }
    __syncthreads();
    for (int r_ = 0; r_ < P0C_REP; ++r_) {
        bf16* XB = (bf16*)(ws + O_XB); float* rs0 = (float*)(ws + O_RS0); float* gates = (float*)(ws + O_GATES);
        const float gb = INP(I_GATEB)[lane >> 2];
        f32x4 nx[4];
        if (gw < NTOK) { const f32x4* xr0 = (const f32x4*)(INP(I_X) + (size_t)gw * DM) + lane;
#pragma unroll
            for (int j = 0; j < 4; ++j) nx[j] = xr0[64 * j]; }
        for (int m = gw; m < NTOK; m += NGW) {
            f32x4 v[4]; float s = 0.f;
#pragma unroll
            for (int j = 0; j < 4; ++j) { v[j] = nx[j]; s += (v[j].x * v[j].x + v[j].y * v[j].y) + (v[j].z * v[j].z + v[j].w * v[j].w); }
            if (m + NGW < NTOK) { const f32x4* xr1 = (const f32x4*)(INP(I_X) + (size_t)(m + NGW) * DM) + lane;
#pragma unroll
                for (int j = 0; j < 4; ++j) nx[j] = xr1[64 * j]; }
            const float rs = 1.0f / sqrtf(wave_sum(s) * (1.f / DM) + RMS_EPS);
            unsigned long long* o8 = (unsigned long long*)(XB + (size_t)m * DM) + lane;
#pragma unroll
            for (int j = 0; j < 4; ++j) o8[64 * j] = (unsigned long long)pk2(v[j].x, v[j].y) | ((unsigned long long)pk2(v[j].z, v[j].w) << 32);
            float p[16];
#pragma unroll
            for (int j = 0; j < 16; ++j) p[j] = 0.f;
#pragma unroll
            for (int jj = 0; jj < 4; ++jj)
#pragma unroll
                for (int ii = 0; ii < 4; ++ii) { const float xv = v[jj][ii];
#pragma unroll
                    for (int j4 = 0; j4 < 4; ++j4) { const f32x4 w = *(const LAS f32x4*)(wg + ((((jj * 4 + ii) * 4 + j4) * 64 + lane) << 2));
                        p[4 * j4 + 0] += xv * w.x; p[4 * j4 + 1] += xv * w.y; p[4 * j4 + 2] += xv * w.z; p[4 * j4 + 3] += xv * w.w; } }
            float q8[8], q4[4], q2[2], q1;
            { const bool hi = (lane & 32) != 0;
#pragma unroll
              for (int k = 0; k < 8; ++k) { const float send = hi ? p[k] : p[k + 8], keep = hi ? p[k + 8] : p[k]; q8[k] = keep + __shfl_xor(send, 32); } }
            { const bool hi = (lane & 16) != 0;
#pragma unroll
              for (int k = 0; k < 4; ++k) { const float send = hi ? q8[k] : q8[k + 4], keep = hi ? q8[k + 4] : q8[k]; q4[k] = keep + __shfl_xor(send, 16); } }
            { const bool hi = (lane & 8) != 0;
#pragma unroll
              for (int k = 0; k < 2; ++k) { const float send = hi ? q4[k] : q4[k + 2], keep = hi ? q4[k + 2] : q4[k]; q2[k] = keep + __shfl_xor(send, 8); } }
            { const bool hi = (lane & 4) != 0; const float send = hi ? q2[0] : q2[1], keep = hi ? q2[1] : q2[0]; q1 = keep + __shfl_xor(send, 4); }
            q1 += __shfl_xor(q1, 2); q1 += __shfl_xor(q1, 1);
            if ((lane & 3) == 0) gates[(size_t)m * 16 + (lane >> 2)] = q1 * rs + gb;
            if (lane == 0) rs0[m] = rs;
        }
    }
    {
        bf16* MB = (bf16*)(ws + O_MEMB); float* rsm = (float*)(ws + O_RSM);
        for (int m = gw; m < NMROWS; m += NGW) {
            const f32x4* xr = (const f32x4*)(INP(I_MEM) + (size_t)m * DM) + lane;
            f32x4 v[4]; float s = 0.f;
#pragma unroll
            for (int j = 0; j < 4; ++j) { v[j] = xr[64 * j]; s += (v[j].x * v[j].x + v[j].y * v[j].y) + (v[j].z * v[j].z + v[j].w * v[j].w); }
            const float rs = 1.0f / sqrtf(wave_sum(s) * (1.f / DM) + RMS_EPS);
            unsigned long long* o8 = (unsigned long long*)(MB + (size_t)m * DM) + lane;
#pragma unroll
            for (int j = 0; j < 4; ++j) o8[64 * j] = (unsigned long long)pk2(v[j].x, v[j].y) | ((unsigned long long)pk2(v[j].z, v[j].w) << 32);
            if (lane == 0) rsm[m] = rs;
        }
    }
}
using pg8::Unit;
typedef const f32x4 (&AccRef)[2][2][4][2];

template <int MODE> struct EpiRowScale {
    static constexpr bool PERM = true;
    bf16* O; int ldc; const float* rs; float extra;
    DI void operator()(AccRef acc, const Unit& u, int wr, int wc, int fr, int fq) const {
        const int row0 = u.orow * 256 + wr * 64 + fr, col0 = u.ocol + wc * 32 + 8 * fq;
        const int act = (MODE == 0) ? (u.pn >= 8 ? 2 : (u.pn >= 6 ? 1 : 0)) : 0;
        float sc[2][4];
#pragma unroll
        for (int ai = 0; ai < 2; ++ai)
#pragma unroll
            for (int m = 0; m < 4; ++m) sc[ai][m] = *(const GAS float*)(rs + row0 + ai * 128 + m * 16);
#pragma unroll
        for (int ai = 0; ai < 2; ++ai)
#pragma unroll
            for (int m = 0; m < 4; ++m) { const int row = row0 + ai * 128 + m * 16; const float s = sc[ai][m] * extra;
#pragma unroll
                for (int bj = 0; bj < 2; ++bj) { f32x4 v0 = acc[ai][bj][m][0] * s, v1 = acc[ai][bj][m][1] * s;
                    if (act == 1) {
#pragma unroll
                        for (int j = 0; j < 4; ++j) { v0[j] = sigmoidf_(v0[j]); v1[j] = sigmoidf_(v1[j]); } }
                    else if (act == 2) {
#pragma unroll
                        for (int j = 0; j < 4; ++j) { v0[j] = gelu_tanh(v0[j]); v1[j] = gelu_tanh(v1[j]); } }
                    u32x4 w; w.x = pk2(v0[0], v0[1]); w.y = pk2(v0[2], v0[3]); w.z = pk2(v1[0], v1[1]); w.w = pk2(v1[2], v1[3]);
                    bf16* dst;
                    if (MODE == 0) {
                        if (u.pn < 8) dst = O + (size_t)(64 * MiB / 2) * (u.pn >> 1) + (size_t)(128 * MiB / 2) + ((size_t)((row >> 12) * 4 + (u.pn & 1) * 2 + bj) * SEQ + (row & (SEQ - 1))) * 128 + wc * 32 + 8 * fq;
                        else dst = O + (size_t)row * ZG + (u.pn - 8) * 256 + bj * 128 + wc * 32 + 8 * fq;
                    } else dst = O + (size_t)row * ldc + col0 + bj * 128;
                    *(GAS u32x4*)dst = w; } }
    }
};
struct EpiQ {
    static constexpr bool PERM = true;
    bf16* O; const float* ssp; float extra;
    DI void operator()(AccRef acc, const Unit& u, int wr, int wc, int fr, int fq) const {
        const int row0 = u.orow * 256 + wr * 64 + fr, col0 = u.ocol + wc * 32 + 8 * fq;
        float sc[2][4];
#pragma unroll
        for (int ai = 0; ai < 2; ++ai) { f32x4 p[4][4];
#pragma unroll
            for (int m = 0; m < 4; ++m) { const GAS f32x4* sp = (const GAS f32x4*)(ssp + (size_t)(row0 + ai * 128 + m * 16) * 16);
                p[m][0] = sp[0]; p[m][1] = sp[1]; p[m][2] = sp[2]; p[m][3] = sp[3]; }
#pragma unroll
            for (int m = 0; m < 4; ++m) { const f32x4 a = p[m][0], b = p[m][1], c = p[m][2], d = p[m][3];
                const float ss = (((a.x + a.y) + (a.z + a.w)) + ((b.x + b.y) + (b.z + b.w))) + (((c.x + c.y) + (c.z + c.w)) + ((d.x + d.y) + (d.z + d.w)));
                sc[ai][m] = extra / sqrtf(ss * (1.f / DM) + RMS_EPS); } }
#pragma unroll
        for (int ai = 0; ai < 2; ++ai)
#pragma unroll
            for (int m = 0; m < 4; ++m) { const int row = row0 + ai * 128 + m * 16; const float s = sc[ai][m]; bf16* rowp = O + (size_t)row * DM + col0;
#pragma unroll
                for (int bj = 0; bj < 2; ++bj) { const f32x4 v0 = acc[ai][bj][m][0] * s, v1 = acc[ai][bj][m][1] * s;
                    u32x4 w; w.x = pk2(v0[0], v0[1]); w.y = pk2(v0[2], v0[3]); w.z = pk2(v1[0], v1[1]); w.w = pk2(v1[2], v1[3]);
                    *(GAS u32x4*)(rowp + bj * 128) = w; } }
    }
};
template <bool BASE_BF16, bool SS, bool F8> struct EpiRes {
    static constexpr bool PERM = true;
    const float* base; bf16* xb; float* ssp; uchar* x8;
    DI void operator()(AccRef acc, const Unit& u, int wr, int wc, int fr, int fq) const {
        static_assert(BASE_BF16, "the residual base is the bf16 stream itself");
        const int row0 = u.orow * 256 + wr * 64 + fr, col0 = u.ocol + wc * 32 + 8 * fq;
        u32x4 bs[2][4][2];
#pragma unroll
        for (int ai = 0; ai < 2; ++ai)
#pragma unroll
            for (int m = 0; m < 4; ++m) { const size_t off = (size_t)(row0 + ai * 128 + m * 16) * DM + col0;
#pragma unroll
                for (int bj = 0; bj < 2; ++bj) bs[ai][m][bj] = *(const GAS u32x4*)(xb + off + bj * 128); }
#pragma unroll
        for (int ai = 0; ai < 2; ++ai)
#pragma unroll
            for (int m = 0; m < 4; ++m) { const int row = row0 + ai * 128 + m * 16; const size_t off = (size_t)row * DM + col0; float q = 0.f;
#pragma unroll
                for (int bj = 0; bj < 2; ++bj) { const u32x4 b4 = bs[ai][m][bj];
                    const f32x4 v0 = (f32x4){bflo(b4.x), bfhi(b4.x), bflo(b4.y), bfhi(b4.y)} + acc[ai][bj][m][0], v1 = (f32x4){bflo(b4.z), bfhi(b4.z), bflo(b4.w), bfhi(b4.w)} + acc[ai][bj][m][1];
                    u32x4 w; w.x = pk2(v0[0], v0[1]); w.y = pk2(v0[2], v0[3]); w.z = pk2(v1[0], v1[1]); w.w = pk2(v1[2], v1[3]);
                    *(GAS u32x4*)(xb + off + bj * 128) = w;
                    if (F8) { u32x2 w8; w8.x = pk4_fp8(v0[0], v0[1], v0[2], v0[3]); w8.y = pk4_fp8(v1[0], v1[1], v1[2], v1[3]); *(GAS u32x2*)(x8 + off + bj * 128) = w8; }
                    if (SS) q += ((v0[0] * v0[0] + v0[1] * v0[1]) + (v0[2] * v0[2] + v0[3] * v0[3])) + ((v1[0] * v1[0] + v1[1] * v1[1]) + (v1[2] * v1[2] + v1[3] * v1[3])); }
                if (SS) { q += __shfl_xor(q, 16); q += __shfl_xor(q, 32); if (fq == 0) *(GAS float*)(ssp + (size_t)row * 16 + u.pn * 4 + wc) = q; } }
    }
};
struct EpiGU {
    static constexpr bool PERM = true;
    bf16* H; const float* rs3;
    DI void operator()(AccRef acc, const Unit& u, int wr, int wc, int fr, int fq) const {
        const int rl0 = wr * 64 + fr, col0 = u.ocol + wc * 32 + 8 * fq;
        int tk[2][4]; float sc[2][4];
#pragma unroll
        for (int ai = 0; ai < 2; ++ai)
#pragma unroll
            for (int m = 0; m < 4; ++m) { const int rl = rl0 + ai * 128 + m * 16; const int rc = rl < u.nvalid ? rl : u.nvalid - 1; tk[ai][m] = *(const GAS int*)(u.ridx + rc); }
#pragma unroll
        for (int ai = 0; ai < 2; ++ai)
#pragma unroll
            for (int m = 0; m < 4; ++m) sc[ai][m] = *(const GAS float*)(rs3 + tk[ai][m]);
#pragma unroll
        for (int ai = 0; ai < 2; ++ai)
#pragma unroll
            for (int m = 0; m < 4; ++m) { const int rl = rl0 + ai * 128 + m * 16; const float s = sc[ai][m];
                uchar* rowp = (uchar*)H + (size_t)(u.orow * 256 + rl) * DEXP + col0;
                f32x4 h0, h1;
#pragma unroll
                for (int j = 0; j < 4; ++j) { h0[j] = siluf_(acc[ai][0][m][0][j] * s) * (acc[ai][1][m][0][j] * s); h1[j] = siluf_(acc[ai][0][m][1][j] * s) * (acc[ai][1][m][1][j] * s); }
                u32x2 w; w.x = pk4_fp8(h0[0], h0[1], h0[2], h0[3]); w.y = pk4_fp8(h1[0], h1[1], h1[2], h1[3]);
                *(GAS u32x2*)rowp = w; }
    }
};
struct EpiPlain {
    static constexpr bool PERM = true;
    bf16* O; int ldc;
    DI void operator()(AccRef acc, const Unit& u, int wr, int wc, int fr, int fq) const {
        const int row0 = u.orow * 256 + wr * 64 + fr, col0 = u.ocol + wc * 32 + 8 * fq;
#pragma unroll
        for (int ai = 0; ai < 2; ++ai)
#pragma unroll
            for (int m = 0; m < 4; ++m) { bf16* rowp = O + (size_t)(row0 + ai * 128 + m * 16) * ldc + col0;
#pragma unroll
                for (int bj = 0; bj < 2; ++bj) { const f32x4 v0 = acc[ai][bj][m][0], v1 = acc[ai][bj][m][1];
                    u32x4 w; w.x = pk2(v0[0], v0[1]); w.y = pk2(v0[2], v0[3]); w.z = pk2(v1[0], v1[1]); w.w = pk2(v1[2], v1[3]);
                    *(GAS u32x4*)(rowp + bj * 128) = w; } }
    }
};
struct MoeOrder {
    const LAS int* ut; const int* ridx; int G, c; bool down;
    DI bool next(int i, Unit& u) const {
        if (i >= 16) return false;
        const u32x4 v = *(const LAS u32x4*)(ut + 4 * i);
        const int e = __builtin_amdgcn_readfirstlane((int)v.x), T = __builtin_amdgcn_readfirstlane((int)v.y), nv = __builtin_amdgcn_readfirstlane((int)v.z), ro = __builtin_amdgcn_readfirstlane((int)v.w);
        if (e < 0) return false;
        const int j = (i * G + c) & 3;
        u.ex = e; u.orow = T; u.nvalid = nv; u.ridx = ridx + ro;
        if (down) { u.pm = T; u.pn = e * 4 + j; u.ocol = 256 * j; } else { u.pm = 0; u.pn = e * 4 + j; u.ocol = 128 * j; }
        return true;
    }
};
#define SFENCE() do { asm volatile("" ::: "memory"); __builtin_amdgcn_sched_barrier(0); } while (0)
DI void conv_issue(u32x4 (&raw)[8], const bf16* src, int c, int tid) {
    const int dg = tid & 15, sg = tid >> 4;
#pragma unroll
    for (int r = 0; r < 8; ++r) { const int pos = c * 128 + 4 * sg - 2 + r; raw[r] = (u32x4){0u, 0u, 0u, 0u};
        if (pos >= 0 && pos < SEQ) raw[r] = *(const GAS u32x4*)(src + (size_t)pos * 128 + 8 * dg); }
}
DI void conv_build(LAS uchar* tile, const u32x4 (&raw)[8], int zcol0, const float* convw, const float* convb, float scale, int tid) {
    const int dg = tid & 15, sg = tid >> 4;
    f32x2 cw[5][4], cb[4];
#pragma unroll
    for (int j = 0; j < 5; ++j) { const f32x4 a = *(const GAS f32x4*)(convw + j * 1024 + zcol0 + 8 * dg), bq = *(const GAS f32x4*)(convw + j * 1024 + zcol0 + 8 * dg + 4);
        cw[j][0] = (f32x2){a.x, a.y}; cw[j][1] = (f32x2){a.z, a.w}; cw[j][2] = (f32x2){bq.x, bq.y}; cw[j][3] = (f32x2){bq.z, bq.w}; }
    { const f32x4 a = *(const GAS f32x4*)(convb + zcol0 + 8 * dg), bq = *(const GAS f32x4*)(convb + zcol0 + 8 * dg + 4);
        cb[0] = (f32x2){a.x, a.y}; cb[1] = (f32x2){a.z, a.w}; cb[2] = (f32x2){bq.x, bq.y}; cb[3] = (f32x2){bq.z, bq.w}; }
    f32x2 in[8][4];
#pragma unroll
    for (int r = 0; r < 8; ++r) { in[r][0] = (f32x2){bflo(raw[r].x), bfhi(raw[r].x)}; in[r][1] = (f32x2){bflo(raw[r].y), bfhi(raw[r].y)}; in[r][2] = (f32x2){bflo(raw[r].z), bfhi(raw[r].z)}; in[r][3] = (f32x2){bflo(raw[r].w), bfhi(raw[r].w)}; }
#pragma unroll
    for (int rr = 0; rr < 4; ++rr) { unsigned ow[4];
#pragma unroll
        for (int i = 0; i < 4; ++i) { f32x2 a = cb[i];
#pragma unroll
            for (int j = 0; j < 5; ++j) a = __builtin_elementwise_fma(in[rr + j][i], cw[j][i], a);
            ow[i] = pk2(siluf_(a.x) * scale, siluf_(a.y) * scale); }
        *(LAS u32x4*)(tile + offb(4 * sg + rr, dg)) = (u32x4){ow[0], ow[1], ow[2], ow[3]}; }
}
DI void build_copy_tile(LAS uchar* tile, const bf16* src, size_t row0, int ld, int col0, int tid) {
    const int dg = tid & 15, sg = tid >> 4;
#pragma unroll
    for (int rr = 0; rr < 4; ++rr) { const int r = 4 * sg + rr; *(LAS u32x4*)(tile + offb(r, dg)) = *(const GAS u32x4*)(src + (row0 + r) * (size_t)ld + col0 + 8 * dg); }
}

DI void scan_issue(u32x4 (&kr)[6], u32x4 (&vr)[4], const bf16* zk, const bf16* zv, int c, int dh, int tid) {
    const int dg = tid & 7, sg = tid >> 3;
#pragma unroll
    for (int r = 0; r < 6; ++r) { const int pos = c * 128 + 2 * sg - 2 + r; kr[r] = (u32x4){0u, 0u, 0u, 0u};
        if (pos >= 0 && pos < SEQ) kr[r] = *(const GAS u32x4*)(zk + (size_t)pos * 128 + 64 * dh + 8 * dg); }
    const int dg2 = tid & 15, sg2 = tid >> 4;
#pragma unroll
    for (int rr = 0; rr < 4; ++rr) vr[rr] = *(const GAS u32x4*)(zv + (size_t)(c * 128 + 4 * sg2 + rr) * 128 + 8 * dg2);
}
DI void scan_build(LAS uchar* TKW, LAS uchar* TV, const u32x4 (&kr)[6], const u32x4 (&vr)[4], const float (&cw)[5][8], const float (&cb)[8], const LAS float* alog, float mnew, int tid) {
    const int dg = tid & 7, sg = tid >> 3;
    float in[6][8];
#pragma unroll
    for (int r = 0; r < 6; ++r) { in[r][0] = bflo(kr[r].x); in[r][1] = bfhi(kr[r].x); in[r][2] = bflo(kr[r].y); in[r][3] = bfhi(kr[r].y); in[r][4] = bflo(kr[r].z); in[r][5] = bfhi(kr[r].z); in[r][6] = bflo(kr[r].w); in[r][7] = bfhi(kr[r].w); }
#pragma unroll
    for (int rr = 0; rr < 2; ++rr) { const float sc = 0.08838834764831845f * __expf(alog[2 * sg + rr] - mnew); float o[8];
#pragma unroll
        for (int i = 0; i < 8; ++i) { float a = cb[i];
#pragma unroll
            for (int j = 0; j < 5; ++j) a += in[rr + j][i] * cw[j][i];
            o[i] = siluf_(a) * sc; }
        u32x4 wv; wv.x = pk2(o[0], o[1]); wv.y = pk2(o[2], o[3]); wv.z = pk2(o[4], o[5]); wv.w = pk2(o[6], o[7]);
        *(LAS u32x4*)(TKW + offb(2 * sg + rr, dg)) = wv; }
    const int dg2 = tid & 15, sg2 = tid >> 4;
#pragma unroll
    for (int rr = 0; rr < 4; ++rr) *(LAS u32x4*)(TV + offb(4 * sg2 + rr, dg2)) = vr[rr];
}
DI void scan_gate_pre(float ig0, float ig1, float fp0, float fp1, int dir, LAS float* al, LAS float* Fv, LAS float* Mv, int lane) {
    const float lf0 = log_sigmoid(fp0), lf1 = log_sigmoid(fp1);
    const float incl = wscan_add(lf0 + lf1, lane);
    const float bf0 = incl - lf1, bf1 = incl, Ftot = __shfl(incl, 63);
    const float a0 = dir ? (bf0 - lf0 + ig0) : (Ftot - bf0 + ig0), a1 = dir ? (bf1 - lf1 + ig1) : (Ftot - bf1 + ig1);
    const float mloc = wave_max(fmaxf(a0, a1));
    al[2 * lane] = a0; al[2 * lane + 1] = a1;
    if (lane == 0) { *Fv = Ftot; *Mv = mloc; }
}
DI void mlstm_scan(Frame& F, int wgid) {
    int tid = F.tid, lane = F.lane; const int w = F.wave;
    const int seq = wgid >> 1, dh = wgid & 1;
    const int dir = seq & 1, h = (seq >> 1) & 3, b = seq >> 3;
    LAS float* AL = (LAS float*)(F.lds + 131072);
    LAS float* FV = AL + 32 * 128; LAS float* MV = FV + 32; LAS float* SC = MV + 32; LAS float* MN = SC + 32; LAS float* MP = MN + 32;
    const float* gates = (const float*)(F.ws + O_GATES);
    const size_t hoff = (size_t)(b * 4 + h) * SEQ * 128;
    const bf16* zk = (const bf16*)(F.ws + O_ZK) + hoff; const bf16* zv = (const bf16*)(F.ws + O_ZV) + hoff;
    float* mst = (float*)(F.ws + O_MST);
    float cw[5][8], cb[8];
    { const int ch0 = 512 + h * 128 + 64 * dh + 8 * (tid & 7);
#pragma unroll
      for (int j = 0; j < 5; ++j) { const f32x4 a = *(const GAS f32x4*)(INP(I_CONVW) + j * 1024 + ch0), bq = *(const GAS f32x4*)(INP(I_CONVW) + j * 1024 + ch0 + 4);
          cw[j][0] = a.x; cw[j][1] = a.y; cw[j][2] = a.z; cw[j][3] = a.w; cw[j][4] = bq.x; cw[j][5] = bq.y; cw[j][6] = bq.z; cw[j][7] = bq.w; }
      const f32x4 a = *(const GAS f32x4*)(INP(I_CONVB) + ch0), bq = *(const GAS f32x4*)(INP(I_CONVB) + ch0 + 4);
      cb[0] = a.x; cb[1] = a.y; cb[2] = a.z; cb[3] = a.w; cb[4] = bq.x; cb[5] = bq.y; cb[6] = bq.z; cb[7] = bq.w; }
    f32x4 acc[4], accn = (f32x4){0.f, 0.f, 0.f, 0.f};
#pragma unroll
    for (int mt = 0; mt < 4; ++mt) acc[mt] = (f32x4){0.f, 0.f, 0.f, 0.f};
    const bf16x8 ones = (bf16x8){0x3F80, 0x3F80, 0x3F80, 0x3F80, 0x3F80, 0x3F80, 0x3F80, 0x3F80};
    const int gi = dir * 8 + h, gf = dir * 8 + 4 + h;
#define SCAN_C(ci) (dir ? 31 - (ci) : (ci))
#pragma unroll 1
    for (int q = 0; q < 4; ++q) { const int ci = w + 8 * q; const size_t r_ = ((size_t)b * SEQ + SCAN_C(ci) * 128 + 2 * lane) * 16;
        scan_gate_pre(gates[r_ + gi], gates[r_ + 16 + gi], gates[r_ + gf], gates[r_ + 16 + gf], dir, AL + ci * 128, FV + ci, MV + ci, lane); }
    __syncthreads();
    if (tid == 0) { float m = -1e30f;
#pragma unroll 1
        for (int ci = 0; ci < 32; ++ci) { MP[ci] = m; const float fm = FV[ci] + m, mn = fmaxf(fm, MV[ci]); SC[ci] = __expf(fm - mn); MN[ci] = mn; m = mn; } }
    __syncthreads();
    if (dh == 0 && tid < 32) mst[seq * 32 + SCAN_C(tid)] = MP[tid];
    unsigned aK[4][2], aV[2];
    { const unsigned g = lane >> 4, q = (lane & 15) >> 2, p = lane & 3, bo = 8u * (p & 1);
#pragma unroll
      for (int mt = 0; mt < 4; ++mt) { aK[mt][0] = offb(8 * g + q, 2 * mt + (p >> 1)) + bo; aK[mt][1] = offb(8 * g + 4 + q, 2 * mt + (p >> 1)) + bo; }
      aV[0] = offb(8 * g + q, 2 * w + (p >> 1)) + bo; aV[1] = offb(8 * g + 4 + q, 2 * w + (p >> 1)) + bo; }
#define FRAG_PRE(tile, o0, o1, kk) ({ const s16x4 lo_ = __builtin_amdgcn_ds_read_tr16_b64_v4i16((LAS s16x4*)((tile) + (o0) + 8192 * (kk))); const s16x4 hi_ = __builtin_amdgcn_ds_read_tr16_b64_v4i16((LAS s16x4*)((tile) + (o1) + 8192 * (kk))); (bf16x8){lo_[0], lo_[1], lo_[2], lo_[3], hi_[0], hi_[1], hi_[2], hi_[3]}; })
    u32x4 krA[6], vrA[4], krB[6], vrB[4];
    scan_issue(krB, vrB, zk, zv, SCAN_C(0), dh, tid);
    scan_issue(krA, vrA, zk, zv, SCAN_C(1), dh, tid);
    __syncthreads();
    scan_build(F.lds, F.lds + 32768, krB, vrB, cw, cb, AL, MN[0], tid);
    scan_issue(krB, vrB, zk, zv, SCAN_C(2), dh, tid);
    __syncthreads();
#define SCAN_ITER(ci, KRN, VRN) do { \
        const int c = SCAN_C(ci); \
        asm volatile("" : "+v"(tid), "+v"(lane)); \
        GASK uchar* wsl_ = (GASK uchar*)F.ws; asm volatile("" : "+s"(wsl_)); \
        const bf16* zk = (const bf16*)((uchar*)wsl_ + O_ZK) + hoff; const bf16* zv = (const bf16*)((uchar*)wsl_ + O_ZV) + hoff; bf16* cst = (bf16*)((uchar*)wsl_ + O_CST); float* nst = (float*)((uchar*)wsl_ + O_NST); \
        LAS uchar* TKW = F.lds + ((ci) & 1) * 65536; LAS uchar* TV = TKW + 32768; \
        { bf16* cp = cst + ((size_t)seq * 32 + c) * 16384; \
          _Pragma("unroll") for (int mt = 0; mt < 4; ++mt) { const int d = 64 * dh + 16 * mt + 4 * (lane >> 4), e = 16 * w + (lane & 15); \
              u32x2 v; v.x = pk2(acc[mt][0], acc[mt][1]); v.y = pk2(acc[mt][2], acc[mt][3]); *(GAS u32x2*)(cp + e * 128 + d) = v; } \
          if (w < 4 && (lane & 15) == 0) *(GAS f32x4*)(nst + ((size_t)seq * 32 + c) * 128 + 64 * dh + 16 * w + 4 * (lane >> 4)) = accn; } \
        if ((ci) + 1 < 32) { \
            scan_build(F.lds + (((ci) + 1) & 1) * 65536, F.lds + (((ci) + 1) & 1) * 65536 + 32768, KRN, VRN, cw, cb, AL + ((ci) + 1) * 128, MN[(ci) + 1], tid); \
            if ((ci) + 3 < 32) scan_issue(KRN, VRN, zk, zv, SCAN_C((ci) + 3), dh, tid); } \
        const float sc_old = SC[(ci)]; \
        _Pragma("unroll") for (int mt = 0; mt < 4; ++mt) acc[mt] *= sc_old; \
        accn *= sc_old; \
        _Pragma("unroll") for (int kk = 0; kk < 4; ++kk) { \
            const bf16x8 Yf = FRAG_PRE(TV, aV[0], aV[1], kk); \
            _Pragma("unroll") for (int mt = 0; mt < 4; ++mt) acc[mt] = mfma16(FRAG_PRE(TKW, aK[mt][0], aK[mt][1], kk), Yf, acc[mt]); \
            if (w < 4) accn = mfma16(FRAG_PRE(TKW, aV[0], aV[1], kk), ones, accn); \
            __builtin_amdgcn_sched_barrier(0); } \
        __syncthreads(); } while (0)
    for (int c2 = 0; c2 < 32; c2 += 2) { SCAN_ITER(c2, krA, vrA); SCAN_ITER(c2 + 1, krB, vrB); }
#undef SCAN_ITER
#undef FRAG_PRE
#undef SCAN_C
}

DI void gmlp_phase(Frame& F) {
    const int w = F.wave;
    const bf16* z = (const bf16*)(F.ws + O_Z); bf16* Y = (bf16*)(F.ws + O_Y); const bf16* wsb = (const bf16*)(F.ws + O_WSB);
    float lg[8], lb[8];
    { const f32x4 a = *(const GAS f32x4*)(INP(I_LNVG) + 8 * F.lane), bq = *(const GAS f32x4*)(INP(I_LNVG) + 8 * F.lane + 4), c = *(const GAS f32x4*)(INP(I_LNVB) + 8 * F.lane), d = *(const GAS f32x4*)(INP(I_LNVB) + 8 * F.lane + 4);
      lg[0] = a.x; lg[1] = a.y; lg[2] = a.z; lg[3] = a.w; lg[4] = bq.x; lg[5] = bq.y; lg[6] = bq.z; lg[7] = bq.w; lb[0] = c.x; lb[1] = c.y; lb[2] = c.z; lb[3] = c.w; lb[4] = d.x; lb[5] = d.y; lb[6] = d.z; lb[7] = d.w; }
    for (int unit = F.bid; unit < 512; unit += F.G) {
        int tid = F.tid, lane = F.lane; asm volatile("" : "+v"(tid), "+v"(lane));
        const size_t row0 = (size_t)unit * 128;
        u32x4 raw[16];
#pragma unroll
        for (int i = 0; i < 16; ++i) raw[i] = *(const GAS u32x4*)(z + (row0 + 16 * w + i) * ZG + 512 + 8 * lane);
#pragma unroll
        for (int i = 0; i < 16; ++i) { const int r = 16 * w + i;
            float v[8] = {bflo(raw[i].x), bfhi(raw[i].x), bflo(raw[i].y), bfhi(raw[i].y), bflo(raw[i].z), bfhi(raw[i].z), bflo(raw[i].w), bfhi(raw[i].w)};
            float s = 0.f;
#pragma unroll
            for (int q = 0; q < 8; ++q) s += v[q];
            const float mu = wave_sum(s) * (1.f / 512.f); float qq = 0.f;
#pragma unroll
            for (int q = 0; q < 8; ++q) { v[q] -= mu; qq += v[q] * v[q]; }
            const float rs = 1.0f / sqrtf(wave_sum(qq) * (1.f / 512.f) + LN_EPS);
#pragma unroll
            for (int q = 0; q < 8; ++q) v[q] = v[q] * rs * lg[q] + lb[q];
            u32x4 wv; wv.x = pk2(v[0], v[1]); wv.y = pk2(v[2], v[3]); wv.z = pk2(v[4], v[5]); wv.w = pk2(v[6], v[7]);
            *(LAS u32x4*)(F.lds + (lane >> 4) * 32768 + offb(r, lane & 15)) = wv; }
        __syncthreads();
        const int tl = 16 * w + (lane & 15); const size_t row = row0 + tl;
        bf16x8 Yw[2][4]; u32x2 gu[2][8];
#define GM_ISSUE(g, sl) do { _Pragma("unroll") for (int kk = 0; kk < 4; ++kk) Yw[sl][kk] = *(const GAS bf16x8*)(wsb + ((size_t)(g) * 128 + tl) * 128 + 32 * kk + 8 * (lane >> 4)); \
        _Pragma("unroll") for (int mt = 0; mt < 8; ++mt) gu[sl][mt] = *(const GAS u32x2*)(z + row * ZG + (g) * 128 + 16 * mt + 4 * (lane >> 4)); } while (0)
        GM_ISSUE(0, 0);
#pragma unroll
        for (int g = 0; g < 4; ++g) {
            const int sl = g & 1;
            if (g < 3) GM_ISSUE(g + 1, sl ^ 1);
            const LAS uchar* T_G = F.lds + g * 32768;
            f32x4 acc[8];
#pragma unroll
            for (int mt = 0; mt < 8; ++mt) acc[mt] = (f32x4){0.f, 0.f, 0.f, 0.f};
#pragma unroll
            for (int kk = 0; kk < 4; ++kk) {
#pragma unroll
                for (int mt = 0; mt < 8; ++mt) acc[mt] = mfma16(frag_tr(T_G, 32 * kk, 16 * mt, lane), Yw[sl][kk], acc[mt]);
                __builtin_amdgcn_sched_barrier(0); }
            const float bs = INP(I_BS)[g * 128 + tl];
#pragma unroll
            for (int mt = 0; mt < 8; ++mt) { const int d = 16 * mt + 4 * (lane >> 4); const u32x2 gv2 = gu[sl][mt];
                u32x2 o; o.x = pk2(bflo(gv2.x) * (acc[mt][0] + bs), bfhi(gv2.x) * (acc[mt][1] + bs)); o.y = pk2(bflo(gv2.y) * (acc[mt][2] + bs), bfhi(gv2.y) * (acc[mt][3] + bs));
                *(GAS u32x2*)(Y + row * DM + 512 + g * 128 + d) = o; }
        }
#undef GM_ISSUE
        __syncthreads();
    }
}

DI void phase2(Frame& F) {
    for (int s = F.bid; s < 256; s += F.G) mlstm_scan(F, s);
    gmlp_phase(F);
}

DI void mlstm_out_phase(Frame& F) {
  constexpr int NU3 = NB * 4 * 32;
  const int w = F.wave;
  u32x4 qraw[8];
  if (F.bid < NU3) { const int u0 = F.bid; const size_t ho = (size_t)(u0 >> 5) * SEQ * 128;
      conv_issue(qraw, (const bf16*)(F.ws + O_ZQ) + ho, u0 & 31, F.tid); }
  for (int unit = F.bid; unit < NU3; unit += F.G) {
    int tid = F.tid, lane = F.lane; asm volatile("" : "+v"(tid), "+v"(lane));
    const int c = unit & 31, h = (unit >> 5) & 3, b = unit >> 7;
    const size_t row0 = (size_t)b * SEQ + c * 128;
    LAS uchar* T_Q = F.lds; LAS uchar* T_K = F.lds + 32768; LAS uchar* T_V = F.lds + 65536; LAS uchar* T_C = F.lds + 98304;
    LAS float* sm = (LAS float*)(F.lds + 131072);
    LAS float* gfa = sm, *gba = sm + 128, *Mfa = sm + 256, *Mba = sm + 384, *sIf = sm + 512, *sIb = sm + 640, *enf = sm + 768, *enb = sm + 896, *nfa = sm + 1024, *nba = sm + 1152, *qnf = sm + 1280, *qnb = sm + 1408;
    const size_t hoff = (size_t)(b * 4 + h) * SEQ * 128;
    const bf16* zq = (const bf16*)(F.ws + O_ZQ) + hoff; const bf16* zk = (const bf16*)(F.ws + O_ZK) + hoff; const bf16* zv = (const bf16*)(F.ws + O_ZV) + hoff; const bf16* zo = (const bf16*)(F.ws + O_ZO) + hoff;
    const float* gates = (const float*)(F.ws + O_GATES);
    const bf16* cst = (const bf16*)(F.ws + O_CST); const float* nst = (const float*)(F.ws + O_NST); const float* mst = (const float*)(F.ws + O_MST);
    bf16* Y = (bf16*)(F.ws + O_Y);
    const int sqf = ((b * 4 + h) * 2 + 0) * 32 + c, sqb = ((b * 4 + h) * 2 + 1) * 32 + c;
    if (w < 2) {
        const float mpf = mst[sqf], mpb = mst[sqb];
        const size_t r0 = (row0 + 2 * lane) * 16, r1 = (row0 + 2 * lane + 1) * 16;
        if (w == 0) {
            const float ig0 = gates[r0 + h], ig1 = gates[r1 + h], lf0 = log_sigmoid(gates[r0 + 4 + h]), lf1 = log_sigmoid(gates[r1 + 4 + h]);
            const float incl = wscan_add(lf0 + lf1, lane), bf0 = incl - lf1, bf1 = incl;
            const float g0 = ig0 - bf0, g1 = ig1 - bf1;
            const float pin = wscan_max(fmaxf(g0, g1), lane); float pex = __shfl_up(pin, 1); if (lane == 0) pex = -3.0e38f;
            const float M0 = fmaxf(mpf, fmaxf(pex, g0)), M1 = fmaxf(mpf, pin);
            gfa[2 * lane] = g0; gfa[2 * lane + 1] = g1; Mfa[2 * lane] = M0; Mfa[2 * lane + 1] = M1;
            sIf[2 * lane] = __expf(mpf - M0); sIf[2 * lane + 1] = __expf(mpf - M1);
            enf[2 * lane] = __expf(-bf0 - M0); enf[2 * lane + 1] = __expf(-bf1 - M1);
        }
        else {
            const float ig0 = gates[r0 + 8 + h], ig1 = gates[r1 + 8 + h], lf0 = log_sigmoid(gates[r0 + 12 + h]), lf1 = log_sigmoid(gates[r1 + 12 + h]);
            const float incl = wscan_add(lf0 + lf1, lane), Ftot = __shfl(incl, 63);
            const float bb0 = Ftot - incl + lf0 + lf1, bb1 = Ftot - incl + lf1;
            const float g0 = ig0 - bb0, g1 = ig1 - bb1;
            const float sin_ = wscan_max_rev(fmaxf(g0, g1), lane); float sex = __shfl_down(sin_, 1); if (lane == 63) sex = -3.0e38f;
            const float M0 = fmaxf(mpb, sin_), M1 = fmaxf(mpb, fmaxf(sex, g1));
            gba[2 * lane] = g0; gba[2 * lane + 1] = g1; Mba[2 * lane] = M0; Mba[2 * lane + 1] = M1;
            sIb[2 * lane] = __expf(mpb - M0); sIb[2 * lane + 1] = __expf(mpb - M1);
            enb[2 * lane] = __expf(-bb0 - M0); enb[2 * lane + 1] = __expf(-bb1 - M1);
        }
    }
    if (tid < 128) { nfa[tid] = nst[(size_t)sqf * 128 + tid]; nba[tid] = nst[(size_t)sqb * 128 + tid]; }
    u32x4 kraw[8]; conv_issue(kraw, zk, c, tid);
    conv_build(T_Q, qraw, h * 128, INP(I_CONVW), INP(I_CONVB), 1.0f, tid);
    conv_build(T_K, kraw, 512 + h * 128, INP(I_CONVW), INP(I_CONVB), 0.08838834764831845f, tid);
    build_copy_tile(T_V, zv, (size_t)c * 128, 128, 0, tid);
    build_copy_tile(T_C, cst + (size_t)sqf * 16384, 0, 128, 0, tid);
    __syncthreads();
    {
        const int t = tid >> 2, part = tid & 3; float af = 0.f, ab = 0.f;
#pragma unroll
        for (int cc = 0; cc < 4; ++cc) { const u32x4 raw = *(const LAS u32x4*)(T_Q + offb(t, 4 * part + cc)); const int dd = 32 * part + 8 * cc;
            const float qv[8] = {bflo(raw.x), bfhi(raw.x), bflo(raw.y), bfhi(raw.y), bflo(raw.z), bfhi(raw.z), bflo(raw.w), bfhi(raw.w)};
#pragma unroll
            for (int i = 0; i < 8; ++i) { af += qv[i] * nfa[dd + i]; ab += qv[i] * nba[dd + i]; } }
        af += __shfl_xor(af, 1); af += __shfl_xor(af, 2); ab += __shfl_xor(ab, 1); ab += __shfl_xor(ab, 2);
        if (part == 0) { qnf[t] = af; qnb[t] = ab; }
    }
    u32x4 cbreg[4];
    { const int dg = tid & 15, sg = tid >> 4; const bf16* src = cst + (size_t)sqb * 16384;
#pragma unroll
      for (int rr = 0; rr < 4; ++rr) cbreg[rr] = *(const GAS u32x4*)(src + (size_t)(4 * sg + rr) * 128 + 8 * dg); }
    bf16x8 Qf[4];
#pragma unroll
    for (int kk = 0; kk < 4; ++kk) Qf[kk] = frag_row(T_Q, 16 * w, kk, lane);
    f32x4 aS[8];
#pragma unroll
    for (int mt = 0; mt < 8; ++mt) aS[mt] = (f32x4){0.f, 0.f, 0.f, 0.f};
#pragma unroll
    for (int kk = 0; kk < 4; ++kk) {
#pragma unroll
        for (int mt = 0; mt < 8; ++mt) aS[mt] = mfma16(frag_row(T_K, 16 * mt, kk, lane), Qf[kk], aS[mt]);
        __builtin_amdgcn_sched_barrier(0); }
    __syncthreads();
    const int tl = 16 * w + (lane & 15);
    float cf, cb_;
    {
        const float Mf = Mfa[tl], Mb = Mba[tl];
        f32x4 wf[8], wb[8]; float sumf = 0.f, sumb = 0.f;
#pragma unroll
        for (int mt = 0; mt < 8; ++mt) { const int s0 = 16 * mt + 4 * (lane >> 4); const f32x4 gf4 = *(const LAS f32x4*)(gfa + s0), gb4 = *(const LAS f32x4*)(gba + s0);
#pragma unroll
            for (int j = 0; j < 4; ++j) { const int s = s0 + j; const float sv = aS[mt][j];
                const float a = (s <= tl) ? __expf(gf4[j] - Mf) * sv : 0.f, bq = (s >= tl) ? __expf(gb4[j] - Mb) * sv : 0.f;
                wf[mt][j] = a; wb[mt][j] = bq; sumf += a; sumb += bq; } }
        sumf += __shfl_xor(sumf, 16); sumf += __shfl_xor(sumf, 32); sumb += __shfl_xor(sumb, 16); sumb += __shfl_xor(sumb, 32);
        const float sif = sIf[tl], sib = sIb[tl];
        const float denf = sumf + sif * qnf[tl], denb = sumb + sib * qnb[tl];
        const float rf = 1.0f / fmaxf(fabsf(denf), enf[tl]), rb = 1.0f / fmaxf(fabsf(denb), enb[tl]);
        cf = sif * rf; cb_ = sib * rb;
#pragma unroll
        for (int mt = 0; mt < 8; ++mt) { const int s0 = 16 * mt + 4 * (lane >> 4);
            u32x2 v; v.x = pk2(wf[mt][0] * rf + wb[mt][0] * rb, wf[mt][1] * rf + wb[mt][1] * rb); v.y = pk2(wf[mt][2] * rf + wb[mt][2] * rb, wf[mt][3] * rf + wb[mt][3] * rb);
            *(LAS u32x2*)(T_K + offb(tl, s0 >> 3) + (s0 & 7) * 2) = v; }
    }
    { const int nu = unit + F.G;
      if (nu < NU3) { const size_t ho = (size_t)(nu >> 5) * SEQ * 128; conv_issue(qraw, (const bf16*)(F.ws + O_ZQ) + ho, nu & 31, tid); } }
    f32x4 aO[8], aZ[8];
#pragma unroll
    for (int mt = 0; mt < 8; ++mt) { aO[mt] = (f32x4){0.f, 0.f, 0.f, 0.f}; aZ[mt] = (f32x4){0.f, 0.f, 0.f, 0.f}; }
#pragma unroll
    for (int kk = 0; kk < 4; ++kk) { const bf16x8 Yw = frag_row(T_K, 16 * w, kk, lane);
#pragma unroll
        for (int mt = 0; mt < 8; ++mt) aO[mt] = mfma16(frag_tr(T_V, 32 * kk, 16 * mt, lane), Yw, aO[mt]);
        __builtin_amdgcn_sched_barrier(0); }
#pragma unroll
    for (int kk = 0; kk < 4; ++kk) {
#pragma unroll
        for (int mt = 0; mt < 8; ++mt) aZ[mt] = mfma16(frag_row(T_C, 16 * mt, kk, lane), Qf[kk], aZ[mt]);
        __builtin_amdgcn_sched_barrier(0); }
#pragma unroll
    for (int mt = 0; mt < 8; ++mt) { aO[mt] += aZ[mt] * cf; aZ[mt] = (f32x4){0.f, 0.f, 0.f, 0.f}; }
    __syncthreads();
    { const int dg = tid & 15, sg = tid >> 4;
#pragma unroll
      for (int rr = 0; rr < 4; ++rr) *(LAS u32x4*)(T_C + offb(4 * sg + rr, dg)) = cbreg[rr]; }
    __syncthreads();
#pragma unroll
    for (int kk = 0; kk < 4; ++kk) {
#pragma unroll
        for (int mt = 0; mt < 8; ++mt) aZ[mt] = mfma16(frag_row(T_C, 16 * mt, kk, lane), Qf[kk], aZ[mt]);
        __builtin_amdgcn_sched_barrier(0); }
    u32x2 og[8];
#pragma unroll
    for (int mt = 0; mt < 8; ++mt) og[mt] = *(const GAS u32x2*)(zo + (size_t)(c * 128 + 16 * w + (lane & 15)) * 128 + 16 * mt + 4 * (lane >> 4));
    float ssq = 0.f;
#pragma unroll
    for (int mt = 0; mt < 8; ++mt) { aO[mt] += aZ[mt] * cb_; ssq += (aO[mt][0] * aO[mt][0] + aO[mt][1] * aO[mt][1]) + (aO[mt][2] * aO[mt][2] + aO[mt][3] * aO[mt][3]); }
    ssq += __shfl_xor(ssq, 16); ssq += __shfl_xor(ssq, 32);
    const float rinv = 1.0f / sqrtf(ssq * (1.f / 128.f) + RMS_EPS);
    const size_t row = row0 + tl;
#pragma unroll
    for (int mt = 0; mt < 8; ++mt) { const int e = 16 * mt + 4 * (lane >> 4);
        const u32x2 ogv = og[mt]; const f32x4 gh = *(const GAS f32x4*)(INP(I_GHEAD) + h * 128 + e);
        u32x2 o; o.x = pk2(bflo(ogv.x) * aO[mt][0] * rinv * gh.x, bfhi(ogv.x) * aO[mt][1] * rinv * gh.y); o.y = pk2(bflo(ogv.y) * aO[mt][2] * rinv * gh.z, bfhi(ogv.y) * aO[mt][3] * rinv * gh.w);
        *(GAS u32x2*)(Y + row * DM + h * 128 + e) = o; }
    __syncthreads();
  }
}
DI void kv_dma(LAS uchar* buf, const bf16* kv, int b, int col0, int w, int lane) {
#pragma unroll
    for (int i = 0; i < 8; ++i) { const int r = 32 * w + 4 * i + (lane >> 4); const int f = ((r & 3) << 2) | ((r >> 2) & 3);
        const bf16* src = kv + (size_t)(b * NMEM + r) * 2048 + col0 + 8 * ((lane & 15) ^ f);
        __builtin_amdgcn_global_load_lds((const unsigned*)src, (LAS unsigned*)(buf + 256 * (32 * w + 4 * i)), 16, 0, 0); }
}
#define DMA_WAIT() asm volatile("s_waitcnt vmcnt(0)" ::: "memory")
DI bf16x8 frag_tr_perm(const LAS uchar* tile, int k0, int c0, int lane) {
    const unsigned g = lane >> 4, q = (lane & 15) >> 2, p = lane & 3;
    const unsigned ch = (c0 >> 3) + (p >> 1), bo = 8u * (p & 1);
    const s16x4 lo = __builtin_amdgcn_ds_read_tr16_b64_v4i16((LAS s16x4*)(tile + offb(k0 + 4 * g + q, ch) + bo));
    const s16x4 hi = __builtin_amdgcn_ds_read_tr16_b64_v4i16((LAS s16x4*)(tile + offb(k0 + 16 + 4 * g + q, ch) + bo));
    return (bf16x8){lo[0], lo[1], lo[2], lo[3], hi[0], hi[1], hi[2], hi[3]};
}
DI void attn_phase(Frame& F) {
    const int w = F.wave;
    constexpr int NU = NB * 4 * 16;
    const bf16* Q = (const bf16*)(F.ws + O_Q); const bf16* kv = (const bf16*)(F.ws + O_KV); uchar* O = F.ws + O_O;
    LAS uchar* B0 = F.lds; LAS uchar* B1 = F.lds + 65536;
    const int vb = F.bid;
    if (vb < NU) { const int u0 = vb; kv_dma(B0, kv, u0 >> 6, ((u0 >> 4) & 3) * 256, w, F.lane); }
    DMA_WAIT(); __syncthreads();
    for (int unit = vb; unit < NU; unit += F.G) {
        int tid = F.tid, lane = F.lane; asm volatile("" : "+v"(tid), "+v"(lane));
        const int qb = unit & 15, hd = (unit >> 4) & 3, b = unit >> 6;
        const int nu = unit + F.G;
        const size_t qrow0 = (size_t)b * SEQ + qb * 256 + 32 * w + (lane & 15);
        f32x4 aS[2][16];
#pragma unroll
        for (int tb = 0; tb < 2; ++tb)
#pragma unroll
            for (int mt = 0; mt < 16; ++mt) aS[tb][mt] = (f32x4){0.f, 0.f, 0.f, 0.f};
        bf16x8 Qc[2], Qn[2];
#pragma unroll
        for (int tb = 0; tb < 2; ++tb) Qn[tb] = *(const GAS bf16x8*)(Q + (qrow0 + 16 * tb) * DM + hd * 256 + 8 * (lane >> 4));
#pragma unroll
        for (int dh = 0; dh < 2; ++dh) {
            const LAS uchar* KB = dh ? B1 : B0;
            if (dh == 0) kv_dma(B1, kv, b, hd * 256 + 128, w, lane);
            else kv_dma(B0, kv, b, 1024 + hd * 256, w, lane);
#pragma unroll
            for (int kk = 0; kk < 4; ++kk) { const int st = dh * 4 + kk;
                Qc[0] = Qn[0]; Qc[1] = Qn[1];
                if (st < 7) {
#pragma unroll
                    for (int tb = 0; tb < 2; ++tb) Qn[tb] = *(const GAS bf16x8*)(Q + (qrow0 + 16 * tb) * DM + hd * 256 + 32 * (st + 1) + 8 * (lane >> 4)); }
#pragma unroll
                for (int mh = 0; mh < 4; ++mh) {
#pragma unroll
                    for (int mq = 0; mq < 4; ++mq) { const int mt = 4 * mh + mq; const bf16x8 X = frag_row(KB, 16 * mt, kk, lane);
                        aS[0][mt] = mfma16(X, Qc[0], aS[0][mt]); aS[1][mt] = mfma16(X, Qc[1], aS[1][mt]); }
                    __builtin_amdgcn_sched_barrier(0); } }
            DMA_WAIT(); __syncthreads();
        }
        bf16x8 Pf[2][8]; float rinv[2];
#pragma unroll
        for (int tb = 0; tb < 2; ++tb) {
            float mx = -3.0e38f;
#pragma unroll
            for (int mt = 0; mt < 16; ++mt) mx = fmaxf(mx, fmaxf(fmaxf(aS[tb][mt][0], aS[tb][mt][1]), fmaxf(aS[tb][mt][2], aS[tb][mt][3])));
            mx = fmaxf(mx, __shfl_xor(mx, 16)); mx = fmaxf(mx, __shfl_xor(mx, 32));
            float sum = 0.f;
#pragma unroll
            for (int s = 0; s < 8; ++s) { f32x4 p0, p1;
#pragma unroll
                for (int j = 0; j < 4; ++j) { p0[j] = __expf(aS[tb][2 * s][j] - mx); p1[j] = __expf(aS[tb][2 * s + 1][j] - mx); sum += p0[j] + p1[j]; }
                u32x4 pk; pk.x = pk2(p0[0], p0[1]); pk.y = pk2(p0[2], p0[3]); pk.z = pk2(p1[0], p1[1]); pk.w = pk2(p1[2], p1[3]);
                Pf[tb][s] = __builtin_bit_cast(bf16x8, pk); }
            sum += __shfl_xor(sum, 16); sum += __shfl_xor(sum, 32);
            rinv[tb] = 1.0f / sum;
        }
#pragma unroll
        for (int eh = 0; eh < 2; ++eh) {
            const LAS uchar* VB = eh ? B1 : B0;
            if (eh == 0) kv_dma(B1, kv, b, 1024 + hd * 256 + 128, w, lane);
            else if (nu < NU) kv_dma(B0, kv, nu >> 6, ((nu >> 4) & 3) * 256, w, lane);
            f32x4 aO[2][8];
#pragma unroll
            for (int tb = 0; tb < 2; ++tb)
#pragma unroll
                for (int mt = 0; mt < 8; ++mt) aO[tb][mt] = (f32x4){0.f, 0.f, 0.f, 0.f};
#pragma unroll
            for (int s = 0; s < 8; ++s) {
#pragma unroll
                for (int mh = 0; mh < 2; ++mh) {
#pragma unroll
                    for (int mq = 0; mq < 4; ++mq) { const int mt = 4 * mh + mq; const bf16x8 X = frag_tr_perm(VB, 32 * s, 16 * mt, lane);
                        aO[0][mt] = mfma16(X, Pf[0][s], aO[0][mt]); aO[1][mt] = mfma16(X, Pf[1][s], aO[1][mt]); }
                    __builtin_amdgcn_sched_barrier(0); } }
#pragma unroll
            for (int tb = 0; tb < 2; ++tb)
#pragma unroll
                for (int mt = 0; mt < 8; ++mt) { const int e = 16 * mt + 4 * (lane >> 4); const float ri = rinv[tb];
                    *(GAS unsigned*)(O + (qrow0 + 16 * tb) * DM + hd * 256 + eh * 128 + e) = pk4_fp8(aO[tb][mt][0] * ri, aO[tb][mt][1] * ri, aO[tb][mt][2] * ri, aO[tb][mt][3] * ri); }
            DMA_WAIT(); __syncthreads();
        }
    }
}

DI void route_block(Frame& F, int blk) {
    const int tid = F.tid, lane = F.lane, w = F.wave;
    LAS float* lg = (LAS float*)F.lds + (size_t)w * (32 * 48);
    LAS int* tokE = (LAS int*)(F.lds + 147456);
    LAS int* tokR = tokE + 512;
    LAS int* wcnt = tokR + 512;
    LAS int* base = wcnt + 256;
    const bf16* x2 = (const bf16*)(F.ws + O_XB); float* rs3 = (float*)(F.ws + O_RS3); unsigned* tok = (unsigned*)(F.ws + O_TOK); int* ridx = (int*)(F.ws + O_RIDX);
    const bf16* wrh = (const bf16*)(F.ws + O_WRH); const bf16* wrl = (const bf16*)(F.ws + O_WRL);
    unsigned* cnt = (unsigned*)(F.ws + O_CTL) + CW_CNT;
    const int r16 = lane & 15, g4 = lane >> 4;
    const size_t row0 = (size_t)blk * 256 + 32 * w;
    f32x4 acc[3][2];
#pragma unroll
    for (int nb = 0; nb < 3; ++nb) { acc[nb][0] = (f32x4){0.f, 0.f, 0.f, 0.f}; acc[nb][1] = (f32x4){0.f, 0.f, 0.f, 0.f}; }
    float ss0 = 0.f, ss1 = 0.f;
    bf16x8 Yn[2], Xhn[3], Xln[3];
#define RT_LOAD(kk) do { _Pragma("unroll") for (int rb = 0; rb < 2; ++rb) Yn[rb] = *(const GAS bf16x8*)(x2 + (row0 + 16 * rb + r16) * DM + 32 * (kk) + 8 * g4); \
        _Pragma("unroll") for (int nb = 0; nb < 3; ++nb) { Xhn[nb] = *(const GAS bf16x8*)(wrh + (size_t)(16 * nb + r16) * 1024 + 32 * (kk) + 8 * g4); Xln[nb] = *(const GAS bf16x8*)(wrl + (size_t)(16 * nb + r16) * 1024 + 32 * (kk) + 8 * g4); } } while (0)
    RT_LOAD(0);
    for (int kk = 0; kk < 32; ++kk) {
        bf16x8 Y[2], Xh[3], Xl[3];
        Y[0] = Yn[0]; Y[1] = Yn[1];
#pragma unroll
        for (int nb = 0; nb < 3; ++nb) { Xh[nb] = Xhn[nb]; Xl[nb] = Xln[nb]; }
        if (kk + 1 < 32) RT_LOAD(kk + 1);
        { float xf[2][8];
#pragma unroll
          for (int rb = 0; rb < 2; ++rb) {
#pragma unroll
            for (int j = 0; j < 8; ++j) xf[rb][j] = bf2f((unsigned short)Y[rb][j]);
            u32x2 o8; o8.x = pk4_fp8(xf[rb][0], xf[rb][1], xf[rb][2], xf[rb][3]); o8.y = pk4_fp8(xf[rb][4], xf[rb][5], xf[rb][6], xf[rb][7]);
            *(GAS u32x2*)((uchar*)F.ws + O_X2F8 + (row0 + 16 * rb + r16) * DM + 32 * kk + 8 * g4) = o8; } }
#pragma unroll
        for (int j = 0; j < 8; ++j) { const float a = bf2f((unsigned short)Y[0][j]), c = bf2f((unsigned short)Y[1][j]); ss0 += a * a; ss1 += c * c; }
#pragma unroll
        for (int nb = 0; nb < 3; ++nb)
#pragma unroll
            for (int rb = 0; rb < 2; ++rb) { acc[nb][rb] = mfma16(Xh[nb], Y[rb], acc[nb][rb]); acc[nb][rb] = mfma16(Xl[nb], Y[rb], acc[nb][rb]); }
    }
#undef RT_LOAD
    ss0 += __shfl_xor(ss0, 16); ss0 += __shfl_xor(ss0, 32); ss1 += __shfl_xor(ss1, 16); ss1 += __shfl_xor(ss1, 32);
    const float rsA = 1.0f / sqrtf(ss0 * (1.f / DM) + RMS_EPS), rsB = 1.0f / sqrtf(ss1 * (1.f / DM) + RMS_EPS);
#pragma unroll
    for (int nb = 0; nb < 3; ++nb)
#pragma unroll
        for (int rb = 0; rb < 2; ++rb) { const float rs = rb ? rsB : rsA;
            *(LAS f32x4*)(lg + (16 * rb + r16) * 48 + 16 * nb + 4 * g4) = acc[nb][rb] * rs; }
    if (g4 == 0) { rs3[row0 + r16] = rsA; rs3[row0 + 16 + r16] = rsB; }
    LDS_WAIT(); asm volatile("" ::: "memory");
    if (lane < 32) {
        const LAS float* L = lg + lane * 48; const int rl = 32 * w + lane; const size_t m = row0 + lane;
        float l4[4];
#pragma unroll
        for (int j = 0; j < 4; ++j) l4[j] = L[j] + INP(I_BRG)[j];
        int gi = 0; float lm = l4[0];
#pragma unroll
        for (int j = 1; j < 4; ++j) if (l4[j] > lm) { lm = l4[j]; gi = j; }
        const float ptop = 1.0f / (__expf(l4[0] - lm) + __expf(l4[1] - lm) + __expf(l4[2] - lm) + __expf(l4[3] - lm));
        float le[8];
#pragma unroll
        for (int j = 0; j < 8; ++j) le[j] = L[16 + gi * 8 + j] + INP(I_BRE)[gi * 8 + j];
        int e0 = 0; float m0 = le[0];
#pragma unroll
        for (int j = 1; j < 8; ++j) if (le[j] > m0) { m0 = le[j]; e0 = j; }
        int e1 = -1; float m1 = -3.0e38f;
#pragma unroll
        for (int j = 0; j < 8; ++j) if (j != e0 && le[j] > m1) { m1 = le[j]; e1 = j; }
        const float t = __expf(m1 - m0), w0 = ptop / (1.0f + t), w1 = ptop * t / (1.0f + t);
        tokE[2 * rl] = gi * 8 + e0; tokE[2 * rl + 1] = gi * 8 + e1;
        tok[m * 8 + 4] = __float_as_uint(w0); tok[m * 8 + 5] = __float_as_uint(w1);
    }
    __syncthreads();
    {
        const int myE = tokE[tid]; int myR = 0;
        for (int e = 0; e < 32; ++e) { const unsigned long long mk = __ballot(myE == e); if (myE == e) myR = __popcll(mk & ((1ull << lane) - 1ull)); if (lane == 0) wcnt[w * 32 + e] = __popcll(mk); }
        __syncthreads();
        int add = 0;
        for (int ww = 0; ww < w; ++ww) add += wcnt[ww * 32 + myE];
        tokR[tid] = myR + add;
        if (tid < 32) { int tot = 0; for (int ww = 0; ww < 8; ++ww) tot += wcnt[ww * 32 + tid]; base[tid] = (int)__hip_atomic_fetch_add(cnt + tid, (unsigned)tot, __ATOMIC_RELAXED, __HIP_MEMORY_SCOPE_AGENT); }
        __syncthreads();
        const int pos = base[myE] + tokR[tid], m = blk * 256 + (tid >> 1);
        ridx[(size_t)myE * NTOK + pos] = m;
        tok[(size_t)m * 8 + (tid & 1) * 2 + 0] = (unsigned)myE; tok[(size_t)m * 8 + (tid & 1) * 2 + 1] = (unsigned)pos;
    }
    __syncthreads();
}
DI void phase8(Frame& F) {
    for (int blk = F.bid; blk < NTOK / 256; blk += F.G) route_block(F, blk);
}

DI void moe_tables(Frame& F, LAS int*& cum, LAS int*& cntl) {
    cum = (LAS int*)(F.lds + 131072); cntl = cum + 64;
    const unsigned* cnt = (const unsigned*)(F.ws + O_CTL) + CW_CNT;
    if (F.tid < 32) cntl[F.tid] = (int)__hip_atomic_load(cnt + F.tid, __ATOMIC_RELAXED, __HIP_MEMORY_SCOPE_AGENT);
    __syncthreads();
    if (F.tid == 0) { int a = 0; for (int e = 0; e < 32; ++e) { cum[e] = a; a += (cntl[e] + 255) >> 8; } cum[32] = a; }
    __syncthreads();
}

DI LAS int* moe_units(Frame& F, const LAS int* cum, const LAS int* cntl, int c) {
    LAS int* ut = (LAS int*)(F.lds + 131072 + 512);
    if (F.tid < 16) { const int L = F.tid * F.G + c, T = L >> 2; int e = -1, nv = 0, ro = 0;
        if (T < cum[32]) { e = 0; for (int k = 1; k < 32; ++k) e += (cum[k] <= T) ? 1 : 0;
            const int mt = T - cum[e]; nv = min(256, cntl[e] - mt * 256); ro = e * NTOK + mt * 256; }
        ut[4 * F.tid + 0] = e; ut[4 * F.tid + 1] = T; ut[4 * F.tid + 2] = nv; ut[4 * F.tid + 3] = ro; }
    __syncthreads();
    return ut;
}

DI void phase11(Frame& F) {
    LAS int* cum; LAS int* cntl; moe_tables(F, cum, cntl);
    const int gw = F.bid * NWAVES + F.wave, NGW = F.G * NWAVES, lane = F.lane;
    const unsigned* tok = (const unsigned*)(F.ws + O_TOK); const bf16* YD = (const bf16*)(F.ws + O_YD);
    f32x4 gfin[4];
#pragma unroll
    for (int j = 0; j < 4; ++j) gfin[j] = ((const f32x4*)INP(I_GFINAL))[lane + 64 * j];
    for (int m0 = gw; m0 < NTOK; m0 += 4 * NGW) {
        u32x4 ti[4]; unsigned tw0[4], tw1[4];
#pragma unroll
        for (int q = 0; q < 4; ++q) { const int m = m0 + q * NGW; ti[q] = *(const GAS u32x4*)(tok + (size_t)m * 8); tw0[q] = tok[(size_t)m * 8 + 4]; tw1[q] = tok[(size_t)m * 8 + 5]; }
        u32x2 xv[4][4]; u32x2 ya[4][4], yb[4][4];
#pragma unroll
        for (int q = 0; q < 4; ++q) { const int m = m0 + q * NGW;
            const size_t s0 = (size_t)cum[ti[q].x] * 256 + ti[q].y, s1 = (size_t)cum[ti[q].z] * 256 + ti[q].w;
            const u32x2* xr = (const u32x2*)((const bf16*)(F.ws + O_XB) + (size_t)m * DM) + lane;
            const u32x2* y0 = (const u32x2*)(YD + s0 * DM) + lane; const u32x2* y1 = (const u32x2*)(YD + s1 * DM) + lane;
#pragma unroll
            for (int j = 0; j < 4; ++j) { xv[q][j] = xr[64 * j]; ya[q][j] = y0[64 * j]; yb[q][j] = y1[64 * j]; } }
#pragma unroll
        for (int q = 0; q < 4; ++q) { const int m = m0 + q * NGW;
            const float w0 = __uint_as_float(tw0[q]), w1 = __uint_as_float(tw1[q]);
            f32x4* xr = (f32x4*)(F.out + (size_t)m * DM) + lane;
            f32x4 v[4]; float s = 0.f;
#pragma unroll
            for (int j = 0; j < 4; ++j) { const u32x2 a = ya[q][j], bq = yb[q][j];
                f32x4 mo; mo.x = w0 * bflo(a.x) + w1 * bflo(bq.x); mo.y = w0 * bfhi(a.x) + w1 * bfhi(bq.x); mo.z = w0 * bflo(a.y) + w1 * bflo(bq.y); mo.w = w0 * bfhi(a.y) + w1 * bfhi(bq.y);
                v[j] = (f32x4){bflo(xv[q][j].x), bfhi(xv[q][j].x), bflo(xv[q][j].y), bfhi(xv[q][j].y)} + mo; s += (v[j].x * v[j].x + v[j].y * v[j].y) + (v[j].z * v[j].z + v[j].w * v[j].w); }
            const float rs = 1.0f / sqrtf(wave_sum(s) * (1.f / DM) + RMS_EPS);
#pragma unroll
            for (int j = 0; j < 4; ++j) xr[64 * j] = v[j] * rs * gfin[j]; }
    }
}
typedef GAS unsigned gu32;
#define RLX_AGENT __ATOMIC_RELAXED, __HIP_MEMORY_SCOPE_AGENT
#define XB_TMO      128
#define XB_XCNT(j)  (256  + 64 * (j))
#define XB_XSUB(j)  (1280 + 64 * (j))
#define XB_XGEN(j)  (2304 + 64 * (j))
#define XB_TOP      3328
#define XB_TOPGEN   3392
#define XCD_BAR_WORDS 3456
#define XB_SPIN_CAP (1u << 18)

__device__ __forceinline__ unsigned xb_ld(unsigned* p)              { return __hip_atomic_load(p, __ATOMIC_RELAXED, __HIP_MEMORY_SCOPE_AGENT); }
__device__ __forceinline__ unsigned xb_add(unsigned* p, unsigned v) { return __hip_atomic_fetch_add(p, v, __ATOMIC_RELAXED, __HIP_MEMORY_SCOPE_AGENT); }
__device__ __forceinline__ unsigned xb_xcc_id() { return (unsigned)__builtin_amdgcn_s_getreg((3 << 11) | 20) & 0xFu; }
#define XB_SPIN(cond, bar) do { unsigned _sp = 0; while (cond) { __builtin_amdgcn_s_sleep(1); \
    if ((++_sp & 255u) == 0u) { if (xb_ld(&(bar)[XB_TMO])) break; if (_sp > XB_SPIN_CAP) { atomicAdd(&(bar)[XB_TMO], 1u); break; } } } } while (0)

struct XcdBarrier {
    unsigned* bar; unsigned x;
    volatile LAS unsigned* st;
};

__device__ __forceinline__ XcdBarrier xcd_barrier_post(unsigned* bar, volatile LAS unsigned* st) {
    XcdBarrier b; b.bar = bar; b.x = xb_xcc_id(); b.st = st;
    if (threadIdx.x == 0) (void)xb_add(&bar[XB_XCNT(b.x)], 1u);
    return b;
}
__device__ __forceinline__ void xcd_barrier_complete(unsigned* bar, unsigned x, unsigned& nloc, unsigned& nx) {
    const unsigned G = gridDim.x * gridDim.y * gridDim.z;
    unsigned sum, cnt, mine, sp = 0u;
    for (;;) {
        sum = 0u; cnt = 0u; mine = 0u;
#pragma unroll
        for (unsigned j = 0; j < 16; ++j) { const unsigned c = xb_ld(&bar[XB_XCNT(j)]); sum += c; cnt += (c > 0u) ? 1u : 0u; mine = (j == x) ? c : mine; }
        if (sum == G) break;
        __builtin_amdgcn_s_sleep(1);
        if ((++sp & 255u) == 0u) { if (xb_ld(&bar[XB_TMO])) break; if (sp > XB_SPIN_CAP) { atomicAdd(&bar[XB_TMO], 1u); break; } }
    }
    nloc = mine > 0u ? mine : 1u; nx = cnt > 0u ? cnt : 1u;
}

__device__ __forceinline__ void xcd_barrier(const XcdBarrier& b) {
    asm volatile("s_waitcnt vmcnt(0)" ::: "memory");
    __syncthreads();
    if (threadIdx.x == 0) {
        unsigned* bar = b.bar;
        __builtin_amdgcn_s_waitcnt(0);
        unsigned nloc = b.st[0], nx = b.st[1];
        if (nloc == 0u) { xcd_barrier_complete(bar, b.x, nloc, nx); b.st[0] = nloc; b.st[1] = nx; }
        const unsigned old = xb_add(&bar[XB_XSUB(b.x)], 1u);
        const unsigned gen = old / nloc;
        if (old + 1u == (gen + 1u) * nloc) {
            __builtin_amdgcn_fence(__ATOMIC_RELEASE, "agent");
            asm volatile("s_waitcnt vmcnt(0)" ::: "memory");
            const unsigned og = xb_add(&bar[XB_TOP], 1u);
            const unsigned tg = og / nx;
            if (og + 1u == (tg + 1u) * nx) xb_add(&bar[XB_TOPGEN], 1u);
            else XB_SPIN(xb_ld(&bar[XB_TOPGEN]) == tg, bar);
            __builtin_amdgcn_fence(__ATOMIC_ACQUIRE, "agent");
            xb_add(&bar[XB_XGEN(b.x)], 1u);
            asm volatile("s_waitcnt vmcnt(0)" ::: "memory");
        } else {
            XB_SPIN(xb_ld(&bar[XB_XGEN(b.x)]) == gen, bar);
            __builtin_amdgcn_fence(__ATOMIC_ACQUIRE, "agent");
            asm volatile("s_waitcnt vmcnt(0)" ::: "memory");
        }
    }
    __syncthreads();
}

#ifndef MK_N_LAUNCHES
#define MK_N_LAUNCHES 1
#define DOUBLE_MASK 0
#endif
constexpr int N_PHASES = 12;

__global__ void __launch_bounds__(NTHR, 2) hybrid_fwd(Args args) {
    extern __shared__ __attribute__((aligned(16))) uchar lds_raw[];
    Frame F;
    F.lds = (LAS uchar*)lds_raw;
    F.tid = threadIdx.x; F.lane = F.tid & 63; F.wave = __builtin_amdgcn_readfirstlane(F.tid >> 6);
    F.G = gridDim.x; F.bid = blockIdx.x;
    F.in = args.in;
    F.out = (float*)args.out; F.ws = (uchar*)args.ws;
    uchar* ws = (uchar*)args.ws;
    const int lo = args.ph_lo, hi = args.ph_hi;
    volatile LAS unsigned* MISC = (volatile LAS unsigned*)(F.lds + LDS_BYTES - 256);
    if (F.tid < 64) MISC[F.tid] = 0u;
    __syncthreads();
    XcdBarrier bar; bar.bar = (unsigned*)((uchar*)args.ws + O_CTL) + CW_BAR; bar.x = 0; bar.st = MISC + 8;
    if (hi - lo > 1) bar = xcd_barrier_post((unsigned*)((uchar*)args.ws + O_CTL) + CW_BAR, MISC + 8);
#ifndef PHASE_MASK
#define PHASE_MASK 0xFFF
#endif
#ifndef DOUBLE_MASK
#define DOUBLE_MASK 0
#endif
#define IN(k) (((PHASE_MASK >> (k)) & 1) && lo <= (k) && (k) < hi)
#define REP(k) for (int rep_ = 0; rep_ < 1 + ((DOUBLE_MASK >> (k)) & 1); ++rep_)
#if defined(__HIP_DEVICE_COMPILE__)
#define ASSUME_GLOBAL(p) __builtin_assume(!__builtin_amdgcn_is_shared((const void*)(p)) && !__builtin_amdgcn_is_private((const void*)(p)))
#else
#define ASSUME_GLOBAL(p) ((void)0)
#endif
#define OPQ() do { GASK uchar* w_ = args.ws; GASK float* o_ = args.out; asm volatile("" : "+s"(w_), "+s"(o_)); ws = (uchar*)w_; F.ws = ws; F.out = (float*)o_; } while (0)
#define SEAM(k) do { OPQ(); if (lo <= (k) && (k) + 1 < hi) { xcd_barrier(bar); } } while (0)
    using pg8::Gemm; using pg8::StaticOrder; using pg8::gemm_phase;
#ifndef TSEL
#define TSEL (-1)
#endif
    unsigned long long tq0 = 0, tq1 = 0;
#ifdef TPROBE
#define TQ0(k) do { if ((k) == TSEL) { if (F.tid == 0) { *(volatile LAS unsigned long long*)(F.lds + LDS_BYTES - 256 + 128) = 0ull; *(volatile LAS unsigned long long*)(F.lds + LDS_BYTES - 256 + 136) = 0ull; } } } while (0)
#define TQ1(k) do { if ((k) == TSEL) { tq0 = 0; tq1 = *(volatile LAS unsigned long long*)(F.lds + LDS_BYTES - 256 + 128); } } while (0)
#else
#define TQ0(k) do { if ((k) == TSEL) tq0 = __builtin_amdgcn_s_memrealtime(); } while (0)
#define TQ1(k) do { if ((k) == TSEL) tq1 = __builtin_amdgcn_s_memrealtime(); } while (0)
#endif

    TQ0(0);
    if (IN(0)) REP(0) phase0(F);
    SEAM(0); TQ1(0);
    TQ0(1);
    if (IN(1)) REP(1) {
        { Gemm g{(const bf16*)(ws + O_XB), (const bf16*)(ws + O_WIN), NTOK, ZC, DM}; StaticOrder S; S.init(NTOK, ZC, F.G, F.bid);
          EpiRowScale<0> E{(bf16*)(ws + O_Z), ZG, (const float*)(ws + O_RS0), 1.0f};
          gemm_phase<EpiRowScale<0>, StaticOrder, true, true, false>(F.lds, g, S, E); }
        { Gemm g{(const bf16*)(ws + O_MEMB), (const bf16*)(ws + O_WKV), NMROWS, 2048, DM}; StaticOrder S; S.init(NMROWS, 2048, F.G, F.bid);
          EpiRowScale<1> E{(bf16*)(ws + O_KV), 2048, (const float*)(ws + O_RSM), 1.0f};
          gemm_phase<EpiRowScale<1>, StaticOrder, true, true, false>(F.lds, g, S, E); }
    }
    SEAM(1); TQ1(1);
    TQ0(2);
    if (IN(2)) REP(2) phase2(F);
    SEAM(2); TQ1(2);
    TQ0(3);
    if (IN(3)) REP(3) mlstm_out_phase(F);
    SEAM(3); TQ1(3);
    TQ0(4);
    if (IN(4)) REP(4) {
        Gemm g{(const bf16*)(ws + O_Y), (const bf16*)(ws + O_WOUT), NTOK, DM, DM}; StaticOrder S; S.init(NTOK, DM, F.G, F.bid);
        EpiRes<true, true, true> E{nullptr, (bf16*)(ws + O_XB), (float*)(ws + O_SS1), ws + O_X1F8};
        gemm_phase<EpiRes<true, true, true>, StaticOrder, true, true, false>(F.lds, g, S, E);
    }
    SEAM(4); TQ1(4);
    TQ0(5);
    if (IN(5)) REP(5) {
        Gemm g{(const bf16*)(ws + O_X1F8), (const bf16*)(ws + O_WQ), NTOK, DM, DM, SC_ONE, SC_W}; StaticOrder S; S.init(NTOK, DM, F.G, F.bid);
        EpiQ E{(bf16*)(ws + O_Q), (const float*)(ws + O_SS1), 0.0625f};
#if defined(KREP_PROBE) && KREP_PROBE == 5
        g.krep = 2; g.scale_a = 0x7E7E7E7E;
#endif
        gemm_phase<EpiQ, StaticOrder, true, true, false, true>(F.lds, g, S, E);
    }
    SEAM(5); TQ1(5);
    TQ0(6);
    if (IN(6)) REP(6) attn_phase(F);
    SEAM(6); TQ1(6);
    TQ0(7);
    if (IN(7)) REP(7) {
        Gemm g{(const bf16*)(ws + O_O), (const bf16*)(ws + O_WO), NTOK, DM, DM, SC_ONE, SC_W}; StaticOrder S; S.init(NTOK, DM, F.G, F.bid);
        EpiRes<true, false, false> E{nullptr, (bf16*)(ws + O_XB), nullptr, nullptr};
#if defined(KREP_PROBE) && KREP_PROBE == 7
        g.krep = 2; g.scale_a = 0x7E7E7E7E;
#endif
        gemm_phase<EpiRes<true, false, false>, StaticOrder, true, true, false, true>(F.lds, g, S, E);
    }
    SEAM(7); TQ1(7);
    TQ0(8);
    if (IN(8)) REP(8) phase8(F);
    SEAM(8); TQ1(8);
    TQ0(9);
    if (IN(9)) REP(9) {
        LAS int* cum; LAS int* cntl; moe_tables(F, cum, cntl);
        const int vb = xcd_major(F.bid, F.G);
        MoeOrder S{moe_units(F, cum, cntl, vb), (const int*)(ws + O_RIDX), F.G, vb, false};
        Gemm g{(const bf16*)(ws + O_X2F8), (const bf16*)(ws + O_WGU8), NTOK, NEXP * 1024, DM, SC_ONE, SC_W};
        EpiGU E{(bf16*)(ws + O_H), (const float*)(ws + O_RS3)};
#if defined(KREP_PROBE) && KREP_PROBE == 9
        g.krep = 2; g.scale_a = 0x7E7E7E7E;
#endif
        gemm_phase<EpiGU, MoeOrder, true, true, true, true>(F.lds, g, S, E);
    }
    SEAM(9); TQ1(9);
    TQ0(10);
    if (IN(10)) REP(10) {
        LAS int* cum; LAS int* cntl; moe_tables(F, cum, cntl);
        const int vb = xcd_major(F.bid, F.G);
        MoeOrder S{moe_units(F, cum, cntl, vb), (const int*)(ws + O_RIDX), F.G, vb, true};
        Gemm g{(const bf16*)(ws + O_H), (const bf16*)(ws + O_WD8), MAXSLOTS, NEXP * 1024, DEXP, SC_ONE, SC_W};
        EpiPlain E{(bf16*)(ws + O_YD), DM};
#if defined(KREP_PROBE) && KREP_PROBE == 10
        g.krep = 2; g.scale_a = 0x7E7E7E7E;
#endif
        gemm_phase<EpiPlain, MoeOrder, true, true, false, true>(F.lds, g, S, E);
    }
    SEAM(10); TQ1(10);
    TQ0(11);
    if (IN(11)) REP(11) phase11(F);
    TQ1(11);
    if (TSEL >= 0 && F.bid == 0 && F.tid == 0) { const unsigned long long tgt = __builtin_amdgcn_s_memrealtime() + 4ull * (tq1 - tq0); while (__builtin_amdgcn_s_memrealtime() < tgt) __builtin_amdgcn_s_sleep(16); }
#undef IN
#undef SEAM
}

extern "C" void kernel_launch(void* const* d_in, const int* in_sizes, int n_in, void* d_out, int out_size, void* d_ws, size_t ws_size, hipStream_t stream) {
    static int grid = 0;
    if (grid == 0) {
        if (n_in != 27 || in_sizes[0] != NTOK * DM || out_size != NTOK * DM || ws_size < WS_NEED) { fprintf(stderr, "kernel_launch: unexpected shapes (n_in %d, in0 %d, out %d, ws %zu); nothing launched\n", n_in, n_in > 0 ? in_sizes[0] : -1, out_size, ws_size); grid = -1; return; }
        int dev = 0, cus = 0, per_cu = 0;
        if (hipGetDevice(&dev) != hipSuccess || hipDeviceGetAttribute(&cus, hipDeviceAttributeMultiprocessorCount, dev) != hipSuccess) { fprintf(stderr, "kernel_launch: device query failed\n"); grid = -1; return; }
        if (hipFuncSetAttribute((const void*)hybrid_fwd, hipFuncAttributeMaxDynamicSharedMemorySize, LDS_BYTES) != hipSuccess) { fprintf(stderr, "kernel_launch: hipFuncSetAttribute failed\n"); grid = -1; return; }
        if (hipOccupancyMaxActiveBlocksPerMultiprocessor(&per_cu, (const void*)hybrid_fwd, NTHR, LDS_BYTES) != hipSuccess || per_cu < 1) { fprintf(stderr, "kernel_launch: occupancy query says %d\n", per_cu); per_cu = 1; }
        (void)hipGetLastError();
        grid = cus * per_cu;
        if (grid > 256) grid = 256;
    }
    if (grid < 0) return;
    (void)hipMemsetAsync((char*)d_ws + O_CTL, 0, CTL_BYTES, stream);
    Args a{};
    for (int i = 0; i < 27; ++i) a.in[i] = (const GASK float*)d_in[i];
    a.out = (GASK float*)d_out; a.ws = (GASK uchar*)d_ws;
#if MK_N_LAUNCHES == 1
    a.ph_lo = 0; a.ph_hi = N_PHASES;
    hipLaunchKernelGGL(hybrid_fwd, dim3(grid), dim3(NTHR), LDS_BYTES, stream, a);
#else
    for (int p = 0; p < N_PHASES; ++p) { a.ph_lo = p; a.ph_hi = p + 1; hipLaunchKernelGGL(hybrid_fwd, dim3(grid), dim3(NTHR), LDS_BYTES, stream, a); }
#endif
}
```

```cpp
#include <hip/hip_runtime.h>
#include <cstdio>
#include <cstdint>
#define MK_N_LAUNCHES 1
#define DOUBLE_MASK 0
namespace pg8 {
#define PG8_LAS __attribute__((address_space(3)))
typedef unsigned short bf16_t;
typedef short bf16x8 __attribute__((ext_vector_type(8)));
typedef float f32x4 __attribute__((ext_vector_type(4)));
typedef unsigned u32x4 __attribute__((ext_vector_type(4)));
typedef unsigned u32x2 __attribute__((ext_vector_type(2)));
constexpr int BM = 256, BK = 64, HALF = 128, HTB = HALF * BK * 2  , STAGE_BYTES = 8 * HTB, NXCD = 8, WGM = 16;

__host__ __device__ __forceinline__ int lds_byte(int r, int c) { const int st = (r >> 4) * 2 + (c >> 5), rr = r & 15, cc = c & 31, ob = rr * 64 + cc * 2; return st * 1024 + (ob ^ (((ob >> 9) & 1) << 5)); }
__host__ __device__ __forceinline__ void stage_rc(int b, int& R, int& C) { const int st = b / 1024, sb = b % 1024, swz = sb ^ (((sb >> 9) & 1) << 5); R = (st >> 1) * 16 + swz / 64; C = (st & 1) * 32 + (swz % 64) / 2; }
__host__ __device__ __forceinline__ int perm32(int rho) { const int n = rho >> 4, i = rho & 15; return 8 * (i >> 2) + 4 * n + (i & 3); }

struct Unit { int pm, pn; const int* ridx; int nvalid; int orow, ocol, ex; };
struct Gemm { const bf16_t* A; const bf16_t* Bt; int M, N, K; int scale_a, scale_b; int krep = 1; };

struct StaticOrder {
    int nM, nN, nwg, G, c;
    __host__ __device__ void init(int M, int N, int G_, int c_) { nM = M / BM; nN = N / BM; nwg = nM * nN; G = G_; c = c_; }
    __host__ __device__ bool next(int i, Unit& u) const {
        const long L = (long)i * G + c; if (L >= nwg) return false;
        int wgid = (int)L; { const int q = nwg / NXCD, r = nwg % NXCD, xcd = wgid % NXCD, off = wgid / NXCD; wgid = (xcd < r ? xcd * (q + 1) : r * (q + 1) + (xcd - r) * q) + off; }
        const int nig = WGM * nN, gid = wgid / nig, fm = gid * WGM, gsz = (nM - fm) < WGM ? (nM - fm) : WGM;
        u.pm = fm + ((wgid % nig) % gsz); u.pn = (wgid % nig) / gsz; u.ridx = nullptr; u.nvalid = 256; u.orow = u.pm; u.ocol = u.pn * BM; u.ex = 0; return true;
    }
};

__device__ __forceinline__ unsigned cvt_pk_bf16(float lo, float hi) { unsigned r; asm("v_cvt_pk_bf16_f32 %0, %1, %2" : "=v"(r) : "v"(lo), "v"(hi)); return r; }

template <class Epi, class Sched, bool ALIGN_EPI, bool SP2, bool GATHER, bool FP8 = false>
__device__ __forceinline__ void gemm_phase(PG8_LAS unsigned char* lds, const Gemm g, const Sched& S, const Epi& E) {
    const int tid = threadIdx.x, wid = __builtin_amdgcn_readfirstlane(tid >> 6), lane = tid & 63, wr = wid >> 2, wc = wid & 3, fr = lane & 15, fq = lane >> 4;
    const int K = FP8 ? g.K / 2 : g.K, nt = K / BK;
    unsigned voffA[2], voffB[2];
#pragma unroll
    for (int i = 0; i < 2; ++i) { int R, C; stage_rc(tid * 16 + i * 8192, R, C); const int Rb = Epi::PERM ? ((R & ~31) + perm32(R & 31)) : R;
        voffA[i] = (unsigned)(R * K + C) * 2u; voffB[i] = (unsigned)(Rb * K + C) * 2u; }
    const size_t kstep = (size_t)(BK * 2);
    const size_t hstepB = (size_t)HALF * K * 2;
    const size_t hstepA = GATHER ? (size_t)0 : hstepB;
    const size_t tstep = 2 * hstepB;
    const unsigned ldsw = (unsigned)wid * 1024u;
    const int aoff = lds_byte(wr * 64 + fr, fq * 8), boff = lds_byte(wc * 32 + fr, fq * 8);
    unsigned vgC[2][2], vgN[2][2];
#define PG8_SA(b, h) (((b) * 2 + (h)) * HTB)
#define PG8_SB(b, h) ((4 + (b) * 2 + (h)) * HTB)
#define PG8_STAGE(bufoff, gbase, voff) do { _Pragma("unroll") for (int _i = 0; _i < 2; ++_i) \
        __builtin_amdgcn_global_load_lds((const unsigned*)((const char*)(gbase) + (voff)[_i]), (PG8_LAS unsigned*)(lds + (bufoff) + ldsw + _i * 8192), 16, 0, 0); } while (0)
#define PG8_STAGE_A(bufoff, gbase, h, nx) do { if constexpr (GATHER) { unsigned _v[2]; _v[0] = (nx) ? vgN[h][0] : vgC[h][0]; _v[1] = (nx) ? vgN[h][1] : vgC[h][1]; PG8_STAGE(bufoff, gbase, _v); } \
        else { PG8_STAGE(bufoff, (gbase) + (h) * hstepA, voffA); } } while (0)
#define PG8_GOFF(dst, u) do { _Pragma("unroll") for (int _h = 0; _h < 2; ++_h) _Pragma("unroll") for (int _i = 0; _i < 2; ++_i) { int _R, _C; stage_rc(tid * 16 + _i * 8192, _R, _C); int _r = _h * HALF + _R; _r = _r < (u).nvalid ? _r : (u).nvalid - 1; \
        dst[_h][_i] = (unsigned)(u).ridx[_r] * (unsigned)(K * 2) + (unsigned)(_C * 2); } } while (0)
#define PG8_CAT(lo, hi) __builtin_shufflevector(lo, hi, 0, 1, 2, 3, 4, 5, 6, 7)
#define PG8_LDA(dst, b, h) do { _Pragma("unroll") for (int m = 0; m < 4; ++m) { if constexpr (FP8) { dst##8[m] = PG8_CAT(*(const PG8_LAS i32x4_*)(lds + PG8_SA(b, h) + aoff + m * 2048), *(const PG8_LAS i32x4_*)(lds + PG8_SA(b, h) + aoff + m * 2048 + 1024)); } \
        else { _Pragma("unroll") for (int k = 0; k < 2; ++k) dst[m][k] = *(const PG8_LAS bf16x8*)(lds + PG8_SA(b, h) + aoff + m * 2048 + k * 1024); } } } while (0)
#define PG8_LDB(dst, b, h) do { _Pragma("unroll") for (int n = 0; n < 2; ++n) { if constexpr (FP8) { dst##8[n] = PG8_CAT(*(const PG8_LAS i32x4_*)(lds + PG8_SB(b, h) + boff + n * 2048), *(const PG8_LAS i32x4_*)(lds + PG8_SB(b, h) + boff + n * 2048 + 1024)); } \
        else { _Pragma("unroll") for (int k = 0; k < 2; ++k) dst[n][k] = *(const PG8_LAS bf16x8*)(lds + PG8_SB(b, h) + boff + n * 2048 + k * 1024); } } } while (0)
#define PG8_MMA(ai, bj, At, Bt) do { __builtin_amdgcn_s_setprio(1); _Pragma("unroll") for (int m = 0; m < 4; ++m) _Pragma("unroll") for (int n = 0; n < 2; ++n) { \
        if constexpr (FP8) { asm volatile("v_mfma_scale_f32_16x16x128_f8f6f4 %0, %1, %2, %0, %3, %4 op_sel_hi:[0,0,0]" : "+v"(acc[ai][bj][m][n]) : "v"(Bt##8[n]), "v"(At##8[m]), "v"(scb_), "v"(sca_)); } \
        else { _Pragma("unroll") for (int k = 0; k < 2; ++k) acc[ai][bj][m][n] = __builtin_amdgcn_mfma_f32_16x16x32_bf16(Bt[n][k], At[m][k], acc[ai][bj][m][n], 0, 0, 0); } } \
        if constexpr (FP8) { asm volatile("s_nop 15\n\ts_nop 3" ::: "memory"); } \
        __builtin_amdgcn_s_setprio(0); } while (0)
#define PG8_WAIT_V(n) asm volatile("s_waitcnt vmcnt(" #n ")" ::: "memory")
#define PG8_WAIT_L(n) asm volatile("s_waitcnt lgkmcnt(" #n ")" ::: "memory")
#define PG8_BAR __builtin_amdgcn_s_barrier()
#define PG8_SCHED __builtin_amdgcn_sched_barrier(0)
    Unit cur, nxt; int ui = 0;
#if defined(TPROBE) && TPROBE <= 6
    volatile PG8_LAS unsigned long long* tpv = (volatile PG8_LAS unsigned long long*)(lds + 163840 - 256 + 128);
#define PG8_TP_MARK(k) do { if (FP8 && (TPROBE == (k) || ((k) == 1 && TPROBE == 2)) && tid == 0) tpv[1] = __builtin_amdgcn_s_memrealtime(); } while (0)
#define PG8_TP_END(k) do { if (FP8 && TPROBE == (k) && tid == 0) { tpv[0] = tpv[0] + (__builtin_amdgcn_s_memrealtime() - tpv[1]); tpv[1] = 0ull; } } while (0)
#define PG8_TP_FIRST do { if (FP8 && (TPROBE == 1 || TPROBE == 3) && tid == 0) { const unsigned long long m_ = tpv[1]; if (m_ != 0ull) { tpv[0] = tpv[0] + (__builtin_amdgcn_s_memrealtime() - m_); tpv[1] = 0ull; } } } while (0)
#else
#define PG8_TP_MARK(k) ((void)0)
#define PG8_TP_END(k) ((void)0)
#define PG8_TP_FIRST ((void)0)
#endif
    if (!S.next(0, cur)) return;
    PG8_TP_MARK(6);
    f32x4 acc[2][2][4][2];
#pragma unroll
    for (int a = 0; a < 2; ++a)
#pragma unroll
        for (int b = 0; b < 2; ++b)
#pragma unroll
            for (int m = 0; m < 4; ++m)
#pragma unroll
                for (int n = 0; n < 2; ++n) acc[a][b][m][n] = (f32x4){0.f, 0.f, 0.f, 0.f};
    typedef int i32x8_ __attribute__((ext_vector_type(8))); typedef int i32x4_ __attribute__((ext_vector_type(4)));
    int sca_ = g.scale_a, scb_ = g.scale_b; asm volatile("" : "+v"(sca_), "+v"(scb_));
    bf16x8 At[4][2], B0[2][2], B1[2][2]; i32x8_ At8[4], B08[2], B18[2];
    const char* cA = GATHER ? (const char*)g.A : (const char*)g.A + (size_t)cur.pm * tstep; const char* cB = (const char*)g.Bt + (size_t)cur.pn * tstep;
    if constexpr (GATHER) { PG8_GOFF(vgC, cur); }
    if constexpr (SP2) {
        PG8_STAGE(PG8_SB(0, 0), cB, voffB); PG8_STAGE(PG8_SB(0, 1), cB + hstepB, voffB); PG8_STAGE_A(PG8_SA(0, 0), cA, 0, false); PG8_STAGE_A(PG8_SA(0, 1), cA, 1, false);
        if (wr == 1) PG8_BAR;
        PG8_WAIT_V(2); PG8_BAR;
        PG8_STAGE(PG8_SB(1, 0), cB + kstep, voffB); PG8_STAGE_A(PG8_SA(1, 0), cA + kstep, 0, false); PG8_STAGE(PG8_SB(1, 1), cB + hstepB + kstep, voffB);
        PG8_WAIT_V(6); PG8_BAR;
    } else {
        PG8_STAGE(PG8_SB(0, 0), cB, voffB); PG8_STAGE_A(PG8_SA(0, 0), cA, 0, false); PG8_STAGE(PG8_SB(0, 1), cB + hstepB, voffB); PG8_STAGE_A(PG8_SA(0, 1), cA, 1, false);
        if (wr == 1) PG8_BAR;
        PG8_WAIT_V(4); PG8_BAR;
        PG8_STAGE(PG8_SB(1, 0), cB + kstep, voffB); PG8_STAGE_A(PG8_SA(1, 0), cA + kstep, 0, false); PG8_STAGE(PG8_SB(1, 1), cB + hstepB + kstep, voffB);
        PG8_WAIT_V(6); PG8_BAR;
    }
    for (;;) {
        const bool has_next = S.next(ui + 1, nxt);
        const char* nA = GATHER ? (const char*)g.A : (has_next ? (const char*)g.A + (size_t)nxt.pm * tstep : cA); const char* nB = has_next ? (const char*)g.Bt + (size_t)nxt.pn * tstep : cB;
        if constexpr (GATHER) { if (has_next) { PG8_GOFF(vgN, nxt); } else {
#pragma unroll
            for (int _h = 0; _h < 2; ++_h) { vgN[_h][0] = vgC[_h][0]; vgN[_h][1] = vgC[_h][1]; } } }
        PG8_TP_MARK(5);
#ifdef KREP_PROBE
        const int ntt = nt * g.krep;
#pragma unroll 1
        for (int tt = 0; tt < ntt; tt += 2) {
            const int t = tt & (nt - 1), t2 = (t + 2) & (nt - 1);
            const bool last = (tt == ntt - 2);
            const char* a1 = cA + (size_t)(t + 1) * kstep;
            const char* a2 = last ? nA : cA + (size_t)t2 * kstep; const char* b2 = last ? nB : cB + (size_t)t2 * kstep;
#else
#pragma unroll 1
        for (int t = 0; t < nt; t += 2) {
            const bool last = (t == nt - 2);
            const char* a1 = cA + (size_t)(t + 1) * kstep;
            const char* a2 = last ? nA : cA + (size_t)(t + 2) * kstep; const char* b2 = last ? nB : cB + (size_t)(t + 2) * kstep;
#endif
            const char* a3 = a2 + kstep; const char* b3 = b2 + kstep;
            if constexpr (SP2) {
            PG8_LDB(B0, 0, 0); PG8_LDB(B1, 0, 1); PG8_SCHED; PG8_LDA(At, 0, 0); PG8_STAGE_A(PG8_SA(1, 1), a1, 1, false);
            PG8_WAIT_V(8); PG8_WAIT_L(0); PG8_BAR; PG8_TP_FIRST; PG8_MMA(0, 0, At, B0); PG8_MMA(0, 1, At, B1); PG8_BAR; PG8_SCHED;
            PG8_LDA(At, 0, 1); PG8_STAGE(PG8_SB(0, 0), b2, voffB); PG8_STAGE(PG8_SB(0, 1), b2 + hstepB, voffB); PG8_STAGE_A(PG8_SA(0, 0), a2, 0, last);
            PG8_WAIT_V(8); PG8_WAIT_L(0); PG8_BAR; PG8_MMA(1, 0, At, B0); PG8_MMA(1, 1, At, B1); PG8_BAR; PG8_SCHED;
            PG8_LDB(B0, 1, 0); PG8_LDB(B1, 1, 1); PG8_SCHED; PG8_LDA(At, 1, 0); PG8_STAGE_A(PG8_SA(0, 1), a2, 1, last);
            PG8_WAIT_V(8); PG8_WAIT_L(0); PG8_BAR; PG8_MMA(0, 0, At, B0); PG8_MMA(0, 1, At, B1); PG8_BAR; PG8_SCHED;
            PG8_LDA(At, 1, 1); PG8_STAGE(PG8_SB(1, 0), b3, voffB); PG8_STAGE(PG8_SB(1, 1), b3 + hstepB, voffB); PG8_STAGE_A(PG8_SA(1, 0), a3, 0, last);
            PG8_WAIT_V(8); PG8_WAIT_L(0); PG8_BAR; PG8_MMA(1, 0, At, B0); PG8_MMA(1, 1, At, B1); PG8_BAR; PG8_SCHED;
            } else {
            PG8_LDB(B0, 0, 0); PG8_SCHED; PG8_LDA(At, 0, 0); PG8_STAGE_A(PG8_SA(1, 1), a1, 1, false);
            PG8_WAIT_L(8); PG8_BAR; PG8_WAIT_L(0); PG8_MMA(0, 0, At, B0); PG8_BAR; PG8_SCHED;
            PG8_LDB(B1, 0, 1); PG8_STAGE(PG8_SB(0, 0), b2, voffB);
            PG8_BAR; PG8_WAIT_L(0); PG8_MMA(0, 1, At, B1); PG8_BAR;
            PG8_LDA(At, 0, 1); PG8_STAGE_A(PG8_SA(0, 0), a2, 0, last);
            PG8_BAR; PG8_WAIT_L(0); PG8_MMA(1, 0, At, B0); PG8_BAR; PG8_SCHED;
            PG8_STAGE(PG8_SB(0, 1), b2 + hstepB, voffB);
            PG8_WAIT_V(6); PG8_BAR; PG8_MMA(1, 1, At, B1); PG8_BAR;
            PG8_LDB(B0, 1, 0); PG8_SCHED; PG8_LDA(At, 1, 0); PG8_STAGE_A(PG8_SA(0, 1), a2, 1, last);
            PG8_WAIT_L(8); PG8_BAR; PG8_WAIT_L(0); PG8_MMA(0, 0, At, B0); PG8_BAR; PG8_SCHED;
            PG8_LDB(B1, 1, 1); PG8_STAGE(PG8_SB(1, 0), b3, voffB);
            PG8_BAR; PG8_WAIT_L(0); PG8_MMA(0, 1, At, B1); PG8_BAR;
            PG8_LDA(At, 1, 1); PG8_STAGE_A(PG8_SA(1, 0), a3, 0, last);
            PG8_BAR; PG8_WAIT_L(0); PG8_MMA(1, 0, At, B0); PG8_BAR; PG8_SCHED;
            PG8_STAGE(PG8_SB(1, 1), b3 + hstepB, voffB);
            PG8_WAIT_V(6); PG8_BAR; PG8_MMA(1, 1, At, B1); PG8_BAR;
            }
        }
        PG8_TP_END(5);
        PG8_TP_MARK(1);
        if constexpr (ALIGN_EPI) { if (wr == 0) PG8_BAR; }
        PG8_TP_MARK(4);
        E(acc, cur, wr, wc, fr, fq);
        PG8_TP_END(2); PG8_TP_END(4); PG8_TP_MARK(3);
        if (!has_next) break;
#pragma unroll
        for (int a = 0; a < 2; ++a)
#pragma unroll
            for (int b = 0; b < 2; ++b)
#pragma unroll
                for (int m = 0; m < 4; ++m)
#pragma unroll
                    for (int n = 0; n < 2; ++n) acc[a][b][m][n] = (f32x4){0.f, 0.f, 0.f, 0.f};
        cur = nxt; cA = nA; cB = nB; ++ui;
        if constexpr (GATHER) {
#pragma unroll
            for (int _h = 0; _h < 2; ++_h) { vgC[_h][0] = vgN[_h][0]; vgC[_h][1] = vgN[_h][1]; } }
        if constexpr (ALIGN_EPI) { if (wr == 1) PG8_BAR; }
    }
    PG8_WAIT_V(0);
    if constexpr (!ALIGN_EPI) { if (wr == 0) PG8_BAR; }
    PG8_BAR;
    PG8_TP_END(6);
#undef PG8_TP_MARK
#undef PG8_TP_END
#undef PG8_TP_FIRST
#undef PG8_SA
#undef PG8_SB
#undef PG8_STAGE
#undef PG8_STAGE_A
#undef PG8_GOFF
#undef PG8_LDA
#undef PG8_CAT
#undef PG8_LDB
#undef PG8_MMA
#undef PG8_WAIT_V
#undef PG8_WAIT_L
#undef PG8_BAR
#undef PG8_SCHED
}
}
#define DI __device__ __forceinline__
#define LAS __attribute__((address_space(3)))
typedef unsigned short bf16;
typedef short bf16x8 __attribute__((ext_vector_type(8)));
typedef short s16x4 __attribute__((ext_vector_type(4)));
typedef float f32x4 __attribute__((ext_vector_type(4)));
typedef float f32x2 __attribute__((ext_vector_type(2)));
typedef unsigned u32x4 __attribute__((ext_vector_type(4)));
typedef unsigned u32x2 __attribute__((ext_vector_type(2)));
typedef unsigned char uchar;

constexpr int NB = 16, SEQ = 4096, DM = 1024, NTOK = NB * SEQ;
constexpr int NMEM = 256, NMROWS = NB * NMEM;
constexpr int ZC = 3072;
constexpr int NEXP = 32, DEXP = 512;
constexpr int MAXTILES = 544, MAXSLOTS = MAXTILES * 256;
constexpr float RMS_EPS = 1e-6f, LN_EPS = 1e-5f;
constexpr int NWAVES = 8, NTHR = 512;
constexpr int LDS_BYTES = 163840;

constexpr size_t MiB = 1u << 20;
constexpr size_t O_CTL = 0, CTL_BYTES = 64 * 1024;
constexpr size_t O_RS0 = 1 * MiB, O_RSM = O_RS0 + 256 * 1024, O_RS3 = O_RS0 + 512 * 1024;
constexpr size_t O_GATES = 2 * MiB;
constexpr size_t O_SS1 = 6 * MiB;
constexpr size_t O_TOK = 10 * MiB;
constexpr size_t O_RIDX = 12 * MiB;
constexpr size_t O_NST = 20 * MiB, O_MST = 22 * MiB;
constexpr size_t O_WSB = 23 * MiB;
constexpr size_t O_WRH = 24 * MiB, O_WRL = O_WRH + 128 * 1024;
constexpr size_t O_WIN = 32 * MiB, O_WOUT = 38 * MiB, O_WQ = 40 * MiB, O_WKV = 42 * MiB, O_WO = 46 * MiB, O_WGU = 48 * MiB, O_WD = 112 * MiB;
constexpr size_t O_XB = 160 * MiB;
constexpr size_t O_MEMB = 288 * MiB, O_KV = 296 * MiB;
constexpr size_t O_Z = 320 * MiB;
constexpr size_t O_ZQ = 448 * MiB, O_ZK = 512 * MiB, O_ZV = 576 * MiB, O_ZO = 640 * MiB;
constexpr int ZG = 1024;
constexpr size_t O_CST = 704 * MiB;
constexpr size_t O_Y = 840 * MiB;
constexpr size_t O_Q = O_Z, O_O = O_Z + 128 * MiB;
constexpr size_t O_H = O_Z, O_YD = O_Z + 144 * MiB;
constexpr size_t O_WGU8 = O_WGU, O_WD8 = O_WGU + 32 * MiB;
constexpr size_t O_X1F8 = 576 * MiB;
constexpr size_t O_X2F8 = O_Y;
constexpr int SC_ONE = 0x7F7F7F7F, SC_X32 = (int)0x84848484, SC_W = 0x7A7A7A7A;
constexpr size_t WS_NEED = 968 * MiB;
constexpr int CW_CNT = 0, CW_BAR = 4096;
constexpr int CW_CNT_UNUSED = 0;

#define LDS_WAIT() asm volatile("s_waitcnt lgkmcnt(0)" ::: "memory")
DI unsigned f2bf(float f) { unsigned u = __builtin_bit_cast(unsigned, f); return (u + 0x7fffu + ((u >> 16) & 1u)) >> 16; }
DI unsigned pk2(float lo, float hi) { return pg8::cvt_pk_bf16(lo, hi); }
DI unsigned pk4_fp8(float a, float b, float c, float d) { int t = __builtin_amdgcn_cvt_pk_fp8_f32(a, b, 0, false); t = __builtin_amdgcn_cvt_pk_fp8_f32(c, d, t, true); return (unsigned)t; }
DI float bf2f(unsigned short h) { return __builtin_bit_cast(float, (unsigned)h << 16); }
DI float bflo(unsigned w) { return __builtin_bit_cast(float, w << 16); }
DI float bfhi(unsigned w) { return __builtin_bit_cast(float, w & 0xffff0000u); }
#define DPP_F(old, src, ctrl, rm) __builtin_bit_cast(float, __builtin_amdgcn_update_dpp(__builtin_bit_cast(int, (float)(old)), __builtin_bit_cast(int, (float)(src)), ctrl, rm, 0xF, false))
DI float wave_sum(float v) {
    v += DPP_F(0.f, v, 0xB1, 0xF); v += DPP_F(0.f, v, 0x4E, 0xF); v += DPP_F(0.f, v, 0x141, 0xF); v += DPP_F(0.f, v, 0x140, 0xF);
    v += DPP_F(0.f, v, 0x142, 0xA); v += DPP_F(0.f, v, 0x143, 0xC);
    return __builtin_bit_cast(float, __builtin_amdgcn_readlane(__builtin_bit_cast(int, v), 63));
}
DI float wave_max(float v) {
    v = fmaxf(v, DPP_F(v, v, 0xB1, 0xF)); v = fmaxf(v, DPP_F(v, v, 0x4E, 0xF)); v = fmaxf(v, DPP_F(v, v, 0x141, 0xF)); v = fmaxf(v, DPP_F(v, v, 0x140, 0xF));
    v = fmaxf(v, DPP_F(v, v, 0x142, 0xA)); v = fmaxf(v, DPP_F(v, v, 0x143, 0xC));
    return __builtin_bit_cast(float, __builtin_amdgcn_readlane(__builtin_bit_cast(int, v), 63));
}
DI float wscan_add(float v, int lane) {
#pragma unroll
    for (int o = 1; o < 64; o <<= 1) { const float u = __shfl_up(v, o); v = (lane >= o) ? v + u : v; }
    return v;
}
DI float wscan_max(float v, int lane) {
#pragma unroll
    for (int o = 1; o < 64; o <<= 1) { const float u = __shfl_up(v, o); v = (lane >= o) ? fmaxf(v, u) : v; }
    return v;
}
DI float wscan_max_rev(float v, int lane) {
#pragma unroll
    for (int o = 1; o < 64; o <<= 1) { const float u = __shfl_down(v, o); v = (lane + o < 64) ? fmaxf(v, u) : v; }
    return v;
}
DI float fast_exp(float x) { return __expf(x); }
DI float sigmoidf_(float x) { return __builtin_amdgcn_rcpf(1.0f + __expf(-x)); }
DI float siluf_(float x) { return x * __builtin_amdgcn_rcpf(1.0f + __expf(-x)); }
DI float gelu_tanh(float x) { const float u = 0.7978845608028654f * (x + 0.044715f * x * x * x); return x * __builtin_amdgcn_rcpf(1.0f + __expf(-2.0f * u)); }
DI float log_sigmoid(float x) { return fminf(x, 0.f) - __logf(1.0f + __expf(-fabsf(x))); }

DI unsigned offb(unsigned row, unsigned ch) { return 256u * row + 16u * (ch ^ (((row & 3u) << 2) | ((row >> 2) & 3u))); }
DI bf16x8 frag_row(const LAS uchar* tile, int r0, int kk, int lane) { return *(const LAS bf16x8*)(tile + offb(r0 + (lane & 15), 4 * kk + (lane >> 4))); }
DI bf16x8 frag_tr(const LAS uchar* tile, int k0, int c0, int lane) {
    const unsigned g = lane >> 4, q = (lane & 15) >> 2, p = lane & 3;
    const unsigned ch = (c0 >> 3) + (p >> 1), bo = 8u * (p & 1);
    const s16x4 lo = __builtin_amdgcn_ds_read_tr16_b64_v4i16((LAS s16x4*)(tile + offb(k0 + 8 * g + q, ch) + bo));
    const s16x4 hi = __builtin_amdgcn_ds_read_tr16_b64_v4i16((LAS s16x4*)(tile + offb(k0 + 8 * g + 4 + q, ch) + bo));
    return (bf16x8){lo[0], lo[1], lo[2], lo[3], hi[0], hi[1], hi[2], hi[3]};
}
DI f32x4 mfma16(bf16x8 x, bf16x8 y, f32x4 acc) { return __builtin_amdgcn_mfma_f32_16x16x32_bf16(x, y, acc, 0, 0, 0); }

#if defined(__HIP_DEVICE_COMPILE__)
#define GASK __attribute__((address_space(1)))
#else
#define GASK
#endif
struct Args { const GASK float* in[27]; GASK float* out; GASK uchar* ws; int ph_lo, ph_hi; };
struct Frame {
    LAS uchar* lds;
    int tid, lane, wave, G, bid;
    const GASK float* const* in;
    float* out; uchar* ws;
};
#define GAS __attribute__((address_space(1)))
#define INP(i) ((const float*)F.in[i])
enum { I_X = 0, I_MEM, I_GMIX, I_WIN, I_CONVW, I_CONVB, I_GATEB, I_GHEAD, I_LNVG, I_LNVB, I_WS, I_BS, I_WOUT, I_GXATTN, I_GMEM, I_WQ, I_WKV, I_WO, I_GMOE, I_WRG, I_BRG, I_WRE, I_BRE, I_WGATE, I_WUP, I_WDOWN, I_GFINAL };
DI int xcd_major(int bid, int G) { return (G & 7) == 0 ? (bid & 7) * (G >> 3) + (bid >> 3) : bid; }

struct P0Item { const float* W; const float* gain; bf16* WT; size_t drow0; int K, ldw, scol0, k0, f8; };
DI void p0_decode(Frame& F, int it, P0Item& I) {
    uchar* ws = F.ws;
    constexpr int I_IN = 16 * 96, I_SQ = 16 * 32, I_KV = 16 * 64, I_GU = 32 * 16 * 16;
    int r = it;
    if (r < I_IN) { const int kb = r / 96, nb = r % 96; I = P0Item{INP(I_WIN), INP(I_GMIX), (bf16*)(ws + O_WIN), (size_t)nb * 32, 1024, 3088, nb * 32 < 2048 ? nb * 32 : nb * 32 + 16, kb * 64, 0}; return; } r -= I_IN;
    if (r < I_SQ) { const int kb = r / 32, nb = r % 32; I = P0Item{INP(I_WOUT), nullptr, (bf16*)(ws + O_WOUT), (size_t)nb * 32, 1024, 1024, nb * 32, kb * 64, 0}; return; } r -= I_SQ;
    if (r < I_SQ) { const int kb = r / 32, nb = r % 32; I = P0Item{INP(I_WQ), INP(I_GXATTN), (bf16*)(ws + O_WQ), (size_t)nb * 32, 1024, 1024, nb * 32, kb * 64, 1}; return; } r -= I_SQ;
    if (r < I_KV) { const int kb = r / 64, nb = r % 64; I = P0Item{INP(I_WKV), INP(I_GMEM), (bf16*)(ws + O_WKV), (size_t)nb * 32, 1024, 2048, nb * 32, kb * 64, 0}; return; } r -= I_KV;
    if (r < I_SQ) { const int kb = r / 32, nb = r % 32; I = P0Item{INP(I_WO), nullptr, (bf16*)(ws + O_WO), (size_t)nb * 32, 1024, 1024, nb * 32, kb * 64, 1}; return; } r -= I_SQ;
    if (r < 2 * I_GU) { const int up = r >= I_GU; if (up) r -= I_GU; const int e = r / 256, q = r % 256, kb = q / 16, nb = q % 16;
        I = P0Item{INP(up ? I_WUP : I_WGATE) + (size_t)e * 1024 * 512, INP(I_GMOE), (bf16*)(ws + O_WGU8), (size_t)e * 1024 + 256 * (nb / 4) + (up ? 128 : 0) + (nb % 4) * 32, 1024, 512, nb * 32, kb * 64, 1}; return; } r -= 2 * I_GU;
    { const int e = r / 256, q = r % 256, kb = q / 32, nb = q % 32;
        I = P0Item{INP(I_WDOWN) + (size_t)e * 512 * 1024, nullptr, (bf16*)(ws + O_WD8), (size_t)e * 1024 + nb * 32, 512, 1024, nb * 32, kb * 64, 1}; }
}
DI void p0_item_load(const P0Item& I, float (&tv)[32], int lane) {
#pragma unroll
    for (int i = 0; i < 32; ++i) { const int kk = 2 * i + (lane >> 5); tv[i] = *(const GAS float*)(I.W + (size_t)(I.k0 + kk) * I.ldw + I.scol0 + (lane & 31)); }
}
DI void p0_item_store(const P0Item& I, float (&tv)[32], LAS float* scr, int lane) {
    if (I.gain) {
#pragma unroll
        for (int i = 0; i < 32; ++i) tv[i] *= I.gain[I.k0 + 2 * i + (lane >> 5)]; }
#pragma unroll
    for (int i = 0; i < 32; ++i) { const int kk = 2 * i + (lane >> 5); scr[kk * 33 + (lane & 31)] = tv[i]; }
    LDS_WAIT(); asm volatile("" ::: "memory");
    if (I.f8) {
        const int c = lane & 3;
#pragma unroll
        for (int j = 0; j < 2; ++j) { const int n = (lane >> 2) + 16 * j; const LAS float* s = scr + (16 * c) * 33 + n;
            u32x4 o; o.x = pk4_fp8(32.f * s[0 * 33], 32.f * s[1 * 33], 32.f * s[2 * 33], 32.f * s[3 * 33]); o.y = pk4_fp8(32.f * s[4 * 33], 32.f * s[5 * 33], 32.f * s[6 * 33], 32.f * s[7 * 33]);
            o.z = pk4_fp8(32.f * s[8 * 33], 32.f * s[9 * 33], 32.f * s[10 * 33], 32.f * s[11 * 33]); o.w = pk4_fp8(32.f * s[12 * 33], 32.f * s[13 * 33], 32.f * s[14 * 33], 32.f * s[15 * 33]);
            *(GAS u32x4*)((uchar*)I.WT + (I.drow0 + n) * (size_t)I.K + I.k0 + 16 * c) = o; }
    } else {
    const int c = lane & 7;
#pragma unroll
    for (int j = 0; j < 4; ++j) { const int n = (lane >> 3) + 8 * j; const LAS float* s = scr + (8 * c) * 33 + n;
        u32x4 o; o.x = pk2(s[0 * 33], s[1 * 33]); o.y = pk2(s[2 * 33], s[3 * 33]); o.z = pk2(s[4 * 33], s[5 * 33]); o.w = pk2(s[6 * 33], s[7 * 33]);
        *(GAS u32x4*)(I.WT + (I.drow0 + n) * (size_t)I.K + I.k0 + 8 * c) = o; }
    }
    LDS_WAIT(); asm volatile("" ::: "memory");
}

#ifndef P0A_REP
#define P0A_REP 1
#endif
#ifndef P0C_REP
#define P0C_REP 1
#endif
DI void phase0(Frame& F) {
    const int gw = F.bid * NWAVES + F.wave, NGW = F.G * NWAVES, lane = F.lane;
    uchar* ws = F.ws;
    for (int r_ = 0; r_ < P0A_REP; ++r_) {
        LAS float* scr = (LAS float*)(F.lds + F.wave * 16384);
        constexpr int NITEMS = 16 * 96 + 3 * 16 * 32 + 16 * 64 + 2 * 32 * 16 * 16 + 32 * 8 * 32;
        P0Item cur, nxt; float tvA[32], tvB[32];
        int it = gw;
        if (it < NITEMS) { p0_decode(F, it, cur); p0_item_load(cur, tvA, lane); }
        while (it < NITEMS) {
            if (it + NGW < NITEMS) { p0_decode(F, it + NGW, nxt); p0_item_load(nxt, tvB, lane); }
            p0_item_store(cur, tvA, scr, lane);
            it += NGW; if (it >= NITEMS) break;
            if (it + NGW < NITEMS) { p0_decode(F, it + NGW, cur); p0_item_load(cur, tvA, lane); }
            p0_item_store(nxt, tvB, scr, lane);
            it += NGW;
        }
        for (int i = F.bid * NTHR + F.tid; i < 48 * 1024; i += F.G * NTHR) { const int n = i >> 10, k = i & 1023; float v = 0.f;
            if (n < 4) v = INP(I_WRG)[k * 4 + n] * INP(I_GMOE)[k]; else if (n >= 16) v = INP(I_WRE)[k * 32 + (n - 16)] * INP(I_GMOE)[k];
            const unsigned h = f2bf(v); const float hf = __builtin_bit_cast(float, h << 16);
            ((bf16*)(ws + O_WRH))[i] = (bf16)h; ((bf16*)(ws + O_WRL))[i] = (bf16)f2bf(v - hf); }
        for (int i = F.bid * NTHR + F.tid; i < 4 * 128 * 128 / 2; i += F.G * NTHR) { const f32x2 v = *(const GAS f32x2*)(INP(I_WS) + 2 * i); ((unsigned*)(ws + O_WSB))[i] = pk2(v.x, v.y); }
    }
    __syncthreads();
    LAS float* wg = (LAS float*)F.lds;
    for (int idx = F.tid; idx < 1024 * 16; idx += NTHR) { const int i = idx >> 4, j = idx & 15; const float v = INP(I_WIN)[(size_t)i * 3088 + 2048 + j] * INP(I_GMIX)[i];
        const int jj = i >> 8, l = (i & 255) >> 2, ii = i & 3, j4 = j >> 2, jr = j & 3; wg[((((jj * 4 + ii) * 4 + j4) * 64 + l) << 2) + jr] = v; }
    __syncthreads();
    for (int r_ = 0; r_ < P0C_REP; ++r_) {
        bf16* XB = (bf16*)(ws + O_XB); float* rs0 = (float*)(ws + O_RS0); float* gates = (float*)(ws + O_GATES);
        const float gb = INP(I_GATEB)[lane >> 2];
        f32x4 nx[4];
        if (gw < NTOK) { const f32x4* xr0 = (const f32x4*)(INP(I_X) + (size_t)gw * DM) + lane;
#pragma unroll
            for (int j = 0; j < 4; ++j) nx[j] = xr0[64 * j]; }
        for (int m = gw; m < NTOK; m += NGW) {
            f32x4 v[4]; float s = 0.f;
#pragma unroll
            for (int j = 0; j < 4; ++j) { v[j] = nx[j]; s += (v[j].x * v[j].x + v[j].y * v[j].y) + (v[j].z * v[j].z + v[j].w * v[j].w); }
            if (m + NGW < NTOK) { const f32x4* xr1 = (const f32x4*)(INP(I_X) + (size_t)(m + NGW) * DM) + lane;
#pragma unroll
                for (int j = 0; j < 4; ++j) nx[j] = xr1[64 * j]; }
            const float rs = 1.0f / sqrtf(wave_sum(s) * (1.f / DM) + RMS_EPS);
            unsigned long long* o8 = (unsigned long long*)(XB + (size_t)m * DM) + lane;
#pragma unroll
            for (int j = 0; j < 4; ++j) o8[64 * j] = (unsigned long long)pk2(v[j].x, v[j].y) | ((unsigned long long)pk2(v[j].z, v[j].w) << 32);
            float p[16];
#pragma unroll
            for (int j = 0; j < 16; ++j) p[j] = 0.f;
#pragma unroll
            for (int jj = 0; jj < 4; ++jj)
#pragma unroll
                for (int ii = 0; ii < 4; ++ii) { const float xv = v[jj][ii];
#pragma unroll
                    for (int j4 = 0; j4 < 4; ++j4) { const f32x4 w = *(const LAS f32x4*)(wg + ((((jj * 4 + ii) * 4 + j4) * 64 + lane) << 2));
                        p[4 * j4 + 0] += xv * w.x; p[4 * j4 + 1] += xv * w.y; p[4 * j4 + 2] += xv * w.z; p[4 * j4 + 3] += xv * w.w; } }
            float q8[8], q4[4], q2[2], q1;
            { const bool hi = (lane & 32) != 0;
#pragma unroll
              for (int k = 0; k < 8; ++k) { const float send = hi ? p[k] : p[k + 8], keep = hi ? p[k + 8] : p[k]; q8[k] = keep + __shfl_xor(send, 32); } }
            { const bool hi = (lane & 16) != 0;
#pragma unroll
              for (int k = 0; k < 4; ++k) { const float send = hi ? q8[k] : q8[k + 4], keep = hi ? q8[k + 4] : q8[k]; q4[k] = keep + __shfl_xor(send, 16); } }
            { const bool hi = (lane & 8) != 0;
#pragma unroll
              for (int k = 0; k < 2; ++k) { const float send = hi ? q4[k] : q4[k + 2], keep = hi ? q4[k + 2] : q4[k]; q2[k] = keep + __shfl_xor(send, 8); } }
            { const bool hi = (lane & 4) != 0; const float send = hi ? q2[0] : q2[1], keep = hi ? q2[1] : q2[0]; q1 = keep + __shfl_xor(send, 4); }
            q1 += __shfl_xor(q1, 2); q1 += __shfl_xor(q1, 1);
            if ((lane & 3) == 0) gates[(size_t)m * 16 + (lane >> 2)] = q1 * rs + gb;
            if (lane == 0) rs0[m] = rs;
        }
    }
    {
        bf16* MB = (bf16*)(ws + O_MEMB); float* rsm = (float*)(ws + O_RSM);
        for (int m = gw; m < NMROWS; m += NGW) {
            const f32x4* xr = (const f32x4*)(INP(I_MEM) + (size_t)m * DM) + lane;
            f32x4 v[4]; float s = 0.f;
#pragma unroll
            for (int j = 0; j < 4; ++j) { v[j] = xr[64 * j]; s += (v[j].x * v[j].x + v[j].y * v[j].y) + (v[j].z * v[j].z + v[j].w * v[j].w); }
            const float rs = 1.0f / sqrtf(wave_sum(s) * (1.f / DM) + RMS_EPS);
            unsigned long long* o8 = (unsigned long long*)(MB + (size_t)m * DM) + lane;
#pragma unroll
            for (int j = 0; j < 4; ++j) o8[64 * j] = (unsigned long long)pk2(v[j].x, v[j].y) | ((unsigned long long)pk2(v[j].z, v[j].w) << 32);
            if (lane == 0) rsm[m] = rs;
        }
    }
}
using pg8::Unit;
typedef const f32x4 (&AccRef)[2][2][4][2];

template <int MODE> struct EpiRowScale {
    static constexpr bool PERM = true;
    bf16* O; int ldc; const float* rs; float extra;
    DI void operator()(AccRef acc, const Unit& u, int wr, int wc, int fr, int fq) const {
        const int row0 = u.orow * 256 + wr * 64 + fr, col0 = u.ocol + wc * 32 + 8 * fq;
        const int act = (MODE == 0) ? (u.pn >= 8 ? 2 : (u.pn >= 6 ? 1 : 0)) : 0;
        float sc[2][4];
#pragma unroll
        for (int ai = 0; ai < 2; ++ai)
#pragma unroll
            for (int m = 0; m < 4; ++m) sc[ai][m] = *(const GAS float*)(rs + row0 + ai * 128 + m * 16);
#pragma unroll
        for (int ai = 0; ai < 2; ++ai)
#pragma unroll
            for (int m = 0; m < 4; ++m) { const int row = row0 + ai * 128 + m * 16; const float s = sc[ai][m] * extra;
#pragma unroll
                for (int bj = 0; bj < 2; ++bj) { f32x4 v0 = acc[ai][bj][m][0] * s, v1 = acc[ai][bj][m][1] * s;
                    if (act == 1) {
#pragma unroll
                        for (int j = 0; j < 4; ++j) { v0[j] = sigmoidf_(v0[j]); v1[j] = sigmoidf_(v1[j]); } }
                    else if (act == 2) {
#pragma unroll
                        for (int j = 0; j < 4; ++j) { v0[j] = gelu_tanh(v0[j]); v1[j] = gelu_tanh(v1[j]); } }
                    u32x4 w; w.x = pk2(v0[0], v0[1]); w.y = pk2(v0[2], v0[3]); w.z = pk2(v1[0], v1[1]); w.w = pk2(v1[2], v1[3]);
                    bf16* dst;
                    if (MODE == 0) {
                        if (u.pn < 8) dst = O + (size_t)(64 * MiB / 2) * (u.pn >> 1) + (size_t)(128 * MiB / 2) + ((size_t)((row >> 12) * 4 + (u.pn & 1) * 2 + bj) * SEQ + (row & (SEQ - 1))) * 128 + wc * 32 + 8 * fq;
                        else dst = O + (size_t)row * ZG + (u.pn - 8) * 256 + bj * 128 + wc * 32 + 8 * fq;
                    } else dst = O + (size_t)row * ldc + col0 + bj * 128;
                    *(GAS u32x4*)dst = w; } }
    }
};
struct EpiQ {
    static constexpr bool PERM = true;
    bf16* O; const float* ssp; float extra;
    DI void operator()(AccRef acc, const Unit& u, int wr, int wc, int fr, int fq) const {
        const int row0 = u.orow * 256 + wr * 64 + fr, col0 = u.ocol + wc * 32 + 8 * fq;
        float sc[2][4];
#pragma unroll
        for (int ai = 0; ai < 2; ++ai) { f32x4 p[4][4];
#pragma unroll
            for (int m = 0; m < 4; ++m) { const GAS f32x4* sp = (const GAS f32x4*)(ssp + (size_t)(row0 + ai * 128 + m * 16) * 16);
                p[m][0] = sp[0]; p[m][1] = sp[1]; p[m][2] = sp[2]; p[m][3] = sp[3]; }
#pragma unroll
            for (int m = 0; m < 4; ++m) { const f32x4 a = p[m][0], b = p[m][1], c = p[m][2], d = p[m][3];
                const float ss = (((a.x + a.y) + (a.z + a.w)) + ((b.x + b.y) + (b.z + b.w))) + (((c.x + c.y) + (c.z + c.w)) + ((d.x + d.y) + (d.z + d.w)));
                sc[ai][m] = extra / sqrtf(ss * (1.f / DM) + RMS_EPS); } }
#pragma unroll
        for (int ai = 0; ai < 2; ++ai)
#pragma unroll
            for (int m = 0; m < 4; ++m) { const int row = row0 + ai * 128 + m * 16; const float s = sc[ai][m]; bf16* rowp = O + (size_t)row * DM + col0;
#pragma unroll
                for (int bj = 0; bj < 2; ++bj) { const f32x4 v0 = acc[ai][bj][m][0] * s, v1 = acc[ai][bj][m][1] * s;
                    u32x4 w; w.x = pk2(v0[0], v0[1]); w.y = pk2(v0[2], v0[3]); w.z = pk2(v1[0], v1[1]); w.w = pk2(v1[2], v1[3]);
                    *(GAS u32x4*)(rowp + bj * 128) = w; } }
    }
};
template <bool BASE_BF16, bool SS, bool F8> struct EpiRes {
    static constexpr bool PERM = true;
    const float* base; bf16* xb; float* ssp; uchar* x8;
    DI void operator()(AccRef acc, const Unit& u, int wr, int wc, int fr, int fq) const {
        static_assert(BASE_BF16, "the residual base is the bf16 stream itself");
        const int row0 = u.orow * 256 + wr * 64 + fr, col0 = u.ocol + wc * 32 + 8 * fq;
        u32x4 bs[2][4][2];
#pragma unroll
        for (int ai = 0; ai < 2; ++ai)
#pragma unroll
            for (int m = 0; m < 4; ++m) { const size_t off = (size_t)(row0 + ai * 128 + m * 16) * DM + col0;
#pragma unroll
                for (int bj = 0; bj < 2; ++bj) bs[ai][m][bj] = *(const GAS u32x4*)(xb + off + bj * 128); }
#pragma unroll
        for (int ai = 0; ai < 2; ++ai)
#pragma unroll
            for (int m = 0; m < 4; ++m) { const int row = row0 + ai * 128 + m * 16; const size_t off = (size_t)row * DM + col0; float q = 0.f;
#pragma unroll
                for (int bj = 0; bj < 2; ++bj) { const u32x4 b4 = bs[ai][m][bj];
                    const f32x4 v0 = (f32x4){bflo(b4.x), bfhi(b4.x), bflo(b4.y), bfhi(b4.y)} + acc[ai][bj][m][0], v1 = (f32x4){bflo(b4.z), bfhi(b4.z), bflo(b4.w), bfhi(b4.w)} + acc[ai][bj][m][1];
                    u32x4 w; w.x = pk2(v0[0], v0[1]); w.y = pk2(v0[2], v0[3]); w.z = pk2(v1[0], v1[1]); w.w = pk2(v1[2], v1[3]);
                    *(GAS u32x4*)(xb + off + bj * 128) = w;
                    if (F8) { u32x2 w8; w8.x = pk4_fp8(v0[0], v0[1], v0[2], v0[3]); w8.y = pk4_fp8(v1[0], v1[1], v1[2], v1[3]); *(GAS u32x2*)(x8 + off + bj * 128) = w8; }
                    if (SS) q += ((v0[0] * v0[0] + v0[1] * v0[1]) + (v0[2] * v0[2] + v0[3] * v0[3])) + ((v1[0] * v1[0] + v1[1] * v1[1]) + (v1[2] * v1[2] + v1[3] * v1[3])); }
                if (SS) { q += __shfl_xor(q, 16); q += __shfl_xor(q, 32); if (fq == 0) *(GAS float*)(ssp + (size_t)row * 16 + u.pn * 4 + wc) = q; } }
    }
};
struct EpiGU {
    static constexpr bool PERM = true;
    bf16* H; const float* rs3;
    DI void operator()(AccRef acc, const Unit& u, int wr, int wc, int fr, int fq) const {
        const int rl0 = wr * 64 + fr, col0 = u.ocol + wc * 32 + 8 * fq;
        int tk[2][4]; float sc[2][4];
#pragma unroll
        for (int ai = 0; ai < 2; ++ai)
#pragma unroll
            for (int m = 0; m < 4; ++m) { const int rl = rl0 + ai * 128 + m * 16; const int rc = rl < u.nvalid ? rl : u.nvalid - 1; tk[ai][m] = *(const GAS int*)(u.ridx + rc); }
#pragma unroll
        for (int ai = 0; ai < 2; ++ai)
#pragma unroll
            for (int m = 0; m < 4; ++m) sc[ai][m] = *(const GAS float*)(rs3 + tk[ai][m]);
#pragma unroll
        for (int ai = 0; ai < 2; ++ai)
#pragma unroll
            for (int m = 0; m < 4; ++m) { const int rl = rl0 + ai * 128 + m * 16; const float s = sc[ai][m];
                uchar* rowp = (uchar*)H + (size_t)(u.orow * 256 + rl) * DEXP + col0;
                f32x4 h0, h1;
#pragma unroll
                for (int j = 0; j < 4; ++j) { h0[j] = siluf_(acc[ai][0][m][0][j] * s) * (acc[ai][1][m][0][j] * s); h1[j] = siluf_(acc[ai][0][m][1][j] * s) * (acc[ai][1][m][1][j] * s); }
                u32x2 w; w.x = pk4_fp8(h0[0], h0[1], h0[2], h0[3]); w.y = pk4_fp8(h1[0], h1[1], h1[2], h1[3]);
                *(GAS u32x2*)rowp = w; }
    }
};
struct EpiPlain {
    static constexpr bool PERM = true;
    bf16* O; int ldc;
    DI void operator()(AccRef acc, const Unit& u, int wr, int wc, int fr, int fq) const {
        const int row0 = u.orow * 256 + wr * 64 + fr, col0 = u.ocol + wc * 32 + 8 * fq;
#pragma unroll
        for (int ai = 0; ai < 2; ++ai)
#pragma unroll
            for (int m = 0; m < 4; ++m) { bf16* rowp = O + (size_t)(row0 + ai * 128 + m * 16) * ldc + col0;
#pragma unroll
                for (int bj = 0; bj < 2; ++bj) { const f32x4 v0 = acc[ai][bj][m][0], v1 = acc[ai][bj][m][1];
                    u32x4 w; w.x = pk2(v0[0], v0[1]); w.y = pk2(v0[2], v0[3]); w.z = pk2(v1[0], v1[1]); w.w = pk2(v1[2], v1[3]);
                    *(GAS u32x4*)(rowp + bj * 128) = w; } }
    }
};
struct EpiPlain8 {
    static constexpr bool PERM = true;
    uchar* O; int ldc;
    DI void operator()(AccRef acc, const Unit& u, int wr, int wc, int fr, int fq) const {
        const int row0 = u.orow * 256 + wr * 64 + fr, col0 = u.ocol + wc * 32 + 8 * fq;
#pragma unroll
        for (int ai = 0; ai < 2; ++ai)
#pragma unroll
            for (int m = 0; m < 4; ++m) { uchar* rowp = O + (size_t)(row0 + ai * 128 + m * 16) * ldc + col0;
#pragma unroll
                for (int bj = 0; bj < 2; ++bj) { const f32x4 v0 = acc[ai][bj][m][0], v1 = acc[ai][bj][m][1];
                    u32x2 w; w.x = pk4_fp8(v0[0], v0[1], v0[2], v0[3]); w.y = pk4_fp8(v1[0], v1[1], v1[2], v1[3]);
                    *(GAS u32x2*)(rowp + bj * 128) = w; } }
    }
};
struct MoeOrder {
    const LAS int* ut; const int* ridx; int G, c; bool down;
    DI bool next(int i, Unit& u) const {
        if (i >= 16) return false;
        const u32x4 v = *(const LAS u32x4*)(ut + 4 * i);
        const int e = __builtin_amdgcn_readfirstlane((int)v.x), T = __builtin_amdgcn_readfirstlane((int)v.y), nv = __builtin_amdgcn_readfirstlane((int)v.z), ro = __builtin_amdgcn_readfirstlane((int)v.w);
        if (e < 0) return false;
        const int j = (i * G + c) & 3;
        u.ex = e; u.orow = T; u.nvalid = nv; u.ridx = ridx + ro;
        if (down) { u.pm = T; u.pn = e * 4 + j; u.ocol = 256 * j; } else { u.pm = 0; u.pn = e * 4 + j; u.ocol = 128 * j; }
        return true;
    }
};
#define SFENCE() do { asm volatile("" ::: "memory"); __builtin_amdgcn_sched_barrier(0); } while (0)
DI void conv_issue(u32x4 (&raw)[8], const bf16* src, int c, int tid) {
    const int dg = tid & 15, sg = tid >> 4;
#pragma unroll
    for (int r = 0; r < 8; ++r) { const int pos = c * 128 + 4 * sg - 2 + r; raw[r] = (u32x4){0u, 0u, 0u, 0u};
        if (pos >= 0 && pos < SEQ) raw[r] = *(const GAS u32x4*)(src + (size_t)pos * 128 + 8 * dg); }
}
DI void conv_build(LAS uchar* tile, const u32x4 (&raw)[8], int zcol0, const float* convw, const float* convb, float scale, int tid) {
    const int dg = tid & 15, sg = tid >> 4;
    f32x2 cw[5][4], cb[4];
#pragma unroll
    for (int j = 0; j < 5; ++j) { const f32x4 a = *(const GAS f32x4*)(convw + j * 1024 + zcol0 + 8 * dg), bq = *(const GAS f32x4*)(convw + j * 1024 + zcol0 + 8 * dg + 4);
        cw[j][0] = (f32x2){a.x, a.y}; cw[j][1] = (f32x2){a.z, a.w}; cw[j][2] = (f32x2){bq.x, bq.y}; cw[j][3] = (f32x2){bq.z, bq.w}; }
    { const f32x4 a = *(const GAS f32x4*)(convb + zcol0 + 8 * dg), bq = *(const GAS f32x4*)(convb + zcol0 + 8 * dg + 4);
        cb[0] = (f32x2){a.x, a.y}; cb[1] = (f32x2){a.z, a.w}; cb[2] = (f32x2){bq.x, bq.y}; cb[3] = (f32x2){bq.z, bq.w}; }
    f32x2 in[8][4];
#pragma unroll
    for (int r = 0; r < 8; ++r) { in[r][0] = (f32x2){bflo(raw[r].x), bfhi(raw[r].x)}; in[r][1] = (f32x2){bflo(raw[r].y), bfhi(raw[r].y)}; in[r][2] = (f32x2){bflo(raw[r].z), bfhi(raw[r].z)}; in[r][3] = (f32x2){bflo(raw[r].w), bfhi(raw[r].w)}; }
#pragma unroll
    for (int rr = 0; rr < 4; ++rr) { unsigned ow[4];
#pragma unroll
        for (int i = 0; i < 4; ++i) { f32x2 a = cb[i];
#pragma unroll
            for (int j = 0; j < 5; ++j) a = __builtin_elementwise_fma(in[rr + j][i], cw[j][i], a);
            ow[i] = pk2(siluf_(a.x) * scale, siluf_(a.y) * scale); }
        *(LAS u32x4*)(tile + offb(4 * sg + rr, dg)) = (u32x4){ow[0], ow[1], ow[2], ow[3]}; }
}
DI void build_copy_tile(LAS uchar* tile, const bf16* src, size_t row0, int ld, int col0, int tid) {
    const int dg = tid & 15, sg = tid >> 4;
#pragma unroll
    for (int rr = 0; rr < 4; ++rr) { const int r = 4 * sg + rr; *(LAS u32x4*)(tile + offb(r, dg)) = *(const GAS u32x4*)(src + (row0 + r) * (size_t)ld + col0 + 8 * dg); }
}

DI void scan_issue(u32x4 (&kr)[6], u32x4 (&vr)[4], const bf16* zk, const bf16* zv, int c, int dh, int tid) {
    const int dg = tid & 7, sg = tid >> 3;
#pragma unroll
    for (int r = 0; r < 6; ++r) { const int pos = c * 128 + 2 * sg - 2 + r; kr[r] = (u32x4){0u, 0u, 0u, 0u};
        if (pos >= 0 && pos < SEQ) kr[r] = *(const GAS u32x4*)(zk + (size_t)pos * 128 + 64 * dh + 8 * dg); }
    const int dg2 = tid & 15, sg2 = tid >> 4;
#pragma unroll
    for (int rr = 0; rr < 4; ++rr) vr[rr] = *(const GAS u32x4*)(zv + (size_t)(c * 128 + 4 * sg2 + rr) * 128 + 8 * dg2);
}
DI void scan_build(LAS uchar* TKW, LAS uchar* TV, const u32x4 (&kr)[6], const u32x4 (&vr)[4], const float (&cw)[5][8], const float (&cb)[8], const LAS float* alog, float mnew, int tid) {
    const int dg = tid & 7, sg = tid >> 3;
    float in[6][8];
#pragma unroll
    for (int r = 0; r < 6; ++r) { in[r][0] = bflo(kr[r].x); in[r][1] = bfhi(kr[r].x); in[r][2] = bflo(kr[r].y); in[r][3] = bfhi(kr[r].y); in[r][4] = bflo(kr[r].z); in[r][5] = bfhi(kr[r].z); in[r][6] = bflo(kr[r].w); in[r][7] = bfhi(kr[r].w); }
#pragma unroll
    for (int rr = 0; rr < 2; ++rr) { const float sc = 0.08838834764831845f * __expf(alog[2 * sg + rr] - mnew); float o[8];
#pragma unroll
        for (int i = 0; i < 8; ++i) { float a = cb[i];
#pragma unroll
            for (int j = 0; j < 5; ++j) a += in[rr + j][i] * cw[j][i];
            o[i] = siluf_(a) * sc; }
        u32x4 wv; wv.x = pk2(o[0], o[1]); wv.y = pk2(o[2], o[3]); wv.z = pk2(o[4], o[5]); wv.w = pk2(o[6], o[7]);
        *(LAS u32x4*)(TKW + offb(2 * sg + rr, dg)) = wv; }
    const int dg2 = tid & 15, sg2 = tid >> 4;
#pragma unroll
    for (int rr = 0; rr < 4; ++rr) *(LAS u32x4*)(TV + offb(4 * sg2 + rr, dg2)) = vr[rr];
}
DI void scan_gate_pre(float ig0, float ig1, float fp0, float fp1, int dir, LAS float* al, LAS float* Fv, LAS float* Mv, int lane) {
    const float lf0 = log_sigmoid(fp0), lf1 = log_sigmoid(fp1);
    const float incl = wscan_add(lf0 + lf1, lane);
    const float bf0 = incl - lf1, bf1 = incl, Ftot = __shfl(incl, 63);
    const float a0 = dir ? (bf0 - lf0 + ig0) : (Ftot - bf0 + ig0), a1 = dir ? (bf1 - lf1 + ig1) : (Ftot - bf1 + ig1);
    const float mloc = wave_max(fmaxf(a0, a1));
    al[2 * lane] = a0; al[2 * lane + 1] = a1;
    if (lane == 0) { *Fv = Ftot; *Mv = mloc; }
}
DI void mlstm_scan(Frame& F, int wgid) {
    int tid = F.tid, lane = F.lane; const int w = F.wave;
    const int seq = wgid >> 1, dh = wgid & 1;
    const int dir = seq & 1, h = (seq >> 1) & 3, b = seq >> 3;
    LAS float* AL = (LAS float*)(F.lds + 131072);
    LAS float* FV = AL + 32 * 128; LAS float* MV = FV + 32; LAS float* SC = MV + 32; LAS float* MN = SC + 32; LAS float* MP = MN + 32;
    const float* gates = (const float*)(F.ws + O_GATES);
    const size_t hoff = (size_t)(b * 4 + h) * SEQ * 128;
    const bf16* zk = (const bf16*)(F.ws + O_ZK) + hoff; const bf16* zv = (const bf16*)(F.ws + O_ZV) + hoff;
    float* mst = (float*)(F.ws + O_MST);
    float cw[5][8], cb[8];
    { const int ch0 = 512 + h * 128 + 64 * dh + 8 * (tid & 7);
#pragma unroll
      for (int j = 0; j < 5; ++j) { const f32x4 a = *(const GAS f32x4*)(INP(I_CONVW) + j * 1024 + ch0), bq = *(const GAS f32x4*)(INP(I_CONVW) + j * 1024 + ch0 + 4);
          cw[j][0] = a.x; cw[j][1] = a.y; cw[j][2] = a.z; cw[j][3] = a.w; cw[j][4] = bq.x; cw[j][5] = bq.y; cw[j][6] = bq.z; cw[j][7] = bq.w; }
      const f32x4 a = *(const GAS f32x4*)(INP(I_CONVB) + ch0), bq = *(const GAS f32x4*)(INP(I_CONVB) + ch0 + 4);
      cb[0] = a.x; cb[1] = a.y; cb[2] = a.z; cb[3] = a.w; cb[4] = bq.x; cb[5] = bq.y; cb[6] = bq.z; cb[7] = bq.w; }
    f32x4 acc[4], accn = (f32x4){0.f, 0.f, 0.f, 0.f};
#pragma unroll
    for (int mt = 0; mt < 4; ++mt) acc[mt] = (f32x4){0.f, 0.f, 0.f, 0.f};
    const bf16x8 ones = (bf16x8){0x3F80, 0x3F80, 0x3F80, 0x3F80, 0x3F80, 0x3F80, 0x3F80, 0x3F80};
    const int gi = dir * 8 + h, gf = dir * 8 + 4 + h;
#define SCAN_C(ci) (dir ? 31 - (ci) : (ci))
#pragma unroll 1
    for (int q = 0; q < 4; ++q) { const int ci = w + 8 * q; const size_t r_ = ((size_t)b * SEQ + SCAN_C(ci) * 128 + 2 * lane) * 16;
        scan_gate_pre(gates[r_ + gi], gates[r_ + 16 + gi], gates[r_ + gf], gates[r_ + 16 + gf], dir, AL + ci * 128, FV + ci, MV + ci, lane); }
    __syncthreads();
    if (tid == 0) { float m = -1e30f;
#pragma unroll 1
        for (int ci = 0; ci < 32; ++ci) { MP[ci] = m; const float fm = FV[ci] + m, mn = fmaxf(fm, MV[ci]); SC[ci] = __expf(fm - mn); MN[ci] = mn; m = mn; } }
    __syncthreads();
    if (dh == 0 && tid < 32) mst[seq * 32 + SCAN_C(tid)] = MP[tid];
    unsigned aK[4][2], aV[2];
    { const unsigned g = lane >> 4, q = (lane & 15) >> 2, p = lane & 3, bo = 8u * (p & 1);
#pragma unroll
      for (int mt = 0; mt < 4; ++mt) { aK[mt][0] = offb(8 * g + q, 2 * mt + (p >> 1)) + bo; aK[mt][1] = offb(8 * g + 4 + q, 2 * mt + (p >> 1)) + bo; }
      aV[0] = offb(8 * g + q, 2 * w + (p >> 1)) + bo; aV[1] = offb(8 * g + 4 + q, 2 * w + (p >> 1)) + bo; }
#define FRAG_PRE(tile, o0, o1, kk) ({ const s16x4 lo_ = __builtin_amdgcn_ds_read_tr16_b64_v4i16((LAS s16x4*)((tile) + (o0) + 8192 * (kk))); const s16x4 hi_ = __builtin_amdgcn_ds_read_tr16_b64_v4i16((LAS s16x4*)((tile) + (o1) + 8192 * (kk))); (bf16x8){lo_[0], lo_[1], lo_[2], lo_[3], hi_[0], hi_[1], hi_[2], hi_[3]}; })
    u32x4 krA[6], vrA[4], krB[6], vrB[4];
    scan_issue(krB, vrB, zk, zv, SCAN_C(0), dh, tid);
    scan_issue(krA, vrA, zk, zv, SCAN_C(1), dh, tid);
    __syncthreads();
    scan_build(F.lds, F.lds + 32768, krB, vrB, cw, cb, AL, MN[0], tid);
    scan_issue(krB, vrB, zk, zv, SCAN_C(2), dh, tid);
    __syncthreads();
#define SCAN_ITER(ci, KRN, VRN) do { \
        const int c = SCAN_C(ci); \
        asm volatile("" : "+v"(tid), "+v"(lane)); \
        GASK uchar* wsl_ = (GASK uchar*)F.ws; asm volatile("" : "+s"(wsl_)); \
        const bf16* zk = (const bf16*)((uchar*)wsl_ + O_ZK) + hoff; const bf16* zv = (const bf16*)((uchar*)wsl_ + O_ZV) + hoff; bf16* cst = (bf16*)((uchar*)wsl_ + O_CST); float* nst = (float*)((uchar*)wsl_ + O_NST); \
        LAS uchar* TKW = F.lds + ((ci) & 1) * 65536; LAS uchar* TV = TKW + 32768; \
        { bf16* cp = cst + ((size_t)seq * 32 + c) * 16384; \
          _Pragma("unroll") for (int mt = 0; mt < 4; ++mt) { const int d = 64 * dh + 16 * mt + 4 * (lane >> 4), e = 16 * w + (lane & 15); \
              u32x2 v; v.x = pk2(acc[mt][0], acc[mt][1]); v.y = pk2(acc[mt][2], acc[mt][3]); *(GAS u32x2*)(cp + e * 128 + d) = v; } \
          if (w < 4 && (lane & 15) == 0) *(GAS f32x4*)(nst + ((size_t)seq * 32 + c) * 128 + 64 * dh + 16 * w + 4 * (lane >> 4)) = accn; } \
        if ((ci) + 1 < 32) { \
            scan_build(F.lds + (((ci) + 1) & 1) * 65536, F.lds + (((ci) + 1) & 1) * 65536 + 32768, KRN, VRN, cw, cb, AL + ((ci) + 1) * 128, MN[(ci) + 1], tid); \
            if ((ci) + 3 < 32) scan_issue(KRN, VRN, zk, zv, SCAN_C((ci) + 3), dh, tid); } \
        const float sc_old = SC[(ci)]; \
        _Pragma("unroll") for (int mt = 0; mt < 4; ++mt) acc[mt] *= sc_old; \
        accn *= sc_old; \
        _Pragma("unroll") for (int kk = 0; kk < 4; ++kk) { \
            const bf16x8 Yf = FRAG_PRE(TV, aV[0], aV[1], kk); \
            _Pragma("unroll") for (int mt = 0; mt < 4; ++mt) acc[mt] = mfma16(FRAG_PRE(TKW, aK[mt][0], aK[mt][1], kk), Yf, acc[mt]); \
            if (w < 4) accn = mfma16(FRAG_PRE(TKW, aV[0], aV[1], kk), ones, accn); \
            __builtin_amdgcn_sched_barrier(0); } \
        __syncthreads(); } while (0)
    for (int c2 = 0; c2 < 32; c2 += 2) { SCAN_ITER(c2, krA, vrA); SCAN_ITER(c2 + 1, krB, vrB); }
#undef SCAN_ITER
#undef FRAG_PRE
#undef SCAN_C
}

DI void gmlp_phase(Frame& F) {
    const int w = F.wave;
    const bf16* z = (const bf16*)(F.ws + O_Z); bf16* Y = (bf16*)(F.ws + O_Y); const bf16* wsb = (const bf16*)(F.ws + O_WSB);
    float lg[8], lb[8];
    { const f32x4 a = *(const GAS f32x4*)(INP(I_LNVG) + 8 * F.lane), bq = *(const GAS f32x4*)(INP(I_LNVG) + 8 * F.lane + 4), c = *(const GAS f32x4*)(INP(I_LNVB) + 8 * F.lane), d = *(const GAS f32x4*)(INP(I_LNVB) + 8 * F.lane + 4);
      lg[0] = a.x; lg[1] = a.y; lg[2] = a.z; lg[3] = a.w; lg[4] = bq.x; lg[5] = bq.y; lg[6] = bq.z; lg[7] = bq.w; lb[0] = c.x; lb[1] = c.y; lb[2] = c.z; lb[3] = c.w; lb[4] = d.x; lb[5] = d.y; lb[6] = d.z; lb[7] = d.w; }
    for (int unit = F.bid; unit < 512; unit += F.G) {
        int tid = F.tid, lane = F.lane; asm volatile("" : "+v"(tid), "+v"(lane));
        const size_t row0 = (size_t)unit * 128;
        u32x4 raw[16];
#pragma unroll
        for (int i = 0; i < 16; ++i) raw[i] = *(const GAS u32x4*)(z + (row0 + 16 * w + i) * ZG + 512 + 8 * lane);
#pragma unroll
        for (int i = 0; i < 16; ++i) { const int r = 16 * w + i;
            float v[8] = {bflo(raw[i].x), bfhi(raw[i].x), bflo(raw[i].y), bfhi(raw[i].y), bflo(raw[i].z), bfhi(raw[i].z), bflo(raw[i].w), bfhi(raw[i].w)};
            float s = 0.f;
#pragma unroll
            for (int q = 0; q < 8; ++q) s += v[q];
            const float mu = wave_sum(s) * (1.f / 512.f); float qq = 0.f;
#pragma unroll
            for (int q = 0; q < 8; ++q) { v[q] -= mu; qq += v[q] * v[q]; }
            const float rs = 1.0f / sqrtf(wave_sum(qq) * (1.f / 512.f) + LN_EPS);
#pragma unroll
            for (int q = 0; q < 8; ++q) v[q] = v[q] * rs * lg[q] + lb[q];
            u32x4 wv; wv.x = pk2(v[0], v[1]); wv.y = pk2(v[2], v[3]); wv.z = pk2(v[4], v[5]); wv.w = pk2(v[6], v[7]);
            *(LAS u32x4*)(F.lds + (lane >> 4) * 32768 + offb(r, lane & 15)) = wv; }
        __syncthreads();
        const int tl = 16 * w + (lane & 15); const size_t row = row0 + tl;
        bf16x8 Yw[2][4]; u32x2 gu[2][8];
#define GM_ISSUE(g, sl) do { _Pragma("unroll") for (int kk = 0; kk < 4; ++kk) Yw[sl][kk] = *(const GAS bf16x8*)(wsb + ((size_t)(g) * 128 + tl) * 128 + 32 * kk + 8 * (lane >> 4)); \
        _Pragma("unroll") for (int mt = 0; mt < 8; ++mt) gu[sl][mt] = *(const GAS u32x2*)(z + row * ZG + (g) * 128 + 16 * mt + 4 * (lane >> 4)); } while (0)
        GM_ISSUE(0, 0);
#pragma unroll
        for (int g = 0; g < 4; ++g) {
            const int sl = g & 1;
            if (g < 3) GM_ISSUE(g + 1, sl ^ 1);
            const LAS uchar* T_G = F.lds + g * 32768;
            f32x4 acc[8];
#pragma unroll
            for (int mt = 0; mt < 8; ++mt) acc[mt] = (f32x4){0.f, 0.f, 0.f, 0.f};
#pragma unroll
            for (int kk = 0; kk < 4; ++kk) {
#pragma unroll
                for (int mt = 0; mt < 8; ++mt) acc[mt] = mfma16(frag_tr(T_G, 32 * kk, 16 * mt, lane), Yw[sl][kk], acc[mt]);
                __builtin_amdgcn_sched_barrier(0); }
            const float bs = INP(I_BS)[g * 128 + tl];
#pragma unroll
            for (int mt = 0; mt < 8; ++mt) { const int d = 16 * mt + 4 * (lane >> 4); const u32x2 gv2 = gu[sl][mt];
                u32x2 o; o.x = pk2(bflo(gv2.x) * (acc[mt][0] + bs), bfhi(gv2.x) * (acc[mt][1] + bs)); o.y = pk2(bflo(gv2.y) * (acc[mt][2] + bs), bfhi(gv2.y) * (acc[mt][3] + bs));
                *(GAS u32x2*)(Y + row * DM + 512 + g * 128 + d) = o; }
        }
#undef GM_ISSUE
        __syncthreads();
    }
}

DI void phase2(Frame& F) {
    for (int s = F.bid; s < 256; s += F.G) mlstm_scan(F, s);
    gmlp_phase(F);
}

DI void mlstm_out_phase(Frame& F) {
  constexpr int NU3 = NB * 4 * 32;
  const int w = F.wave;
  u32x4 qraw[8];
  if (F.bid < NU3) { const int u0 = F.bid; const size_t ho = (size_t)(u0 >> 5) * SEQ * 128;
      conv_issue(qraw, (const bf16*)(F.ws + O_ZQ) + ho, u0 & 31, F.tid); }
  for (int unit = F.bid; unit < NU3; unit += F.G) {
    int tid = F.tid, lane = F.lane; asm volatile("" : "+v"(tid), "+v"(lane));
    const int c = unit & 31, h = (unit >> 5) & 3, b = unit >> 7;
    const size_t row0 = (size_t)b * SEQ + c * 128;
    LAS uchar* T_Q = F.lds; LAS uchar* T_K = F.lds + 32768; LAS uchar* T_V = F.lds + 65536; LAS uchar* T_C = F.lds + 98304;
    LAS float* sm = (LAS float*)(F.lds + 131072);
    LAS float* gfa = sm, *gba = sm + 128, *Mfa = sm + 256, *Mba = sm + 384, *sIf = sm + 512, *sIb = sm + 640, *enf = sm + 768, *enb = sm + 896, *nfa = sm + 1024, *nba = sm + 1152, *qnf = sm + 1280, *qnb = sm + 1408;
    const size_t hoff = (size_t)(b * 4 + h) * SEQ * 128;
    const bf16* zq = (const bf16*)(F.ws + O_ZQ) + hoff; const bf16* zk = (const bf16*)(F.ws + O_ZK) + hoff; const bf16* zv = (const bf16*)(F.ws + O_ZV) + hoff; const bf16* zo = (const bf16*)(F.ws + O_ZO) + hoff;
    const float* gates = (const float*)(F.ws + O_GATES);
    const bf16* cst = (const bf16*)(F.ws + O_CST); const float* nst = (const float*)(F.ws + O_NST); const float* mst = (const float*)(F.ws + O_MST);
    bf16* Y = (bf16*)(F.ws + O_Y);
    const int sqf = ((b * 4 + h) * 2 + 0) * 32 + c, sqb = ((b * 4 + h) * 2 + 1) * 32 + c;
    if (w < 2) {
        const float mpf = mst[sqf], mpb = mst[sqb];
        const size_t r0 = (row0 + 2 * lane) * 16, r1 = (row0 + 2 * lane + 1) * 16;
        if (w == 0) {
            const float ig0 = gates[r0 + h], ig1 = gates[r1 + h], lf0 = log_sigmoid(gates[r0 + 4 + h]), lf1 = log_sigmoid(gates[r1 + 4 + h]);
            const float incl = wscan_add(lf0 + lf1, lane), bf0 = incl - lf1, bf1 = incl;
            const float g0 = ig0 - bf0, g1 = ig1 - bf1;
            const float pin = wscan_max(fmaxf(g0, g1), lane); float pex = __shfl_up(pin, 1); if (lane == 0) pex = -3.0e38f;
            const float M0 = fmaxf(mpf, fmaxf(pex, g0)), M1 = fmaxf(mpf, pin);
            gfa[2 * lane] = g0; gfa[2 * lane + 1] = g1; Mfa[2 * lane] = M0; Mfa[2 * lane + 1] = M1;
            sIf[2 * lane] = __expf(mpf - M0); sIf[2 * lane + 1] = __expf(mpf - M1);
            enf[2 * lane] = __expf(-bf0 - M0); enf[2 * lane + 1] = __expf(-bf1 - M1);
        }
        else {
            const float ig0 = gates[r0 + 8 + h], ig1 = gates[r1 + 8 + h], lf0 = log_sigmoid(gates[r0 + 12 + h]), lf1 = log_sigmoid(gates[r1 + 12 + h]);
            const float incl = wscan_add(lf0 + lf1, lane), Ftot = __shfl(incl, 63);
            const float bb0 = Ftot - incl + lf0 + lf1, bb1 = Ftot - incl + lf1;
            const float g0 = ig0 - bb0, g1 = ig1 - bb1;
            const float sin_ = wscan_max_rev(fmaxf(g0, g1), lane); float sex = __shfl_down(sin_, 1); if (lane == 63) sex = -3.0e38f;
            const float M0 = fmaxf(mpb, sin_), M1 = fmaxf(mpb, fmaxf(sex, g1));
            gba[2 * lane] = g0; gba[2 * lane + 1] = g1; Mba[2 * lane] = M0; Mba[2 * lane + 1] = M1;
            sIb[2 * lane] = __expf(mpb - M0); sIb[2 * lane + 1] = __expf(mpb - M1);
            enb[2 * lane] = __expf(-bb0 - M0); enb[2 * lane + 1] = __expf(-bb1 - M1);
        }
    }
    if (tid < 128) { nfa[tid] = nst[(size_t)sqf * 128 + tid]; nba[tid] = nst[(size_t)sqb * 128 + tid]; }
    u32x4 kraw[8]; conv_issue(kraw, zk, c, tid);
    conv_build(T_Q, qraw, h * 128, INP(I_CONVW), INP(I_CONVB), 1.0f, tid);
    conv_build(T_K, kraw, 512 + h * 128, INP(I_CONVW), INP(I_CONVB), 0.08838834764831845f, tid);
    build_copy_tile(T_V, zv, (size_t)c * 128, 128, 0, tid);
    build_copy_tile(T_C, cst + (size_t)sqf * 16384, 0, 128, 0, tid);
    __syncthreads();
    {
        const int t = tid >> 2, part = tid & 3; float af = 0.f, ab = 0.f;
#pragma unroll
        for (int cc = 0; cc < 4; ++cc) { const u32x4 raw = *(const LAS u32x4*)(T_Q + offb(t, 4 * part + cc)); const int dd = 32 * part + 8 * cc;
            const float qv[8] = {bflo(raw.x), bfhi(raw.x), bflo(raw.y), bfhi(raw.y), bflo(raw.z), bfhi(raw.z), bflo(raw.w), bfhi(raw.w)};
#pragma unroll
            for (int i = 0; i < 8; ++i) { af += qv[i] * nfa[dd + i]; ab += qv[i] * nba[dd + i]; } }
        af += __shfl_xor(af, 1); af += __shfl_xor(af, 2); ab += __shfl_xor(ab, 1); ab += __shfl_xor(ab, 2);
        if (part == 0) { qnf[t] = af; qnb[t] = ab; }
    }
    u32x4 cbreg[4];
    { const int dg = tid & 15, sg = tid >> 4; const bf16* src = cst + (size_t)sqb * 16384;
#pragma unroll
      for (int rr = 0; rr < 4; ++rr) cbreg[rr] = *(const GAS u32x4*)(src + (size_t)(4 * sg + rr) * 128 + 8 * dg); }
    bf16x8 Qf[4];
#pragma unroll
    for (int kk = 0; kk < 4; ++kk) Qf[kk] = frag_row(T_Q, 16 * w, kk, lane);
    f32x4 aS[8];
#pragma unroll
    for (int mt = 0; mt < 8; ++mt) aS[mt] = (f32x4){0.f, 0.f, 0.f, 0.f};
#pragma unroll
    for (int kk = 0; kk < 4; ++kk) {
#pragma unroll
        for (int mt = 0; mt < 8; ++mt) aS[mt] = mfma16(frag_row(T_K, 16 * mt, kk, lane), Qf[kk], aS[mt]);
        __builtin_amdgcn_sched_barrier(0); }
    __syncthreads();
    const int tl = 16 * w + (lane & 15);
    float cf, cb_;
    {
        const float Mf = Mfa[tl], Mb = Mba[tl];
        f32x4 wf[8], wb[8]; float sumf = 0.f, sumb = 0.f;
#pragma unroll
        for (int mt = 0; mt < 8; ++mt) { const int s0 = 16 * mt + 4 * (lane >> 4); const f32x4 gf4 = *(const LAS f32x4*)(gfa + s0), gb4 = *(const LAS f32x4*)(gba + s0);
#pragma unroll
            for (int j = 0; j < 4; ++j) { const int s = s0 + j; const float sv = aS[mt][j];
                const float a = (s <= tl) ? __expf(gf4[j] - Mf) * sv : 0.f, bq = (s >= tl) ? __expf(gb4[j] - Mb) * sv : 0.f;
                wf[mt][j] = a; wb[mt][j] = bq; sumf += a; sumb += bq; } }
        sumf += __shfl_xor(sumf, 16); sumf += __shfl_xor(sumf, 32); sumb += __shfl_xor(sumb, 16); sumb += __shfl_xor(sumb, 32);
        const float sif = sIf[tl], sib = sIb[tl];
        const float denf = sumf + sif * qnf[tl], denb = sumb + sib * qnb[tl];
        const float rf = 1.0f / fmaxf(fabsf(denf), enf[tl]), rb = 1.0f / fmaxf(fabsf(denb), enb[tl]);
        cf = sif * rf; cb_ = sib * rb;
#pragma unroll
        for (int mt = 0; mt < 8; ++mt) { const int s0 = 16 * mt + 4 * (lane >> 4);
            u32x2 v; v.x = pk2(wf[mt][0] * rf + wb[mt][0] * rb, wf[mt][1] * rf + wb[mt][1] * rb); v.y = pk2(wf[mt][2] * rf + wb[mt][2] * rb, wf[mt][3] * rf + wb[mt][3] * rb);
            *(LAS u32x2*)(T_K + offb(tl, s0 >> 3) + (s0 & 7) * 2) = v; }
    }
    { const int nu = unit + F.G;
      if (nu < NU3) { const size_t ho = (size_t)(nu >> 5) * SEQ * 128; conv_issue(qraw, (const bf16*)(F.ws + O_ZQ) + ho, nu & 31, tid); } }
    f32x4 aO[8], aZ[8];
#pragma unroll
    for (int mt = 0; mt < 8; ++mt) { aO[mt] = (f32x4){0.f, 0.f, 0.f, 0.f}; aZ[mt] = (f32x4){0.f, 0.f, 0.f, 0.f}; }
#pragma unroll
    for (int kk = 0; kk < 4; ++kk) { const bf16x8 Yw = frag_row(T_K, 16 * w, kk, lane);
#pragma unroll
        for (int mt = 0; mt < 8; ++mt) aO[mt] = mfma16(frag_tr(T_V, 32 * kk, 16 * mt, lane), Yw, aO[mt]);
        __builtin_amdgcn_sched_barrier(0); }
#pragma unroll
    for (int kk = 0; kk < 4; ++kk) {
#pragma unroll
        for (int mt = 0; mt < 8; ++mt) aZ[mt] = mfma16(frag_row(T_C, 16 * mt, kk, lane), Qf[kk], aZ[mt]);
        __builtin_amdgcn_sched_barrier(0); }
#pragma unroll
    for (int mt = 0; mt < 8; ++mt) { aO[mt] += aZ[mt] * cf; aZ[mt] = (f32x4){0.f, 0.f, 0.f, 0.f}; }
    __syncthreads();
    { const int dg = tid & 15, sg = tid >> 4;
#pragma unroll
      for (int rr = 0; rr < 4; ++rr) *(LAS u32x4*)(T_C + offb(4 * sg + rr, dg)) = cbreg[rr]; }
    __syncthreads();
#pragma unroll
    for (int kk = 0; kk < 4; ++kk) {
#pragma unroll
        for (int mt = 0; mt < 8; ++mt) aZ[mt] = mfma16(frag_row(T_C, 16 * mt, kk, lane), Qf[kk], aZ[mt]);
        __builtin_amdgcn_sched_barrier(0); }
    u32x2 og[8];
#pragma unroll
    for (int mt = 0; mt < 8; ++mt) og[mt] = *(const GAS u32x2*)(zo + (size_t)(c * 128 + 16 * w + (lane & 15)) * 128 + 16 * mt + 4 * (lane >> 4));
    float ssq = 0.f;
#pragma unroll
    for (int mt = 0; mt < 8; ++mt) { aO[mt] += aZ[mt] * cb_; ssq += (aO[mt][0] * aO[mt][0] + aO[mt][1] * aO[mt][1]) + (aO[mt][2] * aO[mt][2] + aO[mt][3] * aO[mt][3]); }
    ssq += __shfl_xor(ssq, 16); ssq += __shfl_xor(ssq, 32);
    const float rinv = 1.0f / sqrtf(ssq * (1.f / 128.f) + RMS_EPS);
    const size_t row = row0 + tl;
#pragma unroll
    for (int mt = 0; mt < 8; ++mt) { const int e = 16 * mt + 4 * (lane >> 4);
        const u32x2 ogv = og[mt]; const f32x4 gh = *(const GAS f32x4*)(INP(I_GHEAD) + h * 128 + e);
        u32x2 o; o.x = pk2(bflo(ogv.x) * aO[mt][0] * rinv * gh.x, bfhi(ogv.x) * aO[mt][1] * rinv * gh.y); o.y = pk2(bflo(ogv.y) * aO[mt][2] * rinv * gh.z, bfhi(ogv.y) * aO[mt][3] * rinv * gh.w);
        *(GAS u32x2*)(Y + row * DM + h * 128 + e) = o; }
    __syncthreads();
  }
}
DI void kv_dma(LAS uchar* buf, const bf16* kv, int b, int col0, int w, int lane) {
#pragma unroll
    for (int i = 0; i < 8; ++i) { const int r = 32 * w + 4 * i + (lane >> 4); const int f = ((r & 3) << 2) | ((r >> 2) & 3);
        const bf16* src = kv + (size_t)(b * NMEM + r) * 2048 + col0 + 8 * ((lane & 15) ^ f);
        __builtin_amdgcn_global_load_lds((const unsigned*)src, (LAS unsigned*)(buf + 256 * (32 * w + 4 * i)), 16, 0, 0); }
}
#define DMA_WAIT() asm volatile("s_waitcnt vmcnt(0)" ::: "memory")
DI bf16x8 frag_tr_perm(const LAS uchar* tile, int k0, int c0, int lane) {
    const unsigned g = lane >> 4, q = (lane & 15) >> 2, p = lane & 3;
    const unsigned ch = (c0 >> 3) + (p >> 1), bo = 8u * (p & 1);
    const s16x4 lo = __builtin_amdgcn_ds_read_tr16_b64_v4i16((LAS s16x4*)(tile + offb(k0 + 4 * g + q, ch) + bo));
    const s16x4 hi = __builtin_amdgcn_ds_read_tr16_b64_v4i16((LAS s16x4*)(tile + offb(k0 + 16 + 4 * g + q, ch) + bo));
    return (bf16x8){lo[0], lo[1], lo[2], lo[3], hi[0], hi[1], hi[2], hi[3]};
}
DI void attn_phase(Frame& F) {
    const int w = F.wave;
    constexpr int NU = NB * 4 * 16;
    const bf16* Q = (const bf16*)(F.ws + O_Q); const bf16* kv = (const bf16*)(F.ws + O_KV); uchar* O = F.ws + O_O;
    LAS uchar* B0 = F.lds; LAS uchar* B1 = F.lds + 65536;
    const int vb = F.bid;
    if (vb < NU) { const int u0 = vb; kv_dma(B0, kv, u0 >> 6, ((u0 >> 4) & 3) * 256, w, F.lane); }
    DMA_WAIT(); __syncthreads();
    for (int unit = vb; unit < NU; unit += F.G) {
        int tid = F.tid, lane = F.lane; asm volatile("" : "+v"(tid), "+v"(lane));
        const int qb = unit & 15, hd = (unit >> 4) & 3, b = unit >> 6;
        const int nu = unit + F.G;
        const size_t qrow0 = (size_t)b * SEQ + qb * 256 + 32 * w + (lane & 15);
        f32x4 aS[2][16];
#pragma unroll
        for (int tb = 0; tb < 2; ++tb)
#pragma unroll
            for (int mt = 0; mt < 16; ++mt) aS[tb][mt] = (f32x4){0.f, 0.f, 0.f, 0.f};
        bf16x8 Qc[2], Qn[2];
#pragma unroll
        for (int tb = 0; tb < 2; ++tb) Qn[tb] = *(const GAS bf16x8*)(Q + (qrow0 + 16 * tb) * DM + hd * 256 + 8 * (lane >> 4));
#pragma unroll
        for (int dh = 0; dh < 2; ++dh) {
            const LAS uchar* KB = dh ? B1 : B0;
            if (dh == 0) kv_dma(B1, kv, b, hd * 256 + 128, w, lane);
            else kv_dma(B0, kv, b, 1024 + hd * 256, w, lane);
#pragma unroll
            for (int kk = 0; kk < 4; ++kk) { const int st = dh * 4 + kk;
                Qc[0] = Qn[0]; Qc[1] = Qn[1];
                if (st < 7) {
#pragma unroll
                    for (int tb = 0; tb < 2; ++tb) Qn[tb] = *(const GAS bf16x8*)(Q + (qrow0 + 16 * tb) * DM + hd * 256 + 32 * (st + 1) + 8 * (lane >> 4)); }
#pragma unroll
                for (int mh = 0; mh < 4; ++mh) {
#pragma unroll
                    for (int mq = 0; mq < 4; ++mq) { const int mt = 4 * mh + mq; const bf16x8 X = frag_row(KB, 16 * mt, kk, lane);
                        aS[0][mt] = mfma16(X, Qc[0], aS[0][mt]); aS[1][mt] = mfma16(X, Qc[1], aS[1][mt]); }
                    __builtin_amdgcn_sched_barrier(0); } }
            DMA_WAIT(); __syncthreads();
        }
        bf16x8 Pf[2][8]; float rinv[2];
#pragma unroll
        for (int tb = 0; tb < 2; ++tb) {
            float mx = -3.0e38f;
#pragma unroll
            for (int mt = 0; mt < 16; ++mt) mx = fmaxf(mx, fmaxf(fmaxf(aS[tb][mt][0], aS[tb][mt][1]), fmaxf(aS[tb][mt][2], aS[tb][mt][3])));
            mx = fmaxf(mx, __shfl_xor(mx, 16)); mx = fmaxf(mx, __shfl_xor(mx, 32));
            float sum = 0.f;
#pragma unroll
            for (int s = 0; s < 8; ++s) { f32x4 p0, p1;
#pragma unroll
                for (int j = 0; j < 4; ++j) { p0[j] = __expf(aS[tb][2 * s][j] - mx); p1[j] = __expf(aS[tb][2 * s + 1][j] - mx); sum += p0[j] + p1[j]; }
                u32x4 pk; pk.x = pk2(p0[0], p0[1]); pk.y = pk2(p0[2], p0[3]); pk.z = pk2(p1[0], p1[1]); pk.w = pk2(p1[2], p1[3]);
                Pf[tb][s] = __builtin_bit_cast(bf16x8, pk); }
            sum += __shfl_xor(sum, 16); sum += __shfl_xor(sum, 32);
            rinv[tb] = 1.0f / sum;
        }
#pragma unroll
        for (int eh = 0; eh < 2; ++eh) {
            const LAS uchar* VB = eh ? B1 : B0;
            if (eh == 0) kv_dma(B1, kv, b, 1024 + hd * 256 + 128, w, lane);
            else if (nu < NU) kv_dma(B0, kv, nu >> 6, ((nu >> 4) & 3) * 256, w, lane);
            f32x4 aO[2][8];
#pragma unroll
            for (int tb = 0; tb < 2; ++tb)
#pragma unroll
                for (int mt = 0; mt < 8; ++mt) aO[tb][mt] = (f32x4){0.f, 0.f, 0.f, 0.f};
#pragma unroll
            for (int s = 0; s < 8; ++s) {
#pragma unroll
                for (int mh = 0; mh < 2; ++mh) {
#pragma unroll
                    for (int mq = 0; mq < 4; ++mq) { const int mt = 4 * mh + mq; const bf16x8 X = frag_tr_perm(VB, 32 * s, 16 * mt, lane);
                        aO[0][mt] = mfma16(X, Pf[0][s], aO[0][mt]); aO[1][mt] = mfma16(X, Pf[1][s], aO[1][mt]); }
                    __builtin_amdgcn_sched_barrier(0); } }
#pragma unroll
            for (int tb = 0; tb < 2; ++tb)
#pragma unroll
                for (int mt = 0; mt < 8; ++mt) { const int e = 16 * mt + 4 * (lane >> 4); const float ri = rinv[tb];
                    *(GAS unsigned*)(O + (qrow0 + 16 * tb) * DM + hd * 256 + eh * 128 + e) = pk4_fp8(aO[tb][mt][0] * ri, aO[tb][mt][1] * ri, aO[tb][mt][2] * ri, aO[tb][mt][3] * ri); }
            DMA_WAIT(); __syncthreads();
        }
    }
}

DI void route_block(Frame& F, int blk) {
    const int tid = F.tid, lane = F.lane, w = F.wave;
    LAS float* lg = (LAS float*)F.lds + (size_t)w * (32 * 48);
    LAS int* tokE = (LAS int*)(F.lds + 147456);
    LAS int* tokR = tokE + 512;
    LAS int* wcnt = tokR + 512;
    LAS int* base = wcnt + 256;
    const bf16* x2 = (const bf16*)(F.ws + O_XB); float* rs3 = (float*)(F.ws + O_RS3); unsigned* tok = (unsigned*)(F.ws + O_TOK); int* ridx = (int*)(F.ws + O_RIDX);
    const bf16* wrh = (const bf16*)(F.ws + O_WRH); const bf16* wrl = (const bf16*)(F.ws + O_WRL);
    unsigned* cnt = (unsigned*)(F.ws + O_CTL) + CW_CNT;
    const int r16 = lane & 15, g4 = lane >> 4;
    const size_t row0 = (size_t)blk * 256 + 32 * w;
    f32x4 acc[3][2];
#pragma unroll
    for (int nb = 0; nb < 3; ++nb) { acc[nb][0] = (f32x4){0.f, 0.f, 0.f, 0.f}; acc[nb][1] = (f32x4){0.f, 0.f, 0.f, 0.f}; }
    float ss0 = 0.f, ss1 = 0.f;
    bf16x8 Yn[2], Xhn[3], Xln[3];
#define RT_LOAD(kk) do { _Pragma("unroll") for (int rb = 0; rb < 2; ++rb) Yn[rb] = *(const GAS bf16x8*)(x2 + (row0 + 16 * rb + r16) * DM + 32 * (kk) + 8 * g4); \
        _Pragma("unroll") for (int nb = 0; nb < 3; ++nb) { Xhn[nb] = *(const GAS bf16x8*)(wrh + (size_t)(16 * nb + r16) * 1024 + 32 * (kk) + 8 * g4); Xln[nb] = *(const GAS bf16x8*)(wrl + (size_t)(16 * nb + r16) * 1024 + 32 * (kk) + 8 * g4); } } while (0)
    RT_LOAD(0);
    for (int kk = 0; kk < 32; ++kk) {
        bf16x8 Y[2], Xh[3], Xl[3];
        Y[0] = Yn[0]; Y[1] = Yn[1];
#pragma unroll
        for (int nb = 0; nb < 3; ++nb) { Xh[nb] = Xhn[nb]; Xl[nb] = Xln[nb]; }
        if (kk + 1 < 32) RT_LOAD(kk + 1);
        { float xf[2][8];
#pragma unroll
          for (int rb = 0; rb < 2; ++rb) {
#pragma unroll
            for (int j = 0; j < 8; ++j) xf[rb][j] = bf2f((unsigned short)Y[rb][j]);
            u32x2 o8; o8.x = pk4_fp8(xf[rb][0], xf[rb][1], xf[rb][2], xf[rb][3]); o8.y = pk4_fp8(xf[rb][4], xf[rb][5], xf[rb][6], xf[rb][7]);
            *(GAS u32x2*)((uchar*)F.ws + O_X2F8 + (row0 + 16 * rb + r16) * DM + 32 * kk + 8 * g4) = o8; } }
#pragma unroll
        for (int j = 0; j < 8; ++j) { const float a = bf2f((unsigned short)Y[0][j]), c = bf2f((unsigned short)Y[1][j]); ss0 += a * a; ss1 += c * c; }
#pragma unroll
        for (int nb = 0; nb < 3; ++nb)
#pragma unroll
            for (int rb = 0; rb < 2; ++rb) { acc[nb][rb] = mfma16(Xh[nb], Y[rb], acc[nb][rb]); acc[nb][rb] = mfma16(Xl[nb], Y[rb], acc[nb][rb]); }
    }
#undef RT_LOAD
    ss0 += __shfl_xor(ss0, 16); ss0 += __shfl_xor(ss0, 32); ss1 += __shfl_xor(ss1, 16); ss1 += __shfl_xor(ss1, 32);
    const float rsA = 1.0f / sqrtf(ss0 * (1.f / DM) + RMS_EPS), rsB = 1.0f / sqrtf(ss1 * (1.f / DM) + RMS_EPS);
#pragma unroll
    for (int nb = 0; nb < 3; ++nb)
#pragma unroll
        for (int rb = 0; rb < 2; ++rb) { const float rs = rb ? rsB : rsA;
            *(LAS f32x4*)(lg + (16 * rb + r16) * 48 + 16 * nb + 4 * g4) = acc[nb][rb] * rs; }
    if (g4 == 0) { rs3[row0 + r16] = rsA; rs3[row0 + 16 + r16] = rsB; }
    LDS_WAIT(); asm volatile("" ::: "memory");
    if (lane < 32) {
        const LAS float* L = lg + lane * 48; const int rl = 32 * w + lane; const size_t m = row0 + lane;
        float l4[4];
#pragma unroll
        for (int j = 0; j < 4; ++j) l4[j] = L[j] + INP(I_BRG)[j];
        int gi = 0; float lm = l4[0];
#pragma unroll
        for (int j = 1; j < 4; ++j) if (l4[j] > lm) { lm = l4[j]; gi = j; }
        const float ptop = 1.0f / (__expf(l4[0] - lm) + __expf(l4[1] - lm) + __expf(l4[2] - lm) + __expf(l4[3] - lm));
        float le[8];
#pragma unroll
        for (int j = 0; j < 8; ++j) le[j] = L[16 + gi * 8 + j] + INP(I_BRE)[gi * 8 + j];
        int e0 = 0; float m0 = le[0];
#pragma unroll
        for (int j = 1; j < 8; ++j) if (le[j] > m0) { m0 = le[j]; e0 = j; }
        int e1 = -1; float m1 = -3.0e38f;
#pragma unroll
        for (int j = 0; j < 8; ++j) if (j != e0 && le[j] > m1) { m1 = le[j]; e1 = j; }
        const float t = __expf(m1 - m0), w0 = ptop / (1.0f + t), w1 = ptop * t / (1.0f + t);
        tokE[2 * rl] = gi * 8 + e0; tokE[2 * rl + 1] = gi * 8 + e1;
        tok[m * 8 + 4] = __float_as_uint(w0); tok[m * 8 + 5] = __float_as_uint(w1);
    }
    __syncthreads();
    {
        const int myE = tokE[tid]; int myR = 0;
        for (int e = 0; e < 32; ++e) { const unsigned long long mk = __ballot(myE == e); if (myE == e) myR = __popcll(mk & ((1ull << lane) - 1ull)); if (lane == 0) wcnt[w * 32 + e] = __popcll(mk); }
        __syncthreads();
        int add = 0;
        for (int ww = 0; ww < w; ++ww) add += wcnt[ww * 32 + myE];
        tokR[tid] = myR + add;
        if (tid < 32) { int tot = 0; for (int ww = 0; ww < 8; ++ww) tot += wcnt[ww * 32 + tid]; base[tid] = (int)__hip_atomic_fetch_add(cnt + tid, (unsigned)tot, __ATOMIC_RELAXED, __HIP_MEMORY_SCOPE_AGENT); }
        __syncthreads();
        const int pos = base[myE] + tokR[tid], m = blk * 256 + (tid >> 1);
        ridx[(size_t)myE * NTOK + pos] = m;
        tok[(size_t)m * 8 + (tid & 1) * 2 + 0] = (unsigned)myE; tok[(size_t)m * 8 + (tid & 1) * 2 + 1] = (unsigned)pos;
    }
    __syncthreads();
}
DI void phase8(Frame& F) {
    for (int blk = F.bid; blk < NTOK / 256; blk += F.G) route_block(F, blk);
}

DI void moe_tables(Frame& F, LAS int*& cum, LAS int*& cntl) {
    cum = (LAS int*)(F.lds + 131072); cntl = cum + 64;
    const unsigned* cnt = (const unsigned*)(F.ws + O_CTL) + CW_CNT;
    if (F.tid < 32) cntl[F.tid] = (int)__hip_atomic_load(cnt + F.tid, __ATOMIC_RELAXED, __HIP_MEMORY_SCOPE_AGENT);
    __syncthreads();
    if (F.tid == 0) { int a = 0; for (int e = 0; e < 32; ++e) { cum[e] = a; a += (cntl[e] + 255) >> 8; } cum[32] = a; }
    __syncthreads();
}

DI LAS int* moe_units(Frame& F, const LAS int* cum, const LAS int* cntl, int c) {
    LAS int* ut = (LAS int*)(F.lds + 131072 + 512);
    if (F.tid < 16) { const int L = F.tid * F.G + c, T = L >> 2; int e = -1, nv = 0, ro = 0;
        if (T < cum[32]) { e = 0; for (int k = 1; k < 32; ++k) e += (cum[k] <= T) ? 1 : 0;
            const int mt = T - cum[e]; nv = min(256, cntl[e] - mt * 256); ro = e * NTOK + mt * 256; }
        ut[4 * F.tid + 0] = e; ut[4 * F.tid + 1] = T; ut[4 * F.tid + 2] = nv; ut[4 * F.tid + 3] = ro; }
    __syncthreads();
    return ut;
}

DI void phase11(Frame& F) {
    LAS int* cum; LAS int* cntl; moe_tables(F, cum, cntl);
    const int gw = F.bid * NWAVES + F.wave, NGW = F.G * NWAVES, lane = F.lane;
    const unsigned* tok = (const unsigned*)(F.ws + O_TOK); const uchar* YD = F.ws + O_YD;
    f32x4 gfin[4];
#pragma unroll
    for (int j = 0; j < 4; ++j) gfin[j] = ((const f32x4*)INP(I_GFINAL))[lane + 64 * j];
    for (int m0 = gw; m0 < NTOK; m0 += 4 * NGW) {
        u32x4 ti[4]; unsigned tw0[4], tw1[4];
#pragma unroll
        for (int q = 0; q < 4; ++q) { const int m = m0 + q * NGW; ti[q] = *(const GAS u32x4*)(tok + (size_t)m * 8); tw0[q] = tok[(size_t)m * 8 + 4]; tw1[q] = tok[(size_t)m * 8 + 5]; }
        u32x2 xv[4][4]; unsigned ya[4][4], yb[4][4];
#pragma unroll
        for (int q = 0; q < 4; ++q) { const int m = m0 + q * NGW;
            const size_t s0 = (size_t)cum[ti[q].x] * 256 + ti[q].y, s1 = (size_t)cum[ti[q].z] * 256 + ti[q].w;
            const u32x2* xr = (const u32x2*)((const bf16*)(F.ws + O_XB) + (size_t)m * DM) + lane;
            const GAS unsigned* y0 = (const GAS unsigned*)(YD + s0 * DM) + lane; const GAS unsigned* y1 = (const GAS unsigned*)(YD + s1 * DM) + lane;
#pragma unroll
            for (int j = 0; j < 4; ++j) { xv[q][j] = xr[64 * j]; ya[q][j] = y0[64 * j]; yb[q][j] = y1[64 * j]; } }
#pragma unroll
        for (int q = 0; q < 4; ++q) { const int m = m0 + q * NGW;
            const float w0 = __uint_as_float(tw0[q]) * 0.03125f, w1 = __uint_as_float(tw1[q]) * 0.03125f;
            f32x4* xr = (f32x4*)(F.out + (size_t)m * DM) + lane;
            f32x4 v[4]; float s = 0.f;
#pragma unroll
            for (int j = 0; j < 4; ++j) { const f32x2 a0 = __builtin_amdgcn_cvt_pk_f32_fp8(ya[q][j], false), a1 = __builtin_amdgcn_cvt_pk_f32_fp8(ya[q][j], true), b0 = __builtin_amdgcn_cvt_pk_f32_fp8(yb[q][j], false), b1 = __builtin_amdgcn_cvt_pk_f32_fp8(yb[q][j], true);
                f32x4 mo; mo.x = w0 * a0.x + w1 * b0.x; mo.y = w0 * a0.y + w1 * b0.y; mo.z = w0 * a1.x + w1 * b1.x; mo.w = w0 * a1.y + w1 * b1.y;
                v[j] = (f32x4){bflo(xv[q][j].x), bfhi(xv[q][j].x), bflo(xv[q][j].y), bfhi(xv[q][j].y)} + mo; s += (v[j].x * v[j].x + v[j].y * v[j].y) + (v[j].z * v[j].z + v[j].w * v[j].w); }
            const float rs = 1.0f / sqrtf(wave_sum(s) * (1.f / DM) + RMS_EPS);
#pragma unroll
            for (int j = 0; j < 4; ++j) xr[64 * j] = v[j] * rs * gfin[j]; }
    }
}
typedef GAS unsigned gu32;
#define RLX_AGENT __ATOMIC_RELAXED, __HIP_MEMORY_SCOPE_AGENT
#define XB_TMO      128
#define XB_XCNT(j)  (256  + 64 * (j))
#define XB_XSUB(j)  (1280 + 64 * (j))
#define XB_XGEN(j)  (2304 + 64 * (j))
#define XB_TOP      3328
#define XB_TOPGEN   3392
#define XCD_BAR_WORDS 3456
#define XB_SPIN_CAP (1u << 18)

__device__ __forceinline__ unsigned xb_ld(unsigned* p)              { return __hip_atomic_load(p, __ATOMIC_RELAXED, __HIP_MEMORY_SCOPE_AGENT); }
__device__ __forceinline__ unsigned xb_add(unsigned* p, unsigned v) { return __hip_atomic_fetch_add(p, v, __ATOMIC_RELAXED, __HIP_MEMORY_SCOPE_AGENT); }
__device__ __forceinline__ unsigned xb_xcc_id() { return (unsigned)__builtin_amdgcn_s_getreg((3 << 11) | 20) & 0xFu; }
#define XB_SPIN(cond, bar) do { unsigned _sp = 0; while (cond) { __builtin_amdgcn_s_sleep(1); \
    if ((++_sp & 255u) == 0u) { if (xb_ld(&(bar)[XB_TMO])) break; if (_sp > XB_SPIN_CAP) { atomicAdd(&(bar)[XB_TMO], 1u); break; } } } } while (0)

struct XcdBarrier {
    unsigned* bar; unsigned x;
    volatile LAS unsigned* st;
};

__device__ __forceinline__ XcdBarrier xcd_barrier_post(unsigned* bar, volatile LAS unsigned* st) {
    XcdBarrier b; b.bar = bar; b.x = xb_xcc_id(); b.st = st;
    if (threadIdx.x == 0) (void)xb_add(&bar[XB_XCNT(b.x)], 1u);
    return b;
}
__device__ __forceinline__ void xcd_barrier_complete(unsigned* bar, unsigned x, unsigned& nloc, unsigned& nx) {
    const unsigned G = gridDim.x * gridDim.y * gridDim.z;
    unsigned sum, cnt, mine, sp = 0u;
    for (;;) {
        sum = 0u; cnt = 0u; mine = 0u;
#pragma unroll
        for (unsigned j = 0; j < 16; ++j) { const unsigned c = xb_ld(&bar[XB_XCNT(j)]); sum += c; cnt += (c > 0u) ? 1u : 0u; mine = (j == x) ? c : mine; }
        if (sum == G) break;
        __builtin_amdgcn_s_sleep(1);
        if ((++sp & 255u) == 0u) { if (xb_ld(&bar[XB_TMO])) break; if (sp > XB_SPIN_CAP) { atomicAdd(&bar[XB_TMO], 1u); break; } }
    }
    nloc = mine > 0u ? mine : 1u; nx = cnt > 0u ? cnt : 1u;
}

__device__ __forceinline__ void xcd_barrier(const XcdBarrier& b) {
    asm volatile("s_waitcnt vmcnt(0)" ::: "memory");
    __syncthreads();
    if (threadIdx.x == 0) {
        unsigned* bar = b.bar;
        __builtin_amdgcn_s_waitcnt(0);
        unsigned nloc = b.st[0], nx = b.st[1];
        if (nloc == 0u) { xcd_barrier_complete(bar, b.x, nloc, nx); b.st[0] = nloc; b.st[1] = nx; }
        const unsigned old = xb_add(&bar[XB_XSUB(b.x)], 1u);
        const unsigned gen = old / nloc;
        if (old + 1u == (gen + 1u) * nloc) {
            __builtin_amdgcn_fence(__ATOMIC_RELEASE, "agent");
            asm volatile("s_waitcnt vmcnt(0)" ::: "memory");
            const unsigned og = xb_add(&bar[XB_TOP], 1u);
            const unsigned tg = og / nx;
            if (og + 1u == (tg + 1u) * nx) xb_add(&bar[XB_TOPGEN], 1u);
            else XB_SPIN(xb_ld(&bar[XB_TOPGEN]) == tg, bar);
            __builtin_amdgcn_fence(__ATOMIC_ACQUIRE, "agent");
            xb_add(&bar[XB_XGEN(b.x)], 1u);
            asm volatile("s_waitcnt vmcnt(0)" ::: "memory");
        } else {
            XB_SPIN(xb_ld(&bar[XB_XGEN(b.x)]) == gen, bar);
            __builtin_amdgcn_fence(__ATOMIC_ACQUIRE, "agent");
            asm volatile("s_waitcnt vmcnt(0)" ::: "memory");
        }
    }
    __syncthreads();
}

#ifndef MK_N_LAUNCHES
#define MK_N_LAUNCHES 1
#define DOUBLE_MASK 0
#endif
constexpr int N_PHASES = 12;

__global__ void __launch_bounds__(NTHR, 2) hybrid_fwd(Args args) {
    extern __shared__ __attribute__((aligned(16))) uchar lds_raw[];
    Frame F;
    F.lds = (LAS uchar*)lds_raw;
    F.tid = threadIdx.x; F.lane = F.tid & 63; F.wave = __builtin_amdgcn_readfirstlane(F.tid >> 6);
    F.G = gridDim.x; F.bid = blockIdx.x;
    F.in = args.in;
    F.out = (float*)args.out; F.ws = (uchar*)args.ws;
    uchar* ws = (uchar*)args.ws;
    const int lo = args.ph_lo, hi = args.ph_hi;
    volatile LAS unsigned* MISC = (volatile LAS unsigned*)(F.lds + LDS_BYTES - 256);
    if (F.tid < 64) MISC[F.tid] = 0u;
    __syncthreads();
    XcdBarrier bar; bar.bar = (unsigned*)((uchar*)args.ws + O_CTL) + CW_BAR; bar.x = 0; bar.st = MISC + 8;
    if (hi - lo > 1) bar = xcd_barrier_post((unsigned*)((uchar*)args.ws + O_CTL) + CW_BAR, MISC + 8);
#ifndef PHASE_MASK
#define PHASE_MASK 0xFFF
#endif
#ifndef DOUBLE_MASK
#define DOUBLE_MASK 0
#endif
#define IN(k) (((PHASE_MASK >> (k)) & 1) && lo <= (k) && (k) < hi)
#define REP(k) for (int rep_ = 0; rep_ < 1 + ((DOUBLE_MASK >> (k)) & 1); ++rep_)
#if defined(__HIP_DEVICE_COMPILE__)
#define ASSUME_GLOBAL(p) __builtin_assume(!__builtin_amdgcn_is_shared((const void*)(p)) && !__builtin_amdgcn_is_private((const void*)(p)))
#else
#define ASSUME_GLOBAL(p) ((void)0)
#endif
#define OPQ() do { GASK uchar* w_ = args.ws; GASK float* o_ = args.out; asm volatile("" : "+s"(w_), "+s"(o_)); ws = (uchar*)w_; F.ws = ws; F.out = (float*)o_; } while (0)
#define SEAM(k) do { OPQ(); if (lo <= (k) && (k) + 1 < hi) { xcd_barrier(bar); } } while (0)
    using pg8::Gemm; using pg8::StaticOrder; using pg8::gemm_phase;
#ifndef TSEL
#define TSEL (-1)
#endif
    unsigned long long tq0 = 0, tq1 = 0;
#ifdef TPROBE
#define TQ0(k) do { if ((k) == TSEL) { if (F.tid == 0) { *(volatile LAS unsigned long long*)(F.lds + LDS_BYTES - 256 + 128) = 0ull; *(volatile LAS unsigned long long*)(F.lds + LDS_BYTES - 256 + 136) = 0ull; } } } while (0)
#define TQ1(k) do { if ((k) == TSEL) { tq0 = 0; tq1 = *(volatile LAS unsigned long long*)(F.lds + LDS_BYTES - 256 + 128); } } while (0)
#else
#define TQ0(k) do { if ((k) == TSEL) tq0 = __builtin_amdgcn_s_memrealtime(); } while (0)
#define TQ1(k) do { if ((k) == TSEL) tq1 = __builtin_amdgcn_s_memrealtime(); } while (0)
#endif

    TQ0(0);
    if (IN(0)) REP(0) phase0(F);
    SEAM(0); TQ1(0);
    TQ0(1);
    if (IN(1)) REP(1) {
        { Gemm g{(const bf16*)(ws + O_XB), (const bf16*)(ws + O_WIN), NTOK, ZC, DM}; StaticOrder S; S.init(NTOK, ZC, F.G, F.bid);
          EpiRowScale<0> E{(bf16*)(ws + O_Z), ZG, (const float*)(ws + O_RS0), 1.0f};
          gemm_phase<EpiRowScale<0>, StaticOrder, true, true, false>(F.lds, g, S, E); }
        { Gemm g{(const bf16*)(ws + O_MEMB), (const bf16*)(ws + O_WKV), NMROWS, 2048, DM}; StaticOrder S; S.init(NMROWS, 2048, F.G, F.bid);
          EpiRowScale<1> E{(bf16*)(ws + O_KV), 2048, (const float*)(ws + O_RSM), 1.0f};
          gemm_phase<EpiRowScale<1>, StaticOrder, true, true, false>(F.lds, g, S, E); }
    }
    SEAM(1); TQ1(1);
    TQ0(2);
    if (IN(2)) REP(2) phase2(F);
    SEAM(2); TQ1(2);
    TQ0(3);
    if (IN(3)) REP(3) mlstm_out_phase(F);
    SEAM(3); TQ1(3);
    TQ0(4);
    if (IN(4)) REP(4) {
        Gemm g{(const bf16*)(ws + O_Y), (const bf16*)(ws + O_WOUT), NTOK, DM, DM}; StaticOrder S; S.init(NTOK, DM, F.G, F.bid);
        EpiRes<true, true, true> E{nullptr, (bf16*)(ws + O_XB), (float*)(ws + O_SS1), ws + O_X1F8};
        gemm_phase<EpiRes<true, true, true>, StaticOrder, true, true, false>(F.lds, g, S, E);
    }
    SEAM(4); TQ1(4);
    TQ0(5);
    if (IN(5)) REP(5) {
        Gemm g{(const bf16*)(ws + O_X1F8), (const bf16*)(ws + O_WQ), NTOK, DM, DM, SC_ONE, SC_W}; StaticOrder S; S.init(NTOK, DM, F.G, F.bid);
        EpiQ E{(bf16*)(ws + O_Q), (const float*)(ws + O_SS1), 0.0625f};
#if defined(KREP_PROBE) && KREP_PROBE == 5
        g.krep = 2; g.scale_a = 0x7E7E7E7E;
#endif
        gemm_phase<EpiQ, StaticOrder, true, true, false, true>(F.lds, g, S, E);
    }
    SEAM(5); TQ1(5);
    TQ0(6);
    if (IN(6)) REP(6) attn_phase(F);
    SEAM(6); TQ1(6);
    TQ0(7);
    if (IN(7)) REP(7) {
        Gemm g{(const bf16*)(ws + O_O), (const bf16*)(ws + O_WO), NTOK, DM, DM, SC_ONE, SC_W}; StaticOrder S; S.init(NTOK, DM, F.G, F.bid);
        EpiRes<true, false, false> E{nullptr, (bf16*)(ws + O_XB), nullptr, nullptr};
#if defined(KREP_PROBE) && KREP_PROBE == 7
        g.krep = 2; g.scale_a = 0x7E7E7E7E;
#endif
        gemm_phase<EpiRes<true, false, false>, StaticOrder, true, true, false, true>(F.lds, g, S, E);
    }
    SEAM(7); TQ1(7);
    TQ0(8);
    if (IN(8)) REP(8) phase8(F);
    SEAM(8); TQ1(8);
    TQ0(9);
    if (IN(9)) REP(9) {
        LAS int* cum; LAS int* cntl; moe_tables(F, cum, cntl);
        const int vb = xcd_major(F.bid, F.G);
        MoeOrder S{moe_units(F, cum, cntl, vb), (const int*)(ws + O_RIDX), F.G, vb, false};
        Gemm g{(const bf16*)(ws + O_X2F8), (const bf16*)(ws + O_WGU8), NTOK, NEXP * 1024, DM, SC_ONE, SC_W};
        EpiGU E{(bf16*)(ws + O_H), (const float*)(ws + O_RS3)};
#if defined(KREP_PROBE) && KREP_PROBE == 9
        g.krep = 2; g.scale_a = 0x7E7E7E7E;
#endif
        gemm_phase<EpiGU, MoeOrder, true, true, true, true>(F.lds, g, S, E);
    }
    SEAM(9); TQ1(9);
    TQ0(10);
    if (IN(10)) REP(10) {
        LAS int* cum; LAS int* cntl; moe_tables(F, cum, cntl);
        const int vb = xcd_major(F.bid, F.G);
        MoeOrder S{moe_units(F, cum, cntl, vb), (const int*)(ws + O_RIDX), F.G, vb, true};
        Gemm g{(const bf16*)(ws + O_H), (const bf16*)(ws + O_WD8), MAXSLOTS, NEXP * 1024, DEXP, SC_X32, SC_W};
        EpiPlain8 E{ws + O_YD, DM};
#if defined(KREP_PROBE) && KREP_PROBE == 10
        g.krep = 2; g.scale_a = 0x83838383;
#endif
        gemm_phase<EpiPlain8, MoeOrder, true, true, false, true>(F.lds, g, S, E);
    }
    SEAM(10); TQ1(10);
    TQ0(11);
    if (IN(11)) REP(11) phase11(F);
    TQ1(11);
    if (TSEL >= 0 && F.bid == 0 && F.tid == 0) { const unsigned long long tgt = __builtin_amdgcn_s_memrealtime() + 4ull * (tq1 - tq0); while (__builtin_amdgcn_s_memrealtime() < tgt) __builtin_amdgcn_s_sleep(16); }
#undef IN
#undef SEAM
}

extern "C" void kernel_launch(void* const* d_in, const int* in_sizes, int n_in, void* d_out, int out_size, void* d_ws, size_t ws_size, hipStream_t stream) {
    static int grid = 0;
    if (grid == 0) {
        if (n_in != 27 || in_sizes[0] != NTOK * DM || out_size != NTOK * DM || ws_size < WS_NEED) { fprintf(stderr, "kernel_launch: unexpected shapes (n_in %d, in0 %d, out %d, ws %zu); nothing launched\n", n_in, n_in > 0 ? in_sizes[0] : -1, out_size, ws_size); grid = -1; return; }
        int dev = 0, cus = 0, per_cu = 0;
        if (hipGetDevice(&dev) != hipSuccess || hipDeviceGetAttribute(&cus, hipDeviceAttributeMultiprocessorCount, dev) != hipSuccess) { fprintf(stderr, "kernel_launch: device query failed\n"); grid = -1; return; }
        if (hipFuncSetAttribute((const void*)hybrid_fwd, hipFuncAttributeMaxDynamicSharedMemorySize, LDS_BYTES) != hipSuccess) { fprintf(stderr, "kernel_launch: hipFuncSetAttribute failed\n"); grid = -1; return; }
        if (hipOccupancyMaxActiveBlocksPerMultiprocessor(&per_cu, (const void*)hybrid_fwd, NTHR, LDS_BYTES) != hipSuccess || per_cu < 1) { fprintf(stderr, "kernel_launch: occupancy query says %d\n", per_cu); per_cu = 1; }
        (void)hipGetLastError();
        grid = cus * per_cu;
        if (grid > 256) grid = 256;
    }
    if (grid < 0) return;
    (void)hipMemsetAsync((char*)d_ws + O_CTL, 0, CTL_BYTES, stream);
    Args a{};
    for (int i = 0; i < 27; ++i) a.in[i] = (const GASK float*)d_in[i];
    a.out = (GASK float*)d_out; a.ws = (GASK uchar*)d_ws;
#if MK_N_LAUNCHES == 1
    a.ph_lo = 0; a.ph_hi = N_PHASES;
    hipLaunchKernelGGL(hybrid_fwd, dim3(grid), dim3(NTHR), LDS_BYTES, stream, a);
#else
    for (int p = 0; p < N_PHASES; ++p) { a.ph_lo = p; a.ph_hi = p + 1; hipLaunchKernelGGL(hybrid_fwd, dim3(grid), dim3(NTHR), LDS_BYTES, stream, a); }
#endif
}
```

```cpp
#include <hip/hip_runtime.h>
#include <cstdio>
#include <cstdint>
#define MK_N_LAUNCHES 1
namespace pg8 {
#define PG8_LAS __attribute__((address_space(3)))
typedef unsigned short bf16_t;
typedef short bf16x8 __attribute__((ext_vector_type(8)));
typedef float f32x4 __attribute__((ext_vector_type(4)));
typedef unsigned u32x4 __attribute__((ext_vector_type(4)));
typedef unsigned u32x2 __attribute__((ext_vector_type(2)));
constexpr int BM = 256, BK = 64, HALF = 128, HTB = HALF * BK * 2  , STAGE_BYTES = 8 * HTB, NXCD = 8, WGM = 16;

__host__ __device__ __forceinline__ int lds_byte(int r, int c) { const int st = (r >> 4) * 2 + (c >> 5), rr = r & 15, cc = c & 31, ob = rr * 64 + cc * 2; return st * 1024 + (ob ^ (((ob >> 9) & 1) << 5)); }
__host__ __device__ __forceinline__ void stage_rc(int b, int& R, int& C) { const int st = b / 1024, sb = b % 1024, swz = sb ^ (((sb >> 9) & 1) << 5); R = (st >> 1) * 16 + swz / 64; C = (st & 1) * 32 + (swz % 64) / 2; }
__host__ __device__ __forceinline__ int perm32(int rho) { const int n = rho >> 4, i = rho & 15; return 8 * (i >> 2) + 4 * n + (i & 3); }

struct Unit { int pm, pn; const int* ridx; int nvalid; int orow, ocol, ex; };
struct Gemm { const bf16_t* A; const bf16_t* Bt; int M, N, K; int scale_a, scale_b; int krep = 1; };

struct StaticOrder {
    int nM, nN, nwg, G, c, wgm;
    __host__ __device__ void init(int M, int N, int G_, int c_, int wgm_ = WGM) { nM = M / BM; nN = N / BM; nwg = nM * nN; G = G_; c = c_; wgm = wgm_; }
    __host__ __device__ bool next(int i, Unit& u) const {
        const long L = (long)i * G + c; if (L >= nwg) return false;
        int wgid = (int)L; { const int q = nwg / NXCD, r = nwg % NXCD, xcd = wgid % NXCD, off = wgid / NXCD; wgid = (xcd < r ? xcd * (q + 1) : r * (q + 1) + (xcd - r) * q) + off; }
        const int nig = wgm * nN, gid = wgid / nig, fm = gid * wgm, gsz = (nM - fm) < wgm ? (nM - fm) : wgm;
        u.pm = fm + ((wgid % nig) % gsz); u.pn = (wgid % nig) / gsz; u.ridx = nullptr; u.nvalid = 256; u.orow = u.pm; u.ocol = u.pn * BM; u.ex = 0; return true;
    }
};

__device__ __forceinline__ unsigned cvt_pk_bf16(float lo, float hi) { unsigned r; asm("v_cvt_pk_bf16_f32 %0, %1, %2" : "=v"(r) : "v"(lo), "v"(hi)); return r; }

template <class Epi, class Sched, bool ALIGN_EPI, bool SP2, bool GATHER, bool FP8 = false>
__device__ __forceinline__ void gemm_phase(PG8_LAS unsigned char* lds, const Gemm g, const Sched& S, const Epi& E) {
    const int tid = threadIdx.x, wid = __builtin_amdgcn_readfirstlane(tid >> 6), lane = tid & 63, wr = wid >> 2, wc = wid & 3, fr = lane & 15, fq = lane >> 4;
    const int K = FP8 ? g.K / 2 : g.K, nt = K / BK;
    unsigned voffA[2], voffB[2];
#pragma unroll
    for (int i = 0; i < 2; ++i) { int R, C; stage_rc(tid * 16 + i * 8192, R, C); const int Rb = Epi::PERM ? ((R & ~31) + perm32(R & 31)) : R;
        voffA[i] = (unsigned)(R * K + C) * 2u; voffB[i] = (unsigned)(Rb * K + C) * 2u; }
    const size_t kstep = (size_t)(BK * 2);
    const size_t hstepB = (size_t)HALF * K * 2;
    const size_t hstepA = GATHER ? (size_t)0 : hstepB;
    const size_t tstep = 2 * hstepB;
    const unsigned ldsw = (unsigned)wid * 1024u;
    const int aoff = lds_byte(wr * 64 + fr, fq * 8), boff = lds_byte(wc * 32 + fr, fq * 8);
    unsigned vgC[2][2], vgN[2][2];
#define PG8_SA(b, h) (((b) * 2 + (h)) * HTB)
#define PG8_SB(b, h) ((4 + (b) * 2 + (h)) * HTB)
#define PG8_STAGE(bufoff, gbase, voff) do { _Pragma("unroll") for (int _i = 0; _i < 2; ++_i) \
        __builtin_amdgcn_global_load_lds((const unsigned*)((const char*)(gbase) + (voff)[_i]), (PG8_LAS unsigned*)(lds + (bufoff) + ldsw + _i * 8192), 16, 0, 0); } while (0)
#define PG8_STAGE_A(bufoff, gbase, h, nx) do { if constexpr (GATHER) { unsigned _v[2]; _v[0] = (nx) ? vgN[h][0] : vgC[h][0]; _v[1] = (nx) ? vgN[h][1] : vgC[h][1]; PG8_STAGE(bufoff, gbase, _v); } \
        else { PG8_STAGE(bufoff, (gbase) + (h) * hstepA, voffA); } } while (0)
#define PG8_GOFF(dst, u) do { _Pragma("unroll") for (int _h = 0; _h < 2; ++_h) _Pragma("unroll") for (int _i = 0; _i < 2; ++_i) { int _R, _C; stage_rc(tid * 16 + _i * 8192, _R, _C); int _r = _h * HALF + _R; _r = _r < (u).nvalid ? _r : (u).nvalid - 1; \
        dst[_h][_i] = (unsigned)(u).ridx[_r] * (unsigned)(K * 2) + (unsigned)(_C * 2); } } while (0)
#define PG8_CAT(lo, hi) __builtin_shufflevector(lo, hi, 0, 1, 2, 3, 4, 5, 6, 7)
#define PG8_LDA(dst, b, h) do { _Pragma("unroll") for (int m = 0; m < 4; ++m) { if constexpr (FP8) { dst##8[m] = PG8_CAT(*(const PG8_LAS i32x4_*)(lds + PG8_SA(b, h) + aoff + m * 2048), *(const PG8_LAS i32x4_*)(lds + PG8_SA(b, h) + aoff + m * 2048 + 1024)); } \
        else { _Pragma("unroll") for (int k = 0; k < 2; ++k) dst[m][k] = *(const PG8_LAS bf16x8*)(lds + PG8_SA(b, h) + aoff + m * 2048 + k * 1024); } } } while (0)
#define PG8_LDB(dst, b, h) do { _Pragma("unroll") for (int n = 0; n < 2; ++n) { if constexpr (FP8) { dst##8[n] = PG8_CAT(*(const PG8_LAS i32x4_*)(lds + PG8_SB(b, h) + boff + n * 2048), *(const PG8_LAS i32x4_*)(lds + PG8_SB(b, h) + boff + n * 2048 + 1024)); } \
        else { _Pragma("unroll") for (int k = 0; k < 2; ++k) dst[n][k] = *(const PG8_LAS bf16x8*)(lds + PG8_SB(b, h) + boff + n * 2048 + k * 1024); } } } while (0)
#define PG8_MMA(ai, bj, At, Bt) do { __builtin_amdgcn_s_setprio(1); _Pragma("unroll") for (int m = 0; m < 4; ++m) _Pragma("unroll") for (int n = 0; n < 2; ++n) { \
        if constexpr (FP8) { asm volatile("v_mfma_scale_f32_16x16x128_f8f6f4 %0, %1, %2, %0, %3, %4 op_sel_hi:[0,0,0]" : "+v"(acc[ai][bj][m][n]) : "v"(Bt##8[n]), "v"(At##8[m]), "v"(scb_), "v"(sca_)); } \
        else { _Pragma("unroll") for (int k = 0; k < 2; ++k) acc[ai][bj][m][n] = __builtin_amdgcn_mfma_f32_16x16x32_bf16(Bt[n][k], At[m][k], acc[ai][bj][m][n], 0, 0, 0); } } \
        if constexpr (FP8) { asm volatile("s_nop 15\n\ts_nop 3" ::: "memory"); } \
        __builtin_amdgcn_s_setprio(0); } while (0)
#define PG8_WAIT_V(n) asm volatile("s_waitcnt vmcnt(" #n ")" ::: "memory")
#define PG8_WAIT_L(n) asm volatile("s_waitcnt lgkmcnt(" #n ")" ::: "memory")
#define PG8_BAR __builtin_amdgcn_s_barrier()
#define PG8_SCHED __builtin_amdgcn_sched_barrier(0)
    Unit cur, nxt; int ui = 0;
#if defined(TPROBE) && TPROBE <= 6
    volatile PG8_LAS unsigned long long* tpv = (volatile PG8_LAS unsigned long long*)(lds + 163840 - 256 + 128);
#define PG8_TP_MARK(k) do { if (FP8 && (TPROBE == (k) || ((k) == 1 && TPROBE == 2)) && tid == 0) tpv[1] = __builtin_amdgcn_s_memrealtime(); } while (0)
#define PG8_TP_END(k) do { if (FP8 && TPROBE == (k) && tid == 0) { tpv[0] = tpv[0] + (__builtin_amdgcn_s_memrealtime() - tpv[1]); tpv[1] = 0ull; } } while (0)
#define PG8_TP_FIRST do { if (FP8 && (TPROBE == 1 || TPROBE == 3) && tid == 0) { const unsigned long long m_ = tpv[1]; if (m_ != 0ull) { tpv[0] = tpv[0] + (__builtin_amdgcn_s_memrealtime() - m_); tpv[1] = 0ull; } } } while (0)
#else
#define PG8_TP_MARK(k) ((void)0)
#define PG8_TP_END(k) ((void)0)
#define PG8_TP_FIRST ((void)0)
#endif
    if (!S.next(0, cur)) return;
    PG8_TP_MARK(6);
    f32x4 acc[2][2][4][2];
#pragma unroll
    for (int a = 0; a < 2; ++a)
#pragma unroll
        for (int b = 0; b < 2; ++b)
#pragma unroll
            for (int m = 0; m < 4; ++m)
#pragma unroll
                for (int n = 0; n < 2; ++n) acc[a][b][m][n] = (f32x4){0.f, 0.f, 0.f, 0.f};
    typedef int i32x8_ __attribute__((ext_vector_type(8))); typedef int i32x4_ __attribute__((ext_vector_type(4)));
    int sca_ = g.scale_a, scb_ = g.scale_b; asm volatile("" : "+v"(sca_), "+v"(scb_));
    bf16x8 At[4][2], B0[2][2], B1[2][2]; i32x8_ At8[4], B08[2], B18[2];
    const char* cA = GATHER ? (const char*)g.A : (const char*)g.A + (size_t)cur.pm * tstep; const char* cB = (const char*)g.Bt + (size_t)cur.pn * tstep;
    if constexpr (GATHER) { PG8_GOFF(vgC, cur); }
    if constexpr (SP2) {
        PG8_STAGE(PG8_SB(0, 0), cB, voffB); PG8_STAGE(PG8_SB(0, 1), cB + hstepB, voffB); PG8_STAGE_A(PG8_SA(0, 0), cA, 0, false); PG8_STAGE_A(PG8_SA(0, 1), cA, 1, false);
        if (wr == 1) PG8_BAR;
        PG8_WAIT_V(2); PG8_BAR;
        PG8_STAGE(PG8_SB(1, 0), cB + kstep, voffB); PG8_STAGE_A(PG8_SA(1, 0), cA + kstep, 0, false); PG8_STAGE(PG8_SB(1, 1), cB + hstepB + kstep, voffB);
        PG8_WAIT_V(6); PG8_BAR;
    } else {
        PG8_STAGE(PG8_SB(0, 0), cB, voffB); PG8_STAGE_A(PG8_SA(0, 0), cA, 0, false); PG8_STAGE(PG8_SB(0, 1), cB + hstepB, voffB); PG8_STAGE_A(PG8_SA(0, 1), cA, 1, false);
        if (wr == 1) PG8_BAR;
        PG8_WAIT_V(4); PG8_BAR;
        PG8_STAGE(PG8_SB(1, 0), cB + kstep, voffB); PG8_STAGE_A(PG8_SA(1, 0), cA + kstep, 0, false); PG8_STAGE(PG8_SB(1, 1), cB + hstepB + kstep, voffB);
        PG8_WAIT_V(6); PG8_BAR;
    }
    for (;;) {
        const bool has_next = S.next(ui + 1, nxt);
        const char* nA = GATHER ? (const char*)g.A : (has_next ? (const char*)g.A + (size_t)nxt.pm * tstep : cA); const char* nB = has_next ? (const char*)g.Bt + (size_t)nxt.pn * tstep : cB;
        if constexpr (GATHER) { if (has_next) { PG8_GOFF(vgN, nxt); } else {
#pragma unroll
            for (int _h = 0; _h < 2; ++_h) { vgN[_h][0] = vgC[_h][0]; vgN[_h][1] = vgC[_h][1]; } } }
        PG8_TP_MARK(5);
#ifdef KREP_PROBE
        const int ntt = nt * g.krep;
#pragma unroll 1
        for (int tt = 0; tt < ntt; tt += 2) {
            const int t = tt & (nt - 1), t2 = (t + 2) & (nt - 1);
            const bool last = (tt == ntt - 2);
            const char* a1 = cA + (size_t)(t + 1) * kstep;
            const char* a2 = last ? nA : cA + (size_t)t2 * kstep; const char* b2 = last ? nB : cB + (size_t)t2 * kstep;
#else
#pragma unroll 1
        for (int t = 0; t < nt; t += 2) {
            const bool last = (t == nt - 2);
            const char* a1 = cA + (size_t)(t + 1) * kstep;
            const char* a2 = last ? nA : cA + (size_t)(t + 2) * kstep; const char* b2 = last ? nB : cB + (size_t)(t + 2) * kstep;
#endif
            const char* a3 = a2 + kstep; const char* b3 = b2 + kstep;
            if constexpr (SP2) {
            PG8_LDB(B0, 0, 0); PG8_LDB(B1, 0, 1); PG8_SCHED; PG8_LDA(At, 0, 0); PG8_STAGE_A(PG8_SA(1, 1), a1, 1, false);
            PG8_WAIT_V(8); PG8_WAIT_L(0); PG8_BAR; PG8_TP_FIRST; PG8_MMA(0, 0, At, B0); PG8_MMA(0, 1, At, B1); PG8_BAR; PG8_SCHED;
            PG8_LDA(At, 0, 1); PG8_STAGE(PG8_SB(0, 0), b2, voffB); PG8_STAGE(PG8_SB(0, 1), b2 + hstepB, voffB); PG8_STAGE_A(PG8_SA(0, 0), a2, 0, last);
            PG8_WAIT_V(8); PG8_WAIT_L(0); PG8_BAR; PG8_MMA(1, 0, At, B0); PG8_MMA(1, 1, At, B1); PG8_BAR; PG8_SCHED;
            PG8_LDB(B0, 1, 0); PG8_LDB(B1, 1, 1); PG8_SCHED; PG8_LDA(At, 1, 0); PG8_STAGE_A(PG8_SA(0, 1), a2, 1, last);
            PG8_WAIT_V(8); PG8_WAIT_L(0); PG8_BAR; PG8_MMA(0, 0, At, B0); PG8_MMA(0, 1, At, B1); PG8_BAR; PG8_SCHED;
            PG8_LDA(At, 1, 1); PG8_STAGE(PG8_SB(1, 0), b3, voffB); PG8_STAGE(PG8_SB(1, 1), b3 + hstepB, voffB); PG8_STAGE_A(PG8_SA(1, 0), a3, 0, last);
            PG8_WAIT_V(8); PG8_WAIT_L(0); PG8_BAR; PG8_MMA(1, 0, At, B0); PG8_MMA(1, 1, At, B1); PG8_BAR; PG8_SCHED;
            } else {
            PG8_LDB(B0, 0, 0); PG8_SCHED; PG8_LDA(At, 0, 0); PG8_STAGE_A(PG8_SA(1, 1), a1, 1, false);
            PG8_WAIT_L(8); PG8_BAR; PG8_WAIT_L(0); PG8_MMA(0, 0, At, B0); PG8_BAR; PG8_SCHED;
            PG8_LDB(B1, 0, 1); PG8_STAGE(PG8_SB(0, 0), b2, voffB);
            PG8_BAR; PG8_WAIT_L(0); PG8_MMA(0, 1, At, B1); PG8_BAR;
            PG8_LDA(At, 0, 1); PG8_STAGE_A(PG8_SA(0, 0), a2, 0, last);
            PG8_BAR; PG8_WAIT_L(0); PG8_MMA(1, 0, At, B0); PG8_BAR; PG8_SCHED;
            PG8_STAGE(PG8_SB(0, 1), b2 + hstepB, voffB);
            PG8_WAIT_V(6); PG8_BAR; PG8_MMA(1, 1, At, B1); PG8_BAR;
            PG8_LDB(B0, 1, 0); PG8_SCHED; PG8_LDA(At, 1, 0); PG8_STAGE_A(PG8_SA(0, 1), a2, 1, last);
            PG8_WAIT_L(8); PG8_BAR; PG8_WAIT_L(0); PG8_MMA(0, 0, At, B0); PG8_BAR; PG8_SCHED;
            PG8_LDB(B1, 1, 1); PG8_STAGE(PG8_SB(1, 0), b3, voffB);
            PG8_BAR; PG8_WAIT_L(0); PG8_MMA(0, 1, At, B1); PG8_BAR;
            PG8_LDA(At, 1, 1); PG8_STAGE_A(PG8_SA(1, 0), a3, 0, last);
            PG8_BAR; PG8_WAIT_L(0); PG8_MMA(1, 0, At, B0); PG8_BAR; PG8_SCHED;
            PG8_STAGE(PG8_SB(1, 1), b3 + hstepB, voffB);
            PG8_WAIT_V(6); PG8_BAR; PG8_MMA(1, 1, At, B1); PG8_BAR;
            }
        }
        PG8_TP_END(5);
        PG8_TP_MARK(1);
        if constexpr (ALIGN_EPI) { if (wr == 0) PG8_BAR; }
        PG8_TP_MARK(4);
        E(acc, cur, wr, wc, fr, fq);
        PG8_TP_END(2); PG8_TP_END(4); PG8_TP_MARK(3);
        if (!has_next) break;
#pragma unroll
        for (int a = 0; a < 2; ++a)
#pragma unroll
            for (int b = 0; b < 2; ++b)
#pragma unroll
                for (int m = 0; m < 4; ++m)
#pragma unroll
                    for (int n = 0; n < 2; ++n) acc[a][b][m][n] = (f32x4){0.f, 0.f, 0.f, 0.f};
        cur = nxt; cA = nA; cB = nB; ++ui;
        if constexpr (GATHER) {
#pragma unroll
            for (int _h = 0; _h < 2; ++_h) { vgC[_h][0] = vgN[_h][0]; vgC[_h][1] = vgN[_h][1]; } }
        if constexpr (ALIGN_EPI) { if (wr == 1) PG8_BAR; }
    }
    PG8_WAIT_V(0);
    if constexpr (!ALIGN_EPI) { if (wr == 0) PG8_BAR; }
    PG8_BAR;
    PG8_TP_END(6);
#undef PG8_TP_MARK
#undef PG8_TP_END
#undef PG8_TP_FIRST
#undef PG8_SA
#undef PG8_SB
#undef PG8_STAGE
#undef PG8_STAGE_A
#undef PG8_GOFF
#undef PG8_LDA
#undef PG8_CAT
#undef PG8_LDB
#undef PG8_MMA
#undef PG8_WAIT_V
#undef PG8_WAIT_L
#undef PG8_BAR
#undef PG8_SCHED
}
}
#define DI __device__ __forceinline__
#define LAS __attribute__((address_space(3)))
typedef unsigned short bf16;
typedef short bf16x8 __attribute__((ext_vector_type(8)));
typedef short s16x4 __attribute__((ext_vector_type(4)));
typedef float f32x4 __attribute__((ext_vector_type(4)));
typedef float f32x2 __attribute__((ext_vector_type(2)));
typedef unsigned u32x4 __attribute__((ext_vector_type(4)));
typedef unsigned u32x2 __attribute__((ext_vector_type(2)));
typedef unsigned char uchar;

constexpr int NB = 16, SEQ = 4096, DM = 1024, NTOK = NB * SEQ;
constexpr int NMEM = 256, NMROWS = NB * NMEM;
constexpr int ZC = 3072;
constexpr int NEXP = 32, DEXP = 512;
constexpr int MAXTILES = 544, MAXSLOTS = MAXTILES * 256;
constexpr float RMS_EPS = 1e-6f, LN_EPS = 1e-5f;
constexpr int NWAVES = 8, NTHR = 512;
constexpr int LDS_BYTES = 163840;

constexpr size_t MiB = 1u << 20;
constexpr size_t O_CTL = 0, CTL_BYTES = 64 * 1024;
constexpr size_t O_RS0 = 1 * MiB, O_RSM = O_RS0 + 256 * 1024, O_RS3 = O_RS0 + 512 * 1024;
constexpr size_t O_GATES = 2 * MiB;
constexpr size_t O_SS1 = 6 * MiB;
constexpr size_t O_TOK = 10 * MiB;
constexpr size_t O_RIDX = 12 * MiB;
constexpr size_t O_NST = 20 * MiB, O_MST = 22 * MiB;
constexpr size_t O_WSB = 23 * MiB;
constexpr size_t O_WRH = 24 * MiB, O_WRL = O_WRH + 128 * 1024;
constexpr size_t O_WIN = 32 * MiB, O_WOUT = 38 * MiB, O_WQ = 40 * MiB, O_WKV = 42 * MiB, O_WO = 46 * MiB, O_WGU = 48 * MiB, O_WD = 112 * MiB;
constexpr size_t O_XB = 160 * MiB;
constexpr size_t O_MEMB = 288 * MiB, O_KV = 296 * MiB;
constexpr size_t O_Z = 320 * MiB;
constexpr size_t O_ZQ = 448 * MiB, O_ZK = 512 * MiB, O_ZV = 576 * MiB, O_ZO = 640 * MiB;
constexpr int ZG = 1024;
constexpr size_t O_CST = 704 * MiB;
constexpr size_t O_Y = 840 * MiB;
constexpr size_t O_Q = O_Z, O_O = O_Z + 128 * MiB;
constexpr size_t O_H = O_Z, O_YD = O_Z + 144 * MiB;
constexpr size_t O_WGU8 = O_WGU, O_WD8 = O_WGU + 32 * MiB;
constexpr size_t O_X1F8 = 576 * MiB;
constexpr size_t O_X2F8 = O_Y;
constexpr int SC_ONE = 0x7F7F7F7F, SC_X32 = (int)0x84848484, SC_W = 0x7A7A7A7A;
constexpr size_t WS_NEED = 968 * MiB;
constexpr int CW_CNT = 0, CW_BAR = 4096;
constexpr int CW_CNT_UNUSED = 0;

#define LDS_WAIT() asm volatile("s_waitcnt lgkmcnt(0)" ::: "memory")
DI unsigned f2bf(float f) { unsigned u = __builtin_bit_cast(unsigned, f); return (u + 0x7fffu + ((u >> 16) & 1u)) >> 16; }
DI unsigned pk2(float lo, float hi) { return pg8::cvt_pk_bf16(lo, hi); }
DI unsigned pk4_fp8(float a, float b, float c, float d) { int t = __builtin_amdgcn_cvt_pk_fp8_f32(a, b, 0, false); t = __builtin_amdgcn_cvt_pk_fp8_f32(c, d, t, true); return (unsigned)t; }
DI float bf2f(unsigned short h) { return __builtin_bit_cast(float, (unsigned)h << 16); }
DI float bflo(unsigned w) { return __builtin_bit_cast(float, w << 16); }
DI float bfhi(unsigned w) { return __builtin_bit_cast(float, w & 0xffff0000u); }
#define DPP_F(old, src, ctrl, rm) __builtin_bit_cast(float, __builtin_amdgcn_update_dpp(__builtin_bit_cast(int, (float)(old)), __builtin_bit_cast(int, (float)(src)), ctrl, rm, 0xF, false))
DI float wave_sum(float v) {
    v += DPP_F(0.f, v, 0xB1, 0xF); v += DPP_F(0.f, v, 0x4E, 0xF); v += DPP_F(0.f, v, 0x141, 0xF); v += DPP_F(0.f, v, 0x140, 0xF);
    v += DPP_F(0.f, v, 0x142, 0xA); v += DPP_F(0.f, v, 0x143, 0xC);
    return __builtin_bit_cast(float, __builtin_amdgcn_readlane(__builtin_bit_cast(int, v), 63));
}
DI float wave_max(float v) {
    v = fmaxf(v, DPP_F(v, v, 0xB1, 0xF)); v = fmaxf(v, DPP_F(v, v, 0x4E, 0xF)); v = fmaxf(v, DPP_F(v, v, 0x141, 0xF)); v = fmaxf(v, DPP_F(v, v, 0x140, 0xF));
    v = fmaxf(v, DPP_F(v, v, 0x142, 0xA)); v = fmaxf(v, DPP_F(v, v, 0x143, 0xC));
    return __builtin_bit_cast(float, __builtin_amdgcn_readlane(__builtin_bit_cast(int, v), 63));
}
DI float wscan_add(float v, int lane) {
#pragma unroll
    for (int o = 1; o < 64; o <<= 1) { const float u = __shfl_up(v, o); v = (lane >= o) ? v + u : v; }
    return v;
}
DI float wscan_max(float v, int lane) {
#pragma unroll
    for (int o = 1; o < 64; o <<= 1) { const float u = __shfl_up(v, o); v = (lane >= o) ? fmaxf(v, u) : v; }
    return v;
}
DI float wscan_max_rev(float v, int lane) {
#pragma unroll
    for (int o = 1; o < 64; o <<= 1) { const float u = __shfl_down(v, o); v = (lane + o < 64) ? fmaxf(v, u) : v; }
    return v;
}
DI float fast_exp(float x) { return __expf(x); }
DI float sigmoidf_(float x) { return __builtin_amdgcn_rcpf(1.0f + __expf(-x)); }
DI float siluf_(float x) { return x * __builtin_amdgcn_rcpf(1.0f + __expf(-x)); }
DI f32x2 rcp2_(f32x2 d) { return (f32x2){__builtin_amdgcn_rcpf(d.x), __builtin_amdgcn_rcpf(d.y)}; }
DI f32x2 exp2_(f32x2 y) { return (f32x2){__expf(y.x), __expf(y.y)}; }
DI f32x2 sigmoid2_(f32x2 x) { return rcp2_(exp2_(-x) + 1.0f); }
DI f32x2 exp2fma2_(f32x2 a, float c, float d) { const f32x2 y = __builtin_elementwise_fma(a, (f32x2){c, c}, (f32x2){d, d}); return (f32x2){__builtin_amdgcn_exp2f(y.x), __builtin_amdgcn_exp2f(y.y)}; }
DI f32x2 silu2_(f32x2 x) { return x * rcp2_(exp2_(-x) + 1.0f); }
DI f32x2 gelu_tanh2(f32x2 x) { const f32x2 u = (x + (x * x * x) * 0.044715f) * 0.7978845608028654f; return x * rcp2_(exp2_(u * -2.0f) + 1.0f); }
DI float gelu_tanh(float x) { const float u = 0.7978845608028654f * (x + 0.044715f * x * x * x); return x * __builtin_amdgcn_rcpf(1.0f + __expf(-2.0f * u)); }
DI float log_sigmoid(float x) { return fminf(x, 0.f) - __logf(1.0f + __expf(-fabsf(x))); }

DI unsigned offb(unsigned row, unsigned ch) { return 256u * row + 16u * (ch ^ (((row & 3u) << 2) | ((row >> 2) & 3u))); }
DI bf16x8 frag_row(const LAS uchar* tile, int r0, int kk, int lane) { return *(const LAS bf16x8*)(tile + offb(r0 + (lane & 15), 4 * kk + (lane >> 4))); }
DI bf16x8 frag_tr(const LAS uchar* tile, int k0, int c0, int lane) {
    const unsigned g = lane >> 4, q = (lane & 15) >> 2, p = lane & 3;
    const unsigned ch = (c0 >> 3) + (p >> 1), bo = 8u * (p & 1);
    const s16x4 lo = __builtin_amdgcn_ds_read_tr16_b64_v4i16((LAS s16x4*)(tile + offb(k0 + 8 * g + q, ch) + bo));
    const s16x4 hi = __builtin_amdgcn_ds_read_tr16_b64_v4i16((LAS s16x4*)(tile + offb(k0 + 8 * g + 4 + q, ch) + bo));
    return (bf16x8){lo[0], lo[1], lo[2], lo[3], hi[0], hi[1], hi[2], hi[3]};
}
DI f32x4 mfma16(bf16x8 x, bf16x8 y, f32x4 acc) { return __builtin_amdgcn_mfma_f32_16x16x32_bf16(x, y, acc, 0, 0, 0); }

#if defined(__HIP_DEVICE_COMPILE__)
#define GASK __attribute__((address_space(1)))
#else
#define GASK
#endif
struct Args { const GASK float* in[27]; GASK float* out; GASK uchar* ws; int ph_lo, ph_hi; };
struct Frame {
    LAS uchar* lds;
    int tid, lane, wave, G, bid;
    const GASK float* const* in;
    float* out; uchar* ws;
};
#define GAS __attribute__((address_space(1)))
#define INP(i) ((const float*)F.in[i])
enum { I_X = 0, I_MEM, I_GMIX, I_WIN, I_CONVW, I_CONVB, I_GATEB, I_GHEAD, I_LNVG, I_LNVB, I_WS, I_BS, I_WOUT, I_GXATTN, I_GMEM, I_WQ, I_WKV, I_WO, I_GMOE, I_WRG, I_BRG, I_WRE, I_BRE, I_WGATE, I_WUP, I_WDOWN, I_GFINAL };
DI void xchg4x4(u32x2 (&p)[4]) {
#define X4_(f) do { auto a_ = __builtin_amdgcn_permlane32_swap(p[0].f, p[2].f, false, false); p[0].f = a_[0]; p[2].f = a_[1]; \
                    a_ = __builtin_amdgcn_permlane32_swap(p[1].f, p[3].f, false, false); p[1].f = a_[0]; p[3].f = a_[1]; \
                    a_ = __builtin_amdgcn_permlane16_swap(p[0].f, p[1].f, false, false); p[0].f = a_[0]; p[1].f = a_[1]; \
                    a_ = __builtin_amdgcn_permlane16_swap(p[2].f, p[3].f, false, false); p[2].f = a_[0]; p[3].f = a_[1]; } while (0)
    X4_(x); X4_(y);
#undef X4_
}
DI void load32(u32x2 (&p)[4], const bf16* src  ) {
    const u32x4 a = *(const GAS u32x4*)src, b = *(const GAS u32x4*)(src + 8); p[0] = (u32x2){a.x, a.y}; p[1] = (u32x2){a.z, a.w}; p[2] = (u32x2){b.x, b.y}; p[3] = (u32x2){b.z, b.w};
}
DI void store32(bf16* dst  , const u32x2 (&p)[4]) {
    *(GAS u32x4*)dst = (u32x4){p[0].x, p[0].y, p[1].x, p[1].y}; *(GAS u32x4*)(dst + 8) = (u32x4){p[2].x, p[2].y, p[3].x, p[3].y};
}
DI int xcd_major(int bid, int G) { return (G & 7) == 0 ? (bid & 7) * (G >> 3) + (bid >> 3) : bid; }

struct P0Item { const float* W; const float* gain; bf16* WT; size_t drow0; int K, ldw, scol0, k0, f8; };
DI void p0_decode(Frame& F, int it, P0Item& I) {
    uchar* ws = F.ws;
    constexpr int I_IN = 16 * 96, I_SQ = 16 * 32, I_KV = 16 * 64, I_GU = 32 * 16 * 16;
    int r = it;
    if (r < I_IN) { const int kb = r / 96, nb = r % 96; I = P0Item{INP(I_WIN), INP(I_GMIX), (bf16*)(ws + O_WIN), (size_t)nb * 32, 1024, 3088, nb * 32 < 2048 ? nb * 32 : nb * 32 + 16, kb * 64, 0}; return; } r -= I_IN;
    if (r < I_SQ) { const int kb = r / 32, nb = r % 32; I = P0Item{INP(I_WOUT), nullptr, (bf16*)(ws + O_WOUT), (size_t)nb * 32, 1024, 1024, nb * 32, kb * 64, 0}; return; } r -= I_SQ;
    if (r < I_SQ) { const int kb = r / 32, nb = r % 32; I = P0Item{INP(I_WQ), INP(I_GXATTN), (bf16*)(ws + O_WQ), (size_t)nb * 32, 1024, 1024, nb * 32, kb * 64, 1}; return; } r -= I_SQ;
    if (r < I_KV) { const int kb = r / 64, nb = r % 64; I = P0Item{INP(I_WKV), INP(I_GMEM), (bf16*)(ws + O_WKV), (size_t)nb * 32, 1024, 2048, nb * 32, kb * 64, 1}; return; } r -= I_KV;
    if (r < I_SQ) { const int kb = r / 32, nb = r % 32; I = P0Item{INP(I_WO), nullptr, (bf16*)(ws + O_WO), (size_t)nb * 32, 1024, 1024, nb * 32, kb * 64, 1}; return; } r -= I_SQ;
    if (r < 2 * I_GU) { const int up = r >= I_GU; if (up) r -= I_GU; const int e = r / 256, q = r % 256, kb = q / 16, nb = q % 16;
        I = P0Item{INP(up ? I_WUP : I_WGATE) + (size_t)e * 1024 * 512, INP(I_GMOE), (bf16*)(ws + O_WGU8), (size_t)e * 1024 + 256 * (nb / 4) + (up ? 128 : 0) + (nb % 4) * 32, 1024, 512, nb * 32, kb * 64, 1}; return; } r -= 2 * I_GU;
    { const int e = r / 256, q = r % 256, kb = q / 32, nb = q % 32;
        I = P0Item{INP(I_WDOWN) + (size_t)e * 512 * 1024, nullptr, (bf16*)(ws + O_WD8), (size_t)e * 1024 + nb * 32, 512, 1024, nb * 32, kb * 64, 1}; }
}
DI void p0_item_load(const P0Item& I, float (&tv)[32], int lane) {
#pragma unroll
    for (int i = 0; i < 32; ++i) { const int kk = 2 * i + (lane >> 5); tv[i] = *(const GAS float*)(I.W + (size_t)(I.k0 + kk) * I.ldw + I.scol0 + (lane & 31)); }
}
DI void p0_item_store(const P0Item& I, float (&tv)[32], LAS float* scr, int lane) {
    if (I.gain) {
#pragma unroll
        for (int i = 0; i < 32; ++i) tv[i] *= I.gain[I.k0 + 2 * i + (lane >> 5)]; }
#pragma unroll
    for (int i = 0; i < 32; ++i) { const int kk = 2 * i + (lane >> 5); scr[kk * 33 + (lane & 31)] = tv[i]; }
    LDS_WAIT(); asm volatile("" ::: "memory");
    if (I.f8) {
        const int c = lane & 3;
#pragma unroll
        for (int j = 0; j < 2; ++j) { const int n = (lane >> 2) + 16 * j; const LAS float* s = scr + (16 * c) * 33 + n;
            u32x4 o; o.x = pk4_fp8(32.f * s[0 * 33], 32.f * s[1 * 33], 32.f * s[2 * 33], 32.f * s[3 * 33]); o.y = pk4_fp8(32.f * s[4 * 33], 32.f * s[5 * 33], 32.f * s[6 * 33], 32.f * s[7 * 33]);
            o.z = pk4_fp8(32.f * s[8 * 33], 32.f * s[9 * 33], 32.f * s[10 * 33], 32.f * s[11 * 33]); o.w = pk4_fp8(32.f * s[12 * 33], 32.f * s[13 * 33], 32.f * s[14 * 33], 32.f * s[15 * 33]);
            *(GAS u32x4*)((uchar*)I.WT + (I.drow0 + n) * (size_t)I.K + I.k0 + 16 * c) = o; }
    } else {
    const int c = lane & 7;
#pragma unroll
    for (int j = 0; j < 4; ++j) { const int n = (lane >> 3) + 8 * j; const LAS float* s = scr + (8 * c) * 33 + n;
        u32x4 o; o.x = pk2(s[0 * 33], s[1 * 33]); o.y = pk2(s[2 * 33], s[3 * 33]); o.z = pk2(s[4 * 33], s[5 * 33]); o.w = pk2(s[6 * 33], s[7 * 33]);
        *(GAS u32x4*)(I.WT + (I.drow0 + n) * (size_t)I.K + I.k0 + 8 * c) = o; }
    }
    LDS_WAIT(); asm volatile("" ::: "memory");
}

#ifndef P0A_REP
#define P0A_REP 1
#endif
#ifndef P0C_REP
#define P0C_REP 1
#endif
DI void phase0(Frame& F) {
    const int gw = F.bid * NWAVES + F.wave, NGW = F.G * NWAVES, lane = F.lane;
    uchar* ws = F.ws;
    for (int r_ = 0; r_ < P0A_REP; ++r_) {
        LAS float* scr = (LAS float*)(F.lds + F.wave * 16384);
        constexpr int NITEMS = 16 * 96 + 3 * 16 * 32 + 16 * 64 + 2 * 32 * 16 * 16 + 32 * 8 * 32;
        P0Item cur, nxt; float tvA[32], tvB[32];
        int it = gw;
        if (it < NITEMS) { p0_decode(F, it, cur); p0_item_load(cur, tvA, lane); }
        while (it < NITEMS) {
            if (it + NGW < NITEMS) { p0_decode(F, it + NGW, nxt); p0_item_load(nxt, tvB, lane); }
            p0_item_store(cur, tvA, scr, lane);
            it += NGW; if (it >= NITEMS) break;
            if (it + NGW < NITEMS) { p0_decode(F, it + NGW, cur); p0_item_load(cur, tvA, lane); }
            p0_item_store(nxt, tvB, scr, lane);
            it += NGW;
        }
        for (int i = F.bid * NTHR + F.tid; i < 48 * 1024; i += F.G * NTHR) { const int n = i >> 10, k = i & 1023; float v = 0.f;
            if (n < 4) v = INP(I_WRG)[k * 4 + n] * INP(I_GMOE)[k]; else if (n >= 16) v = INP(I_WRE)[k * 32 + (n - 16)] * INP(I_GMOE)[k];
            const unsigned h = f2bf(v); const float hf = __builtin_bit_cast(float, h << 16);
            ((bf16*)(ws + O_WRH))[i] = (bf16)h; ((bf16*)(ws + O_WRL))[i] = (bf16)f2bf(v - hf); }
        for (int i = F.bid * NTHR + F.tid; i < 4 * 128 * 128 / 2; i += F.G * NTHR) { const f32x2 v = *(const GAS f32x2*)(INP(I_WS) + 2 * i); ((unsigned*)(ws + O_WSB))[i] = pk2(v.x, v.y); }
    }
    __syncthreads();
    LAS float* wg = (LAS float*)F.lds;
    for (int idx = F.tid; idx < 1024 * 16; idx += NTHR) { const int i = idx >> 4, j = idx & 15; const float v = INP(I_WIN)[(size_t)i * 3088 + 2048 + j] * INP(I_GMIX)[i];
        const int jj = i >> 8, l = (i & 255) >> 2, ii = i & 3, j4 = j >> 2, jr = j & 3; wg[((((jj * 4 + ii) * 4 + j4) * 64 + l) << 2) + jr] = v; }
    __syncthreads();
    for (int r_ = 0; r_ < P0C_REP; ++r_) {
        bf16* XB = (bf16*)(ws + O_XB); float* rs0 = (float*)(ws + O_RS0); float* gates = (float*)(ws + O_GATES);
        const float gb = INP(I_GATEB)[lane >> 2];
        f32x4 nx[4];
        if (gw < NTOK) { const f32x4* xr0 = (const f32x4*)(INP(I_X) + (size_t)gw * DM) + lane;
#pragma unroll
            for (int j = 0; j < 4; ++j) nx[j] = xr0[64 * j]; }
        for (int m = gw; m < NTOK; m += NGW) {
            f32x4 v[4]; float s = 0.f;
#pragma unroll
            for (int j = 0; j < 4; ++j) { v[j] = nx[j]; s += (v[j].x * v[j].x + v[j].y * v[j].y) + (v[j].z * v[j].z + v[j].w * v[j].w); }
            if (m + NGW < NTOK) { const f32x4* xr1 = (const f32x4*)(INP(I_X) + (size_t)(m + NGW) * DM) + lane;
#pragma unroll
                for (int j = 0; j < 4; ++j) nx[j] = xr1[64 * j]; }
            const float rs = 1.0f / sqrtf(wave_sum(s) * (1.f / DM) + RMS_EPS);
            unsigned long long* o8 = (unsigned long long*)(XB + (size_t)m * DM) + lane;
#pragma unroll
            for (int j = 0; j < 4; ++j) o8[64 * j] = (unsigned long long)pk2(v[j].x, v[j].y) | ((unsigned long long)pk2(v[j].z, v[j].w) << 32);
            float p[16];
#pragma unroll
            for (int j = 0; j < 16; ++j) p[j] = 0.f;
#pragma unroll
            for (int jj = 0; jj < 4; ++jj)
#pragma unroll
                for (int ii = 0; ii < 4; ++ii) { const float xv = v[jj][ii];
#pragma unroll
                    for (int j4 = 0; j4 < 4; ++j4) { const f32x4 w = *(const LAS f32x4*)(wg + ((((jj * 4 + ii) * 4 + j4) * 64 + lane) << 2));
                        p[4 * j4 + 0] += xv * w.x; p[4 * j4 + 1] += xv * w.y; p[4 * j4 + 2] += xv * w.z; p[4 * j4 + 3] += xv * w.w; } }
            float q8[8], q4[4], q2[2], q1;
            { const bool hi = (lane & 32) != 0;
#pragma unroll
              for (int k = 0; k < 8; ++k) { const float send = hi ? p[k] : p[k + 8], keep = hi ? p[k + 8] : p[k]; q8[k] = keep + __shfl_xor(send, 32); } }
            { const bool hi = (lane & 16) != 0;
#pragma unroll
              for (int k = 0; k < 4; ++k) { const float send = hi ? q8[k] : q8[k + 4], keep = hi ? q8[k + 4] : q8[k]; q4[k] = keep + __shfl_xor(send, 16); } }
            { const bool hi = (lane & 8) != 0;
#pragma unroll
              for (int k = 0; k < 2; ++k) { const float send = hi ? q4[k] : q4[k + 2], keep = hi ? q4[k + 2] : q4[k]; q2[k] = keep + __shfl_xor(send, 8); } }
            { const bool hi = (lane & 4) != 0; const float send = hi ? q2[0] : q2[1], keep = hi ? q2[1] : q2[0]; q1 = keep + __shfl_xor(send, 4); }
            q1 += __shfl_xor(q1, 2); q1 += __shfl_xor(q1, 1);
            if ((lane & 3) == 0) gates[(size_t)m * 16 + (lane >> 2)] = q1 * rs + gb;
            if (lane == 0) rs0[m] = rs;
        }
    }
    {
        bf16* MB = (bf16*)(ws + O_MEMB); float* rsm = (float*)(ws + O_RSM);
        for (int m = gw; m < NMROWS; m += NGW) {
            const f32x4* xr = (const f32x4*)(INP(I_MEM) + (size_t)m * DM) + lane;
            f32x4 v[4]; float s = 0.f;
#pragma unroll
            for (int j = 0; j < 4; ++j) { v[j] = xr[64 * j]; s += (v[j].x * v[j].x + v[j].y * v[j].y) + (v[j].z * v[j].z + v[j].w * v[j].w); }
            const float rs = 1.0f / sqrtf(wave_sum(s) * (1.f / DM) + RMS_EPS);
            unsigned* o4 = (unsigned*)((uchar*)MB + (size_t)m * DM) + lane;
#pragma unroll
            for (int j = 0; j < 4; ++j) o4[64 * j] = pk4_fp8(v[j].x, v[j].y, v[j].z, v[j].w);
            if (lane == 0) rsm[m] = rs;
        }
    }
}
using pg8::Unit;
DI u32x4 widen8(u32x2 A, u32x2 B) {
    const auto x = __builtin_amdgcn_permlane16_swap(A.x, B.x, false, false); const auto y = __builtin_amdgcn_permlane16_swap(A.y, B.y, false, false);
    return (u32x4){x[0], y[0], x[1], y[1]};
}
typedef const f32x4 (&AccRef)[2][2][4][2];

template <int MODE> struct EpiRowScale {
    static constexpr bool PERM = true;
    bf16* O; int ldc; const float* rs; float extra;
    DI void operator()(AccRef acc, const Unit& u, int wr, int wc, int fr, int fq) const {
        const int row0 = u.orow * 256 + wr * 64 + fr, col0 = u.ocol + wc * 32 + 8 * fq;
        const int act = (MODE == 0) ? (u.pn >= 8 ? 2 : (u.pn >= 6 ? 1 : 0)) : 0;
        float sc[2][4];
#pragma unroll
        for (int ai = 0; ai < 2; ++ai)
#pragma unroll
            for (int m = 0; m < 4; ++m) sc[ai][m] = *(const GAS float*)(rs + row0 + ai * 128 + m * 16);
#pragma unroll
        for (int ai = 0; ai < 2; ++ai)
#pragma unroll
            for (int m = 0; m < 4; ++m) { const int row = row0 + ai * 128 + m * 16; const float s = sc[ai][m] * extra;
#pragma unroll
                for (int bj = 0; bj < 2; ++bj) { f32x4 v0 = acc[ai][bj][m][0] * s, v1 = acc[ai][bj][m][1] * s;
                    if (act == 1) {
#pragma unroll
                        for (int j = 0; j < 4; j += 2) { const f32x2 a = sigmoid2_((f32x2){v0[j], v0[j + 1]}), bq = sigmoid2_((f32x2){v1[j], v1[j + 1]}); v0[j] = a.x; v0[j + 1] = a.y; v1[j] = bq.x; v1[j + 1] = bq.y; } }
                    else if (act == 2) {
#pragma unroll
                        for (int j = 0; j < 4; j += 2) { const f32x2 a = gelu_tanh2((f32x2){v0[j], v0[j + 1]}), bq = gelu_tanh2((f32x2){v1[j], v1[j + 1]}); v0[j] = a.x; v0[j + 1] = a.y; v1[j] = bq.x; v1[j + 1] = bq.y; } }
                    u32x4 w; w.x = pk2(v0[0], v0[1]); w.y = pk2(v0[2], v0[3]); w.z = pk2(v1[0], v1[1]); w.w = pk2(v1[2], v1[3]);
                    bf16* dst;
                    if (MODE == 0) {
                        if (u.pn < 8) dst = O + (size_t)(64 * MiB / 2) * (u.pn >> 1) + (size_t)(128 * MiB / 2) + ((size_t)((row >> 12) * 4 + (u.pn & 1) * 2 + bj) * SEQ + (row & (SEQ - 1))) * 128 + wc * 32 + 8 * fq;
                        else dst = O + (size_t)row * ZG + (u.pn - 8) * 256 + bj * 128 + wc * 32 + 8 * fq;
                    } else dst = O + (size_t)row * ldc + col0 + bj * 128;
                    *(GAS u32x4*)dst = w; } }
    }
};
struct EpiQ {
    static constexpr bool PERM = true;
    bf16* O; const float* ssp; float extra;
    DI void operator()(AccRef acc, const Unit& u, int wr, int wc, int fr, int fq) const {
        const int row0 = u.orow * 256 + wr * 64 + fr, col0 = u.ocol + wc * 32 + 8 * fq;
        float sc[2][4];
        f32x4 p[2][4];
#pragma unroll
        for (int ai = 0; ai < 2; ++ai)
#pragma unroll
            for (int m = 0; m < 4; ++m) p[ai][m] = *((const GAS f32x4*)(ssp + (size_t)(row0 + ai * 128 + m * 16) * 16) + fq);
#pragma unroll
        for (int ai = 0; ai < 2; ++ai)
#pragma unroll
            for (int m = 0; m < 4; ++m) { const f32x4 a = p[ai][m]; float ss = (a.x + a.y) + (a.z + a.w);
                ss += __shfl_xor(ss, 16); ss += __shfl_xor(ss, 32);
                sc[ai][m] = extra / sqrtf(ss * (1.f / DM) + RMS_EPS); }
#pragma unroll
        for (int ai = 0; ai < 2; ++ai)
#pragma unroll
            for (int m = 0; m < 4; ++m) { const int row = row0 + ai * 128 + m * 16; const float s = sc[ai][m]; bf16* rowp = O + (size_t)row * DM + col0;
#pragma unroll
                for (int bj = 0; bj < 2; ++bj) { const f32x4 v0 = acc[ai][bj][m][0] * s, v1 = acc[ai][bj][m][1] * s;
                    u32x4 w; w.x = pk2(v0[0], v0[1]); w.y = pk2(v0[2], v0[3]); w.z = pk2(v1[0], v1[1]); w.w = pk2(v1[2], v1[3]);
                    *(GAS u32x4*)(rowp + bj * 128) = w; } }
    }
};
template <bool BASE_BF16, bool SS, bool F8> struct EpiRes {
    static constexpr bool PERM = true;
    const float* base; bf16* xb; float* ssp; uchar* x8;
    DI void operator()(AccRef acc, const Unit& u, int wr, int wc, int fr, int fq) const {
        static_assert(BASE_BF16, "the residual base is the bf16 stream itself");
        const int row0 = u.orow * 256 + wr * 64 + fr, col0 = u.ocol + wc * 32 + 8 * fq;
        u32x4 bs[2][4][2];
#pragma unroll
        for (int ai = 0; ai < 2; ++ai)
#pragma unroll
            for (int m = 0; m < 4; ++m) { const size_t off = (size_t)(row0 + ai * 128 + m * 16) * DM + col0;
#pragma unroll
                for (int bj = 0; bj < 2; ++bj) bs[ai][m][bj] = *(const GAS u32x4*)(xb + off + bj * 128); }
#pragma unroll
        for (int ai = 0; ai < 2; ++ai)
#pragma unroll
            for (int m = 0; m < 4; ++m) { const int row = row0 + ai * 128 + m * 16; const size_t off = (size_t)row * DM + col0; float q = 0.f;
#pragma unroll
                for (int bj = 0; bj < 2; ++bj) { const u32x4 b4 = bs[ai][m][bj];
                    const f32x4 v0 = (f32x4){bflo(b4.x), bfhi(b4.x), bflo(b4.y), bfhi(b4.y)} + acc[ai][bj][m][0], v1 = (f32x4){bflo(b4.z), bfhi(b4.z), bflo(b4.w), bfhi(b4.w)} + acc[ai][bj][m][1];
                    u32x4 w; w.x = pk2(v0[0], v0[1]); w.y = pk2(v0[2], v0[3]); w.z = pk2(v1[0], v1[1]); w.w = pk2(v1[2], v1[3]);
                    *(GAS u32x4*)(xb + off + bj * 128) = w;
                    if (F8) { u32x2 w8; w8.x = pk4_fp8(v0[0], v0[1], v0[2], v0[3]); w8.y = pk4_fp8(v1[0], v1[1], v1[2], v1[3]); *(GAS u32x2*)(x8 + off + bj * 128) = w8; }
                    if (SS) q += ((v0[0] * v0[0] + v0[1] * v0[1]) + (v0[2] * v0[2] + v0[3] * v0[3])) + ((v1[0] * v1[0] + v1[1] * v1[1]) + (v1[2] * v1[2] + v1[3] * v1[3])); }
                if (SS) { q += __shfl_xor(q, 16); q += __shfl_xor(q, 32); if (fq == 0) *(GAS float*)(ssp + (size_t)row * 16 + u.pn * 4 + wc) = q; } }
    }
};
struct EpiGU {
    static constexpr bool PERM = true;
    bf16* H; const float* rs3;
    DI void operator()(AccRef acc, const Unit& u, int wr, int wc, int fr, int fq) const {
        const int rl0 = wr * 64 + fr, col0 = u.ocol + wc * 32 + 8 * fq;
        float sc[2][4];
        { float mine[2];
#pragma unroll
          for (int ai = 0; ai < 2; ++ai) { const int rl = rl0 + ai * 128 + fq * 16; const int rc = rl < u.nvalid ? rl : u.nvalid - 1; const int tk = *(const GAS int*)(u.ridx + rc); mine[ai] = *(const GAS float*)(rs3 + tk); }
#pragma unroll
          for (int ai = 0; ai < 2; ++ai)
#pragma unroll
              for (int m = 0; m < 4; ++m) sc[ai][m] = __shfl(mine[ai], fr + 16 * m); }
#pragma unroll
        for (int m = 0; m < 4; ++m) { u32x2 w[2];
#pragma unroll
            for (int ai = 0; ai < 2; ++ai) { const float s = sc[ai][m];
                f32x4 h0, h1;
#pragma unroll
                for (int j = 0; j < 4; j += 2) { const f32x2 g0 = (f32x2){acc[ai][0][m][0][j], acc[ai][0][m][0][j + 1]} * s, u0 = (f32x2){acc[ai][1][m][0][j], acc[ai][1][m][0][j + 1]} * s,
                                                           g1 = (f32x2){acc[ai][0][m][1][j], acc[ai][0][m][1][j + 1]} * s, u1 = (f32x2){acc[ai][1][m][1][j], acc[ai][1][m][1][j + 1]} * s;
                    const f32x2 a = silu2_(g0) * u0, bq = silu2_(g1) * u1; h0[j] = a.x; h0[j + 1] = a.y; h1[j] = bq.x; h1[j + 1] = bq.y; }
                w[ai].x = pk4_fp8(h0[0], h0[1], h0[2], h0[3]); w[ai].y = pk4_fp8(h1[0], h1[1], h1[2], h1[3]); }
            const int rl = rl0 + ((fq & 1) ? 128 : 0) + m * 16;
            uchar* rowp = (uchar*)H + (size_t)(u.orow * 256 + rl) * DEXP + col0 - ((fq & 1) ? 8 : 0);
            *(GAS u32x4*)rowp = widen8(w[0], w[1]); }
    }
};
struct EpiPlain {
    static constexpr bool PERM = true;
    bf16* O; int ldc;
    DI void operator()(AccRef acc, const Unit& u, int wr, int wc, int fr, int fq) const {
        const int row0 = u.orow * 256 + wr * 64 + fr, col0 = u.ocol + wc * 32 + 8 * fq;
#pragma unroll
        for (int ai = 0; ai < 2; ++ai)
#pragma unroll
            for (int m = 0; m < 4; ++m) { bf16* rowp = O + (size_t)(row0 + ai * 128 + m * 16) * ldc + col0;
#pragma unroll
                for (int bj = 0; bj < 2; ++bj) { const f32x4 v0 = acc[ai][bj][m][0], v1 = acc[ai][bj][m][1];
                    u32x4 w; w.x = pk2(v0[0], v0[1]); w.y = pk2(v0[2], v0[3]); w.z = pk2(v1[0], v1[1]); w.w = pk2(v1[2], v1[3]);
                    *(GAS u32x4*)(rowp + bj * 128) = w; } }
    }
};
struct EpiPlain8 {
    static constexpr bool PERM = true;
    uchar* O; int ldc;
    DI void operator()(AccRef acc, const Unit& u, int wr, int wc, int fr, int fq) const {
        const int row0 = u.orow * 256 + wr * 64 + fr, col0 = u.ocol + wc * 32 + 8 * fq;
#pragma unroll
        for (int ai = 0; ai < 2; ++ai)
#pragma unroll
            for (int m = 0; m < 4; ++m) { uchar* rowp = O + (size_t)(row0 + ai * 128 + m * 16) * ldc + col0;
                u32x2 w[2];
#pragma unroll
                for (int bj = 0; bj < 2; ++bj) { const f32x4 v0 = acc[ai][bj][m][0], v1 = acc[ai][bj][m][1];
                    w[bj].x = pk4_fp8(v0[0], v0[1], v0[2], v0[3]); w[bj].y = pk4_fp8(v1[0], v1[1], v1[2], v1[3]); }
                *(GAS u32x4*)(rowp + ((fq & 1) ? 120 : 0)) = widen8(w[0], w[1]); }
    }
};
struct MoeOrder {
    const LAS int* ut; const int* ridx; int G, c; bool down;
    DI bool next(int i, Unit& u) const {
        if (i >= 16) return false;
        const u32x4 v = *(const LAS u32x4*)(ut + 4 * i);
        const int e = __builtin_amdgcn_readfirstlane((int)v.x), T = __builtin_amdgcn_readfirstlane((int)v.y), nv = __builtin_amdgcn_readfirstlane((int)v.z), ro = __builtin_amdgcn_readfirstlane((int)v.w);
        if (e < 0) return false;
        const int j = (i * G + c) & 3;
        u.ex = e; u.orow = T; u.nvalid = nv; u.ridx = ridx + ro;
        if (down) { u.pm = T; u.pn = e * 4 + j; u.ocol = 256 * j; } else { u.pm = 0; u.pn = e * 4 + j; u.ocol = 128 * j; }
        return true;
    }
};
struct PanelOrder {
    int pm;
    DI bool next(int i, Unit& u) const { if (i >= 4) return false; u.pm = pm; u.pn = i; u.ridx = nullptr; u.nvalid = 256; u.orow = pm; u.ocol = i * 256; u.ex = 0; return true; }
};
#define SFENCE() do { asm volatile("" ::: "memory"); __builtin_amdgcn_sched_barrier(0); } while (0)
DI void conv_issue(u32x4 (&raw)[8], const bf16* src, int c, int tid) {
    const int dg = tid & 15, sg = tid >> 4;
#pragma unroll
    for (int r = 0; r < 8; ++r) { const int pos = c * 128 + 4 * sg - 2 + r; raw[r] = (u32x4){0u, 0u, 0u, 0u};
        if (pos >= 0 && pos < SEQ) raw[r] = *(const GAS u32x4*)(src + (size_t)pos * 128 + 8 * dg); }
}
DI void conv_build(LAS uchar* tile, const u32x4 (&raw)[8], int zcol0, const float* convw, const float* convb, float scale, int tid) {
    const int dg = tid & 15, sg = tid >> 4;
    f32x2 cw[5][4], cb[4];
#pragma unroll
    for (int j = 0; j < 5; ++j) { const f32x4 a = *(const GAS f32x4*)(convw + j * 1024 + zcol0 + 8 * dg), bq = *(const GAS f32x4*)(convw + j * 1024 + zcol0 + 8 * dg + 4);
        cw[j][0] = (f32x2){a.x, a.y}; cw[j][1] = (f32x2){a.z, a.w}; cw[j][2] = (f32x2){bq.x, bq.y}; cw[j][3] = (f32x2){bq.z, bq.w}; }
    { const f32x4 a = *(const GAS f32x4*)(convb + zcol0 + 8 * dg), bq = *(const GAS f32x4*)(convb + zcol0 + 8 * dg + 4);
        cb[0] = (f32x2){a.x, a.y}; cb[1] = (f32x2){a.z, a.w}; cb[2] = (f32x2){bq.x, bq.y}; cb[3] = (f32x2){bq.z, bq.w}; }
    f32x2 in[8][4];
#pragma unroll
    for (int r = 0; r < 8; ++r) { in[r][0] = (f32x2){bflo(raw[r].x), bfhi(raw[r].x)}; in[r][1] = (f32x2){bflo(raw[r].y), bfhi(raw[r].y)}; in[r][2] = (f32x2){bflo(raw[r].z), bfhi(raw[r].z)}; in[r][3] = (f32x2){bflo(raw[r].w), bfhi(raw[r].w)}; }
#pragma unroll
    for (int rr = 0; rr < 4; ++rr) { unsigned ow[4];
#pragma unroll
        for (int i = 0; i < 4; ++i) { f32x2 a = cb[i];
#pragma unroll
            for (int j = 0; j < 5; ++j) a = __builtin_elementwise_fma(in[rr + j][i], cw[j][i], a);
            { const f32x2 sl_ = silu2_(a) * scale; ow[i] = pk2(sl_.x, sl_.y); } }
        *(LAS u32x4*)(tile + offb(4 * sg + rr, dg)) = (u32x4){ow[0], ow[1], ow[2], ow[3]}; }
}
DI void conv_build_l(LAS uchar* tile, const u32x4 (&raw)[8], const LAS float* tab, float scale, int tid) {
    const int dg = tid & 15, sg = tid >> 4;
    f32x2 cw[5][4], cb[4];
#pragma unroll
    for (int j = 0; j < 5; ++j) { const f32x4 a = *(const LAS f32x4*)(tab + j * 128 + 8 * dg), bq = *(const LAS f32x4*)(tab + j * 128 + 8 * dg + 4);
        cw[j][0] = (f32x2){a.x, a.y}; cw[j][1] = (f32x2){a.z, a.w}; cw[j][2] = (f32x2){bq.x, bq.y}; cw[j][3] = (f32x2){bq.z, bq.w}; }
    { const f32x4 a = *(const LAS f32x4*)(tab + 640 + 8 * dg), bq = *(const LAS f32x4*)(tab + 640 + 8 * dg + 4);
        cb[0] = (f32x2){a.x, a.y}; cb[1] = (f32x2){a.z, a.w}; cb[2] = (f32x2){bq.x, bq.y}; cb[3] = (f32x2){bq.z, bq.w}; }
    f32x2 in[8][4];
#pragma unroll
    for (int r = 0; r < 8; ++r) { in[r][0] = (f32x2){bflo(raw[r].x), bfhi(raw[r].x)}; in[r][1] = (f32x2){bflo(raw[r].y), bfhi(raw[r].y)}; in[r][2] = (f32x2){bflo(raw[r].z), bfhi(raw[r].z)}; in[r][3] = (f32x2){bflo(raw[r].w), bfhi(raw[r].w)}; }
#pragma unroll
    for (int rr = 0; rr < 4; ++rr) { unsigned ow[4];
#pragma unroll
        for (int i = 0; i < 4; ++i) { f32x2 a = cb[i];
#pragma unroll
            for (int j = 0; j < 5; ++j) a = __builtin_elementwise_fma(in[rr + j][i], cw[j][i], a);
            { const f32x2 sl_ = silu2_(a) * scale; ow[i] = pk2(sl_.x, sl_.y); } }
        *(LAS u32x4*)(tile + offb(4 * sg + rr, dg)) = (u32x4){ow[0], ow[1], ow[2], ow[3]}; }
}
DI void build_copy_tile(LAS uchar* tile, const bf16* src, size_t row0, int ld, int col0, int tid) {
    const int dg = tid & 15, sg = tid >> 4;
#pragma unroll
    for (int rr = 0; rr < 4; ++rr) { const int r = 4 * sg + rr; *(LAS u32x4*)(tile + offb(r, dg)) = *(const GAS u32x4*)(src + (row0 + r) * (size_t)ld + col0 + 8 * dg); }
}

DI void scan_issue(u32x4 (&kr)[6], u32x4 (&vr)[4], const bf16* zk, const bf16* zv, int c, int dh, int tid) {
    const int dg = tid & 7, sg = tid >> 3;
#pragma unroll
    for (int r = 0; r < 6; ++r) { const int pos = c * 128 + 2 * sg - 2 + r; kr[r] = (u32x4){0u, 0u, 0u, 0u};
        if (pos >= 0 && pos < SEQ) kr[r] = *(const GAS u32x4*)(zk + (size_t)pos * 128 + 64 * dh + 8 * dg); }
    const int dg2 = tid & 15, sg2 = tid >> 4;
#pragma unroll
    for (int rr = 0; rr < 4; ++rr) vr[rr] = *(const GAS u32x4*)(zv + (size_t)(c * 128 + 4 * sg2 + rr) * 128 + 8 * dg2);
}
DI void scan_build(LAS uchar* TKW, LAS uchar* TV, const u32x4 (&kr)[6], const u32x4 (&vr)[4], const float (&cw)[5][8], const float (&cb)[8], const LAS float* alog, float mnew, int tid) {
    const int dg = tid & 7, sg = tid >> 3;
    float in[6][8];
#pragma unroll
    for (int r = 0; r < 6; ++r) { in[r][0] = bflo(kr[r].x); in[r][1] = bfhi(kr[r].x); in[r][2] = bflo(kr[r].y); in[r][3] = bfhi(kr[r].y); in[r][4] = bflo(kr[r].z); in[r][5] = bfhi(kr[r].z); in[r][6] = bflo(kr[r].w); in[r][7] = bfhi(kr[r].w); }
#pragma unroll
    for (int rr = 0; rr < 2; ++rr) { const float sc = 0.08838834764831845f * __expf(alog[2 * sg + rr] - mnew); float o[8];
#pragma unroll
        for (int i = 0; i < 8; i += 2) { f32x2 a = (f32x2){cb[i], cb[i + 1]};
#pragma unroll
            for (int j = 0; j < 5; ++j) a = __builtin_elementwise_fma((f32x2){in[rr + j][i], in[rr + j][i + 1]}, (f32x2){cw[j][i], cw[j][i + 1]}, a);
            const f32x2 sl_ = silu2_(a) * sc; o[i] = sl_.x; o[i + 1] = sl_.y; }
        u32x4 wv; wv.x = pk2(o[0], o[1]); wv.y = pk2(o[2], o[3]); wv.z = pk2(o[4], o[5]); wv.w = pk2(o[6], o[7]);
        *(LAS u32x4*)(TKW + offb(2 * sg + rr, dg)) = wv; }
    const int dg2 = tid & 15, sg2 = tid >> 4;
#pragma unroll
    for (int rr = 0; rr < 4; ++rr) *(LAS u32x4*)(TV + offb(4 * sg2 + rr, dg2)) = vr[rr];
}
DI void scan_gate_pre(float ig0, float ig1, float fp0, float fp1, int dir, LAS float* al, LAS float* Fv, LAS float* Mv, int lane) {
    const float lf0 = log_sigmoid(fp0), lf1 = log_sigmoid(fp1);
    const float incl = wscan_add(lf0 + lf1, lane);
    const float bf0 = incl - lf1, bf1 = incl, Ftot = __shfl(incl, 63);
    const float a0 = dir ? (bf0 - lf0 + ig0) : (Ftot - bf0 + ig0), a1 = dir ? (bf1 - lf1 + ig1) : (Ftot - bf1 + ig1);
    const float mloc = wave_max(fmaxf(a0, a1));
    al[2 * lane] = a0; al[2 * lane + 1] = a1;
    if (lane == 0) { *Fv = Ftot; *Mv = mloc; }
}
DI void mlstm_scan(Frame& F, int wgid) {
    int tid = F.tid, lane = F.lane; const int w = F.wave;
    const int seq = wgid >> 1, dh = wgid & 1;
    const int dir = seq & 1, h = (seq >> 1) & 3, b = seq >> 3;
    LAS float* AL = (LAS float*)(F.lds + 131072);
    LAS float* FV = AL + 32 * 128; LAS float* MV = FV + 32; LAS float* SC = MV + 32; LAS float* MN = SC + 32; LAS float* MP = MN + 32;
    const float* gates = (const float*)(F.ws + O_GATES);
    const size_t hoff = (size_t)(b * 4 + h) * SEQ * 128;
    const bf16* zk = (const bf16*)(F.ws + O_ZK) + hoff; const bf16* zv = (const bf16*)(F.ws + O_ZV) + hoff;
    float* mst = (float*)(F.ws + O_MST);
    float cw[5][8], cb[8];
    { const int ch0 = 512 + h * 128 + 64 * dh + 8 * (tid & 7);
#pragma unroll
      for (int j = 0; j < 5; ++j) { const f32x4 a = *(const GAS f32x4*)(INP(I_CONVW) + j * 1024 + ch0), bq = *(const GAS f32x4*)(INP(I_CONVW) + j * 1024 + ch0 + 4);
          cw[j][0] = a.x; cw[j][1] = a.y; cw[j][2] = a.z; cw[j][3] = a.w; cw[j][4] = bq.x; cw[j][5] = bq.y; cw[j][6] = bq.z; cw[j][7] = bq.w; }
      const f32x4 a = *(const GAS f32x4*)(INP(I_CONVB) + ch0), bq = *(const GAS f32x4*)(INP(I_CONVB) + ch0 + 4);
      cb[0] = a.x; cb[1] = a.y; cb[2] = a.z; cb[3] = a.w; cb[4] = bq.x; cb[5] = bq.y; cb[6] = bq.z; cb[7] = bq.w; }
    f32x4 acc[4], accn = (f32x4){0.f, 0.f, 0.f, 0.f};
#pragma unroll
    for (int mt = 0; mt < 4; ++mt) acc[mt] = (f32x4){0.f, 0.f, 0.f, 0.f};
    const bf16x8 ones = (bf16x8){0x3F80, 0x3F80, 0x3F80, 0x3F80, 0x3F80, 0x3F80, 0x3F80, 0x3F80};
    const int gi = dir * 8 + h, gf = dir * 8 + 4 + h;
#define SCAN_C(ci) (dir ? 31 - (ci) : (ci))
#pragma unroll 1
    for (int q = 0; q < 4; ++q) { const int ci = w + 8 * q; const size_t r_ = ((size_t)b * SEQ + SCAN_C(ci) * 128 + 2 * lane) * 16;
        scan_gate_pre(gates[r_ + gi], gates[r_ + 16 + gi], gates[r_ + gf], gates[r_ + 16 + gf], dir, AL + ci * 128, FV + ci, MV + ci, lane); }
    __syncthreads();
    if (tid == 0) { float m = -1e30f;
#pragma unroll 1
        for (int ci = 0; ci < 32; ++ci) { MP[ci] = m; const float fm = FV[ci] + m, mn = fmaxf(fm, MV[ci]); SC[ci] = __expf(fm - mn); MN[ci] = mn; m = mn; } }
    __syncthreads();
    if (dh == 0 && tid < 32) mst[seq * 32 + SCAN_C(tid)] = MP[tid];
    unsigned aK[4][2], aV[2];
    { const unsigned g = lane >> 4, q = (lane & 15) >> 2, p = lane & 3, bo = 8u * (p & 1);
#pragma unroll
      for (int mt = 0; mt < 4; ++mt) { aK[mt][0] = offb(8 * g + q, 2 * mt + (p >> 1)) + bo; aK[mt][1] = offb(8 * g + 4 + q, 2 * mt + (p >> 1)) + bo; }
      aV[0] = offb(8 * g + q, 2 * w + (p >> 1)) + bo; aV[1] = offb(8 * g + 4 + q, 2 * w + (p >> 1)) + bo; }
#define FRAG_PRE(tile, o0, o1, kk) ({ const s16x4 lo_ = __builtin_amdgcn_ds_read_tr16_b64_v4i16((LAS s16x4*)((tile) + (o0) + 8192 * (kk))); const s16x4 hi_ = __builtin_amdgcn_ds_read_tr16_b64_v4i16((LAS s16x4*)((tile) + (o1) + 8192 * (kk))); (bf16x8){lo_[0], lo_[1], lo_[2], lo_[3], hi_[0], hi_[1], hi_[2], hi_[3]}; })
    u32x4 krA[6], vrA[4], krB[6], vrB[4];
    scan_issue(krB, vrB, zk, zv, SCAN_C(0), dh, tid);
    scan_issue(krA, vrA, zk, zv, SCAN_C(1), dh, tid);
    __syncthreads();
    scan_build(F.lds, F.lds + 32768, krB, vrB, cw, cb, AL, MN[0], tid);
    scan_issue(krB, vrB, zk, zv, SCAN_C(2), dh, tid);
    __syncthreads();
#define SCAN_ITER(ci, KRN, VRN) do { \
        const int c = SCAN_C(ci); \
        asm volatile("" : "+v"(tid), "+v"(lane)); \
        GASK uchar* wsl_ = (GASK uchar*)F.ws; asm volatile("" : "+s"(wsl_)); \
        const bf16* zk = (const bf16*)((uchar*)wsl_ + O_ZK) + hoff; const bf16* zv = (const bf16*)((uchar*)wsl_ + O_ZV) + hoff; bf16* cst = (bf16*)((uchar*)wsl_ + O_CST); float* nst = (float*)((uchar*)wsl_ + O_NST); \
        LAS uchar* TKW = F.lds + ((ci) & 1) * 65536; LAS uchar* TV = TKW + 32768; \
        { bf16* cp = cst + ((size_t)seq * 32 + c) * 16384; \
          { u32x2 sv[4]; _Pragma("unroll") for (int mt = 0; mt < 4; ++mt) { sv[mt].x = pk2(acc[mt][0], acc[mt][1]); sv[mt].y = pk2(acc[mt][2], acc[mt][3]); } \
            xchg4x4(sv); store32(cp + (16 * w + (lane & 15)) * 128 + 64 * dh + 16 * (lane >> 4), sv); } \
          if (w < 4 && (lane & 15) == 0) *(GAS f32x4*)(nst + ((size_t)seq * 32 + c) * 128 + 64 * dh + 16 * w + 4 * (lane >> 4)) = accn; } \
        if ((ci) + 1 < 32) { \
            scan_build(F.lds + (((ci) + 1) & 1) * 65536, F.lds + (((ci) + 1) & 1) * 65536 + 32768, KRN, VRN, cw, cb, AL + ((ci) + 1) * 128, MN[(ci) + 1], tid); \
            if ((ci) + 3 < 32) scan_issue(KRN, VRN, zk, zv, SCAN_C((ci) + 3), dh, tid); } \
        const float sc_old = SC[(ci)]; \
        _Pragma("unroll") for (int mt = 0; mt < 4; ++mt) acc[mt] *= sc_old; \
        accn *= sc_old; \
        _Pragma("unroll") for (int kk = 0; kk < 4; ++kk) { \
            const bf16x8 Yf = FRAG_PRE(TV, aV[0], aV[1], kk); \
            _Pragma("unroll") for (int mt = 0; mt < 4; ++mt) acc[mt] = mfma16(FRAG_PRE(TKW, aK[mt][0], aK[mt][1], kk), Yf, acc[mt]); \
            if (w < 4) accn = mfma16(FRAG_PRE(TKW, aV[0], aV[1], kk), ones, accn); \
            __builtin_amdgcn_sched_barrier(0); } \
        __syncthreads(); } while (0)
    for (int c2 = 0; c2 < 32; c2 += 2) { SCAN_ITER(c2, krA, vrA); SCAN_ITER(c2 + 1, krB, vrB); }
#undef SCAN_ITER
#undef FRAG_PRE
#undef SCAN_C
}

DI void gmlp_phase(Frame& F) {
    const int w = F.wave;
    const bf16* z = (const bf16*)(F.ws + O_Z); bf16* Y = (bf16*)(F.ws + O_Y); const bf16* wsb = (const bf16*)(F.ws + O_WSB);
    float lg[8], lb[8];
    { const f32x4 a = *(const GAS f32x4*)(INP(I_LNVG) + 8 * F.lane), bq = *(const GAS f32x4*)(INP(I_LNVG) + 8 * F.lane + 4), c = *(const GAS f32x4*)(INP(I_LNVB) + 8 * F.lane), d = *(const GAS f32x4*)(INP(I_LNVB) + 8 * F.lane + 4);
      lg[0] = a.x; lg[1] = a.y; lg[2] = a.z; lg[3] = a.w; lg[4] = bq.x; lg[5] = bq.y; lg[6] = bq.z; lg[7] = bq.w; lb[0] = c.x; lb[1] = c.y; lb[2] = c.z; lb[3] = c.w; lb[4] = d.x; lb[5] = d.y; lb[6] = d.z; lb[7] = d.w; }
    for (int unit = F.bid; unit < 512; unit += F.G) {
        int tid = F.tid, lane = F.lane; asm volatile("" : "+v"(tid), "+v"(lane));
        const size_t row0 = (size_t)unit * 128;
        u32x4 raw[16];
#pragma unroll
        for (int i = 0; i < 16; ++i) raw[i] = *(const GAS u32x4*)(z + (row0 + 16 * w + i) * ZG + 512 + 8 * lane);
#pragma unroll
        for (int i = 0; i < 16; ++i) { const int r = 16 * w + i;
            float v[8] = {bflo(raw[i].x), bfhi(raw[i].x), bflo(raw[i].y), bfhi(raw[i].y), bflo(raw[i].z), bfhi(raw[i].z), bflo(raw[i].w), bfhi(raw[i].w)};
            float s = 0.f;
#pragma unroll
            for (int q = 0; q < 8; ++q) s += v[q];
            const float mu = wave_sum(s) * (1.f / 512.f); float qq = 0.f;
#pragma unroll
            for (int q = 0; q < 8; ++q) { v[q] -= mu; qq += v[q] * v[q]; }
            const float rs = 1.0f / sqrtf(wave_sum(qq) * (1.f / 512.f) + LN_EPS);
#pragma unroll
            for (int q = 0; q < 8; ++q) v[q] = v[q] * rs * lg[q] + lb[q];
            u32x4 wv; wv.x = pk2(v[0], v[1]); wv.y = pk2(v[2], v[3]); wv.z = pk2(v[4], v[5]); wv.w = pk2(v[6], v[7]);
            *(LAS u32x4*)(F.lds + (lane >> 4) * 32768 + offb(r, lane & 15)) = wv; }
        __syncthreads();
        const int tl = 16 * w + (lane & 15); const size_t row = row0 + tl;
        bf16x8 Yw[2][4]; u32x2 guw[2][2][4];
#define GM_ISSUE(g, sl) do { _Pragma("unroll") for (int kk = 0; kk < 4; ++kk) Yw[sl][kk] = *(const GAS bf16x8*)(wsb + ((size_t)(g) * 128 + tl) * 128 + 32 * kk + 8 * (lane >> 4)); \
        load32(guw[sl][0], z + row * ZG + (g) * 128 + 16 * (lane >> 4)); load32(guw[sl][1], z + row * ZG + (g) * 128 + 64 + 16 * (lane >> 4)); } while (0)
        GM_ISSUE(0, 0);
#pragma unroll
        for (int g = 0; g < 4; ++g) {
            const int sl = g & 1;
            if (g < 3) GM_ISSUE(g + 1, sl ^ 1);
            const LAS uchar* T_G = F.lds + g * 32768;
            f32x4 acc[8];
#pragma unroll
            for (int mt = 0; mt < 8; ++mt) acc[mt] = (f32x4){0.f, 0.f, 0.f, 0.f};
#pragma unroll
            for (int kk = 0; kk < 4; ++kk) {
#pragma unroll
                for (int mt = 0; mt < 8; ++mt) acc[mt] = mfma16(frag_tr(T_G, 32 * kk, 16 * mt, lane), Yw[sl][kk], acc[mt]);
                __builtin_amdgcn_sched_barrier(0); }
            const float bs = INP(I_BS)[g * 128 + tl];
#pragma unroll
            for (int G = 0; G < 2; ++G) { u32x2 ov[4]; xchg4x4(guw[sl][G]);
#pragma unroll
                for (int t = 0; t < 4; ++t) { const int mt = 4 * G + t; const u32x2 gv2 = guw[sl][G][t];
                    ov[t].x = pk2(bflo(gv2.x) * (acc[mt][0] + bs), bfhi(gv2.x) * (acc[mt][1] + bs)); ov[t].y = pk2(bflo(gv2.y) * (acc[mt][2] + bs), bfhi(gv2.y) * (acc[mt][3] + bs)); }
                xchg4x4(ov); store32(Y + row * DM + 512 + g * 128 + 64 * G + 16 * (lane >> 4), ov); }
        }
#undef GM_ISSUE
        __syncthreads();
    }
}

DI void phase2(Frame& F) {
    for (int s = xcd_major(F.bid, F.G); s < 256; s += F.G) mlstm_scan(F, s);
    gmlp_phase(F);
}

DI void mlstm_out_phase(Frame& F) {
  constexpr int NU3 = NB * 4 * 32;
  const int w = F.wave;
  u32x4 qraw[8];
  if (F.bid < NU3) { const int u0 = F.bid; const size_t ho = (size_t)(u0 >> 5) * SEQ * 128;
      conv_issue(qraw, (const bf16*)(F.ws + O_ZQ) + ho, u0 & 31, F.tid); }
  int h_tab = -1;
  for (int unit = F.bid; unit < NU3; unit += F.G) {
    int tid = F.tid, lane = F.lane; asm volatile("" : "+v"(tid), "+v"(lane));
    const int c = unit & 31, h = (unit >> 5) & 3, b = unit >> 7;
    const size_t row0 = (size_t)b * SEQ + c * 128;
    LAS uchar* T_Q = F.lds; LAS uchar* T_K = F.lds + 32768; LAS uchar* T_V = F.lds + 65536; LAS uchar* T_C = F.lds + 98304;
    LAS float* sm = (LAS float*)(F.lds + 131072);
    LAS float* ctab = (LAS float*)(F.lds + 139264);
    if (h != h_tab) {
        __syncthreads();
        for (int idx = tid; idx < 1664; idx += NTHR) { float v;
            if (idx < 1536) { const int part = idx < 768 ? idx : idx - 768, j = part >> 7, zc = (idx < 768 ? 0 : 512) + h * 128 + (part & 127); v = j < 5 ? INP(I_CONVW)[j * 1024 + zc] : INP(I_CONVB)[zc]; }
            else v = INP(I_GHEAD)[h * 128 + (idx - 1536)];
            ctab[idx] = v; }
        __syncthreads();
        h_tab = h;
    }
    LAS float* gfa = sm, *gba = sm + 128, *Mfa = sm + 256, *Mba = sm + 384, *sIf = sm + 512, *sIb = sm + 640, *enf = sm + 768, *enb = sm + 896, *nfa = sm + 1024, *nba = sm + 1152, *qnf = sm + 1280, *qnb = sm + 1408;
    const size_t hoff = (size_t)(b * 4 + h) * SEQ * 128;
    const bf16* zq = (const bf16*)(F.ws + O_ZQ) + hoff; const bf16* zk = (const bf16*)(F.ws + O_ZK) + hoff; const bf16* zv = (const bf16*)(F.ws + O_ZV) + hoff; const bf16* zo = (const bf16*)(F.ws + O_ZO) + hoff;
    const float* gates = (const float*)(F.ws + O_GATES);
    const bf16* cst = (const bf16*)(F.ws + O_CST); const float* nst = (const float*)(F.ws + O_NST); const float* mst = (const float*)(F.ws + O_MST);
    bf16* Y = (bf16*)(F.ws + O_Y);
    const int sqf = ((b * 4 + h) * 2 + 0) * 32 + c, sqb = ((b * 4 + h) * 2 + 1) * 32 + c;
    if (w < 2) {
        const float mpf = mst[sqf], mpb = mst[sqb];
        const size_t r0 = (row0 + 2 * lane) * 16, r1 = (row0 + 2 * lane + 1) * 16;
        if (w == 0) {
            const float ig0 = gates[r0 + h], ig1 = gates[r1 + h], lf0 = log_sigmoid(gates[r0 + 4 + h]), lf1 = log_sigmoid(gates[r1 + 4 + h]);
            const float incl = wscan_add(lf0 + lf1, lane), bf0 = incl - lf1, bf1 = incl;
            const float g0 = ig0 - bf0, g1 = ig1 - bf1;
            const float pin = wscan_max(fmaxf(g0, g1), lane); float pex = __shfl_up(pin, 1); if (lane == 0) pex = -3.0e38f;
            const float M0 = fmaxf(mpf, fmaxf(pex, g0)), M1 = fmaxf(mpf, pin);
            gfa[2 * lane] = g0; gfa[2 * lane + 1] = g1; Mfa[2 * lane] = M0; Mfa[2 * lane + 1] = M1;
            sIf[2 * lane] = __expf(mpf - M0); sIf[2 * lane + 1] = __expf(mpf - M1);
            enf[2 * lane] = __expf(-bf0 - M0); enf[2 * lane + 1] = __expf(-bf1 - M1);
        }
        else {
            const float ig0 = gates[r0 + 8 + h], ig1 = gates[r1 + 8 + h], lf0 = log_sigmoid(gates[r0 + 12 + h]), lf1 = log_sigmoid(gates[r1 + 12 + h]);
            const float incl = wscan_add(lf0 + lf1, lane), Ftot = __shfl(incl, 63);
            const float bb0 = Ftot - incl + lf0 + lf1, bb1 = Ftot - incl + lf1;
            const float g0 = ig0 - bb0, g1 = ig1 - bb1;
            const float sin_ = wscan_max_rev(fmaxf(g0, g1), lane); float sex = __shfl_down(sin_, 1); if (lane == 63) sex = -3.0e38f;
            const float M0 = fmaxf(mpb, sin_), M1 = fmaxf(mpb, fmaxf(sex, g1));
            gba[2 * lane] = g0; gba[2 * lane + 1] = g1; Mba[2 * lane] = M0; Mba[2 * lane + 1] = M1;
            sIb[2 * lane] = __expf(mpb - M0); sIb[2 * lane + 1] = __expf(mpb - M1);
            enb[2 * lane] = __expf(-bb0 - M0); enb[2 * lane + 1] = __expf(-bb1 - M1);
        }
    }
    if (tid < 128) { nfa[tid] = nst[(size_t)sqf * 128 + tid]; nba[tid] = nst[(size_t)sqb * 128 + tid]; }
    u32x4 kraw[8]; conv_issue(kraw, zk, c, tid);
    conv_build_l(T_Q, qraw, ctab, 1.0f, tid);
    conv_build_l(T_K, kraw, ctab + 768, 0.08838834764831845f, tid);
    build_copy_tile(T_V, zv, (size_t)c * 128, 128, 0, tid);
    build_copy_tile(T_C, cst + (size_t)sqf * 16384, 0, 128, 0, tid);
    __syncthreads();
    {
        const int t = tid >> 2, part = tid & 3; float af = 0.f, ab = 0.f;
#pragma unroll
        for (int cc = 0; cc < 4; ++cc) { const u32x4 raw = *(const LAS u32x4*)(T_Q + offb(t, 4 * part + cc)); const int dd = 32 * part + 8 * cc;
            const float qv[8] = {bflo(raw.x), bfhi(raw.x), bflo(raw.y), bfhi(raw.y), bflo(raw.z), bfhi(raw.z), bflo(raw.w), bfhi(raw.w)};
#pragma unroll
            for (int i = 0; i < 8; ++i) { af += qv[i] * nfa[dd + i]; ab += qv[i] * nba[dd + i]; } }
        af += __shfl_xor(af, 1); af += __shfl_xor(af, 2); ab += __shfl_xor(ab, 1); ab += __shfl_xor(ab, 2);
        if (part == 0) { qnf[t] = af; qnb[t] = ab; }
    }
    u32x4 cbreg[4];
    { const int dg = tid & 15, sg = tid >> 4; const bf16* src = cst + (size_t)sqb * 16384;
#pragma unroll
      for (int rr = 0; rr < 4; ++rr) cbreg[rr] = *(const GAS u32x4*)(src + (size_t)(4 * sg + rr) * 128 + 8 * dg); }
    bf16x8 Qf[4];
#pragma unroll
    for (int kk = 0; kk < 4; ++kk) Qf[kk] = frag_row(T_Q, 16 * w, kk, lane);
    f32x4 aS[8];
#pragma unroll
    for (int mt = 0; mt < 8; ++mt) aS[mt] = (f32x4){0.f, 0.f, 0.f, 0.f};
#pragma unroll
    for (int kk = 0; kk < 4; ++kk) {
#pragma unroll
        for (int mt = 0; mt < 8; ++mt) aS[mt] = mfma16(frag_row(T_K, 16 * mt, kk, lane), Qf[kk], aS[mt]);
        __builtin_amdgcn_sched_barrier(0); }
    __syncthreads();
    const int tl = 16 * w + (lane & 15);
    float cf, cb_;
    {
        const float Mf = Mfa[tl], Mb = Mba[tl]; const float nMf = -Mf * 1.4426950408889634f, nMb = -Mb * 1.4426950408889634f;
        f32x4 wf[8], wb[8]; float sumf = 0.f, sumb = 0.f;
#pragma unroll
        for (int mt = 0; mt < 8; ++mt) { const int s0 = 16 * mt + 4 * (lane >> 4); const f32x4 gf4 = *(const LAS f32x4*)(gfa + s0), gb4 = *(const LAS f32x4*)(gba + s0);
#pragma unroll
            for (int j = 0; j < 4; ++j) { const int s = s0 + j; const float sv = aS[mt][j];
                const float a = (s <= tl) ? __builtin_amdgcn_exp2f(fmaf(gf4[j], 1.4426950408889634f, nMf)) * sv : 0.f, bq = (s >= tl) ? __builtin_amdgcn_exp2f(fmaf(gb4[j], 1.4426950408889634f, nMb)) * sv : 0.f;
                wf[mt][j] = a; wb[mt][j] = bq; sumf += a; sumb += bq; } }
        sumf += __shfl_xor(sumf, 16); sumf += __shfl_xor(sumf, 32); sumb += __shfl_xor(sumb, 16); sumb += __shfl_xor(sumb, 32);
        const float sif = sIf[tl], sib = sIb[tl];
        const float denf = sumf + sif * qnf[tl], denb = sumb + sib * qnb[tl];
        const float rf = 1.0f / fmaxf(fabsf(denf), enf[tl]), rb = 1.0f / fmaxf(fabsf(denb), enb[tl]);
        cf = sif * rf; cb_ = sib * rb;
#pragma unroll
        for (int mt = 0; mt < 8; ++mt) { const int s0 = 16 * mt + 4 * (lane >> 4);
            const f32x4 wc4 = wf[mt] * rf + wb[mt] * rb;
            u32x2 v; v.x = pk2(wc4[0], wc4[1]); v.y = pk2(wc4[2], wc4[3]);
            *(LAS u32x2*)(T_K + offb(tl, s0 >> 3) + (s0 & 7) * 2) = v; }
    }
    { const int nu = unit + F.G;
      if (nu < NU3) { const size_t ho = (size_t)(nu >> 5) * SEQ * 128; conv_issue(qraw, (const bf16*)(F.ws + O_ZQ) + ho, nu & 31, tid); } }
    f32x4 aO[8], aZ[8];
#pragma unroll
    for (int mt = 0; mt < 8; ++mt) { aO[mt] = (f32x4){0.f, 0.f, 0.f, 0.f}; aZ[mt] = (f32x4){0.f, 0.f, 0.f, 0.f}; }
#pragma unroll
    for (int kk = 0; kk < 4; ++kk) { const bf16x8 Yw = frag_row(T_K, 16 * w, kk, lane);
#pragma unroll
        for (int mt = 0; mt < 8; ++mt) aO[mt] = mfma16(frag_tr(T_V, 32 * kk, 16 * mt, lane), Yw, aO[mt]);
        __builtin_amdgcn_sched_barrier(0); }
#pragma unroll
    for (int kk = 0; kk < 4; ++kk) {
#pragma unroll
        for (int mt = 0; mt < 8; ++mt) aZ[mt] = mfma16(frag_row(T_C, 16 * mt, kk, lane), Qf[kk], aZ[mt]);
        __builtin_amdgcn_sched_barrier(0); }
#pragma unroll
    for (int mt = 0; mt < 8; ++mt) { aO[mt] += aZ[mt] * cf; aZ[mt] = (f32x4){0.f, 0.f, 0.f, 0.f}; }
    __syncthreads();
    { const int dg = tid & 15, sg = tid >> 4;
#pragma unroll
      for (int rr = 0; rr < 4; ++rr) *(LAS u32x4*)(T_C + offb(4 * sg + rr, dg)) = cbreg[rr]; }
    __syncthreads();
#pragma unroll
    for (int kk = 0; kk < 4; ++kk) {
#pragma unroll
        for (int mt = 0; mt < 8; ++mt) aZ[mt] = mfma16(frag_row(T_C, 16 * mt, kk, lane), Qf[kk], aZ[mt]);
        __builtin_amdgcn_sched_barrier(0); }
    u32x2 ogw[2][4];
    load32(ogw[0], zo + (size_t)(c * 128 + 16 * w + (lane & 15)) * 128 + 16 * (lane >> 4)); load32(ogw[1], zo + (size_t)(c * 128 + 16 * w + (lane & 15)) * 128 + 64 + 16 * (lane >> 4));
    float ssq = 0.f;
#pragma unroll
    for (int mt = 0; mt < 8; ++mt) { aO[mt] += aZ[mt] * cb_; ssq += (aO[mt][0] * aO[mt][0] + aO[mt][1] * aO[mt][1]) + (aO[mt][2] * aO[mt][2] + aO[mt][3] * aO[mt][3]); }
    ssq += __shfl_xor(ssq, 16); ssq += __shfl_xor(ssq, 32);
    const float rinv = 1.0f / sqrtf(ssq * (1.f / 128.f) + RMS_EPS);
    const size_t row = row0 + tl;
#pragma unroll
    for (int G = 0; G < 2; ++G) { u32x2 ov[4]; xchg4x4(ogw[G]);
#pragma unroll
        for (int t = 0; t < 4; ++t) { const int mt = 4 * G + t, e = 16 * mt + 4 * (lane >> 4);
            const u32x2 ogv = ogw[G][t]; const f32x4 gh = *(const LAS f32x4*)(ctab + 1536 + e);
            ov[t].x = pk2(bflo(ogv.x) * aO[mt][0] * rinv * gh.x, bfhi(ogv.x) * aO[mt][1] * rinv * gh.y); ov[t].y = pk2(bflo(ogv.y) * aO[mt][2] * rinv * gh.z, bfhi(ogv.y) * aO[mt][3] * rinv * gh.w); }
        xchg4x4(ov); store32(Y + row * DM + h * 128 + 64 * G + 16 * (lane >> 4), ov); }
    __syncthreads();
  }
}
DI void kv_dma(LAS uchar* buf, const bf16* kv, int b, int col0, int w, int lane) {
#pragma unroll
    for (int i = 0; i < 8; ++i) { const int r = 32 * w + 4 * i + (lane >> 4); const int f = ((r & 3) << 2) | ((r >> 2) & 3);
        const bf16* src = kv + (size_t)(b * NMEM + r) * 2048 + col0 + 8 * ((lane & 15) ^ f);
        __builtin_amdgcn_global_load_lds((const unsigned*)src, (LAS unsigned*)(buf + 256 * (32 * w + 4 * i)), 16, 0, 0); }
}
#define DMA_WAIT() asm volatile("s_waitcnt vmcnt(0)" ::: "memory")
DI bf16x8 frag_tr_perm(const LAS uchar* tile, int k0, int c0, int lane) {
    const unsigned g = lane >> 4, q = (lane & 15) >> 2, p = lane & 3;
    const unsigned ch = (c0 >> 3) + (p >> 1), bo = 8u * (p & 1);
    const s16x4 lo = __builtin_amdgcn_ds_read_tr16_b64_v4i16((LAS s16x4*)(tile + offb(k0 + 4 * g + q, ch) + bo));
    const s16x4 hi = __builtin_amdgcn_ds_read_tr16_b64_v4i16((LAS s16x4*)(tile + offb(k0 + 16 + 4 * g + q, ch) + bo));
    return (bf16x8){lo[0], lo[1], lo[2], lo[3], hi[0], hi[1], hi[2], hi[3]};
}
DI void attn_phase(Frame& F, int first, int stride, int limit) {
    const int w = F.wave;
    const int NU = limit;
    const bf16* Q = (const bf16*)(F.ws + O_Q); const bf16* kv = (const bf16*)(F.ws + O_KV); uchar* O = F.ws + O_O;
    LAS uchar* B0 = F.lds; LAS uchar* B1 = F.lds + 65536;
    const int vb = first;
    if (vb < NU) { const int u0 = vb; kv_dma(B0, kv, u0 >> 6, ((u0 >> 4) & 3) * 256, w, F.lane); }
    DMA_WAIT(); __syncthreads();
    for (int unit = vb; unit < NU; unit += stride) {
        int tid = F.tid, lane = F.lane; asm volatile("" : "+v"(tid), "+v"(lane));
        const int qb = unit & 15, hd = (unit >> 4) & 3, b = unit >> 6;
        const int nu = unit + stride;
        const size_t qrow0 = (size_t)b * SEQ + qb * 256 + 32 * w + (lane & 15);
        f32x4 aS[2][16];
#pragma unroll
        for (int tb = 0; tb < 2; ++tb)
#pragma unroll
            for (int mt = 0; mt < 16; ++mt) aS[tb][mt] = (f32x4){0.f, 0.f, 0.f, 0.f};
        bf16x8 Qc[2], Qn[2];
#pragma unroll
        for (int tb = 0; tb < 2; ++tb) Qn[tb] = *(const GAS bf16x8*)(Q + (qrow0 + 16 * tb) * DM + hd * 256 + 8 * (lane >> 4));
#pragma unroll
        for (int dh = 0; dh < 2; ++dh) {
            const LAS uchar* KB = dh ? B1 : B0;
            if (dh == 0) kv_dma(B1, kv, b, hd * 256 + 128, w, lane);
            else kv_dma(B0, kv, b, 1024 + hd * 256, w, lane);
#pragma unroll
            for (int kk = 0; kk < 4; ++kk) { const int st = dh * 4 + kk;
                Qc[0] = Qn[0]; Qc[1] = Qn[1];
                if (st < 7) {
#pragma unroll
                    for (int tb = 0; tb < 2; ++tb) Qn[tb] = *(const GAS bf16x8*)(Q + (qrow0 + 16 * tb) * DM + hd * 256 + 32 * (st + 1) + 8 * (lane >> 4)); }
#pragma unroll
                for (int mh = 0; mh < 4; ++mh) {
#pragma unroll
                    for (int mq = 0; mq < 4; ++mq) { const int mt = 4 * mh + mq; const bf16x8 X = frag_row(KB, 16 * mt, kk, lane);
                        aS[0][mt] = mfma16(X, Qc[0], aS[0][mt]); aS[1][mt] = mfma16(X, Qc[1], aS[1][mt]); }
                    __builtin_amdgcn_sched_barrier(0); } }
            asm volatile("s_waitcnt vmcnt(2)" ::: "memory"); __builtin_amdgcn_s_barrier();
        }
        bf16x8 Pf[2][8]; float rinv[2];
#pragma unroll
        for (int tb = 0; tb < 2; ++tb) {
            float mx = -3.0e38f;
#pragma unroll
            for (int mt = 0; mt < 16; ++mt) mx = fmaxf(mx, fmaxf(fmaxf(aS[tb][mt][0], aS[tb][mt][1]), fmaxf(aS[tb][mt][2], aS[tb][mt][3])));
            mx = fmaxf(mx, __shfl_xor(mx, 16)); mx = fmaxf(mx, __shfl_xor(mx, 32));
            float sum = 0.f; const float nmx = -mx * 1.4426950408889634f;
#pragma unroll
            for (int s = 0; s < 8; ++s) { f32x4 p0, p1;
#pragma unroll
                for (int j = 0; j < 4; j += 2) {
                    const f32x2 e0 = exp2fma2_((f32x2){aS[tb][2 * s][j], aS[tb][2 * s][j + 1]}, 1.4426950408889634f, nmx), e1 = exp2fma2_((f32x2){aS[tb][2 * s + 1][j], aS[tb][2 * s + 1][j + 1]}, 1.4426950408889634f, nmx);
                    p0[j] = e0.x; p0[j + 1] = e0.y; p1[j] = e1.x; p1[j + 1] = e1.y; sum += (e0.x + e0.y) + (e1.x + e1.y); }
                u32x4 pk; pk.x = pk2(p0[0], p0[1]); pk.y = pk2(p0[2], p0[3]); pk.z = pk2(p1[0], p1[1]); pk.w = pk2(p1[2], p1[3]);
                Pf[tb][s] = __builtin_bit_cast(bf16x8, pk); }
            sum += __shfl_xor(sum, 16); sum += __shfl_xor(sum, 32);
            rinv[tb] = 1.0f / sum;
        }
#pragma unroll
        for (int eh = 0; eh < 2; ++eh) {
            const LAS uchar* VB = eh ? B1 : B0;
            if (eh == 0) kv_dma(B1, kv, b, 1024 + hd * 256 + 128, w, lane);
            else if (nu < NU) kv_dma(B0, kv, nu >> 6, ((nu >> 4) & 3) * 256, w, lane);
            f32x4 aO[2][8];
#pragma unroll
            for (int tb = 0; tb < 2; ++tb)
#pragma unroll
                for (int mt = 0; mt < 8; ++mt) aO[tb][mt] = (f32x4){0.f, 0.f, 0.f, 0.f};
#pragma unroll
            for (int s = 0; s < 8; ++s) {
#pragma unroll
                for (int mh = 0; mh < 2; ++mh) {
#pragma unroll
                    for (int mq = 0; mq < 4; ++mq) { const int mt = 4 * mh + mq; const bf16x8 X = frag_tr_perm(VB, 32 * s, 16 * mt, lane);
                        aO[0][mt] = mfma16(X, Pf[0][s], aO[0][mt]); aO[1][mt] = mfma16(X, Pf[1][s], aO[1][mt]); }
                    __builtin_amdgcn_sched_barrier(0); } }
#pragma unroll
            for (int tb = 0; tb < 2; ++tb) { const float ri = rinv[tb];
#pragma unroll
                for (int G = 0; G < 2; ++G) { unsigned r[4];
#pragma unroll
                    for (int t = 0; t < 4; ++t) { const f32x4 o4 = aO[tb][4 * G + t] * ri; r[t] = pk4_fp8(o4[0], o4[1], o4[2], o4[3]); }
                    { const auto a = __builtin_amdgcn_permlane32_swap(r[0], r[2], false, false); r[0] = a[0]; r[2] = a[1]; }
                    { const auto a = __builtin_amdgcn_permlane32_swap(r[1], r[3], false, false); r[1] = a[0]; r[3] = a[1]; }
                    { const auto a = __builtin_amdgcn_permlane16_swap(r[0], r[1], false, false); r[0] = a[0]; r[1] = a[1]; }
                    { const auto a = __builtin_amdgcn_permlane16_swap(r[2], r[3], false, false); r[2] = a[0]; r[3] = a[1]; }
                    *(GAS u32x4*)(O + (qrow0 + 16 * tb) * DM + hd * 256 + eh * 128 + 64 * G + 16 * (lane >> 4)) = (u32x4){r[0], r[1], r[2], r[3]}; } }
            asm volatile("s_waitcnt vmcnt(4)" ::: "memory"); __builtin_amdgcn_s_barrier();
        }
    }
}

#ifdef TPROBE
#define RMARK(k) do { if (TPROBE == (k) && F.tid == 0) ((volatile LAS unsigned long long*)(F.lds + LDS_BYTES - 256 + 128))[1] = __builtin_amdgcn_s_memrealtime(); } while (0)
#define REND(k) do { if (TPROBE == (k) && F.tid == 0) { volatile LAS unsigned long long* t_ = (volatile LAS unsigned long long*)(F.lds + LDS_BYTES - 256 + 128); t_[0] = t_[0] + (__builtin_amdgcn_s_memrealtime() - t_[1]); } } while (0)
#else
#define RMARK(k) ((void)0)
#define REND(k) ((void)0)
#endif
DI void route_block(Frame& F, int blk) {
    RMARK(21);
    const int tid = F.tid, lane = F.lane, w = F.wave;
    LAS float* lg = (LAS float*)F.lds + (size_t)w * (32 * 48);
    LAS int* tokE = (LAS int*)(F.lds + 147456);
    LAS int* tokR = tokE + 512;
    LAS int* wcnt = tokR + 512;
    LAS int* base = wcnt + 256;
    LAS float* brl = (LAS float*)(F.lds + 147456 + 7168);
    if (tid < 36) brl[tid] = tid < 4 ? INP(I_BRG)[tid] : INP(I_BRE)[tid - 4];
    const bf16* x2 = (const bf16*)(F.ws + O_XB); float* rs3 = (float*)(F.ws + O_RS3); unsigned* tok = (unsigned*)(F.ws + O_TOK); int* ridx = (int*)(F.ws + O_RIDX);
    const bf16* wrh = (const bf16*)(F.ws + O_WRH); const bf16* wrl = (const bf16*)(F.ws + O_WRL);
    unsigned* cnt = (unsigned*)(F.ws + O_CTL) + CW_CNT;
    const int r16 = lane & 15, g4 = lane >> 4;
    const size_t row0 = (size_t)blk * 256 + 32 * w;
    f32x4 acc[3][2];
#pragma unroll
    for (int nb = 0; nb < 3; ++nb) { acc[nb][0] = (f32x4){0.f, 0.f, 0.f, 0.f}; acc[nb][1] = (f32x4){0.f, 0.f, 0.f, 0.f}; }
    float ss0 = 0.f, ss1 = 0.f;
    LAS uchar* xr = F.lds + 65536;
    const int wbase = w * 1024, sw = (r16 >> 1) & 7;
    bf16x8 Yq[3][2][2];
#define RT_LDY(kk, sl) do { _Pragma("unroll") for (int h = 0; h < 2; ++h) _Pragma("unroll") for (int rb = 0; rb < 2; ++rb) Yq[sl][rb][h] = *(const GAS bf16x8*)(x2 + (row0 + 16 * rb + r16) * DM + 64 * (kk) + 16 * g4 + 8 * h); } while (0)
#define RT_DMA(kk, slotoff) do { _Pragma("unroll") for (int i = 0; i < 2; ++i) { const int L = i * 512 + tid, row = L >> 3, cp = L & 7, c = cp ^ ((row >> 1) & 7), rr = row < 95 ? row : 95; \
        const bf16* src = (rr < 48 ? wrh + (size_t)rr * 1024 : wrl + (size_t)(rr - 48) * 1024) + 64 * (kk) + 8 * c; \
        __builtin_amdgcn_global_load_lds((const unsigned*)src, (LAS unsigned*)(xr + (slotoff) + i * 8192 + wbase), 16, 0, 0); } } while (0)
    RT_DMA(0, 0); RT_LDY(0, 0); RT_DMA(1, 16384); RT_LDY(1, 1);
    int sc = 0;
#define RT_STEP(j) do { const int kk = k4 + (j); \
        if (kk == 0) asm volatile("s_waitcnt vmcnt(6)" ::: "memory"); else asm volatile("s_waitcnt vmcnt(10)" ::: "memory"); \
        __builtin_amdgcn_s_barrier(); \
        { const int s2 = sc + 32768 >= 49152 ? sc + 32768 - 49152 : sc + 32768; RT_DMA(kk + 2, s2); }     \
        RT_LDY(kk + 2, ((j) + 2) % 3); \
        bf16x8 Xh[3], Xl[3]; \
        _Pragma("unroll") for (int nb = 0; nb < 3; ++nb) { const int co = ((2 * g4) ^ sw) << 4; \
            Xh[nb] = *(const LAS bf16x8*)(xr + sc + (16 * nb + r16) * 128 + co); Xl[nb] = *(const LAS bf16x8*)(xr + sc + (48 + 16 * nb + r16) * 128 + co); } \
        _Pragma("unroll") for (int rb = 0; rb < 2; ++rb) { float xf[16]; \
            _Pragma("unroll") for (int jj = 0; jj < 8; ++jj) { xf[jj] = bf2f((unsigned short)Yq[(j) % 3][rb][0][jj]); xf[8 + jj] = bf2f((unsigned short)Yq[(j) % 3][rb][1][jj]); } \
            u32x4 o8; o8.x = pk4_fp8(xf[0], xf[1], xf[2], xf[3]); o8.y = pk4_fp8(xf[4], xf[5], xf[6], xf[7]); o8.z = pk4_fp8(xf[8], xf[9], xf[10], xf[11]); o8.w = pk4_fp8(xf[12], xf[13], xf[14], xf[15]); \
            *(GAS u32x4*)((uchar*)F.ws + O_X2F8 + (row0 + 16 * rb + r16) * DM + 64 * kk + 16 * g4) = o8; \
            float q = 0.f; \
            _Pragma("unroll") for (int jj = 0; jj < 16; ++jj) q += xf[jj] * xf[jj]; \
            if (rb) ss1 += q; else ss0 += q; } \
        _Pragma("unroll") for (int nb = 0; nb < 3; ++nb) _Pragma("unroll") for (int rb = 0; rb < 2; ++rb) { \
            acc[nb][rb] = mfma16(Xh[nb], Yq[(j) % 3][rb][0], acc[nb][rb]); acc[nb][rb] = mfma16(Xl[nb], Yq[(j) % 3][rb][0], acc[nb][rb]); } \
        __builtin_amdgcn_sched_barrier(0); \
        _Pragma("unroll") for (int nb = 0; nb < 3; ++nb) { const int co = ((2 * g4 + 1) ^ sw) << 4; \
            Xh[nb] = *(const LAS bf16x8*)(xr + sc + (16 * nb + r16) * 128 + co); Xl[nb] = *(const LAS bf16x8*)(xr + sc + (48 + 16 * nb + r16) * 128 + co); } \
        _Pragma("unroll") for (int nb = 0; nb < 3; ++nb) _Pragma("unroll") for (int rb = 0; rb < 2; ++rb) { \
            acc[nb][rb] = mfma16(Xh[nb], Yq[(j) % 3][rb][1], acc[nb][rb]); acc[nb][rb] = mfma16(Xl[nb], Yq[(j) % 3][rb][1], acc[nb][rb]); } \
        sc = sc + 16384 >= 49152 ? 0 : sc + 16384; \
        __builtin_amdgcn_sched_barrier(0); } while (0)
#pragma unroll 1
    for (int k4 = 0; k4 < 15; k4 += 3) { RT_STEP(0); RT_STEP(1); RT_STEP(2); }
    { const int k4 = 15; RT_STEP(0); }
#undef RT_STEP
#undef RT_LDY
#undef RT_DMA
    asm volatile("s_waitcnt vmcnt(0)" ::: "memory");
    REND(21); RMARK(22);
    ss0 += __shfl_xor(ss0, 16); ss0 += __shfl_xor(ss0, 32); ss1 += __shfl_xor(ss1, 16); ss1 += __shfl_xor(ss1, 32);
    const float rsA = 1.0f / sqrtf(ss0 * (1.f / DM) + RMS_EPS), rsB = 1.0f / sqrtf(ss1 * (1.f / DM) + RMS_EPS);
#pragma unroll
    for (int nb = 0; nb < 3; ++nb)
#pragma unroll
        for (int rb = 0; rb < 2; ++rb) { const float rs = rb ? rsB : rsA;
            *(LAS f32x4*)(lg + (16 * rb + r16) * 48 + 16 * nb + 4 * g4) = acc[nb][rb] * rs; }
    if (g4 == 0) { rs3[row0 + r16] = rsA; rs3[row0 + 16 + r16] = rsB; }
    LDS_WAIT(); asm volatile("" ::: "memory");
    if (lane < 32) {
        const LAS float* L = lg + lane * 48; const int rl = 32 * w + lane; const size_t m = row0 + lane;
        float l4[4];
#pragma unroll
        for (int j = 0; j < 4; ++j) l4[j] = L[j] + brl[j];
        int gi = 0; float lm = l4[0];
#pragma unroll
        for (int j = 1; j < 4; ++j) if (l4[j] > lm) { lm = l4[j]; gi = j; }
        const float ptop = 1.0f / (__expf(l4[0] - lm) + __expf(l4[1] - lm) + __expf(l4[2] - lm) + __expf(l4[3] - lm));
        float le[8];
#pragma unroll
        for (int j = 0; j < 8; ++j) le[j] = L[16 + gi * 8 + j] + brl[4 + gi * 8 + j];
        int e0 = 0; float m0 = le[0];
#pragma unroll
        for (int j = 1; j < 8; ++j) if (le[j] > m0) { m0 = le[j]; e0 = j; }
        int e1 = -1; float m1 = -3.0e38f;
#pragma unroll
        for (int j = 0; j < 8; ++j) if (j != e0 && le[j] > m1) { m1 = le[j]; e1 = j; }
        const float t = __expf(m1 - m0), w0 = ptop / (1.0f + t), w1 = ptop * t / (1.0f + t);
        tokE[2 * rl] = gi * 8 + e0; tokE[2 * rl + 1] = gi * 8 + e1;
        tok[m * 8 + 4] = __float_as_uint(w0); tok[m * 8 + 5] = __float_as_uint(w1);
    }
    __syncthreads();
    REND(22); RMARK(23);
    {
        const int myE = tokE[tid]; int myR = 0;
        for (int e = 0; e < 32; ++e) { const unsigned long long mk = __ballot(myE == e); if (myE == e) myR = __popcll(mk & ((1ull << lane) - 1ull)); if (lane == 0) wcnt[w * 32 + e] = __popcll(mk); }
        __syncthreads();
        int add = 0;
        for (int ww = 0; ww < w; ++ww) add += wcnt[ww * 32 + myE];
        tokR[tid] = myR + add;
        if (tid < 32) { int tot = 0; for (int ww = 0; ww < 8; ++ww) tot += wcnt[ww * 32 + tid]; base[tid] = (int)__hip_atomic_fetch_add(cnt + tid, (unsigned)tot, __ATOMIC_RELAXED, __HIP_MEMORY_SCOPE_AGENT);
#ifdef ATOM_PROBE
            { const unsigned z_ = __hip_atomic_fetch_add(cnt + tid, 0u, __ATOMIC_RELAXED, __HIP_MEMORY_SCOPE_AGENT); if (z_ == 0xFFFFFFFFu) base[tid] = 0; }
#endif
        }
        __syncthreads();
        REND(23); RMARK(24);
        const int pos = base[myE] + tokR[tid], m = blk * 256 + (tid >> 1);
        ridx[(size_t)myE * NTOK + pos] = m;
        tok[(size_t)m * 8 + (tid & 1) * 2 + 0] = (unsigned)myE; tok[(size_t)m * 8 + (tid & 1) * 2 + 1] = (unsigned)pos;
    }
    __syncthreads();
    REND(24);
}
DI void phase8(Frame& F) {
    for (int blk = F.bid; blk < NTOK / 256; blk += F.G) route_block(F, blk);
}

DI void moe_tables(Frame& F, LAS int*& cum, LAS int*& cntl) {
    cum = (LAS int*)(F.lds + 131072); cntl = cum + 64;
    const unsigned* cnt = (const unsigned*)(F.ws + O_CTL) + CW_CNT;
    if (F.tid < 32) cntl[F.tid] = (int)__hip_atomic_load(cnt + F.tid, __ATOMIC_RELAXED, __HIP_MEMORY_SCOPE_AGENT);
    __syncthreads();
    if (F.tid == 0) { int a = 0; for (int e = 0; e < 32; ++e) { cum[e] = a; a += (cntl[e] + 255) >> 8; } cum[32] = a; }
    __syncthreads();
}

DI LAS int* moe_units(Frame& F, const LAS int* cum, const LAS int* cntl, int c) {
    LAS int* ut = (LAS int*)(F.lds + 131072 + 512);
    if (F.tid < 16) { const int L = F.tid * F.G + c, T = L >> 2; int e = -1, nv = 0, ro = 0;
        if (T < cum[32]) { e = 0; for (int k = 1; k < 32; ++k) e += (cum[k] <= T) ? 1 : 0;
            const int mt = T - cum[e]; nv = min(256, cntl[e] - mt * 256); ro = e * NTOK + mt * 256; }
        ut[4 * F.tid + 0] = e; ut[4 * F.tid + 1] = T; ut[4 * F.tid + 2] = nv; ut[4 * F.tid + 3] = ro; }
    __syncthreads();
    return ut;
}

DI void phase11(Frame& F) {
    LAS int* cum; LAS int* cntl; moe_tables(F, cum, cntl);
    const int gw = F.bid * NWAVES + F.wave, NGW = F.G * NWAVES, lane = F.lane;
    const unsigned* tok = (const unsigned*)(F.ws + O_TOK); const uchar* YD = F.ws + O_YD;
    f32x4 gfin[4];
#pragma unroll
    for (int j = 0; j < 4; ++j) gfin[j] = ((const f32x4*)INP(I_GFINAL))[lane + 64 * j];
    for (int m0 = gw; m0 < NTOK; m0 += 4 * NGW) {
        u32x4 ti[4]; unsigned tw0[4], tw1[4];
#pragma unroll
        for (int q = 0; q < 4; ++q) { const int m = m0 + q * NGW; ti[q] = *(const GAS u32x4*)(tok + (size_t)m * 8); tw0[q] = tok[(size_t)m * 8 + 4]; tw1[q] = tok[(size_t)m * 8 + 5]; }
        u32x2 xv[4][4]; unsigned ya[4][4], yb[4][4];
#pragma unroll
        for (int q = 0; q < 4; ++q) { const int m = m0 + q * NGW;
            const size_t s0 = (size_t)cum[ti[q].x] * 256 + ti[q].y, s1 = (size_t)cum[ti[q].z] * 256 + ti[q].w;
            const u32x2* xr = (const u32x2*)((const bf16*)(F.ws + O_XB) + (size_t)m * DM) + lane;
            const GAS unsigned* y0 = (const GAS unsigned*)(YD + s0 * DM) + lane; const GAS unsigned* y1 = (const GAS unsigned*)(YD + s1 * DM) + lane;
#pragma unroll
            for (int j = 0; j < 4; ++j) { xv[q][j] = xr[64 * j]; ya[q][j] = y0[64 * j]; yb[q][j] = y1[64 * j]; } }
#pragma unroll
        for (int q = 0; q < 4; ++q) { const int m = m0 + q * NGW;
            const float w0 = __uint_as_float(tw0[q]) * 0.03125f, w1 = __uint_as_float(tw1[q]) * 0.03125f;
            f32x4* xr = (f32x4*)(F.out + (size_t)m * DM) + lane;
            f32x4 v[4]; float s = 0.f;
#pragma unroll
            for (int j = 0; j < 4; ++j) { const f32x2 a0 = __builtin_amdgcn_cvt_pk_f32_fp8(ya[q][j], false), a1 = __builtin_amdgcn_cvt_pk_f32_fp8(ya[q][j], true), b0 = __builtin_amdgcn_cvt_pk_f32_fp8(yb[q][j], false), b1 = __builtin_amdgcn_cvt_pk_f32_fp8(yb[q][j], true);
                f32x4 mo; mo.x = w0 * a0.x + w1 * b0.x; mo.y = w0 * a0.y + w1 * b0.y; mo.z = w0 * a1.x + w1 * b1.x; mo.w = w0 * a1.y + w1 * b1.y;
                v[j] = (f32x4){bflo(xv[q][j].x), bfhi(xv[q][j].x), bflo(xv[q][j].y), bfhi(xv[q][j].y)} + mo; s += (v[j].x * v[j].x + v[j].y * v[j].y) + (v[j].z * v[j].z + v[j].w * v[j].w); }
            const float rs = 1.0f / sqrtf(wave_sum(s) * (1.f / DM) + RMS_EPS);
#pragma unroll
            for (int j = 0; j < 4; ++j) xr[64 * j] = v[j] * rs * gfin[j]; }
    }
}
typedef GAS unsigned gu32;
#define RLX_AGENT __ATOMIC_RELAXED, __HIP_MEMORY_SCOPE_AGENT
#define XB_TMO      128
#define XB_XCNT(j)  (256  + 64 * (j))
#define XB_XSUB(j)  (1280 + 64 * (j))
#define XB_XGEN(j)  (2304 + 64 * (j))
#define XB_TOP      3328
#define XB_TOPGEN   3392
#define XCD_BAR_WORDS 3456
#define XB_SPIN_CAP (1u << 18)

__device__ __forceinline__ unsigned xb_ld(unsigned* p)              { return __hip_atomic_load(p, __ATOMIC_RELAXED, __HIP_MEMORY_SCOPE_AGENT); }
__device__ __forceinline__ unsigned xb_add(unsigned* p, unsigned v) { return __hip_atomic_fetch_add(p, v, __ATOMIC_RELAXED, __HIP_MEMORY_SCOPE_AGENT); }
__device__ __forceinline__ unsigned xb_xcc_id() { return (unsigned)__builtin_amdgcn_s_getreg((3 << 11) | 20) & 0xFu; }
#define XB_SPIN(cond, bar) do { unsigned _sp = 0; while (cond) { __builtin_amdgcn_s_sleep(1); \
    if ((++_sp & 255u) == 0u) { if (xb_ld(&(bar)[XB_TMO])) break; if (_sp > XB_SPIN_CAP) { atomicAdd(&(bar)[XB_TMO], 1u); break; } } } } while (0)

struct XcdBarrier {
    unsigned* bar; unsigned x;
    volatile LAS unsigned* st;
};

__device__ __forceinline__ XcdBarrier xcd_barrier_post(unsigned* bar, volatile LAS unsigned* st) {
    XcdBarrier b; b.bar = bar; b.x = xb_xcc_id(); b.st = st;
    if (threadIdx.x == 0) (void)xb_add(&bar[XB_XCNT(b.x)], 1u);
    return b;
}
__device__ __forceinline__ void xcd_barrier_complete(unsigned* bar, unsigned x, unsigned& nloc, unsigned& nx) {
    const unsigned G = gridDim.x * gridDim.y * gridDim.z;
    unsigned sum, cnt, mine, sp = 0u;
    for (;;) {
        sum = 0u; cnt = 0u; mine = 0u;
#pragma unroll
        for (unsigned j = 0; j < 16; ++j) { const unsigned c = xb_ld(&bar[XB_XCNT(j)]); sum += c; cnt += (c > 0u) ? 1u : 0u; mine = (j == x) ? c : mine; }
        if (sum == G) break;
        __builtin_amdgcn_s_sleep(1);
        if ((++sp & 255u) == 0u) { if (xb_ld(&bar[XB_TMO])) break; if (sp > XB_SPIN_CAP) { atomicAdd(&bar[XB_TMO], 1u); break; } }
    }
    nloc = mine > 0u ? mine : 1u; nx = cnt > 0u ? cnt : 1u;
}

__device__ __forceinline__ void xcd_barrier(const XcdBarrier& b) {
    asm volatile("s_waitcnt vmcnt(0)" ::: "memory");
    __syncthreads();
    if (threadIdx.x == 0) {
        unsigned* bar = b.bar;
        __builtin_amdgcn_s_waitcnt(0);
        unsigned nloc = b.st[0], nx = b.st[1];
        if (nloc == 0u) { xcd_barrier_complete(bar, b.x, nloc, nx); b.st[0] = nloc; b.st[1] = nx; }
        const unsigned old = xb_add(&bar[XB_XSUB(b.x)], 1u);
        const unsigned gen = old / nloc;
        if (old + 1u == (gen + 1u) * nloc) {
            __builtin_amdgcn_fence(__ATOMIC_RELEASE, "agent");
            asm volatile("s_waitcnt vmcnt(0)" ::: "memory");
            const unsigned og = xb_add(&bar[XB_TOP], 1u);
            const unsigned tg = og / nx;
            if (og + 1u == (tg + 1u) * nx) xb_add(&bar[XB_TOPGEN], 1u);
            else XB_SPIN(xb_ld(&bar[XB_TOPGEN]) == tg, bar);
            __builtin_amdgcn_fence(__ATOMIC_ACQUIRE, "agent");
            xb_add(&bar[XB_XGEN(b.x)], 1u);
            asm volatile("s_waitcnt vmcnt(0)" ::: "memory");
        } else {
            XB_SPIN(xb_ld(&bar[XB_XGEN(b.x)]) == gen, bar);
            __builtin_amdgcn_fence(__ATOMIC_ACQUIRE, "agent");
            asm volatile("s_waitcnt vmcnt(0)" ::: "memory");
        }
    }
    __syncthreads();
}

#ifndef MK_N_LAUNCHES
#define MK_N_LAUNCHES 1
#endif
constexpr int N_PHASES = 12;

__global__ void __launch_bounds__(NTHR, 2) hybrid_fwd(Args args) {
    extern __shared__ __attribute__((aligned(16))) uchar lds_raw[];
    Frame F;
    F.lds = (LAS uchar*)lds_raw;
    F.tid = threadIdx.x; F.lane = F.tid & 63; F.wave = __builtin_amdgcn_readfirstlane(F.tid >> 6);
    F.G = gridDim.x; F.bid = blockIdx.x;
    F.in = args.in;
    F.out = (float*)args.out; F.ws = (uchar*)args.ws;
    uchar* ws = (uchar*)args.ws;
    const int lo = args.ph_lo, hi = args.ph_hi;
    volatile LAS unsigned* MISC = (volatile LAS unsigned*)(F.lds + LDS_BYTES - 256);
    if (F.tid < 64) MISC[F.tid] = 0u;
    __syncthreads();
    XcdBarrier bar; bar.bar = (unsigned*)((uchar*)args.ws + O_CTL) + CW_BAR; bar.x = 0; bar.st = MISC + 8;
    if (hi - lo > 1) bar = xcd_barrier_post((unsigned*)((uchar*)args.ws + O_CTL) + CW_BAR, MISC + 8);
#ifndef PHASE_MASK
#define PHASE_MASK 0xFFF
#endif
#ifndef DOUBLE_MASK
#define DOUBLE_MASK 0
#endif
#define IN(k) (((PHASE_MASK >> (k)) & 1) && lo <= (k) && (k) < hi)
#define REP(k) for (int rep_ = 0; rep_ < 1 + ((DOUBLE_MASK >> (k)) & 1); ++rep_)
#if defined(__HIP_DEVICE_COMPILE__)
#define ASSUME_GLOBAL(p) __builtin_assume(!__builtin_amdgcn_is_shared((const void*)(p)) && !__builtin_amdgcn_is_private((const void*)(p)))
#else
#define ASSUME_GLOBAL(p) ((void)0)
#endif
#define OPQ() do { GASK uchar* w_ = args.ws; GASK float* o_ = args.out; asm volatile("" : "+s"(w_), "+s"(o_)); ws = (uchar*)w_; F.ws = ws; F.out = (float*)o_; } while (0)
#define SEAM(k) do { OPQ(); if (lo <= (k) && (k) + 1 < hi) { xcd_barrier(bar); } } while (0)
    using pg8::Gemm; using pg8::StaticOrder; using pg8::gemm_phase;
#ifndef TSEL
#define TSEL (-1)
#endif
    unsigned long long tq0 = 0, tq1 = 0;
#ifdef TPROBE
#define TQ0(k) do { if ((k) == TSEL) { if (F.tid == 0) { *(volatile LAS unsigned long long*)(F.lds + LDS_BYTES - 256 + 128) = 0ull; *(volatile LAS unsigned long long*)(F.lds + LDS_BYTES - 256 + 136) = 0ull; } } } while (0)
#define TQ1(k) do { if ((k) == TSEL) { tq0 = 0; tq1 = *(volatile LAS unsigned long long*)(F.lds + LDS_BYTES - 256 + 128); } } while (0)
#else
#define TQ0(k) do { if ((k) == TSEL) tq0 = __builtin_amdgcn_s_memrealtime(); } while (0)
#define TQ1(k) do { if ((k) == TSEL) tq1 = __builtin_amdgcn_s_memrealtime(); } while (0)
#endif

    TQ0(0);
    if (IN(0)) REP(0) phase0(F);
    SEAM(0); TQ1(0);
    TQ0(1);
    if (IN(1)) REP(1) {
        { Gemm g{(const bf16*)(ws + O_XB), (const bf16*)(ws + O_WIN), NTOK, ZC, DM}; StaticOrder S; S.init(NTOK, ZC, F.G, F.bid, 4);
          EpiRowScale<0> E{(bf16*)(ws + O_Z), ZG, (const float*)(ws + O_RS0), 1.0f};
          gemm_phase<EpiRowScale<0>, StaticOrder, true, true, false>(F.lds, g, S, E); }
        { Gemm g{(const bf16*)(ws + O_MEMB), (const bf16*)(ws + O_WKV), NMROWS, 2048, DM, SC_ONE, SC_W}; StaticOrder S; S.init(NMROWS, 2048, F.G, F.bid);
          EpiRowScale<1> E{(bf16*)(ws + O_KV), 2048, (const float*)(ws + O_RSM), 1.0f};
          gemm_phase<EpiRowScale<1>, StaticOrder, true, true, false, true>(F.lds, g, S, E); }
    }
    SEAM(1); TQ1(1);
    TQ0(2);
    if (IN(2)) REP(2) phase2(F);
    SEAM(2); TQ1(2);
    TQ0(3);
    if (IN(3)) REP(3) mlstm_out_phase(F);
    SEAM(3); TQ1(3);
    TQ0(4);
    if (IN(4)) REP(4) {
        Gemm g{(const bf16*)(ws + O_Y), (const bf16*)(ws + O_WOUT), NTOK, DM, DM}; StaticOrder S; S.init(NTOK, DM, F.G, F.bid);
        EpiRes<true, true, true> E{nullptr, (bf16*)(ws + O_XB), (float*)(ws + O_SS1), ws + O_X1F8};
        gemm_phase<EpiRes<true, true, true>, StaticOrder, true, true, false>(F.lds, g, S, E);
    }
    SEAM(4); TQ1(4);
    const bool own78 = (F.G == NTOK / 256);
    TQ0(5);
    if (IN(5) && own78) {
        Gemm g{(const bf16*)(ws + O_X1F8), (const bf16*)(ws + O_WQ), NTOK, DM, DM, SC_ONE, SC_W}; PanelOrder S{F.bid};
        EpiQ E{(bf16*)(ws + O_Q), (const float*)(ws + O_SS1), 0.0625f};
        gemm_phase<EpiQ, PanelOrder, true, true, false, true>(F.lds, g, S, E);
    }
    if (IN(5) && !own78) {
        Gemm g{(const bf16*)(ws + O_X1F8), (const bf16*)(ws + O_WQ), NTOK, DM, DM, SC_ONE, SC_W}; StaticOrder S; S.init(NTOK, DM, F.G, F.bid);
        EpiQ E{(bf16*)(ws + O_Q), (const float*)(ws + O_SS1), 0.0625f};
        gemm_phase<EpiQ, StaticOrder, true, true, false, true>(F.lds, g, S, E);
    }
    if (own78) { OPQ(); } else { SEAM(5); }
    TQ1(5);
    TQ0(6);
    if (IN(6) && own78) { const int pm = F.bid; attn_phase(F, (pm >> 4) * 64 + (pm & 15), 16, (pm >> 4) * 64 + 64); asm volatile("s_waitcnt vmcnt(0)" ::: "memory"); __syncthreads(); }
    if (IN(6) && !own78) attn_phase(F, F.bid, F.G, NB * 4 * 16);
    if (own78) { OPQ(); } else { SEAM(6); }
    TQ1(6);
#ifndef FUSE_78
#define FUSE_78 1
#endif
#if FUSE_78
    TQ0(7);
    if (IN(7) && IN(8) && own78) {
        const int pm = F.bid;
        Gemm g{(const bf16*)(ws + O_O), (const bf16*)(ws + O_WO), NTOK, DM, DM, SC_ONE, SC_W}; PanelOrder S{pm};
        EpiRes<true, false, false> E{nullptr, (bf16*)(ws + O_XB), nullptr, nullptr};
        gemm_phase<EpiRes<true, false, false>, PanelOrder, true, true, false, true>(F.lds, g, S, E);
        OPQ();
        route_block(F, pm);
    }
    if (IN(7) && !own78) {
        Gemm g{(const bf16*)(ws + O_O), (const bf16*)(ws + O_WO), NTOK, DM, DM, SC_ONE, SC_W}; StaticOrder S; S.init(NTOK, DM, F.G, F.bid);
        EpiRes<true, false, false> E{nullptr, (bf16*)(ws + O_XB), nullptr, nullptr};
        gemm_phase<EpiRes<true, false, false>, StaticOrder, true, true, false, true>(F.lds, g, S, E);
    }
    if (!own78) { SEAM(7); }
    if (IN(8) && !own78) phase8(F);
    TQ1(7);
#else
    TQ0(7);
    if (IN(7)) REP(7) {
        Gemm g{(const bf16*)(ws + O_O), (const bf16*)(ws + O_WO), NTOK, DM, DM, SC_ONE, SC_W}; StaticOrder S; S.init(NTOK, DM, F.G, F.bid);
        EpiRes<true, false, false> E{nullptr, (bf16*)(ws + O_XB), nullptr, nullptr};
#if defined(KREP_PROBE) && KREP_PROBE == 7
        g.krep = 2; g.scale_a = 0x7E7E7E7E;
#endif
        gemm_phase<EpiRes<true, false, false>, StaticOrder, true, true, false, true>(F.lds, g, S, E);
    }
    SEAM(7); TQ1(7);
    TQ0(8);
    if (IN(8)) REP(8) phase8(F);
#endif
    SEAM(8); TQ1(8);
    TQ0(9);
    if (IN(9)) REP(9) {
        LAS int* cum; LAS int* cntl; moe_tables(F, cum, cntl);
        const int vb = xcd_major(F.bid, F.G);
        MoeOrder S{moe_units(F, cum, cntl, vb), (const int*)(ws + O_RIDX), F.G, vb, false};
        Gemm g{(const bf16*)(ws + O_X2F8), (const bf16*)(ws + O_WGU8), NTOK, NEXP * 1024, DM, SC_ONE, SC_W};
        EpiGU E{(bf16*)(ws + O_H), (const float*)(ws + O_RS3)};
#if defined(KREP_PROBE) && KREP_PROBE == 9
        g.krep = 2; g.scale_a = 0x7E7E7E7E;
#endif
        gemm_phase<EpiGU, MoeOrder, true, true, true, true>(F.lds, g, S, E);
    }
    SEAM(9); TQ1(9);
    TQ0(10);
    if (IN(10)) REP(10) {
        LAS int* cum; LAS int* cntl; moe_tables(F, cum, cntl);
        const int vb = xcd_major(F.bid, F.G);
        MoeOrder S{moe_units(F, cum, cntl, vb), (const int*)(ws + O_RIDX), F.G, vb, true};
        Gemm g{(const bf16*)(ws + O_H), (const bf16*)(ws + O_WD8), MAXSLOTS, NEXP * 1024, DEXP, SC_X32, SC_W};
        EpiPlain8 E{ws + O_YD, DM};
#if defined(KREP_PROBE) && KREP_PROBE == 10
        g.krep = 2; g.scale_a = 0x83838383;
#endif
        gemm_phase<EpiPlain8, MoeOrder, true, true, false, true>(F.lds, g, S, E);
    }
    SEAM(10); TQ1(10);
    TQ0(11);
    if (IN(11)) REP(11) phase11(F);
    TQ1(11);
    if (TSEL >= 0 && F.bid == 0 && F.tid == 0) { const unsigned long long tgt = __builtin_amdgcn_s_memrealtime() + 4ull * (tq1 - tq0); while (__builtin_amdgcn_s_memrealtime() < tgt) __builtin_amdgcn_s_sleep(16); }
#undef IN
#undef SEAM
}

extern "C" void kernel_launch(void* const* d_in, const int* in_sizes, int n_in, void* d_out, int out_size, void* d_ws, size_t ws_size, hipStream_t stream) {
    static int grid = 0;
    if (grid == 0) {
        if (n_in != 27 || in_sizes[0] != NTOK * DM || out_size != NTOK * DM || ws_size < WS_NEED) { fprintf(stderr, "kernel_launch: unexpected shapes (n_in %d, in0 %d, out %d, ws %zu); nothing launched\n", n_in, n_in > 0 ? in_sizes[0] : -1, out_size, ws_size); grid = -1; return; }
        int dev = 0, cus = 0, per_cu = 0;
        if (hipGetDevice(&dev) != hipSuccess || hipDeviceGetAttribute(&cus, hipDeviceAttributeMultiprocessorCount, dev) != hipSuccess) { fprintf(stderr, "kernel_launch: device query failed\n"); grid = -1; return; }
        if (hipFuncSetAttribute((const void*)hybrid_fwd, hipFuncAttributeMaxDynamicSharedMemorySize, LDS_BYTES) != hipSuccess) { fprintf(stderr, "kernel_launch: hipFuncSetAttribute failed\n"); grid = -1; return; }
        if (hipOccupancyMaxActiveBlocksPerMultiprocessor(&per_cu, (const void*)hybrid_fwd, NTHR, LDS_BYTES) != hipSuccess || per_cu < 1) { fprintf(stderr, "kernel_launch: occupancy query says %d\n", per_cu); per_cu = 1; }
        (void)hipGetLastError();
        grid = cus * per_cu;
        if (grid > 256) grid = 256;
    }
    if (grid < 0) return;
    (void)hipMemsetAsync((char*)d_ws + O_CTL, 0, CTL_BYTES, stream);
    Args a{};
    for (int i = 0; i < 27; ++i) a.in[i] = (const GASK float*)d_in[i];
    a.out = (GASK float*)d_out; a.ws = (GASK uchar*)d_ws;
#if MK_N_LAUNCHES == 1
    a.ph_lo = 0; a.ph_hi = N_PHASES;
    hipLaunchKernelGGL(hybrid_fwd, dim3(grid), dim3(NTHR), LDS_BYTES, stream, a);
#else
    for (int p = 0; p < N_PHASES; ++p) { a.ph_lo = p; a.ph_hi = p + 1; hipLaunchKernelGGL(hybrid_fwd, dim3(grid), dim3(NTHR), LDS_BYTES, stream, a); }
#endif
}
```
